# Optimizing an MI355X kernel written in HIP

```python
import math
import jax, jax.numpy as jnp
from jax import lax
import numpy as np

D_MODEL = 1024
BATCH = 8
SEQ = 2048
DEPTH = 1
DEC_BATCH = 128
DEC_SEQ = 4
PAST_LEN = 2048
PAGE_SIZE = 128

NSA_HEADS = 8
NSA_KV = 2
NSA_HD = 64
NSA_REP = NSA_HEADS // NSA_KV
CMP_LEN = 32
CMP_STRIDE = 16
CMP_HID = 64
SEL_BLOCK = 64
SEL_TOPN = 8
WINDOW = 512
Q_BLOCK = 128
HG_HEADS = 4
HG_DK = 128
HG_DV = 128
HG_CHUNK = 64
N_BUCKETS = 32
MAX_DIST = 128
EPS = 1e-6
NEG = -1e30
FORCED = 1e9

A_WIDTH = NSA_HEADS * NSA_HD
A_KV = NSA_KV * NSA_HD
B_WIDTH = HG_HEADS * HG_DV
B_KEY = HG_HEADS * HG_DK
SPLIT_SIZES = (A_WIDTH, 6 * A_KV, 3 * NSA_HEADS, A_WIDTH, B_KEY, B_KEY, B_WIDTH, B_WIDTH, D_MODEL, D_MODEL)
IN_COLS = sum(SPLIT_SIZES)

kernel_name = 'nsa_hgrn2_gated_hybrid_step'


def rmsnorm(x, g):
    x32 = x.astype(jnp.float32)
    return x32 * lax.rsqrt(jnp.mean(x32 * x32, axis=-1, keepdims=True) + EPS) * g.astype(jnp.float32)


def t5_bucket(rel):
    n = jnp.maximum(rel, 0)
    exact = N_BUCKETS // 2
    nf = jnp.maximum(n, 1).astype(jnp.float32)
    large = exact + (jnp.log(nf / exact) / math.log(MAX_DIST / exact) * (N_BUCKETS - exact)).astype(jnp.int32)
    large = jnp.minimum(large, N_BUCKETS - 1)
    return jnp.where(n < exact, n, large)


def masked_softmax(s, mask):
    s = jnp.where(mask, s.astype(jnp.float32), NEG)
    p = jax.nn.softmax(s, axis=-1)
    return jnp.where(mask, p, 0.0)


def compress(kv, pos, w1, w2):
    B, L = kv.shape[:2]
    nc = (L - CMP_LEN) // CMP_STRIDE + 1
    idx = np.arange(nc)[:, None] * CMP_STRIDE + np.arange(CMP_LEN)[None, :]
    blk = kv[:, idx] + pos[:, None, :]
    blk = jnp.swapaxes(blk, 2, 3).reshape(B, nc, NSA_KV, CMP_LEN * NSA_HD)
    out = jax.nn.silu(blk @ w1) @ w2
    end = jnp.asarray(np.arange(nc) * CMP_STRIDE + CMP_LEN - 1, jnp.int32)
    return out, end


def cover_matrix(nc, nb):
    cs = np.arange(nc) * CMP_STRIDE
    ce = cs + CMP_LEN
    bs = np.arange(nb) * SEL_BLOCK
    be = bs + SEL_BLOCK
    ov = np.clip(np.minimum(ce[:, None], be[None, :]) - np.maximum(cs[:, None], bs[None, :]), 0, None) / CMP_STRIDE
    return jnp.asarray(ov, jnp.float32)


def nsa_context(kc, vc, ks, vs, pos_k, w1_k, w2_k, pos_v, w1_v, w2_v):
    B, L = kc.shape[:2]
    k_cmp, cend = compress(kc, pos_k, w1_k, w2_k)
    v_cmp, _ = compress(vc, pos_v, w1_v, w2_v)
    pad = (-L) % SEL_BLOCK
    nb = (L + pad) // SEL_BLOCK
    padw = ((0, 0), (0, pad), (0, 0), (0, 0))
    ks_blk = jnp.pad(ks, padw).reshape(B, nb, SEL_BLOCK, NSA_KV, NSA_HD)
    vs_blk = jnp.pad(vs, padw).reshape(B, nb, SEL_BLOCK, NSA_KV, NSA_HD)
    return (k_cmp, v_cmp, cend, cover_matrix(k_cmp.shape[1], nb), ks_blk, vs_blk)


def nsa_attend(q, gates, qpos, kc, vc, cmp_end, cover, ks_blk, vs_blk, kw, vw, kwpos, rel_bias):
    B, T = q.shape[:2]
    qg = q.reshape(B, T, NSA_KV, NSA_REP, NSA_HD).transpose(0, 2, 3, 1, 4) * (NSA_HD ** -0.5)
    table = rel_bias.T.reshape(NSA_KV, NSA_REP, N_BUCKETS)
    sc = jnp.einsum('bgrtd,bngd->bgrtn', qg, kc) + table[:, :, t5_bucket(qpos[:, None] - cmp_end[None, :])]
    pc = masked_softmax(sc, cmp_end[None, :] <= qpos[:, None])
    o_cmp = jnp.einsum('bgrtn,bngd->bgrtd', pc, vc)
    imp = jnp.einsum('bgrtn,nj->bgtj', pc, cover)
    nb = ks_blk.shape[1]
    j = jnp.arange(nb)[None, :]
    cur = (qpos // SEL_BLOCK)[:, None]
    valid = j * SEL_BLOCK <= qpos[:, None]
    forced = (j == 0) | (j == cur) | (j == cur - 1)
    score = jnp.where(valid, jnp.where(forced, FORCED, imp), -1.0)
    _, idx = lax.top_k(score, min(SEL_TOPN, nb))
    n_sel = idx.shape[-1]
    sel_ok = idx * SEL_BLOCK <= qpos[None, None, :, None]
    b_ix = jnp.arange(B)[:, None, None, None]
    g_ix = jnp.arange(NSA_KV)[None, :, None, None]
    ksg = ks_blk.transpose(0, 3, 1, 2, 4)[b_ix, g_ix, idx]
    vsg = vs_blk.transpose(0, 3, 1, 2, 4)[b_ix, g_ix, idx]
    kpos = idx[..., None] * SEL_BLOCK + jnp.arange(SEL_BLOCK)
    ms = (kpos <= qpos[None, None, :, None, None]) & sel_ok[..., None]
    bk = t5_bucket(qpos[None, None, :, None, None] - kpos)
    bias_s = table[jnp.arange(NSA_KV).reshape(1, NSA_KV, 1, 1, 1, 1),
                   jnp.arange(NSA_REP).reshape(1, 1, NSA_REP, 1, 1, 1), bk[:, :, None]]
    ss = jnp.einsum('bgrtd,bgtnsd->bgrtns', qg, ksg) + bias_s
    nk = n_sel * SEL_BLOCK
    ps = masked_softmax(ss.reshape(B, NSA_KV, NSA_REP, T, nk), ms.reshape(B, NSA_KV, 1, T, nk))
    o_sel = jnp.einsum('bgrtk,bgtkd->bgrtd', ps, vsg.reshape(B, NSA_KV, T, nk, NSA_HD))
    rel_w = qpos[:, None] - kwpos[None, :]
    mw = (rel_w >= 0) & (rel_w < WINDOW) & (kwpos[None, :] >= 0)
    sw = jnp.einsum('bgrtd,blgd->bgrtl', qg, kw) + table[:, :, t5_bucket(rel_w)]
    o_win = jnp.einsum('bgrtl,blgd->bgrtd', masked_softmax(sw, mw), vw)
    g = jax.nn.sigmoid(gates.astype(jnp.float32)).reshape(B, T, 3, NSA_KV, NSA_REP).transpose(2, 0, 3, 4, 1)[..., None]
    o = g[0] * o_cmp + g[1] * o_sel + g[2] * o_win
    return o.transpose(0, 3, 1, 2, 4).reshape(B, T, A_WIDTH)


def hgrn2_scan(q, k, v, g, S0):
    B, T, H, _ = q.shape
    C = math.gcd(T, HG_CHUNK)
    nC = T // C
    def to_chunks(a):
        return a.reshape(B, nC, C, H, a.shape[-1]).transpose(1, 0, 3, 2, 4)
    tri = jnp.tril(jnp.ones((C, C), bool))[:, :, None]
    def step(S, xs):
        qc, kc, vc, gc = xs
        G = jnp.cumsum(gc, axis=2)
        o_inter = jnp.einsum('bhtd,bhde->bhte', qc * jnp.exp(G), S)
        D = jnp.where(tri, G[:, :, :, None, :] - G[:, :, None, :, :], -jnp.inf)
        A = jnp.einsum('bhtd,bhtsd,bhsd->bhts', qc, jnp.exp(D), kc)
        o = o_inter + jnp.einsum('bhts,bhse->bhte', A, vc)
        Gl = G[:, :, -1, :]
        S = jnp.exp(Gl)[..., None] * S + jnp.einsum('bhsd,bhse->bhde', kc * jnp.exp(Gl[:, :, None, :] - G), vc)
        return S, o
    S, o = lax.scan(step, S0, (to_chunks(q), to_chunks(k), to_chunks(v), to_chunks(g)))
    return o.transpose(1, 0, 3, 2, 4).reshape(B, T, H, -1), S


def hgrn2_branch(qB, fB, iB, zB, S0, lb, norm_g):
    B, T, _ = qB.shape
    shp = (B, T, HG_HEADS, HG_DK)
    lbh = lb.reshape(HG_HEADS, HG_DK)
    f = lbh + (1.0 - lbh) * jax.nn.sigmoid(fB.astype(jnp.float32).reshape(shp))
    o, S = hgrn2_scan(qB.astype(jnp.float32).reshape(shp), 1.0 - f,
                      iB.astype(jnp.float32).reshape(B, T, HG_HEADS, HG_DV), jnp.log(f), S0)
    o = o * lax.rsqrt(jnp.mean(o * o, axis=-1, keepdims=True) + EPS)
    return o.reshape(B, T, B_WIDTH) * norm_g * jax.nn.silu(zB), S


def project_inputs(x, norm_g, w_in):
    offs = np.cumsum(SPLIT_SIZES)[:-1].tolist()
    return jnp.split(rmsnorm(x, norm_g) @ w_in, offs, axis=-1)


def merge_out(x, oA, oB, mA, mB, w_ba, w_bb, w_out):
    y = jax.nn.sigmoid(mA) * (oA @ w_ba) + jax.nn.sigmoid(mB) * (oB @ w_bb)
    return x + y @ w_out


def layer_prompt(x, norm_g, w_in, pos_k, w1_k, w2_k, pos_v, w1_v, w2_v, rel_bias, lb, hg_norm_g, w_ba, w_bb, w_out):
    B, T, _ = x.shape
    qA, kvA, gA, zA, qB, fB, iB, zB, mA, mB = project_inputs(x, norm_g, w_in)
    q = qA.reshape(B, T, NSA_HEADS, NSA_HD)
    kc, vc, ks, vs, kw, vw = [a.reshape(B, T, NSA_KV, NSA_HD) for a in jnp.split(kvA, 6, axis=-1)]
    ctx = nsa_context(kc, vc, ks, vs, pos_k, w1_k, w2_k, pos_v, w1_v, w2_v)
    padw = ((0, 0), (WINDOW, 0), (0, 0), (0, 0))
    kw_pad = jnp.pad(kw, padw)
    vw_pad = jnp.pad(vw, padw)
    nq = T // Q_BLOCK
    qb = jnp.swapaxes(q.reshape(B, nq, Q_BLOCK, NSA_HEADS, NSA_HD), 0, 1)
    gb = jnp.swapaxes(gA.reshape(B, nq, Q_BLOCK, 3 * NSA_HEADS), 0, 1)
    def one_block(args):
        q_i, g_i, b = args
        start = b * Q_BLOCK
        qpos = start + jnp.arange(Q_BLOCK)
        kwb = lax.dynamic_slice_in_dim(kw_pad, start, WINDOW + Q_BLOCK, axis=1)
        vwb = lax.dynamic_slice_in_dim(vw_pad, start, WINDOW + Q_BLOCK, axis=1)
        kwpos = start - WINDOW + jnp.arange(WINDOW + Q_BLOCK)
        return nsa_attend(q_i, g_i, qpos, *ctx, kwb, vwb, kwpos, rel_bias)
    oA = lax.map(one_block, (qb, gb, jnp.arange(nq)))
    oA = jnp.swapaxes(oA, 0, 1).reshape(B, T, A_WIDTH) * jax.nn.silu(zA)
    S0 = jnp.zeros((B, HG_HEADS, HG_DK, HG_DV), jnp.float32)
    oB, S = hgrn2_branch(qB, fB, iB, zB, S0, lb, hg_norm_g)
    h = merge_out(x, oA, oB, mA, mB, w_ba, w_bb, w_out)
    wb = min(WINDOW, T)
    return h, (kc, vc, ks, vs, kw[:, T - wb:], vw[:, T - wb:], S)


def layer_sample(x, ck, cv, sk, sv, wk, wv, S0, page_table, norm_g, w_in, pos_k, w1_k, w2_k, pos_v, w1_v, w2_v,
                 rel_bias, lb, hg_norm_g, w_ba, w_bb, w_out):
    B, T, _ = x.shape
    qA, kvA, gA, zA, qB, fB, iB, zB, mA, mB = project_inputs(x, norm_g, w_in)
    q = qA.reshape(B, T, NSA_HEADS, NSA_HD)
    kc, vc, ks, vs, kw, vw = [a.reshape(B, T, NSA_KV, NSA_HD) for a in jnp.split(kvA, 6, axis=-1)]
    def with_past(cache, new):
        past = cache[page_table].reshape(B, -1, NSA_KV, NSA_HD)
        return jnp.concatenate([past, new], axis=1)
    ctx = nsa_context(with_past(ck, kc), with_past(cv, vc), with_past(sk, ks), with_past(sv, vs),
                      pos_k, w1_k, w2_k, pos_v, w1_v, w2_v)
    wb = wk.shape[1]
    kw_all = jnp.concatenate([wk, kw], axis=1)
    vw_all = jnp.concatenate([wv, vw], axis=1)
    kwpos = PAST_LEN - wb + jnp.arange(wb + T)
    qpos = PAST_LEN + jnp.arange(T)
    oA = nsa_attend(q, gA, qpos, *ctx, kw_all, vw_all, kwpos, rel_bias) * jax.nn.silu(zA)
    oB, S = hgrn2_branch(qB, fB, iB, zB, S0.astype(jnp.float32), lb, hg_norm_g)
    h = merge_out(x, oA, oB, mA, mB, w_ba, w_bb, w_out)
    return h, (kc, vc, ks, vs, kw_all[:, T:], vw_all[:, T:], S)


def setup_inputs(seed: int = 0) -> dict:
    key = jax.random.key(seed)
    k = jax.random.split(key, 32)
    n_pages = PAST_LEN // PAGE_SIZE
    n_pool = (DEC_BATCH * n_pages * 5) // 4
    win_buf = min(WINDOW, PAST_LEN)
    def nrm(kk, shape, s):
        return jax.random.normal(kk, shape, jnp.float32) * s
    pshape = (DEPTH, n_pool, PAGE_SIZE, NSA_KV, NSA_HD)
    wshape = (DEPTH, DEC_BATCH, win_buf, NSA_KV, NSA_HD)
    page_table = jax.random.permutation(k[9], n_pool)[:DEC_BATCH * n_pages].reshape(DEC_BATCH, n_pages).astype(jnp.int32)
    return {
        'x_prompt': nrm(k[0], (BATCH, SEQ, D_MODEL), 1.0),
        'x_sample': nrm(k[1], (DEC_BATCH, DEC_SEQ, D_MODEL), 1.0),
        'cache_cmp_k': nrm(k[2], pshape, 1.0),
        'cache_cmp_v': nrm(k[3], pshape, 1.0),
        'cache_sel_k': nrm(k[4], pshape, 1.0),
        'cache_sel_v': nrm(k[5], pshape, 1.0),
        'state_win_k': nrm(k[6], wshape, 1.0),
        'state_win_v': nrm(k[7], wshape, 1.0),
        'state_hgrn': nrm(k[8], (DEPTH, DEC_BATCH, HG_HEADS, HG_DK, HG_DV), 1.0),
        'page_table': page_table,
        'norm_g': 1.0 + nrm(k[10], (DEPTH, D_MODEL), 0.02),
        'w_in': nrm(k[11], (DEPTH, D_MODEL, IN_COLS), D_MODEL ** -0.5),
        'cmp_pos_k': nrm(k[12], (DEPTH, CMP_LEN, NSA_HD), 0.5),
        'cmp_w1_k': nrm(k[13], (DEPTH, CMP_LEN * NSA_HD, CMP_HID), (CMP_LEN * NSA_HD) ** -0.5),
        'cmp_w2_k': nrm(k[14], (DEPTH, CMP_HID, NSA_HD), 1.5 * CMP_HID ** -0.5),
        'cmp_pos_v': nrm(k[15], (DEPTH, CMP_LEN, NSA_HD), 0.5),
        'cmp_w1_v': nrm(k[16], (DEPTH, CMP_LEN * NSA_HD, CMP_HID), (CMP_LEN * NSA_HD) ** -0.5),
        'cmp_w2_v': nrm(k[17], (DEPTH, CMP_HID, NSA_HD), 1.5 * CMP_HID ** -0.5),
        'rel_bias': nrm(k[18], (N_BUCKETS, NSA_HEADS), 0.5),
        'hg_lower': nrm(k[19], (DEPTH + 1, B_KEY), 1.0),
        'hg_norm_g': 1.0 + nrm(k[20], (DEPTH, B_WIDTH), 0.02),
        'w_branch_a': nrm(k[21], (DEPTH, A_WIDTH, D_MODEL), A_WIDTH ** -0.5),
        'w_branch_b': nrm(k[22], (DEPTH, B_WIDTH, D_MODEL), B_WIDTH ** -0.5),
        'w_out': nrm(k[23], (DEPTH, D_MODEL, D_MODEL), D_MODEL ** -0.5),
        'final_g': 1.0 + nrm(k[24], (D_MODEL,), 0.02),
    }


def reference(x_prompt, x_sample, cache_cmp_k, cache_cmp_v, cache_sel_k, cache_sel_v, state_win_k, state_win_v,
              state_hgrn, page_table, norm_g, w_in, cmp_pos_k, cmp_w1_k, cmp_w2_k, cmp_pos_v, cmp_w1_v, cmp_w2_v,
              rel_bias, hg_lower, hg_norm_g, w_branch_a, w_branch_b, w_out, final_g):
    lower = jnp.cumsum(jax.nn.softmax(hg_lower.astype(jnp.float32), axis=0), axis=0)
    hp, hs = x_prompt, x_sample
    p_list, s_list = [], []
    for l in range(DEPTH):
        hp, st_p = layer_prompt(hp, norm_g[l], w_in[l], cmp_pos_k[l], cmp_w1_k[l], cmp_w2_k[l], cmp_pos_v[l],
                                cmp_w1_v[l], cmp_w2_v[l], rel_bias, lower[l], hg_norm_g[l],
                                w_branch_a[l], w_branch_b[l], w_out[l])
        hs, st_s = layer_sample(hs, cache_cmp_k[l], cache_cmp_v[l], cache_sel_k[l], cache_sel_v[l],
                                state_win_k[l], state_win_v[l], state_hgrn[l], page_table,
                                norm_g[l], w_in[l], cmp_pos_k[l], cmp_w1_k[l], cmp_w2_k[l], cmp_pos_v[l],
                                cmp_w1_v[l], cmp_w2_v[l], rel_bias, lower[l], hg_norm_g[l],
                                w_branch_a[l], w_branch_b[l], w_out[l])
        p_list.append(st_p)
        s_list.append(st_s)
    p_cmp_k, p_cmp_v, p_sel_k, p_sel_v, p_win_k, p_win_v, p_hgrn = [jnp.stack(s, axis=0) for s in zip(*p_list)]
    s_cmp_k, s_cmp_v, s_sel_k, s_sel_v, s_win_k, s_win_v, s_hgrn = [jnp.stack(s, axis=0) for s in zip(*s_list)]
    y_prompt = rmsnorm(hp, final_g).astype(x_prompt.dtype)
    y_sample = rmsnorm(hs, final_g).astype(x_sample.dtype)
    return (y_prompt, y_sample, p_cmp_k, p_cmp_v, p_sel_k, p_sel_v, p_win_k, p_win_v, p_hgrn,
            s_cmp_k, s_cmp_v, s_sel_k, s_sel_v, s_win_k, s_win_v, s_hgrn)
```

```cpp
#include <hip/hip_runtime.h>
#include <hip/hip_cooperative_groups.h>
#include <cstdio>
namespace cg = cooperative_groups;

#define DI __device__ __forceinline__
typedef unsigned short u16;
typedef __attribute__((ext_vector_type(8))) short bf16x8;
typedef __attribute__((ext_vector_type(4))) short s16x4;
typedef __attribute__((ext_vector_type(16))) float f32x16;
typedef __attribute__((ext_vector_type(4))) float f32x4;
typedef __attribute__((ext_vector_type(2))) float f32x2;
typedef __attribute__((ext_vector_type(2))) __bf16 bf16x2v;
#define MFMA32(a, b, c) __builtin_amdgcn_mfma_f32_32x32x16_bf16((a), (b), (c), 0, 0, 0)
#define MFMA16(a, b, c) __builtin_amdgcn_mfma_f32_16x16x32_bf16((a), (b), (c), 0, 0, 0)

constexpr int D_MODEL = 1024, BATCH = 8, SEQ = 2048, DEC_BATCH = 128, DEC_SEQ = 4, PAST = 2048;
constexpr int NTP = BATCH * SEQ;
constexpr int NTS = DEC_BATCH * DEC_SEQ;
constexpr int NT = NTP + NTS;
constexpr int IN_COLS = 5912, NPAD = 6016;
constexpr int NSEQ = BATCH + DEC_BATCH;

constexpr size_t O_YP = 0;
constexpr size_t O_YS = O_YP + (size_t)NTP * 1024;
constexpr size_t O_PCK = O_YS + (size_t)NTS * 1024;
constexpr size_t O_PWK = O_PCK + 4 * (size_t)NTP * 128;
constexpr size_t O_PHG = O_PWK + 2 * (size_t)BATCH * 512 * 128;
constexpr size_t O_SCK = O_PHG + (size_t)BATCH * 4 * 128 * 128;
constexpr size_t O_SWK = O_SCK + 4 * (size_t)NTS * 128;
constexpr size_t O_SHG = O_SWK + 2 * (size_t)DEC_BATCH * 512 * 128;
constexpr size_t O_END = O_SHG + (size_t)DEC_BATCH * 4 * 128 * 128;

constexpr size_t al256(size_t x) { return (x + 255) & ~(size_t)255; }
constexpr size_t W_WINT = 0;
constexpr size_t W_WBAT = al256(W_WINT + (size_t)NPAD * 1024 * 2);
constexpr size_t W_WBBT = al256(W_WBAT + (size_t)1024 * 512 * 2);
constexpr size_t W_WOUTT = al256(W_WBBT + (size_t)1024 * 512 * 2);
constexpr size_t W_W1T = al256(W_WOUTT + (size_t)1024 * 1024 * 2);
constexpr size_t W_C1 = al256(W_W1T + (size_t)2 * 128 * 1024 * 2);
constexpr size_t W_XN = al256(W_C1 + 2 * 64 * 4);
constexpr size_t W_Q = al256(W_XN + (size_t)NT * 1024 * 2);
constexpr size_t W_KV = al256(W_Q + (size_t)NT * 512 * 2);
constexpr size_t W_VST = al256(W_KV + (size_t)6 * NT * 128 * 2);
constexpr size_t W_VWT = al256(W_VST + (size_t)8 * 2 * 64 * 2048 * 2);
constexpr size_t W_GATE = al256(W_VWT + (size_t)8 * 2 * 64 * 2048 * 2);
constexpr size_t W_ZA = al256(W_GATE + (size_t)NT * 24 * 4);
constexpr size_t W_QB = al256(W_ZA + (size_t)NT * 512 * 2);
constexpr size_t W_KB = al256(W_QB + (size_t)NT * 512 * 2);
constexpr size_t W_GB = al256(W_KB + (size_t)NT * 512 * 2);
constexpr size_t W_VB = al256(W_GB + (size_t)NT * 512 * 4);
constexpr size_t W_ZB = al256(W_VB + (size_t)NT * 512 * 2);
constexpr size_t W_SA = al256(W_ZB + (size_t)NT * 512 * 2);
constexpr size_t W_SB = al256(W_SA + (size_t)NT * 1024 * 2);
constexpr size_t W_KCMP = al256(W_SB + (size_t)NT * 1024 * 2);
constexpr size_t W_VCMP = al256(W_KCMP + (size_t)NSEQ * 2 * 128 * 64 * 2);
constexpr size_t W_VCMPT = al256(W_VCMP + (size_t)NSEQ * 2 * 128 * 64 * 2);
constexpr size_t W_OA = al256(W_VCMPT + (size_t)8 * 2 * 64 * 128 * 2);
constexpr size_t W_OB = al256(W_OA + (size_t)NT * 512 * 2);
constexpr size_t W_Y = al256(W_OB + (size_t)NT * 512 * 2);
constexpr size_t W_SS = al256(W_Y + (size_t)NT * 1024 * 2);
constexpr size_t W_ORAW = al256(W_SS + (size_t)NT * 16 * 4);
constexpr size_t W_OSS = al256(W_ORAW + (size_t)NTP * 512 * 4);
constexpr size_t W_END = al256(W_OSS + (size_t)NTP * 8 * 4);

struct Params {
  const float* x_prompt; const float* x_sample;
  const float* cck; const float* ccv; const float* csk; const float* csv;
  const float* swk; const float* swv; const float* shg; const int* pt;
  const float* norm_g; const float* w_in;
  const float* pos_k; const float* w1_k; const float* w2_k;
  const float* pos_v; const float* w1_v; const float* w2_v;
  const float* rel_bias; const float* hg_lower; const float* hg_norm_g;
  const float* w_ba; const float* w_bb; const float* w_out; const float* final_g;
  float* out; char* ws;
};

DI unsigned pk2(float a, float b) { f32x2 v = {a, b}; bf16x2v r = __builtin_convertvector(v, bf16x2v); return __builtin_bit_cast(unsigned, r); }
DI u16 f2bf(float a) { return (u16)(pk2(a, 0.f) & 0xffffu); }
DI float bf2f(u16 v) { return __uint_as_float(((unsigned)v) << 16); }
DI float bflo(unsigned v) { return __uint_as_float(v << 16); }
DI float bfhi(unsigned v) { return __uint_as_float(v & 0xffff0000u); }
DI float sigmoidf_(float x) { return 1.f / (1.f + __expf(-x)); }
DI float siluf_(float x) { return x / (1.f + __expf(-x)); }
DI int otid() { int t = threadIdx.x; asm volatile("" : "+v"(t)); return t; }
DI int crow(int reg, int h) { return (reg & 3) + 8 * (reg >> 2) + 4 * h; }
DI float wave_sum(float v) {
#pragma unroll
  for (int o = 32; o >= 1; o >>= 1) v += __shfl_xor(v, o);
  return v;
}
DI float wave_max(float v) {
#pragma unroll
  for (int o = 32; o >= 1; o >>= 1) v = fmaxf(v, __shfl_xor(v, o));
  return v;
}

__device__ const unsigned char T5B[128] = {
  0,1,2,3,4,5,6,7,8,9,10,11,12,13,14,15,
  16,16,16,17,17,18,18,18,19,19,19,20,20,20,20,21,
  21,21,21,22,22,22,22,22,23,23,23,23,23,23,24,24,
  24,24,24,24,25,25,25,25,25,25,25,26,26,26,26,26,
  26,26,26,27,27,27,27,27,27,27,27,27,27,28,28,28,
  28,28,28,28,28,28,28,29,29,29,29,29,29,29,29,29,
  29,29,29,30,30,30,30,30,30,30,30,30,30,30,30,30,
  30,31,31,31,31,31,31,31,31,31,31,31,31,31,31,31};

DI void transpose_tile(const float* __restrict__ src, int ldsrc, int K, int N, int k0, int n0,
                       u16* __restrict__ dst, int lddst, int dst_row_off, int dst_k0, int winperm, float* tl) {
  const int tid = threadIdx.x;
  __syncthreads();
  {
    const int n = tid & 63, kb = tid >> 6;
#pragma unroll
    for (int i = 0; i < 16; ++i) {
      const int kk = kb + 4 * i;
      float v = 0.f;
      if (n0 + n < N && k0 + kk < K) v = src[(size_t)(k0 + kk) * ldsrc + n0 + n];
      tl[kk * 65 + n] = v;
    }
  }
  __syncthreads();
  {
    const int k = (tid & 31) * 2, nb = tid >> 5;
#pragma unroll
    for (int i = 0; i < 8; ++i) {
      const int nn = nb + 8 * i;
      int n = n0 + nn;
      if (n < N) {
        if (winperm) n = (n < 1280) ? n : ((n < 1304) ? (5888 + n - 1280) : (n - 24));
        const unsigned v = pk2(tl[k * 65 + nn], tl[(k + 1) * 65 + nn]);
        *(unsigned*)(dst + (size_t)(dst_row_off + n) * lddst + dst_k0 + k) = v;
      }
    }
  }
}

constexpr int P0_WIN = 16 * 93;
constexpr int P0_WBA = 8 * 16, P0_WBB = 8 * 16, P0_WOUT = 16 * 16, P0_W1 = 32 * 2;
constexpr int P0_TR = P0_WIN + P0_WBA + P0_WBB + P0_WOUT + P0_W1;
constexpr int P0_C1 = 2;
constexpr int P0_NORM = NT / 4;
constexpr int P0_WCP = 2 * DEC_BATCH;
constexpr int P0_PAD = NPAD - IN_COLS;
constexpr int P0_TOTAL = P0_TR + P0_C1 + P0_NORM + P0_WCP + P0_PAD;

DI void phase0_item(const Params& p, int it, char* lds) {
  const int tid = threadIdx.x, lane = tid & 63, wave = tid >> 6;
  float* tl = (float*)lds;
  if (it < P0_TR) {
    if (it < P0_WIN) {
      const int kt = it / 93, nt = it % 93;
      transpose_tile(p.w_in, IN_COLS, 1024, IN_COLS, kt * 64, nt * 64, (u16*)(p.ws + W_WINT), 1024, 0, kt * 64, 1, tl);
      return;
    }
    it -= P0_WIN;
    if (it < P0_WBA) { const int kt = it / 16, nt = it % 16;
      transpose_tile(p.w_ba, 1024, 512, 1024, kt * 64, nt * 64, (u16*)(p.ws + W_WBAT), 512, 0, kt * 64, 0, tl); return; }
    it -= P0_WBA;
    if (it < P0_WBB) { const int kt = it / 16, nt = it % 16;
      transpose_tile(p.w_bb, 1024, 512, 1024, kt * 64, nt * 64, (u16*)(p.ws + W_WBBT), 512, 0, kt * 64, 0, tl); return; }
    it -= P0_WBB;
    if (it < P0_WOUT) { const int kt = it / 16, nt = it % 16;
      transpose_tile(p.w_out, 1024, 1024, 1024, kt * 64, nt * 64, (u16*)(p.ws + W_WOUTT), 1024, 0, kt * 64, 0, tl); return; }
    it -= P0_WOUT;
    { const int kv = it >> 5, kt = it & 31;
      const float* w1 = kv ? p.w1_v : p.w1_k;
      transpose_tile(w1, 64, 2048, 64, kt * 64, 0, (u16*)(p.ws + W_W1T) + (size_t)kv * 128 * 1024, 1024,
                     (kt >= 16) ? 64 : 0, (kt & 15) * 64, 0, tl); return; }
  }
  it -= P0_TR;
  if (it < P0_C1) {
    const float* pos = it ? p.pos_v : p.pos_k; const float* w1 = it ? p.w1_v : p.w1_k;
    const int j = tid & 63, part = tid >> 6;
    float s = 0.f;
    for (int i = part * 512; i < part * 512 + 512; ++i) s += pos[i] * w1[(size_t)i * 64 + j];
    __syncthreads();
    tl[part * 64 + j] = s;
    __syncthreads();
    if (tid < 64) ((float*)(p.ws + W_C1))[it * 64 + tid] = tl[tid] + tl[64 + tid] + tl[128 + tid] + tl[192 + tid];
    return;
  }
  it -= P0_C1;
  if (it < P0_NORM) {
    const int row = it * 4 + wave;
    const float* x = (row < NTP) ? (p.x_prompt + (size_t)row * 1024) : (p.x_sample + (size_t)(row - NTP) * 1024);
    float4 v[4]; float ss = 0.f;
#pragma unroll
    for (int i = 0; i < 4; ++i) { v[i] = *(const float4*)(x + (i * 64 + lane) * 4); ss += v[i].x * v[i].x + v[i].y * v[i].y + v[i].z * v[i].z + v[i].w * v[i].w; }
    ss = wave_sum(ss);
    const float rs = rsqrtf(ss * (1.f / 1024.f) + 1e-6f);
    u16* xn = (u16*)(p.ws + W_XN) + (size_t)row * 1024;
#pragma unroll
    for (int i = 0; i < 4; ++i) {
      const float4 g = *(const float4*)(p.norm_g + (i * 64 + lane) * 4);
      uint2 o; o.x = pk2(v[i].x * rs * g.x, v[i].y * rs * g.y); o.y = pk2(v[i].z * rs * g.z, v[i].w * rs * g.w);
      *(uint2*)(xn + (i * 64 + lane) * 4) = o;
    }
    return;
  }
  it -= P0_NORM;
  if (it < P0_WCP) {
    const int kv = it / DEC_BATCH, b = it % DEC_BATCH;
    const float4* src = (const float4*)((kv ? p.swv : p.swk) + ((size_t)b * 512 + 4) * 128);
    float4* dst = (float4*)(p.out + O_SWK + (size_t)kv * DEC_BATCH * 512 * 128 + (size_t)b * 512 * 128);
    for (int i = tid; i < 508 * 32; i += 256) dst[i] = src[i];
    return;
  }
  it -= P0_WCP;
  { u16* d = (u16*)(p.ws + W_WINT) + (size_t)(IN_COLS + it) * 1024; *(uint2*)(d + tid * 4) = make_uint2(0u, 0u); }
}

constexpr int GST = 72;
struct LoadBf16 {
  const u16* base; int ld;
  DI uint4 load(int row, int ch, int kt) const { return *(const uint4*)(base + (size_t)row * ld + kt * 64 + ch * 8); }
};
struct LoadCellBf16 {
  const u16* base;
  DI uint4 load(int row, int ch, int kt) const { return *(const uint4*)(base + (size_t)(row * 16 + kt) * 128 + ch * 8); }
};
struct LoadCellPage {
  const float* cache; const int* pt; int g;
  DI uint4 load(int row, int ch, int kt) const {
    const int pos = row * 16 + kt; const int page = pt[pos >> 7];
    const float* s = cache + (((size_t)page * 128 + (pos & 127)) * 2 + g) * 64 + ch * 8;
    const float4 a = *(const float4*)s, b = *(const float4*)(s + 4);
    uint4 r; r.x = pk2(a.x, a.y); r.y = pk2(a.z, a.w); r.z = pk2(b.x, b.y); r.w = pk2(b.z, b.w); return r;
  }
};

template <int NI, class AL, class BL>
DI void gemm_main(f32x16 (&acc)[2][NI], const AL& al, const BL& bl, int nkt, char* lds) {
  u16* sA = (u16*)lds; u16* sB = sA + 128 * GST;
  const int tid = otid(), lane = tid & 63, wave = tid >> 6, wm = wave >> 1, wn = wave & 1;
  const int lrow = tid >> 3, lch = tid & 7, r = lane & 31, h = lane >> 5;
  uint4 ra[4], rb[2 * NI];
#pragma unroll
  for (int i = 0; i < 4; ++i) ra[i] = al.load(lrow + 32 * i, lch, 0);
#pragma unroll
  for (int i = 0; i < 2 * NI; ++i) rb[i] = bl.load(lrow + 32 * i, lch, 0);
  for (int kt = 0; kt < nkt; ++kt) {
    __syncthreads();
#pragma unroll
    for (int i = 0; i < 4; ++i) *(uint4*)(sA + (lrow + 32 * i) * GST + lch * 8) = ra[i];
#pragma unroll
    for (int i = 0; i < 2 * NI; ++i) *(uint4*)(sB + (lrow + 32 * i) * GST + lch * 8) = rb[i];
    __syncthreads();
    if (kt + 1 < nkt) {
#pragma unroll
      for (int i = 0; i < 4; ++i) ra[i] = al.load(lrow + 32 * i, lch, kt + 1);
#pragma unroll
      for (int i = 0; i < 2 * NI; ++i) rb[i] = bl.load(lrow + 32 * i, lch, kt + 1);
    }
#pragma unroll
    for (int s = 0; s < 4; ++s) {
      bf16x8 a[2], bb[NI];
#pragma unroll
      for (int mi = 0; mi < 2; ++mi) a[mi] = *(const bf16x8*)(sA + (wm * 64 + mi * 32 + r) * GST + s * 16 + 8 * h);
#pragma unroll
      for (int ni = 0; ni < NI; ++ni) bb[ni] = *(const bf16x8*)(sB + (wn * 32 * NI + ni * 32 + r) * GST + s * 16 + 8 * h);
#pragma unroll
      for (int mi = 0; mi < 2; ++mi)
#pragma unroll
        for (int ni = 0; ni < NI; ++ni) acc[mi][ni] = MFMA32(a[mi], bb[ni], acc[mi][ni]);
    }
  }
}
template <int NI>
DI void zero_acc(f32x16 (&acc)[2][NI]) {
#pragma unroll
  for (int a = 0; a < 2; ++a)
#pragma unroll
    for (int b = 0; b < NI; ++b)
#pragma unroll
      for (int i = 0; i < 16; ++i) acc[a][b][i] = 0.f;
}

constexpr int G1_MT = NT / 128, G1_NT = NPAD / 128;
constexpr int P1_GEMM = G1_MT * G1_NT;
constexpr int P1_CMP = DEC_BATCH * 2 * 2;
constexpr int P1_TOTAL = P1_CMP + P1_GEMM;

DI void proj_tile(const Params& p, int tm, int tn, char* lds) {
  f32x16 acc[2][2]; zero_acc<2>(acc);
  LoadBf16 al{(const u16*)(p.ws + W_XN) + (size_t)tm * 128 * 1024, 1024};
  LoadBf16 bl{(const u16*)(p.ws + W_WINT) + (size_t)tn * 128 * 1024, 1024};
  gemm_main<2>(acc, al, bl, 16, lds);
  const int tid = otid(), lane = tid & 63, wave = tid >> 6, wm = wave >> 1, wn = wave & 1, r = lane & 31, h = lane >> 5;
  const bool samp = tm >= 128;
#pragma unroll
  for (int mi = 0; mi < 2; ++mi)
#pragma unroll
    for (int ni = 0; ni < 2; ++ni) {
      const int c = wn * 64 + ni * 32 + r;
      const int row0 = tm * 128 + wm * 64 + mi * 32;
      if (tn < 4) {
        u16* d = (u16*)(p.ws + W_Q) + tn * 128 + c;
#pragma unroll
        for (int i = 0; i < 16; ++i) d[(size_t)(row0 + crow(i, h)) * 512] = f2bf(acc[mi][ni][i] * 0.125f);
      } else if (tn < 10) {
        const int kvg = tn - 4;
        u16* d = (u16*)(p.ws + W_KV) + (size_t)kvg * NT * 128 + c;
#pragma unroll
        for (int i = 0; i < 16; ++i) {
          const int row = row0 + crow(i, h); const float v = acc[mi][ni][i];
          d[(size_t)row * 128] = f2bf(v);
          if (!samp) {
            if (kvg < 4) p.out[O_PCK + (size_t)kvg * NTP * 128 + (size_t)row * 128 + c] = v;
            else { const int t = row & 2047, b = row >> 11;
              if (t >= 1536) p.out[O_PWK + (size_t)(kvg - 4) * BATCH * 512 * 128 + ((size_t)b * 512 + t - 1536) * 128 + c] = v; }
          } else {
            const int srow = row - NTP;
            if (kvg < 4) p.out[O_SCK + (size_t)kvg * NTS * 128 + (size_t)srow * 128 + c] = v;
            else p.out[O_SWK + (size_t)(kvg - 4) * DEC_BATCH * 512 * 128 + ((size_t)(srow >> 2) * 512 + 508 + (srow & 3)) * 128 + c] = v;
          }
        }
        if (!samp && (kvg == 3 || kvg == 5)) {
          u16* vt = (u16*)(p.ws + (kvg == 3 ? W_VST : W_VWT));
          const int b = row0 >> 11, t0 = row0 & 2047, g = c >> 6, dd = c & 63;
          u16* drow = vt + ((size_t)(b * 2 + g) * 64 + dd) * 2048 + t0;
#pragma unroll
          for (int q = 0; q < 4; ++q) {
            uint2 o; o.x = pk2(acc[mi][ni][4 * q], acc[mi][ni][4 * q + 1]); o.y = pk2(acc[mi][ni][4 * q + 2], acc[mi][ni][4 * q + 3]);
            *(uint2*)(drow + 8 * q + 4 * h) = o;
          }
        }
      } else if (tn < 14 || (tn >= 26 && tn < 30)) {
        const bool isA = tn < 14; const int cc = (isA ? tn - 10 : tn - 26) * 128 + c;
        u16* d = (u16*)(p.ws + (isA ? W_ZA : W_ZB)) + cc;
#pragma unroll
        for (int i = 0; i < 16; ++i) d[(size_t)(row0 + crow(i, h)) * 512] = f2bf(siluf_(acc[mi][ni][i]));
      } else if (tn < 18 || (tn >= 22 && tn < 26)) {
        const bool isQ = tn < 18; const int cc = (isQ ? tn - 14 : tn - 22) * 128 + c;
        u16* d = (u16*)(p.ws + (isQ ? W_QB : W_VB)) + cc;
#pragma unroll
        for (int i = 0; i < 16; ++i) d[(size_t)(row0 + crow(i, h)) * 512] = f2bf(acc[mi][ni][i]);
      } else if (tn < 22) {
        const int cc = (tn - 18) * 128 + c;
        const float a0 = p.hg_lower[cc], a1 = p.hg_lower[512 + cc];
        const float lb = 1.f / (1.f + __expf(a1 - a0));
        u16* dk = (u16*)(p.ws + W_KB) + cc; float* dg = (float*)(p.ws + W_GB) + cc;
#pragma unroll
        for (int i = 0; i < 16; ++i) {
          const size_t row = row0 + crow(i, h);
          const float sg = sigmoidf_(acc[mi][ni][i]);
          const float f = lb + (1.f - lb) * sg;
          dg[row * 512] = __logf(f);
          dk[row * 512] = f2bf((1.f - lb) * (1.f - sg));
        }
      } else if (tn < 46) {
        const bool isA = tn < 38; const int cc = (isA ? tn - 30 : tn - 38) * 128 + c;
        u16* d = (u16*)(p.ws + (isA ? W_SA : W_SB)) + cc;
#pragma unroll
        for (int i = 0; i < 16; ++i) d[(size_t)(row0 + crow(i, h)) * 1024] = f2bf(sigmoidf_(acc[mi][ni][i]));
      } else {
        if (c < 24) {
          float* d = (float*)(p.ws + W_GATE) + c;
#pragma unroll
          for (int i = 0; i < 16; ++i) d[(size_t)(row0 + crow(i, h)) * 24] = sigmoidf_(acc[mi][ni][i]);
        }
      }
    }
}

template <class AL>
DI void comp_tile(const Params& p, const AL& al, int seq, int g, int kv, char* lds) {
  f32x16 acc[2][2]; zero_acc<2>(acc);
  LoadBf16 bl{(const u16*)(p.ws + W_W1T) + (size_t)kv * 128 * 1024, 1024};
  gemm_main<2>(acc, al, bl, 16, lds);
  const int tid = otid(), lane = tid & 63, wave = tid >> 6, wm = wave >> 1, wn = wave & 1, r = lane & 31, h = lane >> 5;
  float* T = (float*)lds;
  float* w2s = T + 128 * 65;
  const float* c1 = (const float*)(p.ws + W_C1) + kv * 64;
  const float* w2 = kv ? p.w2_v : p.w2_k;
  __syncthreads();
  for (int i = tid; i < 4096; i += 256) w2s[i] = w2[i];
  if (wn == 1) {
#pragma unroll
    for (int mi = 0; mi < 2; ++mi)
#pragma unroll
      for (int ni = 0; ni < 2; ++ni)
#pragma unroll
        for (int i = 0; i < 16; ++i) T[(wm * 64 + mi * 32 + crow(i, h)) * 65 + ni * 32 + r] = acc[mi][ni][i];
  }
  __syncthreads();
  if (wn == 0) {
#pragma unroll
    for (int mi = 0; mi < 2; ++mi)
#pragma unroll
      for (int ni = 0; ni < 2; ++ni)
#pragma unroll
        for (int i = 0; i < 16; ++i) {
          const int n = wm * 64 + mi * 32 + crow(i, h), j = ni * 32 + r;
          float hv = 0.f;
          if (n < 127) hv = siluf_(acc[mi][ni][i] + T[(n + 1) * 65 + j] + c1[j]);
          acc[mi][ni][i] = hv;
        }
  }
  __syncthreads();
  if (wn == 0) {
#pragma unroll
    for (int mi = 0; mi < 2; ++mi)
#pragma unroll
      for (int ni = 0; ni < 2; ++ni)
#pragma unroll
        for (int i = 0; i < 16; ++i) T[(wm * 64 + mi * 32 + crow(i, h)) * 65 + ni * 32 + r] = acc[mi][ni][i];
  }
  __syncthreads();
  {
    const int n = tid >> 1, eh = tid & 1;
    float o[32];
#pragma unroll
    for (int e = 0; e < 32; ++e) o[e] = 0.f;
#pragma unroll 2
    for (int j = 0; j < 64; ++j) {
      const float hv = T[n * 65 + j];
#pragma unroll
      for (int e = 0; e < 32; ++e) o[e] += hv * w2s[j * 64 + eh * 32 + e];
    }
    u16* dst = (u16*)(p.ws + (kv ? W_VCMP : W_KCMP)) + ((size_t)(seq * 2 + g) * 128 + n) * 64 + eh * 32;
#pragma unroll
    for (int e = 0; e < 32; e += 2) *(unsigned*)(dst + e) = pk2(o[e], o[e + 1]);
    if (kv == 1 && seq < BATCH) {
      u16* dt = (u16*)(p.ws + W_VCMPT) + ((size_t)(seq * 2 + g) * 64 + eh * 32) * 128 + n;
#pragma unroll
      for (int e = 0; e < 32; ++e) dt[(size_t)e * 128] = f2bf(o[e]);
    }
  }
  __syncthreads();
}

DI void phase1_item(const Params& p, int it, char* lds) {
  if (it < P1_CMP) {
    const int kv = it & 1, g = (it >> 1) & 1, b = it >> 2;
    LoadCellPage al{kv ? p.ccv : p.cck, p.pt + b * 16, g};
    comp_tile(p, al, BATCH + b, g, kv, lds);
    return;
  }
  it -= P1_CMP;
  const int tm = it / G1_NT, tn = it % G1_NT;
  proj_tile(p, tm, tn, lds);
}


DI void hgrn_sample_item(const Params& p, int it, char* lds) {
  const int b = it >> 2, h = it & 3, tid = otid(), lane = tid & 63, wave = tid >> 6;
  float* sf = (float*)lds; float* sk = sf + 512; float* sq = sk + 512; float* sv = sq + 512; float* so = sv + 512;
  __syncthreads();
  for (int i = tid; i < 512; i += 256) {
    const int t = i >> 7, c = i & 127; const size_t off = (size_t)(NTP + b * 4 + t) * 512 + h * 128 + c;
    sf[i] = __expf(((const float*)(p.ws + W_GB))[off]);
    sk[i] = bf2f(((const u16*)(p.ws + W_KB))[off]);
    sq[i] = bf2f(((const u16*)(p.ws + W_QB))[off]);
    sv[i] = bf2f(((const u16*)(p.ws + W_VB))[off]);
  }
  __syncthreads();
  const int e = tid & 127, dh = tid >> 7;
  const float* S0 = p.shg + (size_t)(b * 4 + h) * 128 * 128;
  float* S1 = p.out + O_SHG + (size_t)(b * 4 + h) * 128 * 128;
  const float v0 = sv[e], v1 = sv[128 + e], v2 = sv[256 + e], v3 = sv[384 + e];
  float o0 = 0.f, o1 = 0.f, o2 = 0.f, o3 = 0.f;
#pragma unroll 4
  for (int d = dh * 64; d < dh * 64 + 64; ++d) {
    float st = S0[(size_t)d * 128 + e];
    st = sf[d] * st + sk[d] * v0;             o0 += sq[d] * st;
    st = sf[128 + d] * st + sk[128 + d] * v1; o1 += sq[128 + d] * st;
    st = sf[256 + d] * st + sk[256 + d] * v2; o2 += sq[256 + d] * st;
    st = sf[384 + d] * st + sk[384 + d] * v3; o3 += sq[384 + d] * st;
    S1[(size_t)d * 128 + e] = st;
  }
  so[(dh * 4 + 0) * 128 + e] = o0; so[(dh * 4 + 1) * 128 + e] = o1; so[(dh * 4 + 2) * 128 + e] = o2; so[(dh * 4 + 3) * 128 + e] = o3;
  __syncthreads();
  {
    const int t = wave; const size_t row = (size_t)(NTP + b * 4 + t);
    const float a0 = so[t * 128 + lane] + so[(4 + t) * 128 + lane];
    const float a1 = so[t * 128 + 64 + lane] + so[(4 + t) * 128 + 64 + lane];
    const float ss = wave_sum(a0 * a0 + a1 * a1);
    const float rs = rsqrtf(ss * (1.f / 128.f) + 1e-6f);
    const u16* zb = (const u16*)(p.ws + W_ZB) + row * 512 + h * 128; u16* ob = (u16*)(p.ws + W_OB) + row * 512 + h * 128;
    ob[lane] = f2bf(a0 * rs * p.hg_norm_g[h * 128 + lane] * bf2f(zb[lane]));
    ob[64 + lane] = f2bf(a1 * rs * p.hg_norm_g[h * 128 + 64 + lane] * bf2f(zb[64 + lane]));
  }
}

typedef __attribute__((address_space(3))) s16x4 lds_s16x4;
DI s16x4 tr_read(const u16* ptr) { return __builtin_amdgcn_ds_read_tr16_b64_v4i16((lds_s16x4*)ptr); }
DI bf16x8 cat8(s16x4 lo, s16x4 hi) { return __builtin_shufflevector(lo, hi, 0, 1, 2, 3, 4, 5, 6, 7); }
constexpr int HST = 136;

DI void hgrn_prompt_item(const Params& p, int it, char* lds) {
  const int b = it >> 3, h = (it >> 1) & 3, eh = it & 1, tid0 = otid(), w = __builtin_amdgcn_readfirstlane(tid0 >> 6);
  u16* Qe = (u16*)lds; u16* Ke = Qe + 64 * HST; u16* Vv = Ke + 64 * HST; u16* Am = Vv + 64 * 72;
  float* Rr = (float*)(Am + 64 * 72); float* G63 = Rr + 128; float* ssq = G63 + 128;
  const u16* qB = (const u16*)(p.ws + W_QB); const u16* kB = (const u16*)(p.ws + W_KB); const u16* vB = (const u16*)(p.ws + W_VB);
  const float* gB = (const float*)(p.ws + W_GB);
  const int e0 = eh * 64 + 16 * w;
  f32x4 S[8];
#pragma unroll
  for (int a = 0; a < 8; ++a) S[a] = f32x4{0.f, 0.f, 0.f, 0.f};
  for (int ch = 0; ch < 32; ++ch) {
    const size_t tok0 = (size_t)b * 2048 + ch * 64;
    int tid = tid0; asm volatile("" : "+v"(tid));
    const int lane = tid & 63, half = tid >> 7;
    const int c16 = lane & 15, hq = lane >> 4, tq = c16 >> 2, tp = c16 & 3;
    const int d = tid & 127, col = h * 128 + d;
    __syncthreads();
    {
      float run = 0.f;
#pragma unroll 8
      for (int i = 0; i < 32; ++i) run += gB[(tok0 + half * 32 + i) * 512 + col];
      if (half == 0) Rr[d] = run;
    }
#pragma unroll
    for (int i = 0; i < 2; ++i) {
      const int idx = tid + 256 * i, s = idx >> 3, c = idx & 7;
      *(uint4*)(Vv + s * 72 + c * 8) = *(const uint4*)(vB + (tok0 + s) * 512 + h * 128 + eh * 64 + c * 8);
    }
    __syncthreads();
    {
      const float R = Rr[d];
      float run = half ? R : 0.f;
#pragma unroll 4
      for (int i = 0; i < 32; ++i) {
        const int t = half * 32 + i;
        run += gB[(tok0 + t) * 512 + col];
        const float q = bf2f(qB[(tok0 + t) * 512 + col]), k = bf2f(kB[(tok0 + t) * 512 + col]);
        const float dq = fminf(fmaxf(run - R, -80.f), 80.f);
        Qe[t * HST + d] = f2bf(q * __expf(dq));
        Ke[t * HST + d] = f2bf(k * __expf(-dq));
      }
      if (half == 1) G63[d] = run;
    }
    __syncthreads();
    for (int j = 0; j <= w; ++j) {
      f32x4 x = f32x4{0.f, 0.f, 0.f, 0.f};
#pragma unroll
      for (int ks = 0; ks < 4; ++ks) {
        const bf16x8 a = *(const bf16x8*)(Qe + (16 * w + c16) * HST + ks * 32 + 8 * hq);
        const bf16x8 bb = *(const bf16x8*)(Ke + (16 * j + c16) * HST + ks * 32 + 8 * hq);
        x = MFMA16(a, bb, x);
      }
#pragma unroll
      for (int r = 0; r < 4; ++r) {
        const bool ok = (j < w) || (c16 <= 4 * hq + r);
        Am[(16 * w + 4 * hq + r) * 72 + 16 * j + c16] = f2bf(ok ? x[r] : 0.f);
      }
    }
    if ((w & 1) == 0) {
#pragma unroll
      for (int r = 0; r < 4; ++r) Am[(16 * w + 4 * hq + r) * 72 + 16 * (w + 1) + c16] = 0;
    }
    __syncthreads();
    bf16x8 vf[2];
#pragma unroll
    for (int ks = 0; ks < 2; ++ks) {
      const u16* base = Vv + (32 * ks + 8 * hq + tq) * 72 + 16 * w + 4 * tp;
      vf[ks] = cat8(tr_read(base), tr_read(base + 4 * 72));
    }
    f32x4 o[4];
#pragma unroll
    for (int tt = 0; tt < 4; ++tt) o[tt] = f32x4{0.f, 0.f, 0.f, 0.f};
#pragma unroll
    for (int tt = 0; tt < 4; ++tt)
#pragma unroll
      for (int ks = 0; ks <= (tt >> 1); ++ks) {
        const bf16x8 a = *(const bf16x8*)(Am + (16 * tt + c16) * 72 + 32 * ks + 8 * hq);
        o[tt] = MFMA16(a, vf[ks], o[tt]);
      }
#pragma unroll
    for (int k2 = 0; k2 < 4; ++k2) {
      f32x4 ea, eb;
#pragma unroll
      for (int r = 0; r < 4; ++r) { ea[r] = __expf(Rr[32 * k2 + 4 * hq + r]); eb[r] = __expf(Rr[32 * k2 + 16 + 4 * hq + r]); }
      const f32x4 sa = S[2 * k2], sb = S[2 * k2 + 1];
      uint4 u; u.x = pk2(sa[0] * ea[0], sa[1] * ea[1]); u.y = pk2(sa[2] * ea[2], sa[3] * ea[3]);
      u.z = pk2(sb[0] * eb[0], sb[1] * eb[1]); u.w = pk2(sb[2] * eb[2], sb[3] * eb[3]);
      const bf16x8 bfr = __builtin_bit_cast(bf16x8, u);
#pragma unroll
      for (int tt = 0; tt < 4; ++tt) {
        const s16x4 lo = *(const s16x4*)(Qe + (16 * tt + c16) * HST + 32 * k2 + 4 * hq);
        const s16x4 hi = *(const s16x4*)(Qe + (16 * tt + c16) * HST + 32 * k2 + 16 + 4 * hq);
        o[tt] = MFMA16(cat8(lo, hi), bfr, o[tt]);
      }
    }
#pragma unroll
    for (int dt = 0; dt < 8; ++dt) {
      bf16x8 kt[2];
#pragma unroll
      for (int ks = 0; ks < 2; ++ks) {
        const u16* base = Ke + (32 * ks + 8 * hq + tq) * HST + 16 * dt + 4 * tp;
        kt[ks] = cat8(tr_read(base), tr_read(base + 4 * HST));
      }
      f32x4 dd = f32x4{0.f, 0.f, 0.f, 0.f};
      dd = MFMA16(kt[0], vf[0], dd); dd = MFMA16(kt[1], vf[1], dd);
#pragma unroll
      for (int r = 0; r < 4; ++r) {
        const float g63 = G63[16 * dt + 4 * hq + r], rr = Rr[16 * dt + 4 * hq + r];
        S[dt][r] = S[dt][r] * __expf(g63) + __expf(g63 - rr) * dd[r];
      }
    }
#pragma unroll
    for (int tt = 0; tt < 4; ++tt)
#pragma unroll
      for (int r = 0; r < 4; ++r) {
        float v = o[tt][r] * o[tt][r];
        v += __shfl_xor(v, 1); v += __shfl_xor(v, 2); v += __shfl_xor(v, 4); v += __shfl_xor(v, 8);
        if (c16 == 0) ssq[(16 * tt + 4 * hq + r) * 4 + w] = v;
        ((float*)(p.ws + W_ORAW))[(tok0 + 16 * tt + 4 * hq + r) * 512 + h * 128 + e0 + c16] = o[tt][r];
      }
    __syncthreads();
    if (tid < 64) ((float*)(p.ws + W_OSS))[(tok0 + tid) * 8 + h * 2 + eh] = ssq[tid * 4] + ssq[tid * 4 + 1] + ssq[tid * 4 + 2] + ssq[tid * 4 + 3];
  }
  int tidf = tid0; asm volatile("" : "+v"(tidf));
  const int c16 = tidf & 15, hq = (tidf & 63) >> 4;
  float* So = p.out + O_PHG + (size_t)(b * 4 + h) * 128 * 128;
#pragma unroll
  for (int dt = 0; dt < 8; ++dt)
#pragma unroll
    for (int r = 0; r < 4; ++r) So[(size_t)(16 * dt + 4 * hq + r) * 128 + e0 + c16] = S[dt][r];
}

DI void hgrn_finish_item(const Params& p, int it) {
  const int lane = threadIdx.x & 63, wave = threadIdx.x >> 6; const size_t tok = (size_t)it * 4 + wave;
  const int c = lane * 8, hd = lane >> 4;
  const float* ss = (const float*)(p.ws + W_OSS) + tok * 8 + hd * 2;
  const float rs = rsqrtf((ss[0] + ss[1]) * (1.f / 128.f) + 1e-6f);
  const float* orow = (const float*)(p.ws + W_ORAW) + tok * 512 + c;
  const float4 a = *(const float4*)orow, bq = *(const float4*)(orow + 4);
  const float4 g0 = *(const float4*)(p.hg_norm_g + c), g1 = *(const float4*)(p.hg_norm_g + c + 4);
  const uint4 z = *(const uint4*)((const u16*)(p.ws + W_ZB) + tok * 512 + c);
  uint4 o;
  o.x = pk2(a.x * rs * g0.x * bflo(z.x), a.y * rs * g0.y * bfhi(z.x)); o.y = pk2(a.z * rs * g0.z * bflo(z.y), a.w * rs * g0.w * bfhi(z.y));
  o.z = pk2(bq.x * rs * g1.x * bflo(z.z), bq.y * rs * g1.y * bfhi(z.z)); o.w = pk2(bq.z * rs * g1.z * bflo(z.w), bq.w * rs * g1.w * bfhi(z.w));
  *(uint4*)((u16*)(p.ws + W_OB) + tok * 512 + c) = o;
}

constexpr int SA_KMAX = 528;
template <int NR, class KLoad, class VLoad, class ScoreFn>
DI void sattend(const float* qs, int row0, int nkeys, float* Sc, float* tile, float* oout, const KLoad& kload, const VLoad& vload, const ScoreFn& sfn) {
  constexpr int NRQ = NR / 4;
  const int tid = otid(), rq = tid & 3, kk = tid >> 2;
  const int ntile = (nkeys + 63) >> 6;
  for (int j = 0; j < ntile; ++j) {
    __syncthreads();
    kload(j, tile);
    __syncthreads();
#pragma unroll
    for (int rr = 0; rr < NRQ; ++rr) {
      const int row = rq * NRQ + rr; const int key = j * 64 + kk;
      float s = 0.f;
#pragma unroll 16
      for (int dd = 0; dd < 64; ++dd) s += qs[(row0 + row) * 64 + dd] * tile[kk * 65 + dd];
      if (key < nkeys) { float bias; const bool ok = sfn(row, key, bias); Sc[row * SA_KMAX + key] = ok ? (s + bias) : -3.0e38f; }
    }
  }
  __syncthreads();
  {
    constexpr int TPR = 256 / NR;
    const int row = tid / TPR, sub = tid % TPR; const int nk = nkeys;
    float m = -3.0e38f;
    for (int k = sub; k < nk; k += TPR) m = fmaxf(m, Sc[row * SA_KMAX + k]);
#pragma unroll
    for (int o = TPR / 2; o >= 1; o >>= 1) m = fmaxf(m, __shfl_xor(m, o));
    float l = 0.f;
    for (int k = sub; k < nk; k += TPR) { const float sv = Sc[row * SA_KMAX + k]; const float pv = (sv > -1.0e38f) ? __expf(sv - m) : 0.f; Sc[row * SA_KMAX + k] = pv; l += pv; }
#pragma unroll
    for (int o = TPR / 2; o >= 1; o >>= 1) l += __shfl_xor(l, o);
    const float inv = (l > 0.f) ? 1.f / l : 0.f;
    for (int k = sub; k < nk; k += TPR) Sc[row * SA_KMAX + k] *= inv;
  }
  float oacc[NRQ];
#pragma unroll
  for (int rr = 0; rr < NRQ; ++rr) oacc[rr] = 0.f;
  for (int j = 0; j < ntile; ++j) {
    __syncthreads();
    vload(j, tile);
    __syncthreads();
    const int kmax = (nkeys - j * 64 < 64) ? (nkeys - j * 64) : 64;
#pragma unroll 2
    for (int key = 0; key < kmax; ++key) {
      const float vv = tile[key * 65 + kk];
#pragma unroll
      for (int rr = 0; rr < NRQ; ++rr) oacc[rr] += Sc[(rq * NRQ + rr) * SA_KMAX + j * 64 + key] * vv;
    }
  }
#pragma unroll
  for (int rr = 0; rr < NRQ; ++rr) oout[(rq * NRQ + rr) * 64 + kk] = oacc[rr];
  __syncthreads();
}

DI void sample_attn_item(const Params& p, int it, char* lds) {
  const int b = it >> 1, g = it & 1, tid = otid();
  float* qs = (float*)lds;
  float* Sc = qs + 16 * 64;
  float* tile = Sc + 16 * SA_KMAX;
  float* obr = tile + 64 * 65;
  float* ofin = obr + 1024;
  float* imp = ofin + 1024;
  int* sel = (int*)(imp + 4 * 33);
  float* btab = (float*)(sel + 32);
  __syncthreads();
  for (int i = tid; i < 1024; i += 256) { const int row = i >> 6, dd = i & 63, t = row >> 2, r = row & 3;
    qs[i] = bf2f(((const u16*)(p.ws + W_Q))[(size_t)(NTP + b * 4 + t) * 512 + (g * 4 + r) * 64 + dd]); }
  for (int i = tid; i < 4 * 129; i += 256) { const int r = i / 129, rel = i % 129; const int bk = rel < 128 ? T5B[rel] : 31; btab[i] = p.rel_bias[bk * 8 + g * 4 + r]; }
  __syncthreads();
  const int seq = BATCH + b;
  {
    const u16* kc = (const u16*)(p.ws + W_KCMP) + (size_t)(seq * 2 + g) * 128 * 64;
    const u16* vc = (const u16*)(p.ws + W_VCMP) + (size_t)(seq * 2 + g) * 128 * 64;
    auto kl = [&](int j, float* tl) {
_Pragma("unroll 1")
 for (int i = tid; i < 4096; i += 256) { const int k = i >> 6, dd = i & 63; tl[k * 65 + dd] = bf2f(kc[(size_t)(j * 64 + k) * 64 + dd]); } };
    auto vl = [&](int j, float* tl) {
_Pragma("unroll 1")
 for (int i = tid; i < 4096; i += 256) { const int k = i >> 6, dd = i & 63; tl[k * 65 + dd] = bf2f(vc[(size_t)(j * 64 + k) * 64 + dd]); } };
    auto sf = [&](int row, int key, float& bias) { const int rel = PAST + (row >> 2) - (16 * key + 31); bias = btab[(row & 3) * 129 + (rel < 128 ? rel : 128)]; return true; };
    sattend<16>(qs, 0, 127, Sc, tile, obr, kl, vl, sf);
  }
  for (int i = tid; i < 1024; i += 256) { const int row = i >> 6; ofin[i] = ((const float*)(p.ws + W_GATE))[(size_t)(NTP + b * 4 + (row >> 2)) * 24 + g * 4 + (row & 3)] * obr[i]; }
  if (tid < 4 * 33) {
    const int t = tid / 33, j = tid % 33; float s = 0.f;
    for (int r = 0; r < 4; ++r) {
      const float* pr = Sc + (t * 4 + r) * SA_KMAX;
      for (int u = -1; u <= 3; ++u) { const int n = 4 * j + u; if (n >= 0 && n < 127) s += pr[n] * ((u == -1 || u == 3) ? 1.f : 2.f); }
    }
    imp[tid] = s;
  }
  __syncthreads();
  if (tid < 4) {
    const int t = tid; int* sl = sel + t * 8; sl[0] = 0; sl[1] = 31; sl[2] = 32;
    unsigned taken = 0u;
    for (int c = 0; c < 5; ++c) {
      float best = -1.f; int bi = 1;
      for (int j = 1; j <= 30; ++j) { const float v = imp[t * 33 + j]; if (!((taken >> j) & 1u) && v > best) { best = v; bi = j; } }
      taken |= 1u << bi; sl[3 + c] = bi;
    }
  }
  __syncthreads();
  for (int t = 0; t < 4; ++t) {
    const int* sl = sel + t * 8;
    auto ld = [&](const float* cache, const float* fresh, int j, float* tl) {
      const int blk = sl[j];
#pragma unroll 1
      for (int i = tid; i < 4096; i += 256) {
        const int k = i >> 6, dd = i & 63; float v = 0.f;
        if (blk < 32) { const int pos = blk * 64 + k; const int page = p.pt[b * 16 + (pos >> 7)]; v = cache[(((size_t)page * 128 + (pos & 127)) * 2 + g) * 64 + dd]; }
        else if (k < 4) v = fresh[(size_t)(b * 4 + k) * 128 + g * 64 + dd];
        tl[k * 65 + dd] = v;
      }
    };
    auto kl = [&](int j, float* tl) { ld(p.csk, p.out + O_SCK + 2 * (size_t)NTS * 128, j, tl); };
    auto vl = [&](int j, float* tl) { ld(p.csv, p.out + O_SCK + 3 * (size_t)NTS * 128, j, tl); };
    auto sf = [&](int row, int key, float& bias) { const int kpos = sl[key >> 6] * 64 + (key & 63); const int rel = PAST + t - kpos;
      bias = btab[row * 129 + (rel < 0 ? 0 : (rel < 128 ? rel : 128))]; return rel >= 0; };
    sattend<4>(qs, t * 4, 512, Sc, tile, obr + t * 256, kl, vl, sf);
  }
  for (int i = tid; i < 1024; i += 256) { const int row = i >> 6; ofin[i] += ((const float*)(p.ws + W_GATE))[(size_t)(NTP + b * 4 + (row >> 2)) * 24 + 8 + g * 4 + (row & 3)] * obr[i]; }
  __syncthreads();
  {
    auto ld = [&](const float* st, const float* fresh, int j, float* tl) {
#pragma unroll 1
      for (int i = tid; i < 4096; i += 256) {
        const int k = i >> 6, dd = i & 63, key = j * 64 + k; float v = 0.f;
        if (key < 512) v = st[((size_t)b * 512 + key) * 128 + g * 64 + dd];
        else if (key < 516) v = fresh[((size_t)b * 512 + 508 + key - 512) * 128 + g * 64 + dd];
        tl[k * 65 + dd] = v;
      }
    };
    auto kl = [&](int j, float* tl) { ld(p.swk, p.out + O_SWK, j, tl); };
    auto vl = [&](int j, float* tl) { ld(p.swv, p.out + O_SWK + (size_t)DEC_BATCH * 512 * 128, j, tl); };
    auto sf = [&](int row, int key, float& bias) { const int kpos = PAST - 512 + key; const int rel = PAST + (row >> 2) - kpos;
      bias = btab[(row & 3) * 129 + (rel < 0 ? 0 : (rel < 128 ? rel : 128))]; return rel >= 0 && rel < 512; };
    sattend<16>(qs, 0, 516, Sc, tile, obr, kl, vl, sf);
  }
  for (int i = tid; i < 1024; i += 256) {
    const int row = i >> 6, dd = i & 63, t = row >> 2, r = row & 3, hd = g * 4 + r; const size_t tok = (size_t)(NTP + b * 4 + t);
    const float* gt = (const float*)(p.ws + W_GATE) + tok * 24;
    const float o = ofin[i] + gt[16 + hd] * obr[i];
    ((u16*)(p.ws + W_OA))[tok * 512 + hd * 64 + dd] = f2bf(o * bf2f(((const u16*)(p.ws + W_ZA))[tok * 512 + hd * 64 + dd]));
  }
  __syncthreads();
}

constexpr int P2_HP = BATCH * 4 * 2;
constexpr int P2_CMP = BATCH * 2 * 2;
constexpr int P2_SA = DEC_BATCH * 2;
constexpr int P2_HS = DEC_BATCH * 4;
constexpr int P2_TOTAL = P2_HP + P2_CMP + P2_SA + P2_HS;
DI void phase2_item(const Params& p, int it, char* lds) {
  if (it < P2_HP) { hgrn_prompt_item(p, it, lds); return; }
  it -= P2_HP;
  if (it < P2_CMP) {
    const int kv = it & 1, g = (it >> 1) & 1, b = it >> 2;
    LoadCellBf16 al{(const u16*)(p.ws + W_KV) + (size_t)kv * NT * 128 + (size_t)b * 2048 * 128 + g * 64};
    comp_tile(p, al, b, g, kv, lds); return;
  }
  it -= P2_CMP;
  if (it < P2_SA) { sample_attn_item(p, it, lds); return; }
  it -= P2_SA;
  hgrn_sample_item(p, it, lds);
}


constexpr int AKS = 72, AVS = 68, ACS = 132;
DI bf16x8 pack8(const f32x16& x, int s2) {
  uint4 u; u.x = pk2(x[8 * s2], x[8 * s2 + 1]); u.y = pk2(x[8 * s2 + 2], x[8 * s2 + 3]);
  u.z = pk2(x[8 * s2 + 4], x[8 * s2 + 5]); u.w = pk2(x[8 * s2 + 6], x[8 * s2 + 7]);
  return __builtin_bit_cast(bf16x8, u);
}
DI void zero16(f32x16& x) {
#pragma unroll
  for (int i = 0; i < 16; ++i) x[i] = 0.f;
}

template <bool WIN>
DI void attn_tile(const u16* Kt, const u16* Vt, const float* brel_r, const bf16x8 (&qf)[4], int qpos, int kpos0, bool lane_on,
                  float& m_run, float& l_run, f32x16 (&oacc)[2], int ql, int hh) {
  f32x16 sacc[2];
#pragma unroll
  for (int kt = 0; kt < 2; ++kt) {
    zero16(sacc[kt]);
#pragma unroll
    for (int ks = 0; ks < 4; ++ks) {
      const bf16x8 kf = *(const bf16x8*)(Kt + (32 * kt + ql) * AKS + 16 * ks + 8 * hh);
      sacc[kt] = MFMA32(kf, qf[ks], sacc[kt]);
    }
  }
  float mt = -1.0e30f;
#pragma unroll
  for (int kt = 0; kt < 2; ++kt)
#pragma unroll
    for (int i = 0; i < 16; ++i) {
      const int rel = qpos - (kpos0 + 32 * kt + crow(i, hh));
      const bool ok = lane_on && rel >= 0 && (!WIN || rel < 512);
      const float sv = sacc[kt][i] + brel_r[rel < 0 ? 0 : (rel < 128 ? rel : 128)];
      sacc[kt][i] = ok ? sv : -1.0e30f;
      mt = fmaxf(mt, sacc[kt][i]);
    }
  mt = fmaxf(mt, __shfl_xor(mt, 32));
  const float mn = fmaxf(m_run, mt);
  const float alpha = __expf(m_run - mn);
  m_run = mn;
  float ls = 0.f;
#pragma unroll
  for (int kt = 0; kt < 2; ++kt)
#pragma unroll
    for (int i = 0; i < 16; ++i) {
      const float pv = (sacc[kt][i] > -1.0e29f) ? __expf(sacc[kt][i] - mn) : 0.f;
      sacc[kt][i] = pv; ls += pv;
    }
  l_run = l_run * alpha + ls;
#pragma unroll
  for (int dt = 0; dt < 2; ++dt)
#pragma unroll
    for (int i = 0; i < 16; ++i) oacc[dt][i] *= alpha;
#pragma unroll
  for (int kt = 0; kt < 2; ++kt)
#pragma unroll
    for (int s2 = 0; s2 < 2; ++s2) {
      const bf16x8 pf = pack8(sacc[kt], s2);
#pragma unroll
      for (int dt = 0; dt < 2; ++dt) {
        const u16* vp = Vt + (32 * dt + ql) * AVS + 32 * kt + 16 * s2 + 4 * hh;
        const bf16x8 vf = cat8(*(const s16x4*)vp, *(const s16x4*)(vp + 8));
        oacc[dt] = MFMA32(vf, pf, oacc[dt]);
      }
    }
}

DI void attn_load_tile(u16* Kt, u16* Vt, const u16* ksrc  , const u16* vtsrc  ) {
  const int tid = otid();
#pragma unroll
  for (int i = 0; i < 2; ++i) {
    const int idx = tid + 256 * i, rw = idx >> 3, ch = idx & 7;
    *(uint4*)(Kt + rw * AKS + ch * 8) = *(const uint4*)(ksrc + (size_t)rw * 128 + ch * 8);
    const uint4 v = *(const uint4*)(vtsrc + (size_t)rw * 2048 + ch * 8);
    *(uint2*)(Vt + rw * AVS + ch * 8) = make_uint2(v.x, v.y);
    *(uint2*)(Vt + rw * AVS + ch * 8 + 4) = make_uint2(v.z, v.w);
  }
}

DI void prompt_attn_item(const Params& p, int it, char* lds) {
  const int qt = (it < 512) ? (63 - (it & 63)) : (it & 63), g = (it >> 6) & 1, b = (it >> 7) & 7;
  const int t0 = qt * 32;
  const int tid = otid(), lane = tid & 63, w = tid >> 6, ql = lane & 31, hh = lane >> 5, tl = ql >> 2, r = ql & 3;
  const int qpos = t0 + 8 * w + tl, head = g * 4 + r;
  const size_t tok = (size_t)b * 2048 + qpos;
  u16* Kt = (u16*)lds;
  u16* Vt = Kt + 128 * AKS;
  float* brel = (float*)(Vt + 64 * ACS);
  unsigned* wmask = (unsigned*)(brel + 4 * 129);
  const u16* Qb = (const u16*)(p.ws + W_Q);
  __syncthreads();
  for (int i = tid; i < 4 * 129; i += 256) { const int rr = i / 129, rel = i % 129; const int bk = rel < 128 ? T5B[rel] : 31; brel[i] = p.rel_bias[bk * 8 + g * 4 + rr]; }
  bf16x8 qf[4];
#pragma unroll
  for (int ks = 0; ks < 4; ++ks) qf[ks] = *(const bf16x8*)(Qb + tok * 512 + head * 64 + 16 * ks + 8 * hh);
  const float* gt = (const float*)(p.ws + W_GATE) + tok * 24;
  const float* brel_r = brel + r * 129;
  f32x16 of[2];
  unsigned selm;
  {
#pragma unroll
    for (int i = 0; i < 4; ++i) {
      const int idx = tid + 256 * i;
      { const int n = idx >> 3, ch = idx & 7;
        *(uint4*)(Kt + n * AKS + ch * 8) = *(const uint4*)((const u16*)(p.ws + W_KCMP) + ((size_t)(b * 2 + g) * 128 + n) * 64 + ch * 8); }
      { const int dd = idx >> 4, ch = idx & 15;
        const uint4 v = *(const uint4*)((const u16*)(p.ws + W_VCMPT) + ((size_t)(b * 2 + g) * 64 + dd) * 128 + ch * 8);
        *(uint2*)(Vt + dd * ACS + ch * 8) = make_uint2(v.x, v.y); *(uint2*)(Vt + dd * ACS + ch * 8 + 4) = make_uint2(v.z, v.w); }
    }
    __syncthreads();
    f32x16 sacc[4];
#pragma unroll
    for (int kt = 0; kt < 4; ++kt) {
      zero16(sacc[kt]);
#pragma unroll
      for (int ks = 0; ks < 4; ++ks) {
        const bf16x8 kf = *(const bf16x8*)(Kt + (32 * kt + ql) * AKS + 16 * ks + 8 * hh);
        sacc[kt] = MFMA32(kf, qf[ks], sacc[kt]);
      }
    }
    float mt = -1.0e30f;
#pragma unroll
    for (int kt = 0; kt < 4; ++kt)
#pragma unroll
      for (int i = 0; i < 16; ++i) {
        const int n = 32 * kt + crow(i, hh);
        const int rel = qpos - (16 * n + 31);
        const bool ok = rel >= 0 && n < 127;
        const float sv = sacc[kt][i] + brel_r[rel < 0 ? 0 : (rel < 128 ? rel : 128)];
        sacc[kt][i] = ok ? sv : -1.0e30f;
        mt = fmaxf(mt, sacc[kt][i]);
      }
    mt = fmaxf(mt, __shfl_xor(mt, 32));
    float ls = 0.f;
#pragma unroll
    for (int kt = 0; kt < 4; ++kt)
#pragma unroll
      for (int i = 0; i < 16; ++i) { const float pv = (sacc[kt][i] > -1.0e29f) ? __expf(sacc[kt][i] - mt) : 0.f; sacc[kt][i] = pv; ls += pv; }
    ls += __shfl_xor(ls, 32);
    const float inv = ls > 0.f ? 1.f / ls : 0.f;
#pragma unroll
    for (int kt = 0; kt < 4; ++kt)
#pragma unroll
      for (int i = 0; i < 16; ++i) sacc[kt][i] *= inv;
    f32x16 oc[2]; zero16(oc[0]); zero16(oc[1]);
#pragma unroll
    for (int kt = 0; kt < 4; ++kt)
#pragma unroll
      for (int s2 = 0; s2 < 2; ++s2) {
        const bf16x8 pf = pack8(sacc[kt], s2);
#pragma unroll
        for (int dt = 0; dt < 2; ++dt) {
          const u16* vp = Vt + (32 * dt + ql) * ACS + 32 * kt + 16 * s2 + 4 * hh;
          const bf16x8 vf = cat8(*(const s16x4*)vp, *(const s16x4*)(vp + 8));
          oc[dt] = MFMA32(vf, pf, oc[dt]);
        }
      }
    const float g0 = gt[head];
#pragma unroll
    for (int dt = 0; dt < 2; ++dt)
#pragma unroll
      for (int i = 0; i < 16; ++i) of[dt][i] = g0 * oc[dt][i];
    float im[16], cm[16];
#pragma unroll
    for (int kt = 0; kt < 4; ++kt)
#pragma unroll
      for (int q4 = 0; q4 < 4; ++q4) {
        const float p0 = sacc[kt][4 * q4], p1 = sacc[kt][4 * q4 + 1], p2 = sacc[kt][4 * q4 + 2], p3 = sacc[kt][4 * q4 + 3];
        im[4 * kt + q4] = 2.f * (p0 + p1 + p2) + p3; cm[4 * kt + q4] = p3;
      }
#pragma unroll
    for (int m = 0; m < 16; ++m) cm[m] = __shfl_xor(cm[m], 32);
#pragma unroll
    for (int m = 15; m >= 0; --m) im[m] += hh ? cm[m] : (m > 0 ? cm[m - 1] : 0.f);
#pragma unroll
    for (int m = 0; m < 16; ++m) { im[m] += __shfl_xor(im[m], 1); im[m] += __shfl_xor(im[m], 2); }
    float ev[16], od[16];
#pragma unroll
    for (int m = 0; m < 16; ++m) { const float ot = __shfl_xor(im[m], 32); ev[m] = hh ? ot : im[m]; od[m] = hh ? im[m] : ot; }
    const int cur = qpos >> 6;
    if (cur < 8) selm = (2u << cur) - 1u;
    else {
      selm = 1u | (1u << cur) | (1u << (cur - 1));
      for (int c = 0; c < 5; ++c) {
        float best = -1.f;
#pragma unroll
        for (int J = 0; J < 32; ++J) { const float v = (J <= cur && !((selm >> J) & 1u)) ? ((J & 1) ? od[J >> 1] : ev[J >> 1]) : -1.f; best = fmaxf(best, v); }
        int bi = 32;
#pragma unroll
        for (int J = 31; J >= 0; --J) { const float v = (J <= cur && !((selm >> J) & 1u)) ? ((J & 1) ? od[J >> 1] : ev[J >> 1]) : -1.f; if (v == best) bi = J; }
        if (best >= 0.f) selm |= 1u << bi;
      }
    }
    unsigned um = selm;
    um |= __shfl_xor(um, 4); um |= __shfl_xor(um, 8); um |= __shfl_xor(um, 16);
    if (lane == 0) wmask[w] = um;
  }
  __syncthreads();
  const unsigned un = wmask[0] | wmask[1] | wmask[2] | wmask[3];
  {
    float m_run = -1.0e30f, l_run = 0.f; f32x16 oacc[2]; zero16(oacc[0]); zero16(oacc[1]);
    const u16* ks = (const u16*)(p.ws + W_KV) + (size_t)2 * NT * 128 + (size_t)b * 2048 * 128 + g * 64;
    const u16* vt = (const u16*)(p.ws + W_VST) + (size_t)(b * 2 + g) * 64 * 2048;
    for (int j = 0; j < 32; ++j) {
      if (!((un >> j) & 1u)) continue;
      __syncthreads();
      attn_load_tile(Kt, Vt, ks + (size_t)j * 64 * 128, vt + j * 64);
      __syncthreads();
      const bool on = (selm >> j) & 1u;
      if (__ballot(on) != 0ull) attn_tile<false>(Kt, Vt, brel_r, qf, qpos, j * 64, on, m_run, l_run, oacc, ql, hh);
    }
    l_run += __shfl_xor(l_run, 32);
    const float sc = gt[8 + head] * (l_run > 0.f ? 1.f / l_run : 0.f);
#pragma unroll
    for (int dt = 0; dt < 2; ++dt)
#pragma unroll
      for (int i = 0; i < 16; ++i) of[dt][i] += sc * oacc[dt][i];
  }
  {
    float m_run = -1.0e30f, l_run = 0.f; f32x16 oacc[2]; zero16(oacc[0]); zero16(oacc[1]);
    const u16* kw = (const u16*)(p.ws + W_KV) + (size_t)4 * NT * 128 + (size_t)b * 2048 * 128 + g * 64;
    const u16* vt = (const u16*)(p.ws + W_VWT) + (size_t)(b * 2 + g) * 64 * 2048;
    const int jlo = (t0 >= 511) ? ((t0 - 511) >> 6) : 0, jhi = (t0 + 31) >> 6;
    for (int j = jlo; j <= jhi; ++j) {
      __syncthreads();
      attn_load_tile(Kt, Vt, kw + (size_t)j * 64 * 128, vt + j * 64);
      __syncthreads();
      attn_tile<true>(Kt, Vt, brel_r, qf, qpos, j * 64, true, m_run, l_run, oacc, ql, hh);
    }
    l_run += __shfl_xor(l_run, 32);
    const float sc = gt[16 + head] * (l_run > 0.f ? 1.f / l_run : 0.f);
#pragma unroll
    for (int dt = 0; dt < 2; ++dt)
#pragma unroll
      for (int i = 0; i < 16; ++i) of[dt][i] += sc * oacc[dt][i];
  }
  {
    const u16* za = (const u16*)(p.ws + W_ZA) + tok * 512 + head * 64; u16* oa = (u16*)(p.ws + W_OA) + tok * 512 + head * 64;
#pragma unroll
    for (int dt = 0; dt < 2; ++dt)
#pragma unroll
      for (int q4 = 0; q4 < 4; ++q4) {
        const int dd = 32 * dt + 8 * q4 + 4 * hh;
        const uint2 z = *(const uint2*)(za + dd);
        uint2 o; o.x = pk2(of[dt][4 * q4] * bflo(z.x), of[dt][4 * q4 + 1] * bfhi(z.x)); o.y = pk2(of[dt][4 * q4 + 2] * bflo(z.y), of[dt][4 * q4 + 3] * bfhi(z.y));
        *(uint2*)(oa + dd) = o;
      }
  }
}
constexpr int P3_FIN = NTP / 4;
constexpr int P3_ATT = BATCH * 2 * 64;
constexpr int P3_TOTAL = P3_FIN + P3_ATT;

constexpr int P4_TOTAL = G1_MT * 16;
DI void merge_a_tile(const Params& p, int it, char* lds) {
  const int tm = it >> 4, tn = it & 15;
  f32x16 aa[2][1], ab[2][1]; zero_acc<1>(aa); zero_acc<1>(ab);
  { LoadBf16 al{(const u16*)(p.ws + W_OA) + (size_t)tm * 128 * 512, 512}; LoadBf16 bl{(const u16*)(p.ws + W_WBAT) + (size_t)tn * 64 * 512, 512}; gemm_main<1>(aa, al, bl, 8, lds); }
  { LoadBf16 al{(const u16*)(p.ws + W_OB) + (size_t)tm * 128 * 512, 512}; LoadBf16 bl{(const u16*)(p.ws + W_WBBT) + (size_t)tn * 64 * 512, 512}; gemm_main<1>(ab, al, bl, 8, lds); }
  const int tid = threadIdx.x, lane = tid & 63, wave = tid >> 6, wm = wave >> 1, wn = wave & 1, r = lane & 31, h = lane >> 5;
#pragma unroll
  for (int mi = 0; mi < 2; ++mi) {
    const int c = tn * 64 + wn * 32 + r;
#pragma unroll
    for (int i = 0; i < 16; ++i) {
      const size_t off = (size_t)(tm * 128 + wm * 64 + mi * 32 + crow(i, h)) * 1024 + c;
      const float y = bf2f(((const u16*)(p.ws + W_SA))[off]) * aa[mi][0][i] + bf2f(((const u16*)(p.ws + W_SB))[off]) * ab[mi][0][i];
      ((u16*)(p.ws + W_Y))[off] = f2bf(y);
    }
  }
}
constexpr int P5_TOTAL = G1_MT * 8;
DI void merge_b_tile(const Params& p, int it, char* lds) {
  const int tm = it >> 3, tn = it & 7;
  f32x16 acc[2][2]; zero_acc<2>(acc);
  LoadBf16 al{(const u16*)(p.ws + W_Y) + (size_t)tm * 128 * 1024, 1024}; LoadBf16 bl{(const u16*)(p.ws + W_WOUTT) + (size_t)tn * 128 * 1024, 1024};
  gemm_main<2>(acc, al, bl, 16, lds);
  const int tid = threadIdx.x, lane = tid & 63, wave = tid >> 6, wm = wave >> 1, wn = wave & 1, r = lane & 31, h = lane >> 5;
  const float* xin = (tm < 128) ? p.x_prompt : (p.x_sample - (size_t)NTP * 1024);
#pragma unroll
  for (int mi = 0; mi < 2; ++mi) {
#pragma unroll
    for (int i = 0; i < 16; ++i) {
      const size_t row = (size_t)(tm * 128 + wm * 64 + mi * 32 + crow(i, h));
      float ss = 0.f;
#pragma unroll
      for (int ni = 0; ni < 2; ++ni) {
        const int c = tn * 128 + wn * 64 + ni * 32 + r;
        const float hv = acc[mi][ni][i] + xin[row * 1024 + c];
        p.out[row * 1024 + c] = hv; ss += hv * hv;
      }
      ss += __shfl_xor(ss, 1); ss += __shfl_xor(ss, 2); ss += __shfl_xor(ss, 4); ss += __shfl_xor(ss, 8); ss += __shfl_xor(ss, 16);
      if (r == 0) ((float*)(p.ws + W_SS))[row * 16 + tn * 2 + wn] = ss;
    }
  }
}
constexpr int P6_TOTAL = NT / 4;
DI void final_norm_item(const Params& p, int it) {
  const int lane = threadIdx.x & 63, wave = threadIdx.x >> 6; const size_t row = (size_t)it * 4 + wave;
  const float* ssp = (const float*)(p.ws + W_SS) + row * 16;
  float ss = 0.f;
#pragma unroll
  for (int i = 0; i < 16; ++i) ss += ssp[i];
  const float rs = rsqrtf(ss * (1.f / 1024.f) + 1e-6f);
  float* o = p.out + row * 1024;
#pragma unroll
  for (int i = 0; i < 4; ++i) {
    float4 v = *(float4*)(o + (i * 64 + lane) * 4); const float4 gg = *(const float4*)(p.final_g + (i * 64 + lane) * 4);
    v.x *= rs * gg.x; v.y *= rs * gg.y; v.z *= rs * gg.z; v.w *= rs * gg.w;
    *(float4*)(o + (i * 64 + lane) * 4) = v;
  }
}

constexpr int LDS_BYTES = 64 * 1024;

template <int PH>
DI void run_phase(const Params& p, char* lds) {
  if (PH == 0) { for (int it = blockIdx.x; it < P0_TOTAL; it += gridDim.x) phase0_item(p, it, lds); }
  if (PH == 1) { for (int it = blockIdx.x; it < P1_TOTAL; it += gridDim.x) phase1_item(p, it, lds); }
  if (PH == 2) { for (int it = blockIdx.x; it < P2_TOTAL; it += gridDim.x) phase2_item(p, it, lds); }
  if (PH == 3) { for (int it = blockIdx.x; it < P3_TOTAL; it += gridDim.x) { if (it < P3_FIN) hgrn_finish_item(p, it); else prompt_attn_item(p, it - P3_FIN, lds); } }
  if (PH == 4) { for (int it = blockIdx.x; it < P4_TOTAL; it += gridDim.x) merge_a_tile(p, it, lds); }
  if (PH == 5) { for (int it = blockIdx.x; it < P5_TOTAL; it += gridDim.x) merge_b_tile(p, it, lds); }
  if (PH == 6) { for (int it = blockIdx.x; it < P6_TOTAL; it += gridDim.x) final_norm_item(p, it); }
}

template <int PH>
__global__ void __launch_bounds__(256, 2) k_phase(Params p) {
  __shared__ __attribute__((aligned(16))) char lds[LDS_BYTES];
  run_phase<PH>(p, lds);
}

extern "C" void kernel_launch(void* const* d_in, const int* in_sizes, int n_in, void* d_out, int out_size,
                              void* d_ws, size_t ws_size, hipStream_t stream) {
  Params p{};
  p.x_prompt = (const float*)d_in[0]; p.x_sample = (const float*)d_in[1];
  p.cck = (const float*)d_in[2]; p.ccv = (const float*)d_in[3]; p.csk = (const float*)d_in[4]; p.csv = (const float*)d_in[5];
  p.swk = (const float*)d_in[6]; p.swv = (const float*)d_in[7]; p.shg = (const float*)d_in[8]; p.pt = (const int*)d_in[9];
  p.norm_g = (const float*)d_in[10]; p.w_in = (const float*)d_in[11];
  p.pos_k = (const float*)d_in[12]; p.w1_k = (const float*)d_in[13]; p.w2_k = (const float*)d_in[14];
  p.pos_v = (const float*)d_in[15]; p.w1_v = (const float*)d_in[16]; p.w2_v = (const float*)d_in[17];
  p.rel_bias = (const float*)d_in[18]; p.hg_lower = (const float*)d_in[19]; p.hg_norm_g = (const float*)d_in[20];
  p.w_ba = (const float*)d_in[21]; p.w_bb = (const float*)d_in[22]; p.w_out = (const float*)d_in[23]; p.final_g = (const float*)d_in[24];
  p.out = (float*)d_out; p.ws = (char*)d_ws;
  if ((size_t)out_size != O_END || ws_size < W_END) { fprintf(stderr, "kernel_launch: unexpected sizes out=%d ws=%zu (need %zu / %zu)\n", out_size, ws_size, (size_t)O_END, (size_t)W_END); return; }
  const int grid = 512;
  hipLaunchKernelGGL(k_phase<0>, dim3(grid), dim3(256), 0, stream, p);
  hipLaunchKernelGGL(k_phase<1>, dim3(grid), dim3(256), 0, stream, p);
  hipLaunchKernelGGL(k_phase<2>, dim3(grid), dim3(256), 0, stream, p);
  hipLaunchKernelGGL(k_phase<3>, dim3(grid), dim3(256), 0, stream, p);
  hipLaunchKernelGGL(k_phase<4>, dim3(grid), dim3(256), 0, stream, p);
  hipLaunchKernelGGL(k_phase<5>, dim3(grid), dim3(256), 0, stream, p);
  hipLaunchKernelGGL(k_phase<6>, dim3(grid), dim3(256), 0, stream, p);
}
```

```cpp
#include <hip/hip_runtime.h>
#include <hip/hip_cooperative_groups.h>
#include <cstdio>
namespace cg = cooperative_groups;

#define DI __device__ __forceinline__
typedef unsigned short u16;
typedef __attribute__((ext_vector_type(8))) short bf16x8;
typedef __attribute__((ext_vector_type(4))) short s16x4;
typedef __attribute__((ext_vector_type(16))) float f32x16;
typedef __attribute__((ext_vector_type(4))) float f32x4;
typedef __attribute__((ext_vector_type(2))) float f32x2;
typedef __attribute__((ext_vector_type(2))) __bf16 bf16x2v;
#define MFMA32(a, b, c) __builtin_amdgcn_mfma_f32_32x32x16_bf16((a), (b), (c), 0, 0, 0)
#define MFMA16(a, b, c) __builtin_amdgcn_mfma_f32_16x16x32_bf16((a), (b), (c), 0, 0, 0)

constexpr int D_MODEL = 1024, BATCH = 8, SEQ = 2048, DEC_BATCH = 128, DEC_SEQ = 4, PAST = 2048;
constexpr int NTP = BATCH * SEQ;
constexpr int NTS = DEC_BATCH * DEC_SEQ;
constexpr int NT = NTP + NTS;
constexpr int IN_COLS = 5912, NPAD = 6016;
constexpr int NSEQ = BATCH + DEC_BATCH;

constexpr size_t O_YP = 0;
constexpr size_t O_YS = O_YP + (size_t)NTP * 1024;
constexpr size_t O_PCK = O_YS + (size_t)NTS * 1024;
constexpr size_t O_PWK = O_PCK + 4 * (size_t)NTP * 128;
constexpr size_t O_PHG = O_PWK + 2 * (size_t)BATCH * 512 * 128;
constexpr size_t O_SCK = O_PHG + (size_t)BATCH * 4 * 128 * 128;
constexpr size_t O_SWK = O_SCK + 4 * (size_t)NTS * 128;
constexpr size_t O_SHG = O_SWK + 2 * (size_t)DEC_BATCH * 512 * 128;
constexpr size_t O_END = O_SHG + (size_t)DEC_BATCH * 4 * 128 * 128;

constexpr size_t al256(size_t x) { return (x + 255) & ~(size_t)255; }
constexpr size_t W_WINT = 0;
constexpr size_t W_WBAT = al256(W_WINT + (size_t)NPAD * 1024 * 2);
constexpr size_t W_WBBT = al256(W_WBAT + (size_t)1024 * 512 * 2);
constexpr size_t W_WOUTT = al256(W_WBBT + (size_t)1024 * 512 * 2);
constexpr size_t W_W1T = al256(W_WOUTT + (size_t)1024 * 1024 * 2);
constexpr size_t W_C1 = al256(W_W1T + (size_t)2 * 128 * 1024 * 2);
constexpr size_t W_XN = al256(W_C1 + 2 * 64 * 4);
constexpr size_t W_Q = al256(W_XN + (size_t)NT * 1024 * 2);
constexpr size_t W_KV = al256(W_Q + (size_t)NT * 512 * 2);
constexpr size_t W_VST = al256(W_KV + (size_t)6 * NT * 128 * 2);
constexpr size_t W_VWT = al256(W_VST + (size_t)8 * 2 * 64 * 2048 * 2);
constexpr size_t W_GATE = al256(W_VWT + (size_t)8 * 2 * 64 * 2048 * 2);
constexpr size_t W_ZA = al256(W_GATE + (size_t)NT * 24 * 4);
constexpr size_t W_QB = al256(W_ZA + (size_t)NT * 512 * 2);
constexpr size_t W_KB = al256(W_QB + (size_t)NT * 512 * 2);
constexpr size_t W_GB = al256(W_KB + (size_t)NT * 512 * 2);
constexpr size_t W_VB = al256(W_GB + (size_t)NT * 512 * 4);
constexpr size_t W_ZB = al256(W_VB + (size_t)NT * 512 * 2);
constexpr size_t W_SA = al256(W_ZB + (size_t)NT * 512 * 2);
constexpr size_t W_SB = al256(W_SA + (size_t)NT * 1024 * 2);
constexpr size_t W_KCMP = al256(W_SB + (size_t)NT * 1024 * 2);
constexpr size_t W_VCMP = al256(W_KCMP + (size_t)NSEQ * 2 * 128 * 64 * 2);
constexpr size_t W_VCMPT = al256(W_VCMP + (size_t)NSEQ * 2 * 128 * 64 * 2);
constexpr size_t W_OA = al256(W_VCMPT + (size_t)8 * 2 * 64 * 128 * 2);
constexpr size_t W_OB = al256(W_OA + (size_t)NT * 512 * 2);
constexpr size_t W_Y = al256(W_OB + (size_t)NT * 512 * 2);
constexpr size_t W_SS = al256(W_Y + (size_t)NT * 1024 * 2);
constexpr size_t W_ORAW = al256(W_SS + (size_t)NT * 16 * 4);
constexpr size_t W_OSS = al256(W_ORAW + (size_t)NTP * 512 * 4);
constexpr size_t W_END = al256(W_OSS + (size_t)NTP * 8 * 4);

struct Params {
  const float* x_prompt; const float* x_sample;
  const float* cck; const float* ccv; const float* csk; const float* csv;
  const float* swk; const float* swv; const float* shg; const int* pt;
  const float* norm_g; const float* w_in;
  const float* pos_k; const float* w1_k; const float* w2_k;
  const float* pos_v; const float* w1_v; const float* w2_v;
  const float* rel_bias; const float* hg_lower; const float* hg_norm_g;
  const float* w_ba; const float* w_bb; const float* w_out; const float* final_g;
  float* out; char* ws;
};

DI unsigned pk2(float a, float b) { f32x2 v = {a, b}; bf16x2v r = __builtin_convertvector(v, bf16x2v); return __builtin_bit_cast(unsigned, r); }
DI u16 f2bf(float a) { return (u16)(pk2(a, 0.f) & 0xffffu); }
DI float bf2f(u16 v) { return __uint_as_float(((unsigned)v) << 16); }
DI float bflo(unsigned v) { return __uint_as_float(v << 16); }
DI float bfhi(unsigned v) { return __uint_as_float(v & 0xffff0000u); }
DI float sigmoidf_(float x) { return 1.f / (1.f + __expf(-x)); }
DI float siluf_(float x) { return x / (1.f + __expf(-x)); }
DI int otid() { int t = threadIdx.x; asm volatile("" : "+v"(t)); return t; }
DI int crow(int reg, int h) { return (reg & 3) + 8 * (reg >> 2) + 4 * h; }
DI float wave_sum(float v) {
#pragma unroll
  for (int o = 32; o >= 1; o >>= 1) v += __shfl_xor(v, o);
  return v;
}
DI float wave_max(float v) {
#pragma unroll
  for (int o = 32; o >= 1; o >>= 1) v = fmaxf(v, __shfl_xor(v, o));
  return v;
}

__device__ const unsigned char T5B[128] = {
  0,1,2,3,4,5,6,7,8,9,10,11,12,13,14,15,
  16,16,16,17,17,18,18,18,19,19,19,20,20,20,20,21,
  21,21,21,22,22,22,22,22,23,23,23,23,23,23,24,24,
  24,24,24,24,25,25,25,25,25,25,25,26,26,26,26,26,
  26,26,26,27,27,27,27,27,27,27,27,27,27,28,28,28,
  28,28,28,28,28,28,28,29,29,29,29,29,29,29,29,29,
  29,29,29,30,30,30,30,30,30,30,30,30,30,30,30,30,
  30,31,31,31,31,31,31,31,31,31,31,31,31,31,31,31};

DI void transpose_tile(const float* __restrict__ src, int ldsrc, int K, int N, int k0, int n0,
                       u16* __restrict__ dst, int lddst, int dst_row_off, int dst_k0, int winperm, float* tl) {
  const int tid = threadIdx.x;
  __syncthreads();
  {
    const int n = tid & 63, kb = tid >> 6;
#pragma unroll
    for (int i = 0; i < 16; ++i) {
      const int kk = kb + 4 * i;
      float v = 0.f;
      if (n0 + n < N && k0 + kk < K) v = src[(size_t)(k0 + kk) * ldsrc + n0 + n];
      tl[kk * 65 + n] = v;
    }
  }
  __syncthreads();
  {
    const int k = (tid & 31) * 2, nb = tid >> 5;
#pragma unroll
    for (int i = 0; i < 8; ++i) {
      const int nn = nb + 8 * i;
      int n = n0 + nn;
      if (n < N) {
        if (winperm) n = (n < 1280) ? n : ((n < 1304) ? (5888 + n - 1280) : (n - 24));
        const unsigned v = pk2(tl[k * 65 + nn], tl[(k + 1) * 65 + nn]);
        *(unsigned*)(dst + (size_t)(dst_row_off + n) * lddst + dst_k0 + k) = v;
      }
    }
  }
}

constexpr int P0_WIN = 16 * 93;
constexpr int P0_WBA = 8 * 16, P0_WBB = 8 * 16, P0_WOUT = 16 * 16, P0_W1 = 32 * 2;
constexpr int P0_TR = P0_WIN + P0_WBA + P0_WBB + P0_WOUT + P0_W1;
constexpr int P0_C1 = 2;
constexpr int P0_NORM = NT / 4;
constexpr int P0_WCP = 2 * DEC_BATCH;
constexpr int P0_PAD = NPAD - IN_COLS;
constexpr int P0_TOTAL = P0_TR + P0_C1 + P0_NORM + P0_WCP + P0_PAD;

DI void phase0_item(const Params& p, int it, char* lds) {
  const int tid = threadIdx.x, lane = tid & 63, wave = tid >> 6;
  float* tl = (float*)lds;
  if (it < P0_TR) {
    if (it < P0_WIN) {
      const int kt = it / 93, nt = it % 93;
      transpose_tile(p.w_in, IN_COLS, 1024, IN_COLS, kt * 64, nt * 64, (u16*)(p.ws + W_WINT), 1024, 0, kt * 64, 1, tl);
      return;
    }
    it -= P0_WIN;
    if (it < P0_WBA) { const int kt = it / 16, nt = it % 16;
      transpose_tile(p.w_ba, 1024, 512, 1024, kt * 64, nt * 64, (u16*)(p.ws + W_WBAT), 512, 0, kt * 64, 0, tl); return; }
    it -= P0_WBA;
    if (it < P0_WBB) { const int kt = it / 16, nt = it % 16;
      transpose_tile(p.w_bb, 1024, 512, 1024, kt * 64, nt * 64, (u16*)(p.ws + W_WBBT), 512, 0, kt * 64, 0, tl); return; }
    it -= P0_WBB;
    if (it < P0_WOUT) { const int kt = it / 16, nt = it % 16;
      transpose_tile(p.w_out, 1024, 1024, 1024, kt * 64, nt * 64, (u16*)(p.ws + W_WOUTT), 1024, 0, kt * 64, 0, tl); return; }
    it -= P0_WOUT;
    { const int kv = it >> 5, kt = it & 31;
      const float* w1 = kv ? p.w1_v : p.w1_k;
      transpose_tile(w1, 64, 2048, 64, kt * 64, 0, (u16*)(p.ws + W_W1T) + (size_t)kv * 128 * 1024, 1024,
                     (kt >= 16) ? 64 : 0, (kt & 15) * 64, 0, tl); return; }
  }
  it -= P0_TR;
  if (it < P0_C1) {
    const float* pos = it ? p.pos_v : p.pos_k; const float* w1 = it ? p.w1_v : p.w1_k;
    const int j = tid & 63, part = tid >> 6;
    float s = 0.f;
    for (int i = part * 512; i < part * 512 + 512; ++i) s += pos[i] * w1[(size_t)i * 64 + j];
    __syncthreads();
    tl[part * 64 + j] = s;
    __syncthreads();
    if (tid < 64) ((float*)(p.ws + W_C1))[it * 64 + tid] = tl[tid] + tl[64 + tid] + tl[128 + tid] + tl[192 + tid];
    return;
  }
  it -= P0_C1;
  if (it < P0_NORM) {
    const int row = it * 4 + wave;
    const float* x = (row < NTP) ? (p.x_prompt + (size_t)row * 1024) : (p.x_sample + (size_t)(row - NTP) * 1024);
    float4 v[4]; float ss = 0.f;
#pragma unroll
    for (int i = 0; i < 4; ++i) { v[i] = *(const float4*)(x + (i * 64 + lane) * 4); ss += v[i].x * v[i].x + v[i].y * v[i].y + v[i].z * v[i].z + v[i].w * v[i].w; }
    ss = wave_sum(ss);
    const float rs = rsqrtf(ss * (1.f / 1024.f) + 1e-6f);
    u16* xn = (u16*)(p.ws + W_XN) + (size_t)row * 1024;
#pragma unroll
    for (int i = 0; i < 4; ++i) {
      const float4 g = *(const float4*)(p.norm_g + (i * 64 + lane) * 4);
      uint2 o; o.x = pk2(v[i].x * rs * g.x, v[i].y * rs * g.y); o.y = pk2(v[i].z * rs * g.z, v[i].w * rs * g.w);
      *(uint2*)(xn + (i * 64 + lane) * 4) = o;
    }
    return;
  }
  it -= P0_NORM;
  if (it < P0_WCP) {
    const int kv = it / DEC_BATCH, b = it % DEC_BATCH;
    const float4* src = (const float4*)((kv ? p.swv : p.swk) + ((size_t)b * 512 + 4) * 128);
    float4* dst = (float4*)(p.out + O_SWK + (size_t)kv * DEC_BATCH * 512 * 128 + (size_t)b * 512 * 128);
    for (int i = tid; i < 508 * 32; i += 256) dst[i] = src[i];
    return;
  }
  it -= P0_WCP;
  { u16* d = (u16*)(p.ws + W_WINT) + (size_t)(IN_COLS + it) * 1024; *(uint2*)(d + tid * 4) = make_uint2(0u, 0u); }
}

constexpr int GST = 72;
struct LoadBf16 {
  const u16* base; int ld;
  DI uint4 load(int row, int ch, int kt) const { return *(const uint4*)(base + (size_t)row * ld + kt * 64 + ch * 8); }
};
struct LoadCellBf16 {
  const u16* base;
  DI uint4 load(int row, int ch, int kt) const { return *(const uint4*)(base + (size_t)(row * 16 + kt) * 128 + ch * 8); }
};
struct LoadCellPage {
  const float* cache; const int* pt; int g;
  DI uint4 load(int row, int ch, int kt) const {
    const int pos = row * 16 + kt; const int page = pt[pos >> 7];
    const float* s = cache + (((size_t)page * 128 + (pos & 127)) * 2 + g) * 64 + ch * 8;
    const float4 a = *(const float4*)s, b = *(const float4*)(s + 4);
    uint4 r; r.x = pk2(a.x, a.y); r.y = pk2(a.z, a.w); r.z = pk2(b.x, b.y); r.w = pk2(b.z, b.w); return r;
  }
};

template <int NI, class AL, class BL>
DI void gemm_main(f32x16 (&acc)[2][NI], const AL& al, const BL& bl, int nkt, char* lds) {
  u16* sA = (u16*)lds; u16* sB = sA + 128 * GST;
  const int tid = otid(), lane = tid & 63, wave = tid >> 6, wm = wave >> 1, wn = wave & 1;
  const int lrow = tid >> 3, lch = tid & 7, r = lane & 31, h = lane >> 5;
  uint4 ra[4], rb[2 * NI];
#pragma unroll
  for (int i = 0; i < 4; ++i) ra[i] = al.load(lrow + 32 * i, lch, 0);
#pragma unroll
  for (int i = 0; i < 2 * NI; ++i) rb[i] = bl.load(lrow + 32 * i, lch, 0);
  for (int kt = 0; kt < nkt; ++kt) {
    __syncthreads();
#pragma unroll
    for (int i = 0; i < 4; ++i) *(uint4*)(sA + (lrow + 32 * i) * GST + lch * 8) = ra[i];
#pragma unroll
    for (int i = 0; i < 2 * NI; ++i) *(uint4*)(sB + (lrow + 32 * i) * GST + lch * 8) = rb[i];
    __syncthreads();
    if (kt + 1 < nkt) {
#pragma unroll
      for (int i = 0; i < 4; ++i) ra[i] = al.load(lrow + 32 * i, lch, kt + 1);
#pragma unroll
      for (int i = 0; i < 2 * NI; ++i) rb[i] = bl.load(lrow + 32 * i, lch, kt + 1);
    }
#pragma unroll
    for (int s = 0; s < 4; ++s) {
      bf16x8 a[2], bb[NI];
#pragma unroll
      for (int mi = 0; mi < 2; ++mi) a[mi] = *(const bf16x8*)(sA + (wm * 64 + mi * 32 + r) * GST + s * 16 + 8 * h);
#pragma unroll
      for (int ni = 0; ni < NI; ++ni) bb[ni] = *(const bf16x8*)(sB + (wn * 32 * NI + ni * 32 + r) * GST + s * 16 + 8 * h);
#pragma unroll
      for (int mi = 0; mi < 2; ++mi)
#pragma unroll
        for (int ni = 0; ni < NI; ++ni) acc[mi][ni] = MFMA32(a[mi], bb[ni], acc[mi][ni]);
    }
  }
}
template <int NI>
DI void zero_acc(f32x16 (&acc)[2][NI]) {
#pragma unroll
  for (int a = 0; a < 2; ++a)
#pragma unroll
    for (int b = 0; b < NI; ++b)
#pragma unroll
      for (int i = 0; i < 16; ++i) acc[a][b][i] = 0.f;
}

constexpr int G1_MT = NT / 128, G1_NT = NPAD / 128;
constexpr int P1_GEMM = G1_MT * G1_NT;
constexpr int P1_CMP = DEC_BATCH * 2 * 2;
constexpr int P1_TOTAL = P1_CMP + P1_GEMM;

DI void proj_tile(const Params& p, int tm, int tn, char* lds) {
  f32x16 acc[2][2]; zero_acc<2>(acc);
  LoadBf16 al{(const u16*)(p.ws + W_XN) + (size_t)tm * 128 * 1024, 1024};
  LoadBf16 bl{(const u16*)(p.ws + W_WINT) + (size_t)tn * 128 * 1024, 1024};
  gemm_main<2>(acc, al, bl, 16, lds);
  const int tid = otid(), lane = tid & 63, wave = tid >> 6, wm = wave >> 1, wn = wave & 1, r = lane & 31, h = lane >> 5;
  const bool samp = tm >= 128;
#pragma unroll
  for (int mi = 0; mi < 2; ++mi)
#pragma unroll
    for (int ni = 0; ni < 2; ++ni) {
      const int c = wn * 64 + ni * 32 + r;
      const int row0 = tm * 128 + wm * 64 + mi * 32;
      if (tn < 4) {
        u16* d = (u16*)(p.ws + W_Q) + tn * 128 + c;
#pragma unroll
        for (int i = 0; i < 16; ++i) d[(size_t)(row0 + crow(i, h)) * 512] = f2bf(acc[mi][ni][i] * 0.125f);
      } else if (tn < 10) {
        const int kvg = tn - 4;
        u16* d = (u16*)(p.ws + W_KV) + (size_t)kvg * NT * 128 + c;
#pragma unroll
        for (int i = 0; i < 16; ++i) {
          const int row = row0 + crow(i, h); const float v = acc[mi][ni][i];
          d[(size_t)row * 128] = f2bf(v);
          if (!samp) {
            if (kvg < 4) p.out[O_PCK + (size_t)kvg * NTP * 128 + (size_t)row * 128 + c] = v;
            else { const int t = row & 2047, b = row >> 11;
              if (t >= 1536) p.out[O_PWK + (size_t)(kvg - 4) * BATCH * 512 * 128 + ((size_t)b * 512 + t - 1536) * 128 + c] = v; }
          } else {
            const int srow = row - NTP;
            if (kvg < 4) p.out[O_SCK + (size_t)kvg * NTS * 128 + (size_t)srow * 128 + c] = v;
            else p.out[O_SWK + (size_t)(kvg - 4) * DEC_BATCH * 512 * 128 + ((size_t)(srow >> 2) * 512 + 508 + (srow & 3)) * 128 + c] = v;
          }
        }
        if (!samp && (kvg == 3 || kvg == 5)) {
          u16* vt = (u16*)(p.ws + (kvg == 3 ? W_VST : W_VWT));
          const int b = row0 >> 11, t0 = row0 & 2047, g = c >> 6, dd = c & 63;
          u16* drow = vt + ((size_t)(b * 2 + g) * 64 + dd) * 2048 + t0;
#pragma unroll
          for (int q = 0; q < 4; ++q) {
            uint2 o; o.x = pk2(acc[mi][ni][4 * q], acc[mi][ni][4 * q + 1]); o.y = pk2(acc[mi][ni][4 * q + 2], acc[mi][ni][4 * q + 3]);
            *(uint2*)(drow + 8 * q + 4 * h) = o;
          }
        }
      } else if (tn < 14 || (tn >= 26 && tn < 30)) {
        const bool isA = tn < 14; const int cc = (isA ? tn - 10 : tn - 26) * 128 + c;
        u16* d = (u16*)(p.ws + (isA ? W_ZA : W_ZB)) + cc;
#pragma unroll
        for (int i = 0; i < 16; ++i) d[(size_t)(row0 + crow(i, h)) * 512] = f2bf(siluf_(acc[mi][ni][i]));
      } else if (tn < 18 || (tn >= 22 && tn < 26)) {
        const bool isQ = tn < 18; const int cc = (isQ ? tn - 14 : tn - 22) * 128 + c;
        u16* d = (u16*)(p.ws + (isQ ? W_QB : W_VB)) + cc;
#pragma unroll
        for (int i = 0; i < 16; ++i) d[(size_t)(row0 + crow(i, h)) * 512] = f2bf(acc[mi][ni][i]);
      } else if (tn < 22) {
        const int cc = (tn - 18) * 128 + c;
        const float a0 = p.hg_lower[cc], a1 = p.hg_lower[512 + cc];
        const float lb = 1.f / (1.f + __expf(a1 - a0));
        u16* dk = (u16*)(p.ws + W_KB) + cc; float* dg = (float*)(p.ws + W_GB) + cc;
#pragma unroll
        for (int i = 0; i < 16; ++i) {
          const size_t row = row0 + crow(i, h);
          const float sg = sigmoidf_(acc[mi][ni][i]);
          const float f = lb + (1.f - lb) * sg;
          dg[row * 512] = __logf(f);
          dk[row * 512] = f2bf((1.f - lb) * (1.f - sg));
        }
      } else if (tn < 46) {
        const bool isA = tn < 38; const int cc = (isA ? tn - 30 : tn - 38) * 128 + c;
        u16* d = (u16*)(p.ws + (isA ? W_SA : W_SB)) + cc;
#pragma unroll
        for (int i = 0; i < 16; ++i) d[(size_t)(row0 + crow(i, h)) * 1024] = f2bf(sigmoidf_(acc[mi][ni][i]));
      } else {
        if (c < 24) {
          float* d = (float*)(p.ws + W_GATE) + c;
#pragma unroll
          for (int i = 0; i < 16; ++i) d[(size_t)(row0 + crow(i, h)) * 24] = sigmoidf_(acc[mi][ni][i]);
        }
      }
    }
}

template <class AL>
DI void comp_tile(const Params& p, const AL& al, int seq, int g, int kv, char* lds) {
  f32x16 acc[2][2]; zero_acc<2>(acc);
  LoadBf16 bl{(const u16*)(p.ws + W_W1T) + (size_t)kv * 128 * 1024, 1024};
  gemm_main<2>(acc, al, bl, 16, lds);
  const int tid = otid(), lane = tid & 63, wave = tid >> 6, wm = wave >> 1, wn = wave & 1, r = lane & 31, h = lane >> 5;
  float* T = (float*)lds;
  float* w2s = T + 128 * 65;
  const float* c1 = (const float*)(p.ws + W_C1) + kv * 64;
  const float* w2 = kv ? p.w2_v : p.w2_k;
  __syncthreads();
  for (int i = tid; i < 4096; i += 256) w2s[i] = w2[i];
  if (wn == 1) {
#pragma unroll
    for (int mi = 0; mi < 2; ++mi)
#pragma unroll
      for (int ni = 0; ni < 2; ++ni)
#pragma unroll
        for (int i = 0; i < 16; ++i) T[(wm * 64 + mi * 32 + crow(i, h)) * 65 + ni * 32 + r] = acc[mi][ni][i];
  }
  __syncthreads();
  if (wn == 0) {
#pragma unroll
    for (int mi = 0; mi < 2; ++mi)
#pragma unroll
      for (int ni = 0; ni < 2; ++ni)
#pragma unroll
        for (int i = 0; i < 16; ++i) {
          const int n = wm * 64 + mi * 32 + crow(i, h), j = ni * 32 + r;
          float hv = 0.f;
          if (n < 127) hv = siluf_(acc[mi][ni][i] + T[(n + 1) * 65 + j] + c1[j]);
          acc[mi][ni][i] = hv;
        }
  }
  __syncthreads();
  if (wn == 0) {
#pragma unroll
    for (int mi = 0; mi < 2; ++mi)
#pragma unroll
      for (int ni = 0; ni < 2; ++ni)
#pragma unroll
        for (int i = 0; i < 16; ++i) T[(wm * 64 + mi * 32 + crow(i, h)) * 65 + ni * 32 + r] = acc[mi][ni][i];
  }
  __syncthreads();
  {
    const int n = tid >> 1, eh = tid & 1;
    float o[32];
#pragma unroll
    for (int e = 0; e < 32; ++e) o[e] = 0.f;
#pragma unroll 2
    for (int j = 0; j < 64; ++j) {
      const float hv = T[n * 65 + j];
#pragma unroll
      for (int e = 0; e < 32; ++e) o[e] += hv * w2s[j * 64 + eh * 32 + e];
    }
    u16* dst = (u16*)(p.ws + (kv ? W_VCMP : W_KCMP)) + ((size_t)(seq * 2 + g) * 128 + n) * 64 + eh * 32;
#pragma unroll
    for (int e = 0; e < 32; e += 2) *(unsigned*)(dst + e) = pk2(o[e], o[e + 1]);
    if (kv == 1 && seq < BATCH) {
      u16* dt = (u16*)(p.ws + W_VCMPT) + ((size_t)(seq * 2 + g) * 64 + eh * 32) * 128 + n;
#pragma unroll
      for (int e = 0; e < 32; ++e) dt[(size_t)e * 128] = f2bf(o[e]);
    }
  }
  __syncthreads();
}

DI void phase1_item(const Params& p, int it, char* lds) {
  if (it < P1_CMP) {
    const int kv = it & 1, g = (it >> 1) & 1, b = it >> 2;
    LoadCellPage al{kv ? p.ccv : p.cck, p.pt + b * 16, g};
    comp_tile(p, al, BATCH + b, g, kv, lds);
    return;
  }
  it -= P1_CMP;
  const int tm = it / G1_NT, tn = it % G1_NT;
  proj_tile(p, tm, tn, lds);
}


DI void hgrn_sample_item(const Params& p, int it, char* lds) {
  const int b = it >> 2, h = it & 3, tid = otid(), lane = tid & 63, wave = tid >> 6;
  float* sf = (float*)lds; float* sk = sf + 512; float* sq = sk + 512; float* sv = sq + 512; float* so = sv + 512;
  __syncthreads();
  for (int i = tid; i < 512; i += 256) {
    const int t = i >> 7, c = i & 127; const size_t off = (size_t)(NTP + b * 4 + t) * 512 + h * 128 + c;
    sf[i] = __expf(((const float*)(p.ws + W_GB))[off]);
    sk[i] = bf2f(((const u16*)(p.ws + W_KB))[off]);
    sq[i] = bf2f(((const u16*)(p.ws + W_QB))[off]);
    sv[i] = bf2f(((const u16*)(p.ws + W_VB))[off]);
  }
  __syncthreads();
  const int e = tid & 127, dh = tid >> 7;
  const float* S0 = p.shg + (size_t)(b * 4 + h) * 128 * 128;
  float* S1 = p.out + O_SHG + (size_t)(b * 4 + h) * 128 * 128;
  const float v0 = sv[e], v1 = sv[128 + e], v2 = sv[256 + e], v3 = sv[384 + e];
  float o0 = 0.f, o1 = 0.f, o2 = 0.f, o3 = 0.f;
#pragma unroll 4
  for (int d = dh * 64; d < dh * 64 + 64; ++d) {
    float st = S0[(size_t)d * 128 + e];
    st = sf[d] * st + sk[d] * v0;             o0 += sq[d] * st;
    st = sf[128 + d] * st + sk[128 + d] * v1; o1 += sq[128 + d] * st;
    st = sf[256 + d] * st + sk[256 + d] * v2; o2 += sq[256 + d] * st;
    st = sf[384 + d] * st + sk[384 + d] * v3; o3 += sq[384 + d] * st;
    S1[(size_t)d * 128 + e] = st;
  }
  so[(dh * 4 + 0) * 128 + e] = o0; so[(dh * 4 + 1) * 128 + e] = o1; so[(dh * 4 + 2) * 128 + e] = o2; so[(dh * 4 + 3) * 128 + e] = o3;
  __syncthreads();
  {
    const int t = wave; const size_t row = (size_t)(NTP + b * 4 + t);
    const float a0 = so[t * 128 + lane] + so[(4 + t) * 128 + lane];
    const float a1 = so[t * 128 + 64 + lane] + so[(4 + t) * 128 + 64 + lane];
    const float ss = wave_sum(a0 * a0 + a1 * a1);
    const float rs = rsqrtf(ss * (1.f / 128.f) + 1e-6f);
    const u16* zb = (const u16*)(p.ws + W_ZB) + row * 512 + h * 128; u16* ob = (u16*)(p.ws + W_OB) + row * 512 + h * 128;
    ob[lane] = f2bf(a0 * rs * p.hg_norm_g[h * 128 + lane] * bf2f(zb[lane]));
    ob[64 + lane] = f2bf(a1 * rs * p.hg_norm_g[h * 128 + 64 + lane] * bf2f(zb[64 + lane]));
  }
}

typedef __attribute__((address_space(3))) s16x4 lds_s16x4;
DI s16x4 tr_read(const u16* ptr) { return __builtin_amdgcn_ds_read_tr16_b64_v4i16((lds_s16x4*)ptr); }
DI bf16x8 cat8(s16x4 lo, s16x4 hi) { return __builtin_shufflevector(lo, hi, 0, 1, 2, 3, 4, 5, 6, 7); }
constexpr int HST = 136;

DI void hgrn_prompt_item(const Params& p, int it, char* lds) {
  const int b = it >> 3, h = (it >> 1) & 3, eh = it & 1, tid0 = otid(), w = __builtin_amdgcn_readfirstlane(tid0 >> 6);
  u16* Qe = (u16*)lds; u16* Ke = Qe + 64 * HST; u16* Vv = Ke + 64 * HST; u16* Am = Vv + 64 * 72;
  float* Rr = (float*)(Am + 64 * 72); float* G63 = Rr + 128; float* ssq = G63 + 128;
  const u16* qB = (const u16*)(p.ws + W_QB); const u16* kB = (const u16*)(p.ws + W_KB); const u16* vB = (const u16*)(p.ws + W_VB);
  const float* gB = (const float*)(p.ws + W_GB);
  const int e0 = eh * 64 + 16 * w;
  f32x4 S[8];
#pragma unroll
  for (int a = 0; a < 8; ++a) S[a] = f32x4{0.f, 0.f, 0.f, 0.f};
  for (int ch = 0; ch < 32; ++ch) {
    const size_t tok0 = (size_t)b * 2048 + ch * 64;
    int tid = tid0; asm volatile("" : "+v"(tid));
    const int lane = tid & 63, half = tid >> 7;
    const int c16 = lane & 15, hq = lane >> 4, tq = c16 >> 2, tp = c16 & 3;
    const int d = tid & 127, col = h * 128 + d;
    __syncthreads();
    {
      float run = 0.f;
#pragma unroll 8
      for (int i = 0; i < 32; ++i) run += gB[(tok0 + half * 32 + i) * 512 + col];
      if (half == 0) Rr[d] = run;
    }
#pragma unroll
    for (int i = 0; i < 2; ++i) {
      const int idx = tid + 256 * i, s = idx >> 3, c = idx & 7;
      *(uint4*)(Vv + s * 72 + c * 8) = *(const uint4*)(vB + (tok0 + s) * 512 + h * 128 + eh * 64 + c * 8);
    }
    __syncthreads();
    {
      const float R = Rr[d];
      float run = half ? R : 0.f;
#pragma unroll 4
      for (int i = 0; i < 32; ++i) {
        const int t = half * 32 + i;
        run += gB[(tok0 + t) * 512 + col];
        const float q = bf2f(qB[(tok0 + t) * 512 + col]), k = bf2f(kB[(tok0 + t) * 512 + col]);
        const float dq = fminf(fmaxf(run - R, -80.f), 80.f);
        Qe[t * HST + d] = f2bf(q * __expf(dq));
        Ke[t * HST + d] = f2bf(k * __expf(-dq));
      }
      if (half == 1) G63[d] = run;
    }
    __syncthreads();
    for (int j = 0; j <= w; ++j) {
      f32x4 x = f32x4{0.f, 0.f, 0.f, 0.f};
#pragma unroll
      for (int ks = 0; ks < 4; ++ks) {
        const bf16x8 a = *(const bf16x8*)(Qe + (16 * w + c16) * HST + ks * 32 + 8 * hq);
        const bf16x8 bb = *(const bf16x8*)(Ke + (16 * j + c16) * HST + ks * 32 + 8 * hq);
        x = MFMA16(a, bb, x);
      }
#pragma unroll
      for (int r = 0; r < 4; ++r) {
        const bool ok = (j < w) || (c16 <= 4 * hq + r);
        Am[(16 * w + 4 * hq + r) * 72 + 16 * j + c16] = f2bf(ok ? x[r] : 0.f);
      }
    }
    if ((w & 1) == 0) {
#pragma unroll
      for (int r = 0; r < 4; ++r) Am[(16 * w + 4 * hq + r) * 72 + 16 * (w + 1) + c16] = 0;
    }
    __syncthreads();
    bf16x8 vf[2];
#pragma unroll
    for (int ks = 0; ks < 2; ++ks) {
      const u16* base = Vv + (32 * ks + 8 * hq + tq) * 72 + 16 * w + 4 * tp;
      vf[ks] = cat8(tr_read(base), tr_read(base + 4 * 72));
    }
    f32x4 o[4];
#pragma unroll
    for (int tt = 0; tt < 4; ++tt) o[tt] = f32x4{0.f, 0.f, 0.f, 0.f};
#pragma unroll
    for (int tt = 0; tt < 4; ++tt)
#pragma unroll
      for (int ks = 0; ks <= (tt >> 1); ++ks) {
        const bf16x8 a = *(const bf16x8*)(Am + (16 * tt + c16) * 72 + 32 * ks + 8 * hq);
        o[tt] = MFMA16(a, vf[ks], o[tt]);
      }
#pragma unroll
    for (int k2 = 0; k2 < 4; ++k2) {
      f32x4 ea, eb;
#pragma unroll
      for (int r = 0; r < 4; ++r) { ea[r] = __expf(Rr[32 * k2 + 4 * hq + r]); eb[r] = __expf(Rr[32 * k2 + 16 + 4 * hq + r]); }
      const f32x4 sa = S[2 * k2], sb = S[2 * k2 + 1];
      uint4 u; u.x = pk2(sa[0] * ea[0], sa[1] * ea[1]); u.y = pk2(sa[2] * ea[2], sa[3] * ea[3]);
      u.z = pk2(sb[0] * eb[0], sb[1] * eb[1]); u.w = pk2(sb[2] * eb[2], sb[3] * eb[3]);
      const bf16x8 bfr = __builtin_bit_cast(bf16x8, u);
#pragma unroll
      for (int tt = 0; tt < 4; ++tt) {
        const s16x4 lo = *(const s16x4*)(Qe + (16 * tt + c16) * HST + 32 * k2 + 4 * hq);
        const s16x4 hi = *(const s16x4*)(Qe + (16 * tt + c16) * HST + 32 * k2 + 16 + 4 * hq);
        o[tt] = MFMA16(cat8(lo, hi), bfr, o[tt]);
      }
    }
#pragma unroll
    for (int dt = 0; dt < 8; ++dt) {
      bf16x8 kt[2];
#pragma unroll
      for (int ks = 0; ks < 2; ++ks) {
        const u16* base = Ke + (32 * ks + 8 * hq + tq) * HST + 16 * dt + 4 * tp;
        kt[ks] = cat8(tr_read(base), tr_read(base + 4 * HST));
      }
      f32x4 dd = f32x4{0.f, 0.f, 0.f, 0.f};
      dd = MFMA16(kt[0], vf[0], dd); dd = MFMA16(kt[1], vf[1], dd);
#pragma unroll
      for (int r = 0; r < 4; ++r) {
        const float g63 = G63[16 * dt + 4 * hq + r], rr = Rr[16 * dt + 4 * hq + r];
        S[dt][r] = S[dt][r] * __expf(g63) + __expf(g63 - rr) * dd[r];
      }
    }
#pragma unroll
    for (int tt = 0; tt < 4; ++tt)
#pragma unroll
      for (int r = 0; r < 4; ++r) {
        float v = o[tt][r] * o[tt][r];
        v += __shfl_xor(v, 1); v += __shfl_xor(v, 2); v += __shfl_xor(v, 4); v += __shfl_xor(v, 8);
        if (c16 == 0) ssq[(16 * tt + 4 * hq + r) * 4 + w] = v;
        ((float*)(p.ws + W_ORAW))[(tok0 + 16 * tt + 4 * hq + r) * 512 + h * 128 + e0 + c16] = o[tt][r];
      }
    __syncthreads();
    if (tid < 64) ((float*)(p.ws + W_OSS))[(tok0 + tid) * 8 + h * 2 + eh] = ssq[tid * 4] + ssq[tid * 4 + 1] + ssq[tid * 4 + 2] + ssq[tid * 4 + 3];
  }
  int tidf = tid0; asm volatile("" : "+v"(tidf));
  const int c16 = tidf & 15, hq = (tidf & 63) >> 4;
  float* So = p.out + O_PHG + (size_t)(b * 4 + h) * 128 * 128;
#pragma unroll
  for (int dt = 0; dt < 8; ++dt)
#pragma unroll
    for (int r = 0; r < 4; ++r) So[(size_t)(16 * dt + 4 * hq + r) * 128 + e0 + c16] = S[dt][r];
}

DI void hgrn_finish_item(const Params& p, int it) {
  const int lane = threadIdx.x & 63, wave = threadIdx.x >> 6; const size_t tok = (size_t)it * 4 + wave;
  const int c = lane * 8, hd = lane >> 4;
  const float* ss = (const float*)(p.ws + W_OSS) + tok * 8 + hd * 2;
  const float rs = rsqrtf((ss[0] + ss[1]) * (1.f / 128.f) + 1e-6f);
  const float* orow = (const float*)(p.ws + W_ORAW) + tok * 512 + c;
  const float4 a = *(const float4*)orow, bq = *(const float4*)(orow + 4);
  const float4 g0 = *(const float4*)(p.hg_norm_g + c), g1 = *(const float4*)(p.hg_norm_g + c + 4);
  const uint4 z = *(const uint4*)((const u16*)(p.ws + W_ZB) + tok * 512 + c);
  uint4 o;
  o.x = pk2(a.x * rs * g0.x * bflo(z.x), a.y * rs * g0.y * bfhi(z.x)); o.y = pk2(a.z * rs * g0.z * bflo(z.y), a.w * rs * g0.w * bfhi(z.y));
  o.z = pk2(bq.x * rs * g1.x * bflo(z.z), bq.y * rs * g1.y * bfhi(z.z)); o.w = pk2(bq.z * rs * g1.z * bflo(z.w), bq.w * rs * g1.w * bfhi(z.w));
  *(uint4*)((u16*)(p.ws + W_OB) + tok * 512 + c) = o;
}

constexpr int SA_KMAX = 528;
template <int NR, class KLoad, class VLoad, class ScoreFn>
DI void sattend(const float* qs, int row0, int nkeys, float* Sc, float* tile, float* oout, const KLoad& kload, const VLoad& vload, const ScoreFn& sfn) {
  constexpr int NRQ = NR / 4;
  const int tid = otid(), rq = tid & 3, kk = tid >> 2;
  const int ntile = (nkeys + 63) >> 6;
  for (int j = 0; j < ntile; ++j) {
    __syncthreads();
    kload(j, tile);
    __syncthreads();
#pragma unroll
    for (int rr = 0; rr < NRQ; ++rr) {
      const int row = rq * NRQ + rr; const int key = j * 64 + kk;
      float s = 0.f;
#pragma unroll 16
      for (int dd = 0; dd < 64; ++dd) s += qs[(row0 + row) * 64 + dd] * tile[kk * 65 + dd];
      if (key < nkeys) { float bias; const bool ok = sfn(row, key, bias); Sc[row * SA_KMAX + key] = ok ? (s + bias) : -3.0e38f; }
    }
  }
  __syncthreads();
  {
    constexpr int TPR = 256 / NR;
    const int row = tid / TPR, sub = tid % TPR; const int nk = nkeys;
    float m = -3.0e38f;
    for (int k = sub; k < nk; k += TPR) m = fmaxf(m, Sc[row * SA_KMAX + k]);
#pragma unroll
    for (int o = TPR / 2; o >= 1; o >>= 1) m = fmaxf(m, __shfl_xor(m, o));
    float l = 0.f;
    for (int k = sub; k < nk; k += TPR) { const float sv = Sc[row * SA_KMAX + k]; const float pv = (sv > -1.0e38f) ? __expf(sv - m) : 0.f; Sc[row * SA_KMAX + k] = pv; l += pv; }
#pragma unroll
    for (int o = TPR / 2; o >= 1; o >>= 1) l += __shfl_xor(l, o);
    const float inv = (l > 0.f) ? 1.f / l : 0.f;
    for (int k = sub; k < nk; k += TPR) Sc[row * SA_KMAX + k] *= inv;
  }
  float oacc[NRQ];
#pragma unroll
  for (int rr = 0; rr < NRQ; ++rr) oacc[rr] = 0.f;
  for (int j = 0; j < ntile; ++j) {
    __syncthreads();
    vload(j, tile);
    __syncthreads();
    const int kmax = (nkeys - j * 64 < 64) ? (nkeys - j * 64) : 64;
#pragma unroll 2
    for (int key = 0; key < kmax; ++key) {
      const float vv = tile[key * 65 + kk];
#pragma unroll
      for (int rr = 0; rr < NRQ; ++rr) oacc[rr] += Sc[(rq * NRQ + rr) * SA_KMAX + j * 64 + key] * vv;
    }
  }
#pragma unroll
  for (int rr = 0; rr < NRQ; ++rr) oout[(rq * NRQ + rr) * 64 + kk] = oacc[rr];
  __syncthreads();
}

DI void sample_attn_item(const Params& p, int it, char* lds) {
  const int b = it >> 1, g = it & 1, tid = otid();
  float* qs = (float*)lds;
  float* Sc = qs + 16 * 64;
  float* tile = Sc + 16 * SA_KMAX;
  float* obr = tile + 64 * 65;
  float* ofin = obr + 1024;
  float* imp = ofin + 1024;
  int* sel = (int*)(imp + 4 * 33);
  float* btab = (float*)(sel + 32);
  __syncthreads();
  for (int i = tid; i < 1024; i += 256) { const int row = i >> 6, dd = i & 63, t = row >> 2, r = row & 3;
    qs[i] = bf2f(((const u16*)(p.ws + W_Q))[(size_t)(NTP + b * 4 + t) * 512 + (g * 4 + r) * 64 + dd]); }
  for (int i = tid; i < 4 * 129; i += 256) { const int r = i / 129, rel = i % 129; const int bk = rel < 128 ? T5B[rel] : 31; btab[i] = p.rel_bias[bk * 8 + g * 4 + r]; }
  __syncthreads();
  const int seq = BATCH + b;
  {
    const u16* kc = (const u16*)(p.ws + W_KCMP) + (size_t)(seq * 2 + g) * 128 * 64;
    const u16* vc = (const u16*)(p.ws + W_VCMP) + (size_t)(seq * 2 + g) * 128 * 64;
    auto kl = [&](int j, float* tl) {
_Pragma("unroll 1")
 for (int i = tid; i < 4096; i += 256) { const int k = i >> 6, dd = i & 63; tl[k * 65 + dd] = bf2f(kc[(size_t)(j * 64 + k) * 64 + dd]); } };
    auto vl = [&](int j, float* tl) {
_Pragma("unroll 1")
 for (int i = tid; i < 4096; i += 256) { const int k = i >> 6, dd = i & 63; tl[k * 65 + dd] = bf2f(vc[(size_t)(j * 64 + k) * 64 + dd]); } };
    auto sf = [&](int row, int key, float& bias) { const int rel = PAST + (row >> 2) - (16 * key + 31); bias = btab[(row & 3) * 129 + (rel < 128 ? rel : 128)]; return true; };
    sattend<16>(qs, 0, 127, Sc, tile, obr, kl, vl, sf);
  }
  for (int i = tid; i < 1024; i += 256) { const int row = i >> 6; ofin[i] = ((const float*)(p.ws + W_GATE))[(size_t)(NTP + b * 4 + (row >> 2)) * 24 + g * 4 + (row & 3)] * obr[i]; }
  if (tid < 4 * 33) {
    const int t = tid / 33, j = tid % 33; float s = 0.f;
    for (int r = 0; r < 4; ++r) {
      const float* pr = Sc + (t * 4 + r) * SA_KMAX;
      for (int u = -1; u <= 3; ++u) { const int n = 4 * j + u; if (n >= 0 && n < 127) s += pr[n] * ((u == -1 || u == 3) ? 1.f : 2.f); }
    }
    imp[tid] = s;
  }
  __syncthreads();
  if (tid < 4) {
    const int t = tid; int* sl = sel + t * 8; sl[0] = 0; sl[1] = 31; sl[2] = 32;
    unsigned taken = 0u;
    for (int c = 0; c < 5; ++c) {
      float best = -1.f; int bi = 1;
      for (int j = 1; j <= 30; ++j) { const float v = imp[t * 33 + j]; if (!((taken >> j) & 1u) && v > best) { best = v; bi = j; } }
      taken |= 1u << bi; sl[3 + c] = bi;
    }
  }
  __syncthreads();
  for (int t = 0; t < 4; ++t) {
    const int* sl = sel + t * 8;
    auto ld = [&](const float* cache, const float* fresh, int j, float* tl) {
      const int blk = sl[j];
#pragma unroll 1
      for (int i = tid; i < 4096; i += 256) {
        const int k = i >> 6, dd = i & 63; float v = 0.f;
        if (blk < 32) { const int pos = blk * 64 + k; const int page = p.pt[b * 16 + (pos >> 7)]; v = cache[(((size_t)page * 128 + (pos & 127)) * 2 + g) * 64 + dd]; }
        else if (k < 4) v = fresh[(size_t)(b * 4 + k) * 128 + g * 64 + dd];
        tl[k * 65 + dd] = v;
      }
    };
    auto kl = [&](int j, float* tl) { ld(p.csk, p.out + O_SCK + 2 * (size_t)NTS * 128, j, tl); };
    auto vl = [&](int j, float* tl) { ld(p.csv, p.out + O_SCK + 3 * (size_t)NTS * 128, j, tl); };
    auto sf = [&](int row, int key, float& bias) { const int kpos = sl[key >> 6] * 64 + (key & 63); const int rel = PAST + t - kpos;
      bias = btab[row * 129 + (rel < 0 ? 0 : (rel < 128 ? rel : 128))]; return rel >= 0; };
    sattend<4>(qs, t * 4, 512, Sc, tile, obr + t * 256, kl, vl, sf);
  }
  for (int i = tid; i < 1024; i += 256) { const int row = i >> 6; ofin[i] += ((const float*)(p.ws + W_GATE))[(size_t)(NTP + b * 4 + (row >> 2)) * 24 + 8 + g * 4 + (row & 3)] * obr[i]; }
  __syncthreads();
  {
    auto ld = [&](const float* st, const float* fresh, int j, float* tl) {
#pragma unroll 1
      for (int i = tid; i < 4096; i += 256) {
        const int k = i >> 6, dd = i & 63, key = j * 64 + k; float v = 0.f;
        if (key < 512) v = st[((size_t)b * 512 + key) * 128 + g * 64 + dd];
        else if (key < 516) v = fresh[((size_t)b * 512 + 508 + key - 512) * 128 + g * 64 + dd];
        tl[k * 65 + dd] = v;
      }
    };
    auto kl = [&](int j, float* tl) { ld(p.swk, p.out + O_SWK, j, tl); };
    auto vl = [&](int j, float* tl) { ld(p.swv, p.out + O_SWK + (size_t)DEC_BATCH * 512 * 128, j, tl); };
    auto sf = [&](int row, int key, float& bias) { const int kpos = PAST - 512 + key; const int rel = PAST + (row >> 2) - kpos;
      bias = btab[(row & 3) * 129 + (rel < 0 ? 0 : (rel < 128 ? rel : 128))]; return rel >= 0 && rel < 512; };
    sattend<16>(qs, 0, 516, Sc, tile, obr, kl, vl, sf);
  }
  for (int i = tid; i < 1024; i += 256) {
    const int row = i >> 6, dd = i & 63, t = row >> 2, r = row & 3, hd = g * 4 + r; const size_t tok = (size_t)(NTP + b * 4 + t);
    const float* gt = (const float*)(p.ws + W_GATE) + tok * 24;
    const float o = ofin[i] + gt[16 + hd] * obr[i];
    ((u16*)(p.ws + W_OA))[tok * 512 + hd * 64 + dd] = f2bf(o * bf2f(((const u16*)(p.ws + W_ZA))[tok * 512 + hd * 64 + dd]));
  }
  __syncthreads();
}

constexpr int P2_HP = BATCH * 4 * 2;
constexpr int P2_CMP = BATCH * 2 * 2;
constexpr int P2_SA = DEC_BATCH * 2;
constexpr int P2_HS = DEC_BATCH * 4;
constexpr int P2_TOTAL = P2_HP + P2_CMP + P2_SA + P2_HS;
DI void phase2_item(const Params& p, int it, char* lds) {
  if (it < P2_HP) { hgrn_prompt_item(p, it, lds); return; }
  it -= P2_HP;
  if (it < P2_CMP) {
    const int kv = it & 1, g = (it >> 1) & 1, b = it >> 2;
    LoadCellBf16 al{(const u16*)(p.ws + W_KV) + (size_t)kv * NT * 128 + (size_t)b * 2048 * 128 + g * 64};
    comp_tile(p, al, b, g, kv, lds); return;
  }
  it -= P2_CMP;
  if (it < P2_SA) { sample_attn_item(p, it, lds); return; }
  it -= P2_SA;
  hgrn_sample_item(p, it, lds);
}


constexpr int AKS = 72, AVS = 68, ACS = 132;
DI bf16x8 pack8(const f32x16& x, int s2) {
  uint4 u; u.x = pk2(x[8 * s2], x[8 * s2 + 1]); u.y = pk2(x[8 * s2 + 2], x[8 * s2 + 3]);
  u.z = pk2(x[8 * s2 + 4], x[8 * s2 + 5]); u.w = pk2(x[8 * s2 + 6], x[8 * s2 + 7]);
  return __builtin_bit_cast(bf16x8, u);
}
DI void zero16(f32x16& x) {
#pragma unroll
  for (int i = 0; i < 16; ++i) x[i] = 0.f;
}

template <bool WIN>
DI void attn_tile(const u16* Kt, const u16* Vt, const float* brel_r, const bf16x8 (&qf)[4], int qpos, int kpos0, bool lane_on,
                  float& m_run, float& l_run, f32x16 (&oacc)[2], int ql, int hh) {
  f32x16 sacc[2];
#pragma unroll
  for (int kt = 0; kt < 2; ++kt) {
    zero16(sacc[kt]);
#pragma unroll
    for (int ks = 0; ks < 4; ++ks) {
      const bf16x8 kf = *(const bf16x8*)(Kt + (32 * kt + ql) * AKS + 16 * ks + 8 * hh);
      sacc[kt] = MFMA32(kf, qf[ks], sacc[kt]);
    }
  }
  float mt = -1.0e30f;
#pragma unroll
  for (int kt = 0; kt < 2; ++kt)
#pragma unroll
    for (int i = 0; i < 16; ++i) {
      const int rel = qpos - (kpos0 + 32 * kt + crow(i, hh));
      const bool ok = lane_on && rel >= 0 && (!WIN || rel < 512);
      const float sv = sacc[kt][i] + brel_r[rel < 0 ? 0 : (rel < 128 ? rel : 128)];
      sacc[kt][i] = ok ? sv : -1.0e30f;
      mt = fmaxf(mt, sacc[kt][i]);
    }
  mt = fmaxf(mt, __shfl_xor(mt, 32));
  const float mn = fmaxf(m_run, mt);
  const float alpha = __expf(m_run - mn);
  m_run = mn;
  float ls = 0.f;
#pragma unroll
  for (int kt = 0; kt < 2; ++kt)
#pragma unroll
    for (int i = 0; i < 16; ++i) {
      const float pv = (sacc[kt][i] > -1.0e29f) ? __expf(sacc[kt][i] - mn) : 0.f;
      sacc[kt][i] = pv; ls += pv;
    }
  l_run = l_run * alpha + ls;
#pragma unroll
  for (int dt = 0; dt < 2; ++dt)
#pragma unroll
    for (int i = 0; i < 16; ++i) oacc[dt][i] *= alpha;
#pragma unroll
  for (int kt = 0; kt < 2; ++kt)
#pragma unroll
    for (int s2 = 0; s2 < 2; ++s2) {
      const bf16x8 pf = pack8(sacc[kt], s2);
#pragma unroll
      for (int dt = 0; dt < 2; ++dt) {
        const u16* vp = Vt + (32 * dt + ql) * AVS + 32 * kt + 16 * s2 + 4 * hh;
        const bf16x8 vf = cat8(*(const s16x4*)vp, *(const s16x4*)(vp + 8));
        oacc[dt] = MFMA32(vf, pf, oacc[dt]);
      }
    }
}

DI void attn_load_tile(u16* Kt, u16* Vt, const u16* ksrc  , const u16* vtsrc  ) {
  const int tid = otid();
#pragma unroll
  for (int i = 0; i < 2; ++i) {
    const int idx = tid + 256 * i, rw = idx >> 3, ch = idx & 7;
    *(uint4*)(Kt + rw * AKS + ch * 8) = *(const uint4*)(ksrc + (size_t)rw * 128 + ch * 8);
    const uint4 v = *(const uint4*)(vtsrc + (size_t)rw * 2048 + ch * 8);
    *(uint2*)(Vt + rw * AVS + ch * 8) = make_uint2(v.x, v.y);
    *(uint2*)(Vt + rw * AVS + ch * 8 + 4) = make_uint2(v.z, v.w);
  }
}

DI void prompt_attn_item(const Params& p, int it, char* lds) {
  const int qt = (it < 512) ? (63 - (it & 63)) : (it & 63), g = (it >> 6) & 1, b = (it >> 7) & 7;
  const int t0 = qt * 32;
  const int tid = otid(), lane = tid & 63, w = tid >> 6, ql = lane & 31, hh = lane >> 5, tl = ql >> 2, r = ql & 3;
  const int qpos = t0 + 8 * w + tl, head = g * 4 + r;
  const size_t tok = (size_t)b * 2048 + qpos;
  u16* Kt = (u16*)lds;
  u16* Vt = Kt + 128 * AKS;
  float* brel = (float*)(Vt + 64 * ACS);
  unsigned* wmask = (unsigned*)(brel + 4 * 129);
  const u16* Qb = (const u16*)(p.ws + W_Q);
  __syncthreads();
  for (int i = tid; i < 4 * 129; i += 256) { const int rr = i / 129, rel = i % 129; const int bk = rel < 128 ? T5B[rel] : 31; brel[i] = p.rel_bias[bk * 8 + g * 4 + rr]; }
  bf16x8 qf[4];
#pragma unroll
  for (int ks = 0; ks < 4; ++ks) qf[ks] = *(const bf16x8*)(Qb + tok * 512 + head * 64 + 16 * ks + 8 * hh);
  const float* gt = (const float*)(p.ws + W_GATE) + tok * 24;
  const float* brel_r = brel + r * 129;
  f32x16 of[2];
  unsigned selm;
  {
#pragma unroll
    for (int i = 0; i < 4; ++i) {
      const int idx = tid + 256 * i;
      { const int n = idx >> 3, ch = idx & 7;
        *(uint4*)(Kt + n * AKS + ch * 8) = *(const uint4*)((const u16*)(p.ws + W_KCMP) + ((size_t)(b * 2 + g) * 128 + n) * 64 + ch * 8); }
      { const int dd = idx >> 4, ch = idx & 15;
        const uint4 v = *(const uint4*)((const u16*)(p.ws + W_VCMPT) + ((size_t)(b * 2 + g) * 64 + dd) * 128 + ch * 8);
        *(uint2*)(Vt + dd * ACS + ch * 8) = make_uint2(v.x, v.y); *(uint2*)(Vt + dd * ACS + ch * 8 + 4) = make_uint2(v.z, v.w); }
    }
    __syncthreads();
    f32x16 sacc[4];
#pragma unroll
    for (int kt = 0; kt < 4; ++kt) {
      zero16(sacc[kt]);
#pragma unroll
      for (int ks = 0; ks < 4; ++ks) {
        const bf16x8 kf = *(const bf16x8*)(Kt + (32 * kt + ql) * AKS + 16 * ks + 8 * hh);
        sacc[kt] = MFMA32(kf, qf[ks], sacc[kt]);
      }
    }
    float mt = -1.0e30f;
#pragma unroll
    for (int kt = 0; kt < 4; ++kt)
#pragma unroll
      for (int i = 0; i < 16; ++i) {
        const int n = 32 * kt + crow(i, hh);
        const int rel = qpos - (16 * n + 31);
        const bool ok = rel >= 0 && n < 127;
        const float sv = sacc[kt][i] + brel_r[rel < 0 ? 0 : (rel < 128 ? rel : 128)];
        sacc[kt][i] = ok ? sv : -1.0e30f;
        mt = fmaxf(mt, sacc[kt][i]);
      }
    mt = fmaxf(mt, __shfl_xor(mt, 32));
    float ls = 0.f;
#pragma unroll
    for (int kt = 0; kt < 4; ++kt)
#pragma unroll
      for (int i = 0; i < 16; ++i) { const float pv = (sacc[kt][i] > -1.0e29f) ? __expf(sacc[kt][i] - mt) : 0.f; sacc[kt][i] = pv; ls += pv; }
    ls += __shfl_xor(ls, 32);
    const float inv = ls > 0.f ? 1.f / ls : 0.f;
#pragma unroll
    for (int kt = 0; kt < 4; ++kt)
#pragma unroll
      for (int i = 0; i < 16; ++i) sacc[kt][i] *= inv;
    f32x16 oc[2]; zero16(oc[0]); zero16(oc[1]);
#pragma unroll
    for (int kt = 0; kt < 4; ++kt)
#pragma unroll
      for (int s2 = 0; s2 < 2; ++s2) {
        const bf16x8 pf = pack8(sacc[kt], s2);
#pragma unroll
        for (int dt = 0; dt < 2; ++dt) {
          const u16* vp = Vt + (32 * dt + ql) * ACS + 32 * kt + 16 * s2 + 4 * hh;
          const bf16x8 vf = cat8(*(const s16x4*)vp, *(const s16x4*)(vp + 8));
          oc[dt] = MFMA32(vf, pf, oc[dt]);
        }
      }
    const float g0 = gt[head];
#pragma unroll
    for (int dt = 0; dt < 2; ++dt)
#pragma unroll
      for (int i = 0; i < 16; ++i) of[dt][i] = g0 * oc[dt][i];
    float im[16], cm[16];
#pragma unroll
    for (int kt = 0; kt < 4; ++kt)
#pragma unroll
      for (int q4 = 0; q4 < 4; ++q4) {
        const float p0 = sacc[kt][4 * q4], p1 = sacc[kt][4 * q4 + 1], p2 = sacc[kt][4 * q4 + 2], p3 = sacc[kt][4 * q4 + 3];
        im[4 * kt + q4] = 2.f * (p0 + p1 + p2) + p3; cm[4 * kt + q4] = p3;
      }
#pragma unroll
    for (int m = 0; m < 16; ++m) cm[m] = __shfl_xor(cm[m], 32);
#pragma unroll
    for (int m = 15; m >= 0; --m) im[m] += hh ? cm[m] : (m > 0 ? cm[m - 1] : 0.f);
#pragma unroll
    for (int m = 0; m < 16; ++m) { im[m] += __shfl_xor(im[m], 1); im[m] += __shfl_xor(im[m], 2); }
    float ev[16], od[16];
#pragma unroll
    for (int m = 0; m < 16; ++m) { const float ot = __shfl_xor(im[m], 32); ev[m] = hh ? ot : im[m]; od[m] = hh ? im[m] : ot; }
    const int cur = qpos >> 6;
    if (cur < 8) selm = (2u << cur) - 1u;
    else {
      selm = 1u | (1u << cur) | (1u << (cur - 1));
      for (int c = 0; c < 5; ++c) {
        float best = -1.f;
#pragma unroll
        for (int J = 0; J < 32; ++J) { const float v = (J <= cur && !((selm >> J) & 1u)) ? ((J & 1) ? od[J >> 1] : ev[J >> 1]) : -1.f; best = fmaxf(best, v); }
        int bi = 32;
#pragma unroll
        for (int J = 31; J >= 0; --J) { const float v = (J <= cur && !((selm >> J) & 1u)) ? ((J & 1) ? od[J >> 1] : ev[J >> 1]) : -1.f; if (v == best) bi = J; }
        if (best >= 0.f) selm |= 1u << bi;
      }
    }
    unsigned um = selm;
    um |= __shfl_xor(um, 4); um |= __shfl_xor(um, 8); um |= __shfl_xor(um, 16);
    if (lane == 0) wmask[w] = um;
  }
  __syncthreads();
  const unsigned un = wmask[0] | wmask[1] | wmask[2] | wmask[3];
  {
    float m_run = -1.0e30f, l_run = 0.f; f32x16 oacc[2]; zero16(oacc[0]); zero16(oacc[1]);
    const u16* ks = (const u16*)(p.ws + W_KV) + (size_t)2 * NT * 128 + (size_t)b * 2048 * 128 + g * 64;
    const u16* vt = (const u16*)(p.ws + W_VST) + (size_t)(b * 2 + g) * 64 * 2048;
    for (int j = 0; j < 32; ++j) {
      if (!((un >> j) & 1u)) continue;
      __syncthreads();
      attn_load_tile(Kt, Vt, ks + (size_t)j * 64 * 128, vt + j * 64);
      __syncthreads();
      const bool on = (selm >> j) & 1u;
      if (__ballot(on) != 0ull) attn_tile<false>(Kt, Vt, brel_r, qf, qpos, j * 64, on, m_run, l_run, oacc, ql, hh);
    }
    l_run += __shfl_xor(l_run, 32);
    const float sc = gt[8 + head] * (l_run > 0.f ? 1.f / l_run : 0.f);
#pragma unroll
    for (int dt = 0; dt < 2; ++dt)
#pragma unroll
      for (int i = 0; i < 16; ++i) of[dt][i] += sc * oacc[dt][i];
  }
  {
    float m_run = -1.0e30f, l_run = 0.f; f32x16 oacc[2]; zero16(oacc[0]); zero16(oacc[1]);
    const u16* kw = (const u16*)(p.ws + W_KV) + (size_t)4 * NT * 128 + (size_t)b * 2048 * 128 + g * 64;
    const u16* vt = (const u16*)(p.ws + W_VWT) + (size_t)(b * 2 + g) * 64 * 2048;
    const int jlo = (t0 >= 511) ? ((t0 - 511) >> 6) : 0, jhi = (t0 + 31) >> 6;
    for (int j = jlo; j <= jhi; ++j) {
      __syncthreads();
      attn_load_tile(Kt, Vt, kw + (size_t)j * 64 * 128, vt + j * 64);
      __syncthreads();
      attn_tile<true>(Kt, Vt, brel_r, qf, qpos, j * 64, true, m_run, l_run, oacc, ql, hh);
    }
    l_run += __shfl_xor(l_run, 32);
    const float sc = gt[16 + head] * (l_run > 0.f ? 1.f / l_run : 0.f);
#pragma unroll
    for (int dt = 0; dt < 2; ++dt)
#pragma unroll
      for (int i = 0; i < 16; ++i) of[dt][i] += sc * oacc[dt][i];
  }
  {
    const u16* za = (const u16*)(p.ws + W_ZA) + tok * 512 + head * 64; u16* oa = (u16*)(p.ws + W_OA) + tok * 512 + head * 64;
#pragma unroll
    for (int dt = 0; dt < 2; ++dt)
#pragma unroll
      for (int q4 = 0; q4 < 4; ++q4) {
        const int dd = 32 * dt + 8 * q4 + 4 * hh;
        const uint2 z = *(const uint2*)(za + dd);
        uint2 o; o.x = pk2(of[dt][4 * q4] * bflo(z.x), of[dt][4 * q4 + 1] * bfhi(z.x)); o.y = pk2(of[dt][4 * q4 + 2] * bflo(z.y), of[dt][4 * q4 + 3] * bfhi(z.y));
        *(uint2*)(oa + dd) = o;
      }
  }
}
constexpr int P3_FIN = NTP / 4;
constexpr int P3_ATT = BATCH * 2 * 64;
constexpr int P3_TOTAL = P3_FIN + P3_ATT;

constexpr int P4_TOTAL = G1_MT * 16;
DI void merge_a_tile(const Params& p, int it, char* lds) {
  const int tm = it >> 4, tn = it & 15;
  f32x16 aa[2][1], ab[2][1]; zero_acc<1>(aa); zero_acc<1>(ab);
  { LoadBf16 al{(const u16*)(p.ws + W_OA) + (size_t)tm * 128 * 512, 512}; LoadBf16 bl{(const u16*)(p.ws + W_WBAT) + (size_t)tn * 64 * 512, 512}; gemm_main<1>(aa, al, bl, 8, lds); }
  { LoadBf16 al{(const u16*)(p.ws + W_OB) + (size_t)tm * 128 * 512, 512}; LoadBf16 bl{(const u16*)(p.ws + W_WBBT) + (size_t)tn * 64 * 512, 512}; gemm_main<1>(ab, al, bl, 8, lds); }
  const int tid = threadIdx.x, lane = tid & 63, wave = tid >> 6, wm = wave >> 1, wn = wave & 1, r = lane & 31, h = lane >> 5;
#pragma unroll
  for (int mi = 0; mi < 2; ++mi) {
    const int c = tn * 64 + wn * 32 + r;
#pragma unroll
    for (int i = 0; i < 16; ++i) {
      const size_t off = (size_t)(tm * 128 + wm * 64 + mi * 32 + crow(i, h)) * 1024 + c;
      const float y = bf2f(((const u16*)(p.ws + W_SA))[off]) * aa[mi][0][i] + bf2f(((const u16*)(p.ws + W_SB))[off]) * ab[mi][0][i];
      ((u16*)(p.ws + W_Y))[off] = f2bf(y);
    }
  }
}
constexpr int P5_TOTAL = G1_MT * 8;
DI void merge_b_tile(const Params& p, int it, char* lds) {
  const int tm = it >> 3, tn = it & 7;
  f32x16 acc[2][2]; zero_acc<2>(acc);
  LoadBf16 al{(const u16*)(p.ws + W_Y) + (size_t)tm * 128 * 1024, 1024}; LoadBf16 bl{(const u16*)(p.ws + W_WOUTT) + (size_t)tn * 128 * 1024, 1024};
  gemm_main<2>(acc, al, bl, 16, lds);
  const int tid = threadIdx.x, lane = tid & 63, wave = tid >> 6, wm = wave >> 1, wn = wave & 1, r = lane & 31, h = lane >> 5;
  const float* xin = (tm < 128) ? p.x_prompt : (p.x_sample - (size_t)NTP * 1024);
#pragma unroll
  for (int mi = 0; mi < 2; ++mi) {
#pragma unroll
    for (int i = 0; i < 16; ++i) {
      const size_t row = (size_t)(tm * 128 + wm * 64 + mi * 32 + crow(i, h));
      float ss = 0.f;
#pragma unroll
      for (int ni = 0; ni < 2; ++ni) {
        const int c = tn * 128 + wn * 64 + ni * 32 + r;
        const float hv = acc[mi][ni][i] + xin[row * 1024 + c];
        p.out[row * 1024 + c] = hv; ss += hv * hv;
      }
      ss += __shfl_xor(ss, 1); ss += __shfl_xor(ss, 2); ss += __shfl_xor(ss, 4); ss += __shfl_xor(ss, 8); ss += __shfl_xor(ss, 16);
      if (r == 0) ((float*)(p.ws + W_SS))[row * 16 + tn * 2 + wn] = ss;
    }
  }
}
constexpr int P6_TOTAL = NT / 4;
DI void final_norm_item(const Params& p, int it) {
  const int lane = threadIdx.x & 63, wave = threadIdx.x >> 6; const size_t row = (size_t)it * 4 + wave;
  const float* ssp = (const float*)(p.ws + W_SS) + row * 16;
  float ss = 0.f;
#pragma unroll
  for (int i = 0; i < 16; ++i) ss += ssp[i];
  const float rs = rsqrtf(ss * (1.f / 1024.f) + 1e-6f);
  float* o = p.out + row * 1024;
#pragma unroll
  for (int i = 0; i < 4; ++i) {
    float4 v = *(float4*)(o + (i * 64 + lane) * 4); const float4 gg = *(const float4*)(p.final_g + (i * 64 + lane) * 4);
    v.x *= rs * gg.x; v.y *= rs * gg.y; v.z *= rs * gg.z; v.w *= rs * gg.w;
    *(float4*)(o + (i * 64 + lane) * 4) = v;
  }
}

constexpr int LDS_BYTES = 64 * 1024;

template <int PH>
DI void run_phase(const Params& p, char* lds) {
  if (PH == 0) { for (int it = blockIdx.x; it < P0_TOTAL; it += gridDim.x) phase0_item(p, it, lds); }
  if (PH == 1) { for (int it = blockIdx.x; it < P1_TOTAL; it += gridDim.x) phase1_item(p, it, lds); }
  if (PH == 2) { for (int it = blockIdx.x; it < P2_TOTAL; it += gridDim.x) phase2_item(p, it, lds); }
  if (PH == 3) { for (int it = blockIdx.x; it < P3_TOTAL; it += gridDim.x) { if (it < P3_FIN) hgrn_finish_item(p, it); else prompt_attn_item(p, it - P3_FIN, lds); } }
  if (PH == 4) { for (int it = blockIdx.x; it < P4_TOTAL; it += gridDim.x) merge_a_tile(p, it, lds); }
  if (PH == 5) { for (int it = blockIdx.x; it < P5_TOTAL; it += gridDim.x) merge_b_tile(p, it, lds); }
  if (PH == 6) { for (int it = blockIdx.x; it < P6_TOTAL; it += gridDim.x) final_norm_item(p, it); }
}

__global__ void __launch_bounds__(256, 2) k_mega(Params p) {
  __shared__ __attribute__((aligned(16))) char lds[LDS_BYTES];
  cg::grid_group grid = cg::this_grid();
  run_phase<0>(p, lds); grid.sync();
  run_phase<1>(p, lds); grid.sync();
  run_phase<2>(p, lds); grid.sync();
  run_phase<3>(p, lds); grid.sync();
  run_phase<4>(p, lds); grid.sync();
  run_phase<5>(p, lds); grid.sync();
  run_phase<6>(p, lds);
}

extern "C" void kernel_launch(void* const* d_in, const int* in_sizes, int n_in, void* d_out, int out_size,
                              void* d_ws, size_t ws_size, hipStream_t stream) {
  Params p{};
  p.x_prompt = (const float*)d_in[0]; p.x_sample = (const float*)d_in[1];
  p.cck = (const float*)d_in[2]; p.ccv = (const float*)d_in[3]; p.csk = (const float*)d_in[4]; p.csv = (const float*)d_in[5];
  p.swk = (const float*)d_in[6]; p.swv = (const float*)d_in[7]; p.shg = (const float*)d_in[8]; p.pt = (const int*)d_in[9];
  p.norm_g = (const float*)d_in[10]; p.w_in = (const float*)d_in[11];
  p.pos_k = (const float*)d_in[12]; p.w1_k = (const float*)d_in[13]; p.w2_k = (const float*)d_in[14];
  p.pos_v = (const float*)d_in[15]; p.w1_v = (const float*)d_in[16]; p.w2_v = (const float*)d_in[17];
  p.rel_bias = (const float*)d_in[18]; p.hg_lower = (const float*)d_in[19]; p.hg_norm_g = (const float*)d_in[20];
  p.w_ba = (const float*)d_in[21]; p.w_bb = (const float*)d_in[22]; p.w_out = (const float*)d_in[23]; p.final_g = (const float*)d_in[24];
  p.out = (float*)d_out; p.ws = (char*)d_ws;
  if ((size_t)out_size != O_END || ws_size < W_END) { fprintf(stderr, "kernel_launch: unexpected sizes out=%d ws=%zu (need %zu / %zu)\n", out_size, ws_size, (size_t)O_END, (size_t)W_END); return; }
  static int grid_blocks = 0;
  if (!grid_blocks) {
    int dev = 0, cus = 0, per_cu = 0;
    hipGetDevice(&dev);
    hipDeviceGetAttribute(&cus, hipDeviceAttributeMultiprocessorCount, dev);
    hipOccupancyMaxActiveBlocksPerMultiprocessor(&per_cu, k_mega, 256, 0);
    if (per_cu > 2) per_cu = 2;
    if (per_cu < 1) per_cu = 1;
    grid_blocks = cus * per_cu;
  }
  void* args[] = {&p};
  hipError_t e = hipLaunchCooperativeKernel((void*)k_mega, dim3(grid_blocks), dim3(256), args, 0, stream);
  if (e != hipSuccess) fprintf(stderr, "cooperative launch failed: %s (grid %d)\n", hipGetErrorString(e), grid_blocks);
}
```

```cpp
#include <hip/hip_runtime.h>
#include <hip/hip_cooperative_groups.h>
#include <cstdio>
namespace cg = cooperative_groups;

#define DI __device__ __forceinline__
typedef unsigned short u16;
typedef __attribute__((ext_vector_type(8))) short bf16x8;
typedef __attribute__((ext_vector_type(4))) short s16x4;
typedef __attribute__((ext_vector_type(16))) float f32x16;
typedef __attribute__((ext_vector_type(4))) float f32x4;
typedef __attribute__((ext_vector_type(2))) float f32x2;
typedef __attribute__((ext_vector_type(2))) __bf16 bf16x2v;
#define MFMA32(a, b, c) __builtin_amdgcn_mfma_f32_32x32x16_bf16((a), (b), (c), 0, 0, 0)
#define MFMA16(a, b, c) __builtin_amdgcn_mfma_f32_16x16x32_bf16((a), (b), (c), 0, 0, 0)

constexpr int D_MODEL = 1024, BATCH = 8, SEQ = 2048, DEC_BATCH = 128, DEC_SEQ = 4, PAST = 2048;
constexpr int NTP = BATCH * SEQ;
constexpr int NTS = DEC_BATCH * DEC_SEQ;
constexpr int NT = NTP + NTS;
constexpr int IN_COLS = 5912, NPAD = 6016;
constexpr int NSEQ = BATCH + DEC_BATCH;

constexpr size_t O_YP = 0;
constexpr size_t O_YS = O_YP + (size_t)NTP * 1024;
constexpr size_t O_PCK = O_YS + (size_t)NTS * 1024;
constexpr size_t O_PWK = O_PCK + 4 * (size_t)NTP * 128;
constexpr size_t O_PHG = O_PWK + 2 * (size_t)BATCH * 512 * 128;
constexpr size_t O_SCK = O_PHG + (size_t)BATCH * 4 * 128 * 128;
constexpr size_t O_SWK = O_SCK + 4 * (size_t)NTS * 128;
constexpr size_t O_SHG = O_SWK + 2 * (size_t)DEC_BATCH * 512 * 128;
constexpr size_t O_END = O_SHG + (size_t)DEC_BATCH * 4 * 128 * 128;

constexpr size_t al256(size_t x) { return (x + 255) & ~(size_t)255; }
constexpr size_t W_WINT = 0;
constexpr size_t W_WBAT = al256(W_WINT + (size_t)NPAD * 1024 * 2);
constexpr size_t W_WBBT = al256(W_WBAT + (size_t)1024 * 512 * 2);
constexpr size_t W_WOUTT = al256(W_WBBT + (size_t)1024 * 512 * 2);
constexpr size_t W_W1T = al256(W_WOUTT + (size_t)1024 * 1024 * 2);
constexpr size_t W_C1 = al256(W_W1T + (size_t)2 * 128 * 1024 * 2);
constexpr size_t W_XN = al256(W_C1 + 2 * 64 * 4);
constexpr size_t W_Q = al256(W_XN + (size_t)NT * 1024 * 2);
constexpr size_t W_KV = al256(W_Q + (size_t)NT * 512 * 2);
constexpr size_t W_VST = al256(W_KV + (size_t)6 * NT * 128 * 2);
constexpr size_t W_VWT = al256(W_VST + (size_t)8 * 2 * 64 * 2048 * 2);
constexpr size_t W_GATE = al256(W_VWT + (size_t)8 * 2 * 64 * 2048 * 2);
constexpr size_t W_ZA = al256(W_GATE + (size_t)NT * 24 * 4);
constexpr size_t W_QB = al256(W_ZA + (size_t)NT * 512 * 2);
constexpr size_t W_KB = al256(W_QB + (size_t)NT * 512 * 2);
constexpr size_t W_GB = al256(W_KB + (size_t)NT * 512 * 2);
constexpr size_t W_VB = al256(W_GB + (size_t)NT * 512 * 4);
constexpr size_t W_ZB = al256(W_VB + (size_t)NT * 512 * 2);
constexpr size_t W_SA = al256(W_ZB + (size_t)NT * 512 * 2);
constexpr size_t W_SB = al256(W_SA + (size_t)NT * 1024 * 2);
constexpr size_t W_KCMP = al256(W_SB + (size_t)NT * 1024 * 2);
constexpr size_t W_VCMP = al256(W_KCMP + (size_t)NSEQ * 2 * 128 * 64 * 2);
constexpr size_t W_VCMPT = al256(W_VCMP + (size_t)NSEQ * 2 * 128 * 64 * 2);
constexpr size_t W_OA = al256(W_VCMPT + (size_t)8 * 2 * 64 * 128 * 2);
constexpr size_t W_OB = al256(W_OA + (size_t)NT * 512 * 2);
constexpr size_t W_Y = al256(W_OB + (size_t)NT * 512 * 2);
constexpr size_t W_SS = al256(W_Y + (size_t)NT * 1024 * 2);
constexpr size_t W_ORAW = al256(W_SS + (size_t)NT * 16 * 4);
constexpr size_t W_OSS = al256(W_ORAW + (size_t)NTP * 512 * 4);
constexpr size_t W_QG = al256(W_OSS + (size_t)NTP * 8 * 4);
constexpr size_t W_DST = al256(W_QG + (size_t)NTP * 512 * 2);
constexpr size_t W_DEC = al256(W_DST + (size_t)1024 * 128 * 128 * 4);
constexpr size_t W_SPT = al256(W_DEC + (size_t)1024 * 128 * 4);
constexpr size_t W_BAR = al256(W_SPT + (size_t)1024 * 128 * 128 * 2);
constexpr size_t W_END = al256(W_BAR + 3456 * 4);

struct Params {
  const float* x_prompt; const float* x_sample;
  const float* cck; const float* ccv; const float* csk; const float* csv;
  const float* swk; const float* swv; const float* shg; const int* pt;
  const float* norm_g; const float* w_in;
  const float* pos_k; const float* w1_k; const float* w2_k;
  const float* pos_v; const float* w1_v; const float* w2_v;
  const float* rel_bias; const float* hg_lower; const float* hg_norm_g;
  const float* w_ba; const float* w_bb; const float* w_out; const float* final_g;
  float* out; char* ws;
};

DI unsigned pk2(float a, float b) { f32x2 v = {a, b}; bf16x2v r = __builtin_convertvector(v, bf16x2v); return __builtin_bit_cast(unsigned, r); }
DI u16 f2bf(float a) { return (u16)(pk2(a, 0.f) & 0xffffu); }
DI float bf2f(u16 v) { return __uint_as_float(((unsigned)v) << 16); }
DI float bflo(unsigned v) { return __uint_as_float(v << 16); }
DI float bfhi(unsigned v) { return __uint_as_float(v & 0xffff0000u); }
DI float sigmoidf_(float x) { return 1.f / (1.f + __expf(-x)); }
DI float siluf_(float x) { return x / (1.f + __expf(-x)); }
DI int otid() { int t = threadIdx.x; asm volatile("" : "+v"(t)); return t; }
DI int crow(int reg, int h) { return (reg & 3) + 8 * (reg >> 2) + 4 * h; }
DI float wave_sum(float v) {
#pragma unroll
  for (int o = 32; o >= 1; o >>= 1) v += __shfl_xor(v, o);
  return v;
}
DI float wave_max(float v) {
#pragma unroll
  for (int o = 32; o >= 1; o >>= 1) v = fmaxf(v, __shfl_xor(v, o));
  return v;
}

__device__ const unsigned char T5B[128] = {
  0,1,2,3,4,5,6,7,8,9,10,11,12,13,14,15,
  16,16,16,17,17,18,18,18,19,19,19,20,20,20,20,21,
  21,21,21,22,22,22,22,22,23,23,23,23,23,23,24,24,
  24,24,24,24,25,25,25,25,25,25,25,26,26,26,26,26,
  26,26,26,27,27,27,27,27,27,27,27,27,27,28,28,28,
  28,28,28,28,28,28,28,29,29,29,29,29,29,29,29,29,
  29,29,29,30,30,30,30,30,30,30,30,30,30,30,30,30,
  30,31,31,31,31,31,31,31,31,31,31,31,31,31,31,31};

DI void transpose_tile(const float* __restrict__ src, int ldsrc, int K, int N, int k0, int n0,
                       u16* __restrict__ dst, int lddst, int dst_row_off, int dst_k0, int winperm, float* tl) {
  const int tid = threadIdx.x;
  __syncthreads();
  {
    const int n = tid & 63, kb = tid >> 6;
#pragma unroll
    for (int i = 0; i < 16; ++i) {
      const int kk = kb + 4 * i;
      float v = 0.f;
      if (n0 + n < N && k0 + kk < K) v = src[(size_t)(k0 + kk) * ldsrc + n0 + n];
      tl[kk * 65 + n] = v;
    }
  }
  __syncthreads();
  {
    const int k = (tid & 31) * 2, nb = tid >> 5;
#pragma unroll
    for (int i = 0; i < 8; ++i) {
      const int nn = nb + 8 * i;
      int n = n0 + nn;
      if (n < N) {
        if (winperm) n = (n < 1280) ? n : ((n < 1304) ? (5888 + n - 1280) : (n - 24));
        const unsigned v = pk2(tl[k * 65 + nn], tl[(k + 1) * 65 + nn]);
        *(unsigned*)(dst + (size_t)(dst_row_off + n) * lddst + dst_k0 + k) = v;
      }
    }
  }
}

constexpr int P0_WIN = 16 * 93;
constexpr int P0_WBA = 8 * 16, P0_WBB = 8 * 16, P0_WOUT = 16 * 16, P0_W1 = 32 * 2;
constexpr int P0_TR = P0_WIN + P0_WBA + P0_WBB + P0_WOUT + P0_W1;
constexpr int P0_C1 = 2;
constexpr int P0_NORM = NT / 4;
constexpr int P0_WCP = 2 * DEC_BATCH;
constexpr int P0_PAD = NPAD - IN_COLS;
constexpr int P0_TOTAL = P0_TR + P0_C1 + P0_NORM + P0_WCP + P0_PAD;

DI void phase0_item(const Params& p, int it, char* lds) {
  const int tid = threadIdx.x, lane = tid & 63, wave = tid >> 6;
  float* tl = (float*)lds;
  if (it < P0_TR) {
    if (it < P0_WIN) {
      const int kt = it / 93, nt = it % 93;
      transpose_tile(p.w_in, IN_COLS, 1024, IN_COLS, kt * 64, nt * 64, (u16*)(p.ws + W_WINT), 1024, 0, kt * 64, 1, tl);
      return;
    }
    it -= P0_WIN;
    if (it < P0_WBA) { const int kt = it / 16, nt = it % 16;
      transpose_tile(p.w_ba, 1024, 512, 1024, kt * 64, nt * 64, (u16*)(p.ws + W_WBAT), 512, 0, kt * 64, 0, tl); return; }
    it -= P0_WBA;
    if (it < P0_WBB) { const int kt = it / 16, nt = it % 16;
      transpose_tile(p.w_bb, 1024, 512, 1024, kt * 64, nt * 64, (u16*)(p.ws + W_WBBT), 512, 0, kt * 64, 0, tl); return; }
    it -= P0_WBB;
    if (it < P0_WOUT) { const int kt = it / 16, nt = it % 16;
      transpose_tile(p.w_out, 1024, 1024, 1024, kt * 64, nt * 64, (u16*)(p.ws + W_WOUTT), 1024, 0, kt * 64, 0, tl); return; }
    it -= P0_WOUT;
    { const int kv = it >> 5, kt = it & 31;
      const float* w1 = kv ? p.w1_v : p.w1_k;
      transpose_tile(w1, 64, 2048, 64, kt * 64, 0, (u16*)(p.ws + W_W1T) + (size_t)kv * 128 * 1024, 1024,
                     (kt >= 16) ? 64 : 0, (kt & 15) * 64, 0, tl); return; }
  }
  it -= P0_TR;
  if (it < P0_C1) {
    const float* pos = it ? p.pos_v : p.pos_k; const float* w1 = it ? p.w1_v : p.w1_k;
    const int j = tid & 63, part = tid >> 6;
    float s = 0.f;
    for (int i = part * 512; i < part * 512 + 512; ++i) s += pos[i] * w1[(size_t)i * 64 + j];
    __syncthreads();
    tl[part * 64 + j] = s;
    __syncthreads();
    if (tid < 64) ((float*)(p.ws + W_C1))[it * 64 + tid] = tl[tid] + tl[64 + tid] + tl[128 + tid] + tl[192 + tid];
    return;
  }
  it -= P0_C1;
  if (it < P0_NORM) {
    const int row = it * 4 + wave;
    const float* x = (row < NTP) ? (p.x_prompt + (size_t)row * 1024) : (p.x_sample + (size_t)(row - NTP) * 1024);
    float4 v[4]; float ss = 0.f;
#pragma unroll
    for (int i = 0; i < 4; ++i) { v[i] = *(const float4*)(x + (i * 64 + lane) * 4); ss += v[i].x * v[i].x + v[i].y * v[i].y + v[i].z * v[i].z + v[i].w * v[i].w; }
    ss = wave_sum(ss);
    const float rs = rsqrtf(ss * (1.f / 1024.f) + 1e-6f);
    u16* xn = (u16*)(p.ws + W_XN) + (size_t)row * 1024;
#pragma unroll
    for (int i = 0; i < 4; ++i) {
      const float4 g = *(const float4*)(p.norm_g + (i * 64 + lane) * 4);
      uint2 o; o.x = pk2(v[i].x * rs * g.x, v[i].y * rs * g.y); o.y = pk2(v[i].z * rs * g.z, v[i].w * rs * g.w);
      *(uint2*)(xn + (i * 64 + lane) * 4) = o;
    }
    return;
  }
  it -= P0_NORM;
  if (it < P0_WCP) {
    const int kv = it / DEC_BATCH, b = it % DEC_BATCH;
    const float4* src = (const float4*)((kv ? p.swv : p.swk) + ((size_t)b * 512 + 4) * 128);
    float4* dst = (float4*)(p.out + O_SWK + (size_t)kv * DEC_BATCH * 512 * 128 + (size_t)b * 512 * 128);
    for (int i = tid; i < 508 * 32; i += 256) dst[i] = src[i];
    return;
  }
  it -= P0_WCP;
  { u16* d = (u16*)(p.ws + W_WINT) + (size_t)(IN_COLS + it) * 1024; *(uint2*)(d + tid * 4) = make_uint2(0u, 0u); }
}

constexpr int GST = 72;
struct LoadBf16 {
  const u16* base; int ld;
  DI uint4 load(int row, int ch, int kt) const { return *(const uint4*)(base + (size_t)row * ld + kt * 64 + ch * 8); }
};
struct LoadCellBf16 {
  const u16* base;
  DI uint4 load(int row, int ch, int kt) const { return *(const uint4*)(base + (size_t)(row * 16 + kt) * 128 + ch * 8); }
};
struct LoadCellPage {
  const float* cache; const int* pt; int g;
  DI uint4 load(int row, int ch, int kt) const {
    const int pos = row * 16 + kt; const int page = pt[pos >> 7];
    const float* s = cache + (((size_t)page * 128 + (pos & 127)) * 2 + g) * 64 + ch * 8;
    const float4 a = *(const float4*)s, b = *(const float4*)(s + 4);
    uint4 r; r.x = pk2(a.x, a.y); r.y = pk2(a.z, a.w); r.z = pk2(b.x, b.y); r.w = pk2(b.z, b.w); return r;
  }
};

template <int NI, class AL, class BL>
DI void gemm_main(f32x16 (&acc)[2][NI], const AL& al, const BL& bl, int nkt, char* lds) {
  u16* sA = (u16*)lds; u16* sB = sA + 128 * GST;
  const int tid = otid(), lane = tid & 63, wave = tid >> 6, wm = wave >> 1, wn = wave & 1;
  const int lrow = tid >> 3, lch = tid & 7, r = lane & 31, h = lane >> 5;
  uint4 ra[4], rb[2 * NI];
#pragma unroll
  for (int i = 0; i < 4; ++i) ra[i] = al.load(lrow + 32 * i, lch, 0);
#pragma unroll
  for (int i = 0; i < 2 * NI; ++i) rb[i] = bl.load(lrow + 32 * i, lch, 0);
  for (int kt = 0; kt < nkt; ++kt) {
    __syncthreads();
#pragma unroll
    for (int i = 0; i < 4; ++i) *(uint4*)(sA + (lrow + 32 * i) * GST + lch * 8) = ra[i];
#pragma unroll
    for (int i = 0; i < 2 * NI; ++i) *(uint4*)(sB + (lrow + 32 * i) * GST + lch * 8) = rb[i];
    __syncthreads();
    if (kt + 1 < nkt) {
#pragma unroll
      for (int i = 0; i < 4; ++i) ra[i] = al.load(lrow + 32 * i, lch, kt + 1);
#pragma unroll
      for (int i = 0; i < 2 * NI; ++i) rb[i] = bl.load(lrow + 32 * i, lch, kt + 1);
    }
#pragma unroll
    for (int s = 0; s < 4; ++s) {
      bf16x8 a[2], bb[NI];
#pragma unroll
      for (int mi = 0; mi < 2; ++mi) a[mi] = *(const bf16x8*)(sA + (wm * 64 + mi * 32 + r) * GST + s * 16 + 8 * h);
#pragma unroll
      for (int ni = 0; ni < NI; ++ni) bb[ni] = *(const bf16x8*)(sB + (wn * 32 * NI + ni * 32 + r) * GST + s * 16 + 8 * h);
#pragma unroll
      for (int mi = 0; mi < 2; ++mi)
#pragma unroll
        for (int ni = 0; ni < NI; ++ni) acc[mi][ni] = MFMA32(a[mi], bb[ni], acc[mi][ni]);
    }
  }
}
template <int NI>
DI void zero_acc(f32x16 (&acc)[2][NI]) {
#pragma unroll
  for (int a = 0; a < 2; ++a)
#pragma unroll
    for (int b = 0; b < NI; ++b)
#pragma unroll
      for (int i = 0; i < 16; ++i) acc[a][b][i] = 0.f;
}

constexpr int G1_MT = NT / 128, G1_NT = NPAD / 128;
constexpr int P1_GEMM = G1_MT * G1_NT;
constexpr int P1_CMP = DEC_BATCH * 2 * 2;
constexpr int P1_TOTAL = P1_CMP + P1_GEMM;

DI void proj_tile(const Params& p, int tm, int tn, char* lds) {
  f32x16 acc[2][2]; zero_acc<2>(acc);
  LoadBf16 al{(const u16*)(p.ws + W_XN) + (size_t)tm * 128 * 1024, 1024};
  LoadBf16 bl{(const u16*)(p.ws + W_WINT) + (size_t)tn * 128 * 1024, 1024};
  gemm_main<2>(acc, al, bl, 16, lds);
  const int tid = otid(), lane = tid & 63, wave = tid >> 6, wm = wave >> 1, wn = wave & 1, r = lane & 31, h = lane >> 5;
  const bool samp = tm >= 128;
#pragma unroll
  for (int mi = 0; mi < 2; ++mi)
#pragma unroll
    for (int ni = 0; ni < 2; ++ni) {
      const int c = wn * 64 + ni * 32 + r;
      const int row0 = tm * 128 + wm * 64 + mi * 32;
      if (tn < 4) {
        u16* d = (u16*)(p.ws + W_Q) + tn * 128 + c;
#pragma unroll
        for (int i = 0; i < 16; ++i) d[(size_t)(row0 + crow(i, h)) * 512] = f2bf(acc[mi][ni][i] * 0.125f);
      } else if (tn < 10) {
        const int kvg = tn - 4;
        u16* d = (u16*)(p.ws + W_KV) + (size_t)kvg * NT * 128 + c;
#pragma unroll
        for (int i = 0; i < 16; ++i) {
          const int row = row0 + crow(i, h); const float v = acc[mi][ni][i];
          d[(size_t)row * 128] = f2bf(v);
          if (!samp) {
            if (kvg < 4) p.out[O_PCK + (size_t)kvg * NTP * 128 + (size_t)row * 128 + c] = v;
            else { const int t = row & 2047, b = row >> 11;
              if (t >= 1536) p.out[O_PWK + (size_t)(kvg - 4) * BATCH * 512 * 128 + ((size_t)b * 512 + t - 1536) * 128 + c] = v; }
          } else {
            const int srow = row - NTP;
            if (kvg < 4) p.out[O_SCK + (size_t)kvg * NTS * 128 + (size_t)srow * 128 + c] = v;
            else p.out[O_SWK + (size_t)(kvg - 4) * DEC_BATCH * 512 * 128 + ((size_t)(srow >> 2) * 512 + 508 + (srow & 3)) * 128 + c] = v;
          }
        }
        if (!samp && (kvg == 3 || kvg == 5)) {
          u16* vt = (u16*)(p.ws + (kvg == 3 ? W_VST : W_VWT));
          const int b = row0 >> 11, t0 = row0 & 2047, g = c >> 6, dd = c & 63;
          u16* drow = vt + ((size_t)(b * 2 + g) * 64 + dd) * 2048 + t0;
#pragma unroll
          for (int q = 0; q < 4; ++q) {
            uint2 o; o.x = pk2(acc[mi][ni][4 * q], acc[mi][ni][4 * q + 1]); o.y = pk2(acc[mi][ni][4 * q + 2], acc[mi][ni][4 * q + 3]);
            *(uint2*)(drow + 8 * q + 4 * h) = o;
          }
        }
      } else if (tn < 14 || (tn >= 26 && tn < 30)) {
        const bool isA = tn < 14; const int cc = (isA ? tn - 10 : tn - 26) * 128 + c;
        u16* d = (u16*)(p.ws + (isA ? W_ZA : W_ZB)) + cc;
#pragma unroll
        for (int i = 0; i < 16; ++i) d[(size_t)(row0 + crow(i, h)) * 512] = f2bf(siluf_(acc[mi][ni][i]));
      } else if (tn < 18 || (tn >= 22 && tn < 26)) {
        const bool isQ = tn < 18; const int cc = (isQ ? tn - 14 : tn - 22) * 128 + c;
        u16* d = (u16*)(p.ws + (isQ ? W_QB : W_VB)) + cc;
#pragma unroll
        for (int i = 0; i < 16; ++i) d[(size_t)(row0 + crow(i, h)) * 512] = f2bf(acc[mi][ni][i]);
      } else if (tn < 22) {
        const int cc = (tn - 18) * 128 + c;
        const float a0 = p.hg_lower[cc], a1 = p.hg_lower[512 + cc];
        const float lb = 1.f / (1.f + __expf(a1 - a0));
        u16* dk = (u16*)(p.ws + W_KB) + cc; float* dg = (float*)(p.ws + W_GB) + cc;
#pragma unroll
        for (int i = 0; i < 16; ++i) {
          const size_t row = row0 + crow(i, h);
          const float sg = sigmoidf_(acc[mi][ni][i]);
          const float f = lb + (1.f - lb) * sg;
          dg[row * 512] = __logf(f);
          dk[row * 512] = f2bf((1.f - lb) * (1.f - sg));
        }
      } else if (tn < 46) {
        const bool isA = tn < 38; const int cc = (isA ? tn - 30 : tn - 38) * 128 + c;
        u16* d = (u16*)(p.ws + (isA ? W_SA : W_SB)) + cc;
#pragma unroll
        for (int i = 0; i < 16; ++i) d[(size_t)(row0 + crow(i, h)) * 1024] = f2bf(sigmoidf_(acc[mi][ni][i]));
      } else {
        if (c < 24) {
          float* d = (float*)(p.ws + W_GATE) + c;
#pragma unroll
          for (int i = 0; i < 16; ++i) d[(size_t)(row0 + crow(i, h)) * 24] = sigmoidf_(acc[mi][ni][i]);
        }
      }
    }
}

template <class AL>
DI void comp_tile(const Params& p, const AL& al, int seq, int g, int kv, char* lds) {
  f32x16 acc[2][2]; zero_acc<2>(acc);
  LoadBf16 bl{(const u16*)(p.ws + W_W1T) + (size_t)kv * 128 * 1024, 1024};
  gemm_main<2>(acc, al, bl, 16, lds);
  const int tid = otid(), lane = tid & 63, wave = tid >> 6, wm = wave >> 1, wn = wave & 1, r = lane & 31, h = lane >> 5;
  float* T = (float*)lds;
  float* w2s = T + 128 * 65;
  const float* c1 = (const float*)(p.ws + W_C1) + kv * 64;
  const float* w2 = kv ? p.w2_v : p.w2_k;
  __syncthreads();
  for (int i = tid; i < 4096; i += 256) w2s[i] = w2[i];
  if (wn == 1) {
#pragma unroll
    for (int mi = 0; mi < 2; ++mi)
#pragma unroll
      for (int ni = 0; ni < 2; ++ni)
#pragma unroll
        for (int i = 0; i < 16; ++i) T[(wm * 64 + mi * 32 + crow(i, h)) * 65 + ni * 32 + r] = acc[mi][ni][i];
  }
  __syncthreads();
  if (wn == 0) {
#pragma unroll
    for (int mi = 0; mi < 2; ++mi)
#pragma unroll
      for (int ni = 0; ni < 2; ++ni)
#pragma unroll
        for (int i = 0; i < 16; ++i) {
          const int n = wm * 64 + mi * 32 + crow(i, h), j = ni * 32 + r;
          float hv = 0.f;
          if (n < 127) hv = siluf_(acc[mi][ni][i] + T[(n + 1) * 65 + j] + c1[j]);
          acc[mi][ni][i] = hv;
        }
  }
  __syncthreads();
  if (wn == 0) {
#pragma unroll
    for (int mi = 0; mi < 2; ++mi)
#pragma unroll
      for (int ni = 0; ni < 2; ++ni)
#pragma unroll
        for (int i = 0; i < 16; ++i) T[(wm * 64 + mi * 32 + crow(i, h)) * 65 + ni * 32 + r] = acc[mi][ni][i];
  }
  __syncthreads();
  {
    const int n = tid >> 1, eh = tid & 1;
    float o[32];
#pragma unroll
    for (int e = 0; e < 32; ++e) o[e] = 0.f;
#pragma unroll 2
    for (int j = 0; j < 64; ++j) {
      const float hv = T[n * 65 + j];
#pragma unroll
      for (int e = 0; e < 32; ++e) o[e] += hv * w2s[j * 64 + eh * 32 + e];
    }
    u16* dst = (u16*)(p.ws + (kv ? W_VCMP : W_KCMP)) + ((size_t)(seq * 2 + g) * 128 + n) * 64 + eh * 32;
#pragma unroll
    for (int e = 0; e < 32; e += 2) *(unsigned*)(dst + e) = pk2(o[e], o[e + 1]);
    if (kv == 1 && seq < BATCH) {
      u16* dt = (u16*)(p.ws + W_VCMPT) + ((size_t)(seq * 2 + g) * 64 + eh * 32) * 128 + n;
#pragma unroll
      for (int e = 0; e < 32; ++e) dt[(size_t)e * 128] = f2bf(o[e]);
    }
  }
  __syncthreads();
}

DI void phase1_item(const Params& p, int it, char* lds) {
  if (it < P1_CMP) {
    const int kv = it & 1, g = (it >> 1) & 1, b = it >> 2;
    LoadCellPage al{kv ? p.ccv : p.cck, p.pt + b * 16, g};
    comp_tile(p, al, BATCH + b, g, kv, lds);
    return;
  }
  it -= P1_CMP;
  const int tm = it / G1_NT, tn = it % G1_NT;
  proj_tile(p, tm, tn, lds);
}


DI void hgrn_sample_item(const Params& p, int it, char* lds) {
  const int b = it >> 2, h = it & 3, tid = otid(), lane = tid & 63, wave = tid >> 6;
  float* sf = (float*)lds; float* sk = sf + 512; float* sq = sk + 512; float* sv = sq + 512; float* so = sv + 512;
  __syncthreads();
  for (int i = tid; i < 512; i += 256) {
    const int t = i >> 7, c = i & 127; const size_t off = (size_t)(NTP + b * 4 + t) * 512 + h * 128 + c;
    sf[i] = __expf(((const float*)(p.ws + W_GB))[off]);
    sk[i] = bf2f(((const u16*)(p.ws + W_KB))[off]);
    sq[i] = bf2f(((const u16*)(p.ws + W_QB))[off]);
    sv[i] = bf2f(((const u16*)(p.ws + W_VB))[off]);
  }
  __syncthreads();
  const int e = tid & 127, dh = tid >> 7;
  const float* S0 = p.shg + (size_t)(b * 4 + h) * 128 * 128;
  float* S1 = p.out + O_SHG + (size_t)(b * 4 + h) * 128 * 128;
  const float v0 = sv[e], v1 = sv[128 + e], v2 = sv[256 + e], v3 = sv[384 + e];
  float o0 = 0.f, o1 = 0.f, o2 = 0.f, o3 = 0.f;
#pragma unroll 4
  for (int d = dh * 64; d < dh * 64 + 64; ++d) {
    float st = S0[(size_t)d * 128 + e];
    st = sf[d] * st + sk[d] * v0;             o0 += sq[d] * st;
    st = sf[128 + d] * st + sk[128 + d] * v1; o1 += sq[128 + d] * st;
    st = sf[256 + d] * st + sk[256 + d] * v2; o2 += sq[256 + d] * st;
    st = sf[384 + d] * st + sk[384 + d] * v3; o3 += sq[384 + d] * st;
    S1[(size_t)d * 128 + e] = st;
  }
  so[(dh * 4 + 0) * 128 + e] = o0; so[(dh * 4 + 1) * 128 + e] = o1; so[(dh * 4 + 2) * 128 + e] = o2; so[(dh * 4 + 3) * 128 + e] = o3;
  __syncthreads();
  {
    const int t = wave; const size_t row = (size_t)(NTP + b * 4 + t);
    const float a0 = so[t * 128 + lane] + so[(4 + t) * 128 + lane];
    const float a1 = so[t * 128 + 64 + lane] + so[(4 + t) * 128 + 64 + lane];
    const float ss = wave_sum(a0 * a0 + a1 * a1);
    const float rs = rsqrtf(ss * (1.f / 128.f) + 1e-6f);
    const u16* zb = (const u16*)(p.ws + W_ZB) + row * 512 + h * 128; u16* ob = (u16*)(p.ws + W_OB) + row * 512 + h * 128;
    ob[lane] = f2bf(a0 * rs * p.hg_norm_g[h * 128 + lane] * bf2f(zb[lane]));
    ob[64 + lane] = f2bf(a1 * rs * p.hg_norm_g[h * 128 + 64 + lane] * bf2f(zb[64 + lane]));
  }
}

typedef __attribute__((address_space(3))) s16x4 lds_s16x4;
DI s16x4 tr_read(const u16* ptr) { return __builtin_amdgcn_ds_read_tr16_b64_v4i16((lds_s16x4*)ptr); }
DI bf16x8 cat8(s16x4 lo, s16x4 hi) { return __builtin_shufflevector(lo, hi, 0, 1, 2, 3, 4, 5, 6, 7); }
constexpr int HST = 136;

DI void hgrn_h1_item(const Params& p, int it, char* lds) {
  const int c = it & 31, h = (it >> 5) & 3, b = it >> 7;
  const int tid = otid(), lane = tid & 63, w = __builtin_amdgcn_readfirstlane(tid >> 6), half = tid >> 7;
  const int c16 = lane & 15, hq = lane >> 4, tq = c16 >> 2, tp = c16 & 3;
  const int d = tid & 127, col = h * 128 + d;
  u16* Qe = (u16*)lds; u16* Ke = Qe + 64 * HST; u16* Vv = Ke + 64 * HST; u16* Am = Vv + 64 * HST;
  float* Rr = (float*)(Am + 64 * 72); float* G63 = Rr + 128;
  const u16* qB = (const u16*)(p.ws + W_QB); const u16* kB = (const u16*)(p.ws + W_KB); const u16* vB = (const u16*)(p.ws + W_VB);
  const float* gB = (const float*)(p.ws + W_GB);
  const size_t tok0 = (size_t)b * 2048 + c * 64;
  __syncthreads();
  float G[32];
  {
    float run = 0.f;
#pragma unroll
    for (int i = 0; i < 32; ++i) { run += gB[(tok0 + half * 32 + i) * 512 + col]; G[i] = run; }
    if (half == 0) Rr[d] = run;
  }
#pragma unroll
  for (int i = 0; i < 4; ++i) {
    const int idx = tid + 256 * i, s_ = idx >> 4, cc = idx & 15;
    *(uint4*)(Vv + s_ * HST + cc * 8) = *(const uint4*)(vB + (tok0 + s_) * 512 + h * 128 + cc * 8);
  }
  __syncthreads();
  {
    const float R = Rr[d];
    const float base = half ? R : 0.f;
    u16* qg = (u16*)(p.ws + W_QG);
#pragma unroll
    for (int i = 0; i < 32; ++i) {
      const int t = half * 32 + i;
      const float gt = base + G[i];
      const float q = bf2f(qB[(tok0 + t) * 512 + col]), k = bf2f(kB[(tok0 + t) * 512 + col]);
      const float dq = fminf(fmaxf(gt - R, -80.f), 80.f);
      Qe[t * HST + d] = f2bf(q * __expf(dq));
      Ke[t * HST + d] = f2bf(k * __expf(-dq));
      qg[(tok0 + t) * 512 + col] = f2bf(q * __expf(gt));
    }
    if (half == 1) G63[d] = base + G[31];
  }
  __syncthreads();
  for (int j = 0; j <= w; ++j) {
    f32x4 x = f32x4{0.f, 0.f, 0.f, 0.f};
#pragma unroll
    for (int ks = 0; ks < 4; ++ks) {
      const bf16x8 a = *(const bf16x8*)(Qe + (16 * w + c16) * HST + ks * 32 + 8 * hq);
      const bf16x8 bb = *(const bf16x8*)(Ke + (16 * j + c16) * HST + ks * 32 + 8 * hq);
      x = MFMA16(a, bb, x);
    }
#pragma unroll
    for (int r = 0; r < 4; ++r) {
      const bool ok = (j < w) || (c16 <= 4 * hq + r);
      Am[(16 * w + 4 * hq + r) * 72 + 16 * j + c16] = f2bf(ok ? x[r] : 0.f);
    }
  }
  if ((w & 1) == 0) {
#pragma unroll
    for (int r = 0; r < 4; ++r) Am[(16 * w + 4 * hq + r) * 72 + 16 * (w + 1) + c16] = 0;
  }
  __syncthreads();
  bf16x8 vf[2][2];
#pragma unroll
  for (int ks = 0; ks < 2; ++ks)
#pragma unroll
    for (int et = 0; et < 2; ++et) {
      const u16* base = Vv + (32 * ks + 8 * hq + tq) * HST + 32 * w + 16 * et + 4 * tp;
      vf[ks][et] = cat8(tr_read(base), tr_read(base + 4 * HST));
    }
  {
    f32x4 o[4][2];
#pragma unroll
    for (int tt = 0; tt < 4; ++tt)
#pragma unroll
      for (int et = 0; et < 2; ++et) o[tt][et] = f32x4{0.f, 0.f, 0.f, 0.f};
#pragma unroll
    for (int tt = 0; tt < 4; ++tt)
#pragma unroll
      for (int ks = 0; ks <= (tt >> 1); ++ks) {
        const bf16x8 a = *(const bf16x8*)(Am + (16 * tt + c16) * 72 + 32 * ks + 8 * hq);
#pragma unroll
        for (int et = 0; et < 2; ++et) o[tt][et] = MFMA16(a, vf[ks][et], o[tt][et]);
      }
    float* oraw = (float*)(p.ws + W_ORAW);
#pragma unroll
    for (int tt = 0; tt < 4; ++tt)
#pragma unroll
      for (int et = 0; et < 2; ++et)
#pragma unroll
        for (int r = 0; r < 4; ++r) oraw[(tok0 + 16 * tt + 4 * hq + r) * 512 + h * 128 + 32 * w + 16 * et + c16] = o[tt][et][r];
  }
  float* dst = (float*)(p.ws + W_DST) + (size_t)it * 128 * 128;
#pragma unroll
  for (int dt = 0; dt < 8; ++dt) {
    bf16x8 kt[2];
#pragma unroll
    for (int ks = 0; ks < 2; ++ks) {
      const u16* base = Ke + (32 * ks + 8 * hq + tq) * HST + 16 * dt + 4 * tp;
      kt[ks] = cat8(tr_read(base), tr_read(base + 4 * HST));
    }
    f32x4 sc2;
#pragma unroll
    for (int r = 0; r < 4; ++r) sc2[r] = __expf(G63[16 * dt + 4 * hq + r] - Rr[16 * dt + 4 * hq + r]);
#pragma unroll
    for (int et = 0; et < 2; ++et) {
      f32x4 dd = f32x4{0.f, 0.f, 0.f, 0.f};
      dd = MFMA16(kt[0], vf[0][et], dd); dd = MFMA16(kt[1], vf[1][et], dd);
      *(float4*)(dst + (size_t)(32 * w + 16 * et + c16) * 128 + 16 * dt + 4 * hq) = make_float4(dd[0] * sc2[0], dd[1] * sc2[1], dd[2] * sc2[2], dd[3] * sc2[3]);
    }
  }
  if (tid < 128) ((float*)(p.ws + W_DEC))[(size_t)it * 128 + tid] = __expf(G63[tid]);
}

constexpr int H2_ITEMS = 8 * 4 * 128 * 32 / 256;
DI void hgrn_h2_item(const Params& p, int it) {
  const int gt = it * 256 + threadIdx.x, bh = gt >> 12, e = (gt >> 5) & 127, dq = gt & 31;
  const float* dst = (const float*)(p.ws + W_DST); const float* dec = (const float*)(p.ws + W_DEC); u16* spt = (u16*)(p.ws + W_SPT);
  float4 s = make_float4(0.f, 0.f, 0.f, 0.f);
#pragma unroll 4
  for (int c = 0; c < 32; ++c) {
    const size_t idx = ((size_t)(bh * 32 + c) * 128 + e) * 128 + dq * 4;
    const float4 d4 = *(const float4*)(dst + idx);
    const float4 k4 = *(const float4*)(dec + (size_t)(bh * 32 + c) * 128 + dq * 4);
    *(uint2*)(spt + idx) = make_uint2(pk2(s.x, s.y), pk2(s.z, s.w));
    s.x = k4.x * s.x + d4.x; s.y = k4.y * s.y + d4.y; s.z = k4.z * s.z + d4.z; s.w = k4.w * s.w + d4.w;
  }
  float* So = p.out + O_PHG + (size_t)bh * 128 * 128;
  So[(size_t)(dq * 4 + 0) * 128 + e] = s.x; So[(size_t)(dq * 4 + 1) * 128 + e] = s.y;
  So[(size_t)(dq * 4 + 2) * 128 + e] = s.z; So[(size_t)(dq * 4 + 3) * 128 + e] = s.w;
}

DI void hgrn_h3_item(const Params& p, int it) {
  const int c = it & 31, h = (it >> 5) & 3, b = it >> 7;
  const int tid = otid(), lane = tid & 63, w = tid >> 6, c16 = lane & 15, hq = lane >> 4;
  const size_t tok0 = (size_t)b * 2048 + c * 64 + 16 * w;
  const u16* qg = (const u16*)(p.ws + W_QG) + (tok0 + c16) * 512 + h * 128 + 8 * hq;
  bf16x8 af[4];
#pragma unroll
  for (int ks = 0; ks < 4; ++ks) af[ks] = *(const bf16x8*)(qg + 32 * ks);
  const float* oraw = (const float*)(p.ws + W_ORAW) + (tok0 + 4 * hq) * 512 + h * 128 + c16;
  const u16* spt = (const u16*)(p.ws + W_SPT) + ((size_t)it * 128 + c16) * 128 + 8 * hq;
  f32x4 acc[8];
#pragma unroll
  for (int et = 0; et < 8; ++et) {
#pragma unroll
    for (int r = 0; r < 4; ++r) acc[et][r] = oraw[(size_t)r * 512 + 16 * et];
#pragma unroll
    for (int ks = 0; ks < 4; ++ks) {
      const bf16x8 bfr = *(const bf16x8*)(spt + (size_t)(16 * et) * 128 + 32 * ks);
      acc[et] = MFMA16(af[ks], bfr, acc[et]);
    }
  }
  const u16* zb = (const u16*)(p.ws + W_ZB) + (tok0 + 4 * hq) * 512 + h * 128 + c16;
  u16* ob = (u16*)(p.ws + W_OB) + (tok0 + 4 * hq) * 512 + h * 128 + c16;
#pragma unroll
  for (int r = 0; r < 4; ++r) {
    float v = 0.f;
#pragma unroll
    for (int et = 0; et < 8; ++et) v += acc[et][r] * acc[et][r];
    v += __shfl_xor(v, 1); v += __shfl_xor(v, 2); v += __shfl_xor(v, 4); v += __shfl_xor(v, 8);
    const float rs = rsqrtf(v * (1.f / 128.f) + 1e-6f);
#pragma unroll
    for (int et = 0; et < 8; ++et)
      ob[(size_t)r * 512 + 16 * et] = f2bf(acc[et][r] * rs * p.hg_norm_g[h * 128 + 16 * et + c16] * bf2f(zb[(size_t)r * 512 + 16 * et]));
  }
}

template <int NR>
DI void sa_scores(const float* qrows_, const float4 (&kk)[16], float (&sc)[NR]) {
  const float* qrows = qrows_; asm volatile("" : "+v"(qrows));
#pragma unroll
  for (int r = 0; r < NR; ++r) {
    float a0 = 0.f, a1 = 0.f;
#pragma unroll
    for (int dq = 0; dq < 16; dq += 2) {
      const float4 q0 = *(const float4*)(qrows + r * 64 + dq * 4), q1 = *(const float4*)(qrows + r * 64 + dq * 4 + 4);
      a0 += q0.x * kk[dq].x + q0.y * kk[dq].y + q0.z * kk[dq].z + q0.w * kk[dq].w;
      a1 += q1.x * kk[dq + 1].x + q1.y * kk[dq + 1].y + q1.z * kk[dq + 1].z + q1.w * kk[dq + 1].w;
    }
    sc[r] = a0 + a1;
    asm volatile("" : "+v"(sc[r]) :: "memory");
  }
}
DI void sa_load_f32(const float* rowp, bool ok, float4 (&kk)[16]) {
#pragma unroll
  for (int i = 0; i < 16; ++i) kk[i] = ok ? ((const float4*)rowp)[i] : make_float4(0.f, 0.f, 0.f, 0.f);
}
template <int NR>
DI void sa_softmax(float* P, int nk, int row, int sub) {
  float m = -3.0e38f;
  for (int k = sub; k < nk; k += 16) m = fmaxf(m, P[k * NR + row]);
  m = fmaxf(m, __shfl_xor(m, 1)); m = fmaxf(m, __shfl_xor(m, 2)); m = fmaxf(m, __shfl_xor(m, 4)); m = fmaxf(m, __shfl_xor(m, 8));
  float l = 0.f;
  for (int k = sub; k < nk; k += 16) { const float sv = P[k * NR + row]; const float pv = (sv > -1.0e38f) ? __expf(sv - m) : 0.f; P[k * NR + row] = pv; l += pv; }
  l += __shfl_xor(l, 1); l += __shfl_xor(l, 2); l += __shfl_xor(l, 4); l += __shfl_xor(l, 8);
  const float inv = (l > 0.f) ? 1.f / l : 0.f;
  for (int k = sub; k < nk; k += 16) P[k * NR + row] *= inv;
}

DI void sample_attn_item(const Params& p, int it, char* lds) {
  const int b = it >> 1, g = it & 1, tid = otid(), lane = tid & 63, w = __builtin_amdgcn_readfirstlane(tid >> 6);
  float* qs = (float*)lds;
  float* Sc = qs + 1024;
  float* obuf = Sc + 9216;
  float* ofin = obuf + 4096;
  float* imp = ofin + 1024;
  int* sel = (int*)(imp + 4 * 33);
  float* btab = (float*)(sel + 32);
  __syncthreads();
  for (int i = tid; i < 1024; i += 256) { const int row = i >> 6, dd = i & 63, t = row >> 2, r = row & 3;
    qs[i] = bf2f(((const u16*)(p.ws + W_Q))[(size_t)(NTP + b * 4 + t) * 512 + (g * 4 + r) * 64 + dd]); }
  for (int i = tid; i < 4 * 129; i += 256) { const int r = i / 129, rel = i % 129; const int bk = rel < 128 ? T5B[rel] : 31; btab[i] = p.rel_bias[bk * 8 + g * 4 + r]; }
  __syncthreads();
  const int seq = BATCH + b;
  const float* gate = (const float*)(p.ws + W_GATE) + (size_t)(NTP + b * 4) * 24;
  const int srow = tid >> 4, ssub = tid & 15;
  if (w < 2) {
    const int n = 64 * w + lane; const bool okn = n < 127;
    float4 kk[16];
    const uint4* kp = (const uint4*)((const u16*)(p.ws + W_KCMP) + ((size_t)(seq * 2 + g) * 128 + n) * 64);
#pragma unroll
    for (int i = 0; i < 8; ++i) { const uint4 u = kp[i]; kk[2 * i] = make_float4(bflo(u.x), bfhi(u.x), bflo(u.y), bfhi(u.y)); kk[2 * i + 1] = make_float4(bflo(u.z), bfhi(u.z), bflo(u.w), bfhi(u.w)); }
    float sc[16]; sa_scores<16>(qs, kk, sc);
#pragma unroll
    for (int r = 0; r < 16; ++r) { const int rel = PAST + (r >> 2) - (16 * n + 31); sc[r] = okn ? sc[r] + btab[(r & 3) * 129 + (rel < 128 ? rel : 128)] : -3.0e38f; }
#pragma unroll
    for (int r4 = 0; r4 < 4; ++r4) *(float4*)(Sc + n * 16 + 4 * r4) = make_float4(sc[4 * r4], sc[4 * r4 + 1], sc[4 * r4 + 2], sc[4 * r4 + 3]);
  }
  __syncthreads();
  sa_softmax<16>(Sc, 128, srow, ssub);
  __syncthreads();
  {
    float o[16];
#pragma unroll
    for (int r = 0; r < 16; ++r) o[r] = 0.f;
    const u16* vc = (const u16*)(p.ws + W_VCMP) + (size_t)(seq * 2 + g) * 128 * 64 + lane;
    const int n1 = (32 * w + 32 < 127) ? 32 * w + 32 : 127;
#pragma unroll 8
    for (int n = 32 * w; n < n1; ++n) {
      const float v = bf2f(vc[(size_t)n * 64]);
#pragma unroll
      for (int r4 = 0; r4 < 4; ++r4) { const float4 p4 = *(const float4*)(Sc + n * 16 + 4 * r4); o[4 * r4] += p4.x * v; o[4 * r4 + 1] += p4.y * v; o[4 * r4 + 2] += p4.z * v; o[4 * r4 + 3] += p4.w * v; }
    }
#pragma unroll
    for (int r = 0; r < 16; ++r) obuf[(w * 16 + r) * 64 + lane] = o[r];
  }
  if (tid < 4 * 33) {
    const int t = tid / 33, j = tid % 33; float sm = 0.f;
    for (int u = -1; u <= 3; ++u) { const int n = 4 * j + u; if (n >= 0 && n < 127) { const float4 p4 = *(const float4*)(Sc + n * 16 + 4 * t); sm += (p4.x + p4.y + p4.z + p4.w) * ((u == -1 || u == 3) ? 1.f : 2.f); } }
    imp[tid] = sm;
  }
  __syncthreads();
  for (int i = tid; i < 1024; i += 256) { const int row = i >> 6; ofin[i] = gate[(row >> 2) * 24 + g * 4 + (row & 3)] * (obuf[i] + obuf[1024 + i] + obuf[2048 + i] + obuf[3072 + i]); }
  if (tid < 4) {
    const int t = tid; int* sl = sel + t * 8; sl[0] = 0; sl[1] = 31; sl[2] = 32;
    unsigned taken = 0u;
    for (int c = 0; c < 5; ++c) {
      float best = -1.f; int bi = 1;
      for (int j = 1; j <= 30; ++j) { const float v = imp[t * 33 + j]; if (!((taken >> j) & 1u) && v > best) { best = v; bi = j; } }
      taken |= 1u << bi; sl[3 + c] = bi;
    }
  }
  __syncthreads();
  {
    float* P = Sc + w * 2048;
    const int t = w; const int* sl = sel + t * 8;
    const float* fresh_k = p.out + O_SCK + 2 * (size_t)NTS * 128 + (size_t)(b * 4) * 128 + g * 64;
    const float* fresh_v = p.out + O_SCK + 3 * (size_t)NTS * 128 + (size_t)(b * 4) * 128 + g * 64;
    for (int jj = 0; jj < 8; ++jj) {
      const int blk = sl[jj];
      const float* kbase; bool okk;
      if (blk < 32) { const int page = p.pt[b * 16 + (blk >> 1)]; kbase = p.csk + (((size_t)page * 128 + (blk & 1) * 64) * 2 + g) * 64; okk = true; }
      else { kbase = fresh_k; okk = lane < 4; }
      float4 kk[16]; sa_load_f32(kbase + (size_t)(okk ? lane : 0) * 128, okk, kk);
      float sc[4]; sa_scores<4>(qs + 4 * t * 64, kk, sc);
      const int rel = PAST + t - (blk * 64 + lane);
      const bool ok = okk && rel >= 0;
      const int bi = rel < 0 ? 0 : (rel < 128 ? rel : 128);
      *(float4*)(P + (jj * 64 + lane) * 4) = make_float4(ok ? sc[0] + btab[bi] : -3.0e38f, ok ? sc[1] + btab[129 + bi] : -3.0e38f,
                                                        ok ? sc[2] + btab[258 + bi] : -3.0e38f, ok ? sc[3] + btab[387 + bi] : -3.0e38f);
    }
    __syncthreads();
    sa_softmax<4>(P, 512, lane >> 4, lane & 15);
    __syncthreads();
    float o[4] = {0.f, 0.f, 0.f, 0.f};
    for (int jj = 0; jj < 8; ++jj) {
      const int blk = sl[jj];
      const float* vbase; int ns;
      if (blk < 32) { const int page = p.pt[b * 16 + (blk >> 1)]; vbase = p.csv + (((size_t)page * 128 + (blk & 1) * 64) * 2 + g) * 64; ns = 64; }
      else { vbase = fresh_v; ns = 4; }
#pragma unroll 8
      for (int s_ = 0; s_ < ns; ++s_) {
        const float v = vbase[(size_t)s_ * 128 + lane];
        const float4 p4 = *(const float4*)(P + (jj * 64 + s_) * 4);
        o[0] += p4.x * v; o[1] += p4.y * v; o[2] += p4.z * v; o[3] += p4.w * v;
      }
    }
#pragma unroll
    for (int r = 0; r < 4; ++r) ofin[(4 * t + r) * 64 + lane] += gate[t * 24 + 8 + g * 4 + r] * o[r];
  }
  __syncthreads();
  {
    const float* fresh_k = p.out + O_SWK + ((size_t)b * 512 + 508) * 128 + g * 64;
    const float* fresh_v = p.out + O_SWK + (size_t)DEC_BATCH * 512 * 128 + ((size_t)b * 512 + 508) * 128 + g * 64;
    for (int j = w; j < 9; j += 4) {
      const int key = j * 64 + lane; const bool okk = key < 516;
      const float* rowp = (key < 512) ? (p.swk + ((size_t)b * 512 + key) * 128 + g * 64) : (fresh_k + (size_t)(okk ? key - 512 : 0) * 128);
      float4 kk[16]; sa_load_f32(rowp, okk, kk);
      float sc[16]; sa_scores<16>(qs, kk, sc);
#pragma unroll
      for (int r = 0; r < 16; ++r) {
        const int rel = PAST + (r >> 2) - (PAST - 512 + key);
        const bool ok = okk && rel >= 0 && rel < 512;
        sc[r] = ok ? sc[r] + btab[(r & 3) * 129 + (rel < 128 ? rel : 128)] : -3.0e38f;
      }
#pragma unroll
      for (int r4 = 0; r4 < 4; ++r4) *(float4*)(Sc + key * 16 + 4 * r4) = make_float4(sc[4 * r4], sc[4 * r4 + 1], sc[4 * r4 + 2], sc[4 * r4 + 3]);
    }
    __syncthreads();
    sa_softmax<16>(Sc, 576, srow, ssub);
    __syncthreads();
    float o[16];
#pragma unroll
    for (int r = 0; r < 16; ++r) o[r] = 0.f;
    const float* vst = p.swv + (size_t)b * 512 * 128 + g * 64 + lane;
#pragma unroll 4
    for (int key = 129 * w; key < 129 * w + 129; ++key) {
      const float v = (key < 512) ? vst[(size_t)key * 128] : fresh_v[(size_t)(key - 512) * 128 + lane];
#pragma unroll
      for (int r4 = 0; r4 < 4; ++r4) { const float4 p4 = *(const float4*)(Sc + key * 16 + 4 * r4); o[4 * r4] += p4.x * v; o[4 * r4 + 1] += p4.y * v; o[4 * r4 + 2] += p4.z * v; o[4 * r4 + 3] += p4.w * v; }
    }
#pragma unroll
    for (int r = 0; r < 16; ++r) obuf[(w * 16 + r) * 64 + lane] = o[r];
  }
  __syncthreads();
  for (int i = tid; i < 1024; i += 256) {
    const int row = i >> 6, dd = i & 63, t = row >> 2, r = row & 3, hd = g * 4 + r; const size_t tok = (size_t)(NTP + b * 4 + t);
    const float o = ofin[i] + gate[t * 24 + 16 + hd] * (obuf[i] + obuf[1024 + i] + obuf[2048 + i] + obuf[3072 + i]);
    ((u16*)(p.ws + W_OA))[tok * 512 + hd * 64 + dd] = f2bf(o * bf2f(((const u16*)(p.ws + W_ZA))[tok * 512 + hd * 64 + dd]));
  }
  __syncthreads();
}

constexpr int P2_HP = BATCH * 4 * 32;
constexpr int P2_CMP = BATCH * 2 * 2;
constexpr int P2_SA = DEC_BATCH * 2;
constexpr int P2_HS = DEC_BATCH * 4;
constexpr int P2_TOTAL = P2_HP + P2_CMP + P2_SA + P2_HS;
DI void phase2_item(const Params& p, int it, char* lds) {
  if (it < P2_SA) { sample_attn_item(p, it, lds); return; }
  it -= P2_SA;
  if (it < P2_CMP) {
    const int kv = it & 1, g = (it >> 1) & 1, b = it >> 2;
    LoadCellBf16 al{(const u16*)(p.ws + W_KV) + (size_t)kv * NT * 128 + (size_t)b * 2048 * 128 + g * 64};
    comp_tile(p, al, b, g, kv, lds); return;
  }
  it -= P2_CMP;
  if (it < P2_HP) { hgrn_h1_item(p, it, lds); return; }
  it -= P2_HP;
  hgrn_sample_item(p, it, lds);
}

constexpr int AKS = 72, AVS = 68, ACS = 132;
DI bf16x8 pack8(const f32x16& x, int s2) {
  uint4 u; u.x = pk2(x[8 * s2], x[8 * s2 + 1]); u.y = pk2(x[8 * s2 + 2], x[8 * s2 + 3]);
  u.z = pk2(x[8 * s2 + 4], x[8 * s2 + 5]); u.w = pk2(x[8 * s2 + 6], x[8 * s2 + 7]);
  return __builtin_bit_cast(bf16x8, u);
}
DI void zero16(f32x16& x) {
#pragma unroll
  for (int i = 0; i < 16; ++i) x[i] = 0.f;
}

template <bool WIN>
DI void attn_tile(const u16* Kt, const u16* Vt, const float* brel_r, const bf16x8 (&qf)[4], int qpos, int kpos0, bool lane_on,
                  float& m_run, float& l_run, f32x16 (&oacc)[2], int ql, int hh) {
  f32x16 sacc[2];
#pragma unroll
  for (int kt = 0; kt < 2; ++kt) {
    zero16(sacc[kt]);
#pragma unroll
    for (int ks = 0; ks < 4; ++ks) {
      const bf16x8 kf = *(const bf16x8*)(Kt + (32 * kt + ql) * AKS + 16 * ks + 8 * hh);
      sacc[kt] = MFMA32(kf, qf[ks], sacc[kt]);
    }
  }
  float mt = -1.0e30f;
#pragma unroll
  for (int kt = 0; kt < 2; ++kt)
#pragma unroll
    for (int i = 0; i < 16; ++i) {
      const int rel = qpos - (kpos0 + 32 * kt + crow(i, hh));
      const bool ok = lane_on && rel >= 0 && (!WIN || rel < 512);
      const float sv = sacc[kt][i] + brel_r[rel < 0 ? 0 : (rel < 128 ? rel : 128)];
      sacc[kt][i] = ok ? sv : -1.0e30f;
      mt = fmaxf(mt, sacc[kt][i]);
    }
  mt = fmaxf(mt, __shfl_xor(mt, 32));
  const float mn = fmaxf(m_run, mt);
  const float alpha = __expf(m_run - mn);
  m_run = mn;
  float ls = 0.f;
#pragma unroll
  for (int kt = 0; kt < 2; ++kt)
#pragma unroll
    for (int i = 0; i < 16; ++i) {
      const float pv = (sacc[kt][i] > -1.0e29f) ? __expf(sacc[kt][i] - mn) : 0.f;
      sacc[kt][i] = pv; ls += pv;
    }
  l_run = l_run * alpha + ls;
#pragma unroll
  for (int dt = 0; dt < 2; ++dt)
#pragma unroll
    for (int i = 0; i < 16; ++i) oacc[dt][i] *= alpha;
#pragma unroll
  for (int kt = 0; kt < 2; ++kt)
#pragma unroll
    for (int s2 = 0; s2 < 2; ++s2) {
      const bf16x8 pf = pack8(sacc[kt], s2);
#pragma unroll
      for (int dt = 0; dt < 2; ++dt) {
        const u16* vp = Vt + (32 * dt + ql) * AVS + 32 * kt + 16 * s2 + 4 * hh;
        const bf16x8 vf = cat8(*(const s16x4*)vp, *(const s16x4*)(vp + 8));
        oacc[dt] = MFMA32(vf, pf, oacc[dt]);
      }
    }
}

DI void attn_load_tile(u16* Kt, u16* Vt, const u16* ksrc  , const u16* vtsrc  ) {
  const int tid = otid();
#pragma unroll
  for (int i = 0; i < 2; ++i) {
    const int idx = tid + 256 * i, rw = idx >> 3, ch = idx & 7;
    *(uint4*)(Kt + rw * AKS + ch * 8) = *(const uint4*)(ksrc + (size_t)rw * 128 + ch * 8);
    const uint4 v = *(const uint4*)(vtsrc + (size_t)rw * 2048 + ch * 8);
    *(uint2*)(Vt + rw * AVS + ch * 8) = make_uint2(v.x, v.y);
    *(uint2*)(Vt + rw * AVS + ch * 8 + 4) = make_uint2(v.z, v.w);
  }
}

DI void prompt_attn_item(const Params& p, int it, char* lds) {
  const int qt = (it < 512) ? (63 - (it & 63)) : (it & 63), g = (it >> 6) & 1, b = (it >> 7) & 7;
  const int t0 = qt * 32;
  const int tid = otid(), lane = tid & 63, w = tid >> 6, ql = lane & 31, hh = lane >> 5, tl = ql >> 2, r = ql & 3;
  const int qpos = t0 + 8 * w + tl, head = g * 4 + r;
  const size_t tok = (size_t)b * 2048 + qpos;
  u16* Kt = (u16*)lds;
  u16* Vt = Kt + 128 * AKS;
  float* brel = (float*)(Vt + 64 * ACS);
  unsigned* wmask = (unsigned*)(brel + 4 * 129);
  const u16* Qb = (const u16*)(p.ws + W_Q);
  __syncthreads();
  for (int i = tid; i < 4 * 129; i += 256) { const int rr = i / 129, rel = i % 129; const int bk = rel < 128 ? T5B[rel] : 31; brel[i] = p.rel_bias[bk * 8 + g * 4 + rr]; }
  bf16x8 qf[4];
#pragma unroll
  for (int ks = 0; ks < 4; ++ks) qf[ks] = *(const bf16x8*)(Qb + tok * 512 + head * 64 + 16 * ks + 8 * hh);
  const float* gt = (const float*)(p.ws + W_GATE) + tok * 24;
  const float* brel_r = brel + r * 129;
  f32x16 of[2];
  unsigned selm;
  {
#pragma unroll
    for (int i = 0; i < 4; ++i) {
      const int idx = tid + 256 * i;
      { const int n = idx >> 3, ch = idx & 7;
        *(uint4*)(Kt + n * AKS + ch * 8) = *(const uint4*)((const u16*)(p.ws + W_KCMP) + ((size_t)(b * 2 + g) * 128 + n) * 64 + ch * 8); }
      { const int dd = idx >> 4, ch = idx & 15;
        const uint4 v = *(const uint4*)((const u16*)(p.ws + W_VCMPT) + ((size_t)(b * 2 + g) * 64 + dd) * 128 + ch * 8);
        *(uint2*)(Vt + dd * ACS + ch * 8) = make_uint2(v.x, v.y); *(uint2*)(Vt + dd * ACS + ch * 8 + 4) = make_uint2(v.z, v.w); }
    }
    __syncthreads();
    f32x16 sacc[4];
#pragma unroll
    for (int kt = 0; kt < 4; ++kt) {
      zero16(sacc[kt]);
#pragma unroll
      for (int ks = 0; ks < 4; ++ks) {
        const bf16x8 kf = *(const bf16x8*)(Kt + (32 * kt + ql) * AKS + 16 * ks + 8 * hh);
        sacc[kt] = MFMA32(kf, qf[ks], sacc[kt]);
      }
    }
    float mt = -1.0e30f;
#pragma unroll
    for (int kt = 0; kt < 4; ++kt)
#pragma unroll
      for (int i = 0; i < 16; ++i) {
        const int n = 32 * kt + crow(i, hh);
        const int rel = qpos - (16 * n + 31);
        const bool ok = rel >= 0 && n < 127;
        const float sv = sacc[kt][i] + brel_r[rel < 0 ? 0 : (rel < 128 ? rel : 128)];
        sacc[kt][i] = ok ? sv : -1.0e30f;
        mt = fmaxf(mt, sacc[kt][i]);
      }
    mt = fmaxf(mt, __shfl_xor(mt, 32));
    float ls = 0.f;
#pragma unroll
    for (int kt = 0; kt < 4; ++kt)
#pragma unroll
      for (int i = 0; i < 16; ++i) { const float pv = (sacc[kt][i] > -1.0e29f) ? __expf(sacc[kt][i] - mt) : 0.f; sacc[kt][i] = pv; ls += pv; }
    ls += __shfl_xor(ls, 32);
    const float inv = ls > 0.f ? 1.f / ls : 0.f;
#pragma unroll
    for (int kt = 0; kt < 4; ++kt)
#pragma unroll
      for (int i = 0; i < 16; ++i) sacc[kt][i] *= inv;
    f32x16 oc[2]; zero16(oc[0]); zero16(oc[1]);
#pragma unroll
    for (int kt = 0; kt < 4; ++kt)
#pragma unroll
      for (int s2 = 0; s2 < 2; ++s2) {
        const bf16x8 pf = pack8(sacc[kt], s2);
#pragma unroll
        for (int dt = 0; dt < 2; ++dt) {
          const u16* vp = Vt + (32 * dt + ql) * ACS + 32 * kt + 16 * s2 + 4 * hh;
          const bf16x8 vf = cat8(*(const s16x4*)vp, *(const s16x4*)(vp + 8));
          oc[dt] = MFMA32(vf, pf, oc[dt]);
        }
      }
    const float g0 = gt[head];
#pragma unroll
    for (int dt = 0; dt < 2; ++dt)
#pragma unroll
      for (int i = 0; i < 16; ++i) of[dt][i] = g0 * oc[dt][i];
    float im[16], cm[16];
#pragma unroll
    for (int kt = 0; kt < 4; ++kt)
#pragma unroll
      for (int q4 = 0; q4 < 4; ++q4) {
        const float p0 = sacc[kt][4 * q4], p1 = sacc[kt][4 * q4 + 1], p2 = sacc[kt][4 * q4 + 2], p3 = sacc[kt][4 * q4 + 3];
        im[4 * kt + q4] = 2.f * (p0 + p1 + p2) + p3; cm[4 * kt + q4] = p3;
      }
#pragma unroll
    for (int m = 0; m < 16; ++m) cm[m] = __shfl_xor(cm[m], 32);
#pragma unroll
    for (int m = 15; m >= 0; --m) im[m] += hh ? cm[m] : (m > 0 ? cm[m - 1] : 0.f);
#pragma unroll
    for (int m = 0; m < 16; ++m) { im[m] += __shfl_xor(im[m], 1); im[m] += __shfl_xor(im[m], 2); }
    float ev[16], od[16];
#pragma unroll
    for (int m = 0; m < 16; ++m) { const float ot = __shfl_xor(im[m], 32); ev[m] = hh ? ot : im[m]; od[m] = hh ? im[m] : ot; }
    const int cur = qpos >> 6;
    if (cur < 8) selm = (2u << cur) - 1u;
    else {
      selm = 1u | (1u << cur) | (1u << (cur - 1));
      for (int c = 0; c < 5; ++c) {
        float best = -1.f;
#pragma unroll
        for (int J = 0; J < 32; ++J) { const float v = (J <= cur && !((selm >> J) & 1u)) ? ((J & 1) ? od[J >> 1] : ev[J >> 1]) : -1.f; best = fmaxf(best, v); }
        int bi = 32;
#pragma unroll
        for (int J = 31; J >= 0; --J) { const float v = (J <= cur && !((selm >> J) & 1u)) ? ((J & 1) ? od[J >> 1] : ev[J >> 1]) : -1.f; if (v == best) bi = J; }
        if (best >= 0.f) selm |= 1u << bi;
      }
    }
    unsigned um = selm;
    um |= __shfl_xor(um, 4); um |= __shfl_xor(um, 8); um |= __shfl_xor(um, 16);
    if (lane == 0) wmask[w] = um;
  }
  __syncthreads();
  const unsigned un = wmask[0] | wmask[1] | wmask[2] | wmask[3];
  {
    float m_run = -1.0e30f, l_run = 0.f; f32x16 oacc[2]; zero16(oacc[0]); zero16(oacc[1]);
    const u16* ks = (const u16*)(p.ws + W_KV) + (size_t)2 * NT * 128 + (size_t)b * 2048 * 128 + g * 64;
    const u16* vt = (const u16*)(p.ws + W_VST) + (size_t)(b * 2 + g) * 64 * 2048;
    for (int j = 0; j < 32; ++j) {
      if (!((un >> j) & 1u)) continue;
      __syncthreads();
      attn_load_tile(Kt, Vt, ks + (size_t)j * 64 * 128, vt + j * 64);
      __syncthreads();
      const bool on = (selm >> j) & 1u;
      if (__ballot(on) != 0ull) attn_tile<false>(Kt, Vt, brel_r, qf, qpos, j * 64, on, m_run, l_run, oacc, ql, hh);
    }
    l_run += __shfl_xor(l_run, 32);
    const float sc = gt[8 + head] * (l_run > 0.f ? 1.f / l_run : 0.f);
#pragma unroll
    for (int dt = 0; dt < 2; ++dt)
#pragma unroll
      for (int i = 0; i < 16; ++i) of[dt][i] += sc * oacc[dt][i];
  }
  {
    float m_run = -1.0e30f, l_run = 0.f; f32x16 oacc[2]; zero16(oacc[0]); zero16(oacc[1]);
    const u16* kw = (const u16*)(p.ws + W_KV) + (size_t)4 * NT * 128 + (size_t)b * 2048 * 128 + g * 64;
    const u16* vt = (const u16*)(p.ws + W_VWT) + (size_t)(b * 2 + g) * 64 * 2048;
    const int jlo = (t0 >= 511) ? ((t0 - 511) >> 6) : 0, jhi = (t0 + 31) >> 6;
    for (int j = jlo; j <= jhi; ++j) {
      __syncthreads();
      attn_load_tile(Kt, Vt, kw + (size_t)j * 64 * 128, vt + j * 64);
      __syncthreads();
      attn_tile<true>(Kt, Vt, brel_r, qf, qpos, j * 64, true, m_run, l_run, oacc, ql, hh);
    }
    l_run += __shfl_xor(l_run, 32);
    const float sc = gt[16 + head] * (l_run > 0.f ? 1.f / l_run : 0.f);
#pragma unroll
    for (int dt = 0; dt < 2; ++dt)
#pragma unroll
      for (int i = 0; i < 16; ++i) of[dt][i] += sc * oacc[dt][i];
  }
  {
    const u16* za = (const u16*)(p.ws + W_ZA) + tok * 512 + head * 64; u16* oa = (u16*)(p.ws + W_OA) + tok * 512 + head * 64;
#pragma unroll
    for (int dt = 0; dt < 2; ++dt)
#pragma unroll
      for (int q4 = 0; q4 < 4; ++q4) {
        const int dd = 32 * dt + 8 * q4 + 4 * hh;
        const uint2 z = *(const uint2*)(za + dd);
        uint2 o; o.x = pk2(of[dt][4 * q4] * bflo(z.x), of[dt][4 * q4 + 1] * bfhi(z.x)); o.y = pk2(of[dt][4 * q4 + 2] * bflo(z.y), of[dt][4 * q4 + 3] * bfhi(z.y));
        *(uint2*)(oa + dd) = o;
      }
  }
}
constexpr int P3_FIN = BATCH * 4 * 32;
constexpr int P3_ATT = BATCH * 2 * 64;
constexpr int P3_TOTAL = P3_FIN + P3_ATT;

constexpr int P4_TOTAL = G1_MT * 16;
DI void merge_a_tile(const Params& p, int it, char* lds) {
  const int tm = it >> 4, tn = it & 15;
  f32x16 aa[2][1], ab[2][1]; zero_acc<1>(aa); zero_acc<1>(ab);
  { LoadBf16 al{(const u16*)(p.ws + W_OA) + (size_t)tm * 128 * 512, 512}; LoadBf16 bl{(const u16*)(p.ws + W_WBAT) + (size_t)tn * 64 * 512, 512}; gemm_main<1>(aa, al, bl, 8, lds); }
  { LoadBf16 al{(const u16*)(p.ws + W_OB) + (size_t)tm * 128 * 512, 512}; LoadBf16 bl{(const u16*)(p.ws + W_WBBT) + (size_t)tn * 64 * 512, 512}; gemm_main<1>(ab, al, bl, 8, lds); }
  const int tid = threadIdx.x, lane = tid & 63, wave = tid >> 6, wm = wave >> 1, wn = wave & 1, r = lane & 31, h = lane >> 5;
#pragma unroll
  for (int mi = 0; mi < 2; ++mi) {
    const int c = tn * 64 + wn * 32 + r;
#pragma unroll
    for (int i = 0; i < 16; ++i) {
      const size_t off = (size_t)(tm * 128 + wm * 64 + mi * 32 + crow(i, h)) * 1024 + c;
      const float y = bf2f(((const u16*)(p.ws + W_SA))[off]) * aa[mi][0][i] + bf2f(((const u16*)(p.ws + W_SB))[off]) * ab[mi][0][i];
      ((u16*)(p.ws + W_Y))[off] = f2bf(y);
    }
  }
}
constexpr int P5_TOTAL = G1_MT * 8;
DI void merge_b_tile(const Params& p, int it, char* lds) {
  const int tm = it >> 3, tn = it & 7;
  f32x16 acc[2][2]; zero_acc<2>(acc);
  LoadBf16 al{(const u16*)(p.ws + W_Y) + (size_t)tm * 128 * 1024, 1024}; LoadBf16 bl{(const u16*)(p.ws + W_WOUTT) + (size_t)tn * 128 * 1024, 1024};
  gemm_main<2>(acc, al, bl, 16, lds);
  const int tid = threadIdx.x, lane = tid & 63, wave = tid >> 6, wm = wave >> 1, wn = wave & 1, r = lane & 31, h = lane >> 5;
  const float* xin = (tm < 128) ? p.x_prompt : (p.x_sample - (size_t)NTP * 1024);
#pragma unroll
  for (int mi = 0; mi < 2; ++mi) {
#pragma unroll
    for (int i = 0; i < 16; ++i) {
      const size_t row = (size_t)(tm * 128 + wm * 64 + mi * 32 + crow(i, h));
      float ss = 0.f;
#pragma unroll
      for (int ni = 0; ni < 2; ++ni) {
        const int c = tn * 128 + wn * 64 + ni * 32 + r;
        const float hv = acc[mi][ni][i] + xin[row * 1024 + c];
        p.out[row * 1024 + c] = hv; ss += hv * hv;
      }
      ss += __shfl_xor(ss, 1); ss += __shfl_xor(ss, 2); ss += __shfl_xor(ss, 4); ss += __shfl_xor(ss, 8); ss += __shfl_xor(ss, 16);
      if (r == 0) ((float*)(p.ws + W_SS))[row * 16 + tn * 2 + wn] = ss;
    }
  }
}
constexpr int P6_TOTAL = NT / 4;
DI void final_norm_item(const Params& p, int it) {
  const int lane = threadIdx.x & 63, wave = threadIdx.x >> 6; const size_t row = (size_t)it * 4 + wave;
  const float* ssp = (const float*)(p.ws + W_SS) + row * 16;
  float ss = 0.f;
#pragma unroll
  for (int i = 0; i < 16; ++i) ss += ssp[i];
  const float rs = rsqrtf(ss * (1.f / 1024.f) + 1e-6f);
  float* o = p.out + row * 1024;
#pragma unroll
  for (int i = 0; i < 4; ++i) {
    float4 v = *(float4*)(o + (i * 64 + lane) * 4); const float4 gg = *(const float4*)(p.final_g + (i * 64 + lane) * 4);
    v.x *= rs * gg.x; v.y *= rs * gg.y; v.z *= rs * gg.z; v.w *= rs * gg.w;
    *(float4*)(o + (i * 64 + lane) * 4) = v;
  }
}


#define XB_TMO      128
#define XB_XCNT(j)  (256  + 64 * (j))
#define XB_XSUB(j)  (1280 + 64 * (j))
#define XB_XGEN(j)  (2304 + 64 * (j))
#define XB_TOP      3328
#define XB_TOPGEN   3392
#define XCD_BAR_WORDS 3456
#define XB_SPIN_CAP (1u << 18)
#define LAS __attribute__((address_space(3)))
DI unsigned xb_ld(unsigned* p)              { return __hip_atomic_load(p, __ATOMIC_RELAXED, __HIP_MEMORY_SCOPE_AGENT); }
DI unsigned xb_add(unsigned* p, unsigned v) { return __hip_atomic_fetch_add(p, v, __ATOMIC_RELAXED, __HIP_MEMORY_SCOPE_AGENT); }
DI unsigned xb_xcc_id() { return (unsigned)__builtin_amdgcn_s_getreg((3 << 11) | 20) & 0xFu; }
#define XB_SPIN(cond, bar) do { unsigned _sp = 0; while (cond) { __builtin_amdgcn_s_sleep(1); \
    if ((++_sp & 255u) == 0u) { if (xb_ld(&(bar)[XB_TMO])) break; if (_sp > XB_SPIN_CAP) { atomicAdd(&(bar)[XB_TMO], 1u); break; } } } } while (0)
struct XcdBarrier { unsigned* bar; unsigned x; volatile LAS unsigned* st; };
DI XcdBarrier xcd_barrier_post(unsigned* bar, volatile LAS unsigned* st) {
  XcdBarrier b; b.bar = bar; b.x = xb_xcc_id(); b.st = st;
  if (threadIdx.x == 0) (void)xb_add(&bar[XB_XCNT(b.x)], 1u);
  return b;
}
DI void xcd_barrier_complete(unsigned* bar, unsigned x, unsigned& nloc, unsigned& nx) {
  const unsigned G = gridDim.x * gridDim.y * gridDim.z;
  unsigned sum, cnt, mine, sp = 0u;
  for (;;) {
    sum = 0u; cnt = 0u; mine = 0u;
#pragma unroll
    for (unsigned j = 0; j < 16; ++j) { const unsigned c = xb_ld(&bar[XB_XCNT(j)]); sum += c; cnt += (c > 0u) ? 1u : 0u; mine = (j == x) ? c : mine; }
    if (sum == G) break;
    __builtin_amdgcn_s_sleep(1);
    if ((++sp & 255u) == 0u) { if (xb_ld(&bar[XB_TMO])) break; if (sp > XB_SPIN_CAP) { atomicAdd(&bar[XB_TMO], 1u); break; } }
  }
  nloc = mine > 0u ? mine : 1u; nx = cnt > 0u ? cnt : 1u;
}
DI void xcd_barrier(const XcdBarrier& b) {
  asm volatile("s_waitcnt vmcnt(0)" ::: "memory");
  __syncthreads();
  if (threadIdx.x == 0) {
    unsigned* bar = b.bar;
    __builtin_amdgcn_s_waitcnt(0);
    unsigned nloc = b.st[0], nx = b.st[1];
    if (nloc == 0u) { xcd_barrier_complete(bar, b.x, nloc, nx); b.st[0] = nloc; b.st[1] = nx; }
    const unsigned old = xb_add(&bar[XB_XSUB(b.x)], 1u);
    const unsigned gen = old / nloc;
    if (old + 1u == (gen + 1u) * nloc) {
      __builtin_amdgcn_fence(__ATOMIC_RELEASE, "agent");
      asm volatile("s_waitcnt vmcnt(0)" ::: "memory");
      const unsigned og = xb_add(&bar[XB_TOP], 1u);
      const unsigned tg = og / nx;
      if (og + 1u == (tg + 1u) * nx) xb_add(&bar[XB_TOPGEN], 1u);
      else XB_SPIN(xb_ld(&bar[XB_TOPGEN]) == tg, bar);
      __builtin_amdgcn_fence(__ATOMIC_ACQUIRE, "agent");
      xb_add(&bar[XB_XGEN(b.x)], 1u);
      asm volatile("s_waitcnt vmcnt(0)" ::: "memory");
    } else {
      XB_SPIN(xb_ld(&bar[XB_XGEN(b.x)]) == gen, bar);
      __builtin_amdgcn_fence(__ATOMIC_ACQUIRE, "agent");
      asm volatile("s_waitcnt vmcnt(0)" ::: "memory");
    }
  }
  __syncthreads();
}

constexpr int LDS_BYTES = 64 * 1024;

template <int PH>
DI void run_phase(const Params& p, char* lds) {
  if (PH == 0) { for (int it = blockIdx.x; it < P0_TOTAL; it += gridDim.x) phase0_item(p, it, lds); }
  if (PH == 1) { for (int it = blockIdx.x; it < P1_TOTAL; it += gridDim.x) phase1_item(p, it, lds); }
  if (PH == 2) { for (int it = blockIdx.x; it < P2_TOTAL; it += gridDim.x) phase2_item(p, it, lds); }
  if (PH == 7) { for (int it = blockIdx.x; it < H2_ITEMS; it += gridDim.x) hgrn_h2_item(p, it); }
  if (PH == 3) { for (int it = blockIdx.x; it < P3_TOTAL; it += gridDim.x) { if (it < P3_FIN) hgrn_h3_item(p, it); else prompt_attn_item(p, it - P3_FIN, lds); } }
  if (PH == 4) { for (int it = blockIdx.x; it < P4_TOTAL; it += gridDim.x) merge_a_tile(p, it, lds); }
  if (PH == 5) { for (int it = blockIdx.x; it < P5_TOTAL; it += gridDim.x) merge_b_tile(p, it, lds); }
  if (PH == 6) { for (int it = blockIdx.x; it < P6_TOTAL; it += gridDim.x) final_norm_item(p, it); }
}

__global__ void __launch_bounds__(256, 2) k_mega(Params p) {
  __shared__ __attribute__((aligned(16))) char lds[LDS_BYTES];
  volatile LAS unsigned* st = (volatile LAS unsigned*)(lds + LDS_BYTES - 16);
  if (threadIdx.x == 0) { st[0] = 0u; st[1] = 0u; }
  __syncthreads();
  const XcdBarrier bar = xcd_barrier_post((unsigned*)(p.ws + W_BAR), st);
  run_phase<0>(p, lds); xcd_barrier(bar);
  run_phase<1>(p, lds); xcd_barrier(bar);
  run_phase<2>(p, lds); xcd_barrier(bar);
  run_phase<7>(p, lds); xcd_barrier(bar);
  run_phase<3>(p, lds); xcd_barrier(bar);
  run_phase<4>(p, lds); xcd_barrier(bar);
  run_phase<5>(p, lds); xcd_barrier(bar);
  run_phase<6>(p, lds);
}

extern "C" void kernel_launch(void* const* d_in, const int* in_sizes, int n_in, void* d_out, int out_size,
                              void* d_ws, size_t ws_size, hipStream_t stream) {
  Params p{};
  p.x_prompt = (const float*)d_in[0]; p.x_sample = (const float*)d_in[1];
  p.cck = (const float*)d_in[2]; p.ccv = (const float*)d_in[3]; p.csk = (const float*)d_in[4]; p.csv = (const float*)d_in[5];
  p.swk = (const float*)d_in[6]; p.swv = (const float*)d_in[7]; p.shg = (const float*)d_in[8]; p.pt = (const int*)d_in[9];
  p.norm_g = (const float*)d_in[10]; p.w_in = (const float*)d_in[11];
  p.pos_k = (const float*)d_in[12]; p.w1_k = (const float*)d_in[13]; p.w2_k = (const float*)d_in[14];
  p.pos_v = (const float*)d_in[15]; p.w1_v = (const float*)d_in[16]; p.w2_v = (const float*)d_in[17];
  p.rel_bias = (const float*)d_in[18]; p.hg_lower = (const float*)d_in[19]; p.hg_norm_g = (const float*)d_in[20];
  p.w_ba = (const float*)d_in[21]; p.w_bb = (const float*)d_in[22]; p.w_out = (const float*)d_in[23]; p.final_g = (const float*)d_in[24];
  p.out = (float*)d_out; p.ws = (char*)d_ws;
  if ((size_t)out_size != O_END || ws_size < W_END) { fprintf(stderr, "kernel_launch: unexpected sizes out=%d ws=%zu (need %zu / %zu)\n", out_size, ws_size, (size_t)O_END, (size_t)W_END); return; }
  static int grid_blocks = 0;
  if (!grid_blocks) {
    int dev = 0, cus = 0, per_cu = 0;
    hipGetDevice(&dev);
    hipDeviceGetAttribute(&cus, hipDeviceAttributeMultiprocessorCount, dev);
    hipOccupancyMaxActiveBlocksPerMultiprocessor(&per_cu, k_mega, 256, 0);
    if (per_cu > 2) per_cu = 2;
    if (per_cu < 1) per_cu = 1;
    grid_blocks = cus * per_cu;
  }
  hipMemsetAsync((char*)d_ws + W_BAR, 0, XCD_BAR_WORDS * 4, stream);
  void* args[] = {&p};
  hipError_t e = hipLaunchCooperativeKernel((void*)k_mega, dim3(grid_blocks), dim3(256), args, 0, stream);
  if (e != hipSuccess) fprintf(stderr, "cooperative launch failed: %s (grid %d)\n", hipGetErrorString(e), grid_blocks);
}
```

```cpp
#include <hip/hip_runtime.h>
#include <hip/hip_cooperative_groups.h>
#include <cstdio>
namespace cg = cooperative_groups;

#define DI __device__ __forceinline__
typedef unsigned short u16;
typedef __attribute__((ext_vector_type(8))) short bf16x8;
typedef __attribute__((ext_vector_type(4))) short s16x4;
typedef __attribute__((ext_vector_type(16))) float f32x16;
typedef __attribute__((ext_vector_type(4))) float f32x4;
typedef __attribute__((ext_vector_type(2))) float f32x2;
typedef __attribute__((ext_vector_type(2))) __bf16 bf16x2v;
#define MFMA32(a, b, c) __builtin_amdgcn_mfma_f32_32x32x16_bf16((a), (b), (c), 0, 0, 0)
#define MFMA16(a, b, c) __builtin_amdgcn_mfma_f32_16x16x32_bf16((a), (b), (c), 0, 0, 0)

constexpr int D_MODEL = 1024, BATCH = 8, SEQ = 2048, DEC_BATCH = 128, DEC_SEQ = 4, PAST = 2048;
constexpr int NTP = BATCH * SEQ;
constexpr int NTS = DEC_BATCH * DEC_SEQ;
constexpr int NT = NTP + NTS;
constexpr int IN_COLS = 5912, NPAD = 6016;
constexpr int NSEQ = BATCH + DEC_BATCH;

constexpr size_t O_YP = 0;
constexpr size_t O_YS = O_YP + (size_t)NTP * 1024;
constexpr size_t O_PCK = O_YS + (size_t)NTS * 1024;
constexpr size_t O_PWK = O_PCK + 4 * (size_t)NTP * 128;
constexpr size_t O_PHG = O_PWK + 2 * (size_t)BATCH * 512 * 128;
constexpr size_t O_SCK = O_PHG + (size_t)BATCH * 4 * 128 * 128;
constexpr size_t O_SWK = O_SCK + 4 * (size_t)NTS * 128;
constexpr size_t O_SHG = O_SWK + 2 * (size_t)DEC_BATCH * 512 * 128;
constexpr size_t O_END = O_SHG + (size_t)DEC_BATCH * 4 * 128 * 128;

constexpr size_t al256(size_t x) { return (x + 255) & ~(size_t)255; }
constexpr size_t W_WINT = 0;
constexpr size_t W_WBAT = al256(W_WINT + (size_t)NPAD * 1024 * 2);
constexpr size_t W_WBBT = al256(W_WBAT + (size_t)1024 * 512 * 2);
constexpr size_t W_WOUTT = al256(W_WBBT + (size_t)1024 * 512 * 2);
constexpr size_t W_W1T = al256(W_WOUTT + (size_t)1024 * 1024 * 2);
constexpr size_t W_C1 = al256(W_W1T + (size_t)2 * 128 * 1024 * 2);
constexpr size_t W_XN = al256(W_C1 + 2 * 64 * 4);
constexpr size_t W_Q = al256(W_XN + (size_t)NT * 1024 * 2);
constexpr size_t W_KV = al256(W_Q + (size_t)NT * 512 * 2);
constexpr size_t W_VST = al256(W_KV + (size_t)6 * NT * 128 * 2);
constexpr size_t W_VWT = al256(W_VST + (size_t)8 * 2 * 64 * 2048 * 2);
constexpr size_t W_GATE = al256(W_VWT + (size_t)8 * 2 * 64 * 2048 * 2);
constexpr size_t W_ZA = al256(W_GATE + (size_t)NT * 24 * 4);
constexpr size_t W_QB = al256(W_ZA + (size_t)NT * 512 * 2);
constexpr size_t W_KB = al256(W_QB + (size_t)NT * 512 * 2);
constexpr size_t W_GB = al256(W_KB + (size_t)NT * 512 * 2);
constexpr size_t W_VB = al256(W_GB + (size_t)NT * 512 * 4);
constexpr size_t W_ZB = al256(W_VB + (size_t)NT * 512 * 2);
constexpr size_t W_SA = al256(W_ZB + (size_t)NT * 512 * 2);
constexpr size_t W_SB = al256(W_SA + (size_t)NT * 1024 * 2);
constexpr size_t W_KCMP = al256(W_SB + (size_t)NT * 1024 * 2);
constexpr size_t W_VCMP = al256(W_KCMP + (size_t)NSEQ * 2 * 128 * 64 * 2);
constexpr size_t W_VCMPT = al256(W_VCMP + (size_t)NSEQ * 2 * 128 * 64 * 2);
constexpr size_t W_OA = al256(W_VCMPT + (size_t)8 * 2 * 64 * 128 * 2);
constexpr size_t W_OB = al256(W_OA + (size_t)NT * 512 * 2);
constexpr size_t W_Y = al256(W_OB + (size_t)NT * 512 * 2);
constexpr size_t W_SS = al256(W_Y + (size_t)NT * 1024 * 2);
constexpr size_t W_ORAW = al256(W_SS + (size_t)NT * 16 * 4);
constexpr size_t W_OSS = al256(W_ORAW + (size_t)NTP * 512 * 4);
constexpr size_t W_QG = al256(W_OSS + (size_t)NTP * 8 * 4);
constexpr size_t W_DST = al256(W_QG + (size_t)NTP * 512 * 2);
constexpr size_t W_DEC = al256(W_DST + (size_t)1024 * 128 * 128 * 4);
constexpr size_t W_SPT = al256(W_DEC + (size_t)1024 * 128 * 4);
constexpr size_t W_BAR = al256(W_SPT + (size_t)1024 * 128 * 128 * 2);
constexpr size_t W_END = al256(W_BAR + 3456 * 4);

struct Params {
  const float* x_prompt; const float* x_sample;
  const float* cck; const float* ccv; const float* csk; const float* csv;
  const float* swk; const float* swv; const float* shg; const int* pt;
  const float* norm_g; const float* w_in;
  const float* pos_k; const float* w1_k; const float* w2_k;
  const float* pos_v; const float* w1_v; const float* w2_v;
  const float* rel_bias; const float* hg_lower; const float* hg_norm_g;
  const float* w_ba; const float* w_bb; const float* w_out; const float* final_g;
  float* out; char* ws;
};

DI unsigned pk2(float a, float b) { f32x2 v = {a, b}; bf16x2v r = __builtin_convertvector(v, bf16x2v); return __builtin_bit_cast(unsigned, r); }
DI u16 f2bf(float a) { return (u16)(pk2(a, 0.f) & 0xffffu); }
DI float bf2f(u16 v) { return __uint_as_float(((unsigned)v) << 16); }
DI float bflo(unsigned v) { return __uint_as_float(v << 16); }
DI float bfhi(unsigned v) { return __uint_as_float(v & 0xffff0000u); }
constexpr float LOG2E = 1.4426950408889634f;
DI float sigmoidf_(float x) { return 1.f / (1.f + __expf(-x)); }
DI float siluf_(float x) { return x / (1.f + __expf(-x)); }
DI int otid() { int t = threadIdx.x & 255; asm volatile("" : "+v"(t)); return t; }
DI int otid512() { int t = threadIdx.x; asm volatile("" : "+v"(t)); return t; }
DI int crow(int reg, int h) { return (reg & 3) + 8 * (reg >> 2) + 4 * h; }
DI float wave_sum(float v) {
#pragma unroll
  for (int o = 32; o >= 1; o >>= 1) v += __shfl_xor(v, o);
  return v;
}
DI float wave_max(float v) {
#pragma unroll
  for (int o = 32; o >= 1; o >>= 1) v = fmaxf(v, __shfl_xor(v, o));
  return v;
}

__device__ const unsigned char T5B[128] = {
  0,1,2,3,4,5,6,7,8,9,10,11,12,13,14,15,
  16,16,16,17,17,18,18,18,19,19,19,20,20,20,20,21,
  21,21,21,22,22,22,22,22,23,23,23,23,23,23,24,24,
  24,24,24,24,25,25,25,25,25,25,25,26,26,26,26,26,
  26,26,26,27,27,27,27,27,27,27,27,27,27,28,28,28,
  28,28,28,28,28,28,28,29,29,29,29,29,29,29,29,29,
  29,29,29,30,30,30,30,30,30,30,30,30,30,30,30,30,
  30,31,31,31,31,31,31,31,31,31,31,31,31,31,31,31};

DI void transpose_tile(const float* __restrict__ src, int ldsrc, int K, int N, int k0, int n0,
                       u16* __restrict__ dst, int lddst, int dst_row_off, int dst_k0, int winperm, float* tl) {
  const int tid = otid();
  __syncthreads();
  {
    const int n = tid & 63, kb = tid >> 6;
#pragma unroll
    for (int i = 0; i < 16; ++i) {
      const int kk = kb + 4 * i;
      float v = 0.f;
      if (n0 + n < N && k0 + kk < K) v = src[(size_t)(k0 + kk) * ldsrc + n0 + n];
      tl[kk * 65 + n] = v;
    }
  }
  __syncthreads();
  {
    const int k = (tid & 31) * 2, nb = tid >> 5;
#pragma unroll
    for (int i = 0; i < 8; ++i) {
      const int nn = nb + 8 * i;
      int n = n0 + nn;
      if (n < N) {
        if (winperm) n = (n < 1280) ? n : ((n < 1304) ? (5888 + n - 1280) : (n - 24));
        const unsigned v = pk2(tl[k * 65 + nn], tl[(k + 1) * 65 + nn]);
        *(unsigned*)(dst + (size_t)(dst_row_off + n) * lddst + dst_k0 + k) = v;
      }
    }
  }
}

constexpr int P0_WIN = 16 * 93;
constexpr int P0_WBA = 8 * 16, P0_WBB = 8 * 16, P0_WOUT = 16 * 16, P0_W1 = 32 * 2;
constexpr int P0_TR = P0_WIN + P0_WBA + P0_WBB + P0_WOUT + P0_W1;
constexpr int P0_C1 = 2;
constexpr int P0_NORM = NT / 4;
constexpr int P0_WCP = 2 * DEC_BATCH;
constexpr int P0_PAD = NPAD - IN_COLS;
constexpr int P0_TOTAL = P0_TR + P0_C1 + P0_NORM + P0_WCP + P0_PAD;

DI void phase0_item(const Params& p, int it, char* lds) {
  const int tid = otid(), lane = tid & 63, wave = tid >> 6;
  float* tl = (float*)lds;
  if (it < P0_TR) {
    if (it < P0_WIN) {
      const int kt = it / 93, nt = it % 93;
      transpose_tile(p.w_in, IN_COLS, 1024, IN_COLS, kt * 64, nt * 64, (u16*)(p.ws + W_WINT), 1024, 0, kt * 64, 1, tl);
      return;
    }
    it -= P0_WIN;
    if (it < P0_WBA) { const int kt = it / 16, nt = it % 16;
      transpose_tile(p.w_ba, 1024, 512, 1024, kt * 64, nt * 64, (u16*)(p.ws + W_WBAT), 512, 0, kt * 64, 0, tl); return; }
    it -= P0_WBA;
    if (it < P0_WBB) { const int kt = it / 16, nt = it % 16;
      transpose_tile(p.w_bb, 1024, 512, 1024, kt * 64, nt * 64, (u16*)(p.ws + W_WBBT), 512, 0, kt * 64, 0, tl); return; }
    it -= P0_WBB;
    if (it < P0_WOUT) { const int kt = it / 16, nt = it % 16;
      transpose_tile(p.w_out, 1024, 1024, 1024, kt * 64, nt * 64, (u16*)(p.ws + W_WOUTT), 1024, 0, kt * 64, 0, tl); return; }
    it -= P0_WOUT;
    { const int kv = it >> 5, kt = it & 31;
      const float* w1 = kv ? p.w1_v : p.w1_k;
      transpose_tile(w1, 64, 2048, 64, kt * 64, 0, (u16*)(p.ws + W_W1T) + (size_t)kv * 128 * 1024, 1024,
                     (kt >= 16) ? 64 : 0, (kt & 15) * 64, 0, tl); return; }
  }
  it -= P0_TR;
  if (it < P0_C1) {
    const float* pos = it ? p.pos_v : p.pos_k; const float* w1 = it ? p.w1_v : p.w1_k;
    const int j = tid & 63, part = tid >> 6;
    float s = 0.f;
    for (int i = part * 512; i < part * 512 + 512; ++i) s += pos[i] * w1[(size_t)i * 64 + j];
    __syncthreads();
    tl[part * 64 + j] = s;
    __syncthreads();
    if (tid < 64) ((float*)(p.ws + W_C1))[it * 64 + tid] = tl[tid] + tl[64 + tid] + tl[128 + tid] + tl[192 + tid];
    return;
  }
  it -= P0_C1;
  if (it < P0_NORM) {
    const int row = it * 4 + wave;
    const float* x = (row < NTP) ? (p.x_prompt + (size_t)row * 1024) : (p.x_sample + (size_t)(row - NTP) * 1024);
    float4 v[4]; float ss = 0.f;
#pragma unroll
    for (int i = 0; i < 4; ++i) { v[i] = *(const float4*)(x + (i * 64 + lane) * 4); ss += v[i].x * v[i].x + v[i].y * v[i].y + v[i].z * v[i].z + v[i].w * v[i].w; }
    ss = wave_sum(ss);
    const float rs = rsqrtf(ss * (1.f / 1024.f) + 1e-6f);
    u16* xn = (u16*)(p.ws + W_XN) + (size_t)row * 1024;
#pragma unroll
    for (int i = 0; i < 4; ++i) {
      const float4 g = *(const float4*)(p.norm_g + (i * 64 + lane) * 4);
      uint2 o; o.x = pk2(v[i].x * rs * g.x, v[i].y * rs * g.y); o.y = pk2(v[i].z * rs * g.z, v[i].w * rs * g.w);
      *(uint2*)(xn + (i * 64 + lane) * 4) = o;
    }
    return;
  }
  it -= P0_NORM;
  if (it < P0_WCP) {
    const int kv = it / DEC_BATCH, b = it % DEC_BATCH;
    const float4* src = (const float4*)((kv ? p.swv : p.swk) + ((size_t)b * 512 + 4) * 128);
    float4* dst = (float4*)(p.out + O_SWK + (size_t)kv * DEC_BATCH * 512 * 128 + (size_t)b * 512 * 128);
    for (int i = tid; i < 508 * 32; i += 256) dst[i] = src[i];
    return;
  }
  it -= P0_WCP;
  { u16* d = (u16*)(p.ws + W_WINT) + (size_t)(IN_COLS + it) * 1024; *(uint2*)(d + tid * 4) = make_uint2(0u, 0u); }
}

constexpr int GST = 72;
struct LoadBf16 {
  const u16* base; int ld;
  DI uint4 load(int row, int ch, int kt) const { return *(const uint4*)(base + (size_t)row * ld + kt * 64 + ch * 8); }
};
struct LoadCellBf16 {
  const u16* base;
  DI uint4 load(int row, int ch, int kt) const { return *(const uint4*)(base + (size_t)(row * 16 + kt) * 128 + ch * 8); }
};
struct LoadCellPage {
  const float* cache; const int* pt; int g;
  DI uint4 load(int row, int ch, int kt) const {
    const int pos = row * 16 + kt; const int page = pt[pos >> 7];
    const float* s = cache + (((size_t)page * 128 + (pos & 127)) * 2 + g) * 64 + ch * 8;
    const float4 a = *(const float4*)s, b = *(const float4*)(s + 4);
    uint4 r; r.x = pk2(a.x, a.y); r.y = pk2(a.z, a.w); r.z = pk2(b.x, b.y); r.w = pk2(b.z, b.w); return r;
  }
};

template <int NI, class AL, class BL>
DI void gemm_main(f32x16 (&acc)[2][NI], const AL& al, const BL& bl, int nkt, char* lds) {
  u16* sA = (u16*)lds; u16* sB = sA + 128 * GST;
  const int tid = otid(), lane = tid & 63, wave = tid >> 6, wm = wave >> 1, wn = wave & 1;
  const int lrow = tid >> 3, lch = tid & 7, r = lane & 31, h = lane >> 5;
  uint4 ra[4], rb[2 * NI];
#pragma unroll
  for (int i = 0; i < 4; ++i) ra[i] = al.load(lrow + 32 * i, lch, 0);
#pragma unroll
  for (int i = 0; i < 2 * NI; ++i) rb[i] = bl.load(lrow + 32 * i, lch, 0);
  for (int kt = 0; kt < nkt; ++kt) {
    __syncthreads();
#pragma unroll
    for (int i = 0; i < 4; ++i) *(uint4*)(sA + (lrow + 32 * i) * GST + lch * 8) = ra[i];
#pragma unroll
    for (int i = 0; i < 2 * NI; ++i) *(uint4*)(sB + (lrow + 32 * i) * GST + lch * 8) = rb[i];
    __syncthreads();
    if (kt + 1 < nkt) {
#pragma unroll
      for (int i = 0; i < 4; ++i) ra[i] = al.load(lrow + 32 * i, lch, kt + 1);
#pragma unroll
      for (int i = 0; i < 2 * NI; ++i) rb[i] = bl.load(lrow + 32 * i, lch, kt + 1);
    }
#pragma unroll
    for (int s = 0; s < 4; ++s) {
      bf16x8 a[2], bb[NI];
#pragma unroll
      for (int mi = 0; mi < 2; ++mi) a[mi] = *(const bf16x8*)(sA + (wm * 64 + mi * 32 + r) * GST + s * 16 + 8 * h);
#pragma unroll
      for (int ni = 0; ni < NI; ++ni) bb[ni] = *(const bf16x8*)(sB + (wn * 32 * NI + ni * 32 + r) * GST + s * 16 + 8 * h);
#pragma unroll
      for (int mi = 0; mi < 2; ++mi)
#pragma unroll
        for (int ni = 0; ni < NI; ++ni) acc[mi][ni] = MFMA32(a[mi], bb[ni], acc[mi][ni]);
    }
  }
}

typedef __attribute__((address_space(1))) const unsigned gptr_t;
typedef __attribute__((address_space(3))) unsigned lptr_t;
template <int NI>
DI void gemm_glds(f32x16 (&acc)[2][NI], const u16* A, int lda, const u16* B, int ldb, int nkt, char* lds) {
  const int tid = otid(), lane = tid & 63, wave = tid >> 6, wm = wave >> 1, wn = wave & 1;
  const int r = lane & 31, h = lane >> 5;
  const int lr = (wave << 3) + (lane >> 3);
  const int lc = (lane & 7) ^ ((lane >> 3) & 7) ^ (wave & 1);
  const u16* ga = A + (size_t)lr * lda + lc * 8;
  const u16* gb = B + (size_t)lr * ldb + lc * 8;
  const int sw = (lane & 7) ^ ((lane >> 3) & 1);
  constexpr int STAGE = 16384 + 8192 * NI;
#define GLDS_ISSUE(buf, kt_) do { \
    char* sa_ = lds + (buf) * STAGE + tid * 16; \
    _Pragma("unroll") for (int i_ = 0; i_ < 4; ++i_) \
      __builtin_amdgcn_global_load_lds((gptr_t*)(ga + (size_t)(32 * i_) * lda + (kt_) * 64), (lptr_t*)(sa_ + i_ * 4096), 16, 0, 0); \
    _Pragma("unroll") for (int i_ = 0; i_ < 2 * NI; ++i_) \
      __builtin_amdgcn_global_load_lds((gptr_t*)(gb + (size_t)(32 * i_) * ldb + (kt_) * 64), (lptr_t*)(sa_ + 16384 + i_ * 4096), 16, 0, 0); \
  } while (0)
  __syncthreads();
  GLDS_ISSUE(0, 0);
#pragma unroll 1
  for (int kt = 0; kt < nkt; ++kt) {
    asm volatile("s_waitcnt vmcnt(0)" ::: "memory");
    __syncthreads();
    if (kt + 1 < nkt) GLDS_ISSUE((kt + 1) & 1, kt + 1);
    const char* sA = lds + (kt & 1) * STAGE; const char* sB = sA + 16384;
#pragma unroll
    for (int s = 0; s < 4; ++s) {
      const int co = ((2 * s + h) ^ sw) << 4;
      bf16x8 a[2], bb[NI];
#pragma unroll
      for (int mi = 0; mi < 2; ++mi) a[mi] = *(const bf16x8*)(sA + (wm * 64 + mi * 32 + r) * 128 + co);
#pragma unroll
      for (int ni = 0; ni < NI; ++ni) bb[ni] = *(const bf16x8*)(sB + (wn * 32 * NI + ni * 32 + r) * 128 + co);
#pragma unroll
      for (int mi = 0; mi < 2; ++mi)
#pragma unroll
        for (int ni = 0; ni < NI; ++ni) acc[mi][ni] = MFMA32(a[mi], bb[ni], acc[mi][ni]);
    }
  }
#undef GLDS_ISSUE
  __syncthreads();
}
template <int NI>
DI void zero_acc(f32x16 (&acc)[2][NI]) {
#pragma unroll
  for (int a = 0; a < 2; ++a)
#pragma unroll
    for (int b = 0; b < NI; ++b)
#pragma unroll
      for (int i = 0; i < 16; ++i) acc[a][b][i] = 0.f;
}

constexpr int G1_MT = NT / 128, G1_NT = NPAD / 128;
constexpr int P1_GEMM = G1_MT * G1_NT;
constexpr int P1_CMP = DEC_BATCH * 2 * 2;
constexpr int P1_TOTAL = P1_CMP + P1_GEMM;

DI void proj_tile(const Params& p, int tm, int tn, char* lds, bool store_ok) {
  f32x16 acc[2][2]; zero_acc<2>(acc);
  gemm_glds<2>(acc, (const u16*)(p.ws + W_XN) + (size_t)tm * 128 * 1024, 1024, (const u16*)(p.ws + W_WINT) + (size_t)tn * 128 * 1024, 1024, 16, lds);
  const int tid = otid(), lane = tid & 63, wave = tid >> 6, wm = wave >> 1, wn = wave & 1, r = lane & 31, h = lane >> 5;
  const bool samp = tm >= 128;
  if (!store_ok) return;
#pragma unroll
  for (int mi = 0; mi < 2; ++mi)
#pragma unroll
    for (int ni = 0; ni < 2; ++ni) {
      const int c = wn * 64 + ni * 32 + r;
      const int row0 = tm * 128 + wm * 64 + mi * 32;
      if (tn < 4) {
        u16* d = (u16*)(p.ws + W_Q) + tn * 128 + c;
#pragma unroll
        for (int i = 0; i < 16; ++i) d[(size_t)(row0 + crow(i, h)) * 512] = f2bf(acc[mi][ni][i] * (0.125f * LOG2E));
      } else if (tn < 10) {
        const int kvg = tn - 4;
        u16* d = (u16*)(p.ws + W_KV) + (size_t)kvg * NT * 128 + c;
#pragma unroll
        for (int i = 0; i < 16; ++i) {
          const int row = row0 + crow(i, h); const float v = acc[mi][ni][i];
          d[(size_t)row * 128] = f2bf(v);
          if (!samp) {
            if (kvg < 4) p.out[O_PCK + (size_t)kvg * NTP * 128 + (size_t)row * 128 + c] = v;
            else { const int t = row & 2047, b = row >> 11;
              if (t >= 1536) p.out[O_PWK + (size_t)(kvg - 4) * BATCH * 512 * 128 + ((size_t)b * 512 + t - 1536) * 128 + c] = v; }
          } else {
            const int srow = row - NTP;
            if (kvg < 4) p.out[O_SCK + (size_t)kvg * NTS * 128 + (size_t)srow * 128 + c] = v;
            else p.out[O_SWK + (size_t)(kvg - 4) * DEC_BATCH * 512 * 128 + ((size_t)(srow >> 2) * 512 + 508 + (srow & 3)) * 128 + c] = v;
          }
        }
        if (!samp && (kvg == 3 || kvg == 5)) {
          u16* vt = (u16*)(p.ws + (kvg == 3 ? W_VST : W_VWT));
          const int b = row0 >> 11, t0 = row0 & 2047, g = c >> 6, dd = c & 63;
          u16* drow = vt + ((size_t)(b * 2 + g) * 64 + dd) * 2048 + t0;
#pragma unroll
          for (int q = 0; q < 4; ++q) {
            uint2 o; o.x = pk2(acc[mi][ni][4 * q], acc[mi][ni][4 * q + 1]); o.y = pk2(acc[mi][ni][4 * q + 2], acc[mi][ni][4 * q + 3]);
            *(uint2*)(drow + 8 * q + 4 * h) = o;
          }
        }
      } else if (tn < 14 || (tn >= 26 && tn < 30)) {
        const bool isA = tn < 14; const int cc = (isA ? tn - 10 : tn - 26) * 128 + c;
        u16* d = (u16*)(p.ws + (isA ? W_ZA : W_ZB)) + cc;
#pragma unroll
        for (int i = 0; i < 16; ++i) d[(size_t)(row0 + crow(i, h)) * 512] = f2bf(siluf_(acc[mi][ni][i]));
      } else if (tn < 18 || (tn >= 22 && tn < 26)) {
        const bool isQ = tn < 18; const int cc = (isQ ? tn - 14 : tn - 22) * 128 + c;
        u16* d = (u16*)(p.ws + (isQ ? W_QB : W_VB)) + cc;
#pragma unroll
        for (int i = 0; i < 16; ++i) d[(size_t)(row0 + crow(i, h)) * 512] = f2bf(acc[mi][ni][i]);
      } else if (tn < 22) {
        const int cc = (tn - 18) * 128 + c;
        const float a0 = p.hg_lower[cc], a1 = p.hg_lower[512 + cc];
        const float lb = 1.f / (1.f + __expf(a1 - a0));
        u16* dk = (u16*)(p.ws + W_KB) + cc; float* dg = (float*)(p.ws + W_GB) + cc;
#pragma unroll
        for (int i = 0; i < 16; ++i) {
          const size_t row = row0 + crow(i, h);
          const float sg = sigmoidf_(acc[mi][ni][i]);
          const float f = lb + (1.f - lb) * sg;
          dg[row * 512] = __logf(f);
          dk[row * 512] = f2bf((1.f - lb) * (1.f - sg));
        }
      } else if (tn < 46) {
        const bool isA = tn < 38; const int cc = (isA ? tn - 30 : tn - 38) * 128 + c;
        u16* d = (u16*)(p.ws + (isA ? W_SA : W_SB)) + cc;
#pragma unroll
        for (int i = 0; i < 16; ++i) d[(size_t)(row0 + crow(i, h)) * 1024] = f2bf(sigmoidf_(acc[mi][ni][i]));
      } else {
        if (c < 24) {
          float* d = (float*)(p.ws + W_GATE) + c;
#pragma unroll
          for (int i = 0; i < 16; ++i) d[(size_t)(row0 + crow(i, h)) * 24] = sigmoidf_(acc[mi][ni][i]);
        }
      }
    }
}

template <class AL>
DI void comp_tile(const Params& p, const AL& al, int seq, int g, int kv, char* lds) {
  f32x16 acc[2][2]; zero_acc<2>(acc);
  LoadBf16 bl{(const u16*)(p.ws + W_W1T) + (size_t)kv * 128 * 1024, 1024};
  gemm_main<2>(acc, al, bl, 16, lds);
  const int tid = otid(), lane = tid & 63, wave = tid >> 6, wm = wave >> 1, wn = wave & 1, r = lane & 31, h = lane >> 5;
  float* T = (float*)lds;
  float* w2s = T + 128 * 65;
  const float* c1 = (const float*)(p.ws + W_C1) + kv * 64;
  const float* w2 = kv ? p.w2_v : p.w2_k;
  __syncthreads();
  for (int i = tid; i < 4096; i += 256) w2s[i] = w2[i];
  if (wn == 1) {
#pragma unroll
    for (int mi = 0; mi < 2; ++mi)
#pragma unroll
      for (int ni = 0; ni < 2; ++ni)
#pragma unroll
        for (int i = 0; i < 16; ++i) T[(wm * 64 + mi * 32 + crow(i, h)) * 65 + ni * 32 + r] = acc[mi][ni][i];
  }
  __syncthreads();
  if (wn == 0) {
#pragma unroll
    for (int mi = 0; mi < 2; ++mi)
#pragma unroll
      for (int ni = 0; ni < 2; ++ni)
#pragma unroll
        for (int i = 0; i < 16; ++i) {
          const int n = wm * 64 + mi * 32 + crow(i, h), j = ni * 32 + r;
          float hv = 0.f;
          if (n < 127) hv = siluf_(acc[mi][ni][i] + T[(n + 1) * 65 + j] + c1[j]);
          acc[mi][ni][i] = hv;
        }
  }
  __syncthreads();
  if (wn == 0) {
#pragma unroll
    for (int mi = 0; mi < 2; ++mi)
#pragma unroll
      for (int ni = 0; ni < 2; ++ni)
#pragma unroll
        for (int i = 0; i < 16; ++i) T[(wm * 64 + mi * 32 + crow(i, h)) * 65 + ni * 32 + r] = acc[mi][ni][i];
  }
  __syncthreads();
  {
    const int n = tid >> 1, eh = tid & 1;
    float o[32];
#pragma unroll
    for (int e = 0; e < 32; ++e) o[e] = 0.f;
#pragma unroll 2
    for (int j = 0; j < 64; ++j) {
      const float hv = T[n * 65 + j];
#pragma unroll
      for (int e = 0; e < 32; ++e) o[e] += hv * w2s[j * 64 + eh * 32 + e];
    }
    u16* dst = (u16*)(p.ws + (kv ? W_VCMP : W_KCMP)) + ((size_t)(seq * 2 + g) * 128 + n) * 64 + eh * 32;
#pragma unroll
    for (int e = 0; e < 32; e += 2) *(unsigned*)(dst + e) = pk2(o[e], o[e + 1]);
    if (kv == 1 && seq < BATCH) {
      u16* dt = (u16*)(p.ws + W_VCMPT) + ((size_t)(seq * 2 + g) * 64 + eh * 32) * 128 + n;
#pragma unroll
      for (int e = 0; e < 32; ++e) dt[(size_t)e * 128] = f2bf(o[e]);
    }
  }
  __syncthreads();
}

DI void phase1_item(const Params& p, int it, char* lds) {
  if (it < P1_CMP) {
    const int kv = it & 1, g = (it >> 1) & 1, b = it >> 2;
    LoadCellPage al{kv ? p.ccv : p.cck, p.pt + b * 16, g};
    comp_tile(p, al, BATCH + b, g, kv, lds);
    return;
  }
  it -= P1_CMP;
  const int tm = it / G1_NT, tn = it % G1_NT;
  proj_tile(p, tm, tn, lds, true);
}


DI void hgrn_sample_item(const Params& p, int it, char* lds) {
  const int b = it >> 2, h = it & 3, tid = otid(), lane = tid & 63, wave = tid >> 6;
  float* sf = (float*)lds; float* sk = sf + 512; float* sq = sk + 512; float* sv = sq + 512; float* so = sv + 512;
  __syncthreads();
  for (int i = tid; i < 512; i += 256) {
    const int t = i >> 7, c = i & 127; const size_t off = (size_t)(NTP + b * 4 + t) * 512 + h * 128 + c;
    sf[i] = __expf(((const float*)(p.ws + W_GB))[off]);
    sk[i] = bf2f(((const u16*)(p.ws + W_KB))[off]);
    sq[i] = bf2f(((const u16*)(p.ws + W_QB))[off]);
    sv[i] = bf2f(((const u16*)(p.ws + W_VB))[off]);
  }
  __syncthreads();
  const int e = tid & 127, dh = tid >> 7;
  const float* S0 = p.shg + (size_t)(b * 4 + h) * 128 * 128;
  float* S1 = p.out + O_SHG + (size_t)(b * 4 + h) * 128 * 128;
  const float v0 = sv[e], v1 = sv[128 + e], v2 = sv[256 + e], v3 = sv[384 + e];
  float o0 = 0.f, o1 = 0.f, o2 = 0.f, o3 = 0.f;
#pragma unroll 4
  for (int d = dh * 64; d < dh * 64 + 64; ++d) {
    float st = S0[(size_t)d * 128 + e];
    st = sf[d] * st + sk[d] * v0;             o0 += sq[d] * st;
    st = sf[128 + d] * st + sk[128 + d] * v1; o1 += sq[128 + d] * st;
    st = sf[256 + d] * st + sk[256 + d] * v2; o2 += sq[256 + d] * st;
    st = sf[384 + d] * st + sk[384 + d] * v3; o3 += sq[384 + d] * st;
    S1[(size_t)d * 128 + e] = st;
  }
  so[(dh * 4 + 0) * 128 + e] = o0; so[(dh * 4 + 1) * 128 + e] = o1; so[(dh * 4 + 2) * 128 + e] = o2; so[(dh * 4 + 3) * 128 + e] = o3;
  __syncthreads();
  {
    const int t = wave; const size_t row = (size_t)(NTP + b * 4 + t);
    const float a0 = so[t * 128 + lane] + so[(4 + t) * 128 + lane];
    const float a1 = so[t * 128 + 64 + lane] + so[(4 + t) * 128 + 64 + lane];
    const float ss = wave_sum(a0 * a0 + a1 * a1);
    const float rs = rsqrtf(ss * (1.f / 128.f) + 1e-6f);
    const u16* zb = (const u16*)(p.ws + W_ZB) + row * 512 + h * 128; u16* ob = (u16*)(p.ws + W_OB) + row * 512 + h * 128;
    ob[lane] = f2bf(a0 * rs * p.hg_norm_g[h * 128 + lane] * bf2f(zb[lane]));
    ob[64 + lane] = f2bf(a1 * rs * p.hg_norm_g[h * 128 + 64 + lane] * bf2f(zb[64 + lane]));
  }
}

typedef __attribute__((address_space(3))) s16x4 lds_s16x4;
DI s16x4 tr_read(const u16* ptr) { return __builtin_amdgcn_ds_read_tr16_b64_v4i16((lds_s16x4*)ptr); }
DI bf16x8 cat8(s16x4 lo, s16x4 hi) { return __builtin_shufflevector(lo, hi, 0, 1, 2, 3, 4, 5, 6, 7); }
constexpr int HST = 136;

DI void hgrn_h1_item(const Params& p, int it, char* lds) {
  const int c = it & 31, h = (it >> 5) & 3, b = it >> 7;
  const int tid = otid(), lane = tid & 63, w = __builtin_amdgcn_readfirstlane(tid >> 6), half = tid >> 7;
  const int c16 = lane & 15, hq = lane >> 4, tq = c16 >> 2, tp = c16 & 3;
  const int d = tid & 127, col = h * 128 + d;
  u16* Qe = (u16*)lds; u16* Ke = Qe + 64 * HST; u16* Vv = Ke + 64 * HST; u16* Am = Vv + 64 * HST;
  float* Rr = (float*)(Am + 64 * 72); float* G63 = Rr + 128;
  const u16* qB = (const u16*)(p.ws + W_QB); const u16* kB = (const u16*)(p.ws + W_KB); const u16* vB = (const u16*)(p.ws + W_VB);
  const float* gB = (const float*)(p.ws + W_GB);
  const size_t tok0 = (size_t)b * 2048 + c * 64;
  __syncthreads();
  float G[32];
  {
    float run = 0.f;
#pragma unroll
    for (int i = 0; i < 32; ++i) { run += gB[(tok0 + half * 32 + i) * 512 + col]; G[i] = run; }
    if (half == 0) Rr[d] = run;
  }
#pragma unroll
  for (int i = 0; i < 4; ++i) {
    const int idx = tid + 256 * i, s_ = idx >> 4, cc = idx & 15;
    *(uint4*)(Vv + s_ * HST + cc * 8) = *(const uint4*)(vB + (tok0 + s_) * 512 + h * 128 + cc * 8);
  }
  __syncthreads();
  {
    const float R = Rr[d];
    const float base = half ? R : 0.f;
    u16* qg = (u16*)(p.ws + W_QG);
#pragma unroll
    for (int i = 0; i < 32; ++i) {
      const int t = half * 32 + i;
      const float gt = base + G[i];
      const float q = bf2f(qB[(tok0 + t) * 512 + col]), k = bf2f(kB[(tok0 + t) * 512 + col]);
      const float dq = fminf(fmaxf(gt - R, -80.f), 80.f);
      Qe[t * HST + d] = f2bf(q * __expf(dq));
      Ke[t * HST + d] = f2bf(k * __expf(-dq));
      qg[(tok0 + t) * 512 + col] = f2bf(q * __expf(gt));
    }
    if (half == 1) G63[d] = base + G[31];
  }
  __syncthreads();
  for (int j = 0; j <= w; ++j) {
    f32x4 x = f32x4{0.f, 0.f, 0.f, 0.f};
#pragma unroll
    for (int ks = 0; ks < 4; ++ks) {
      const bf16x8 a = *(const bf16x8*)(Qe + (16 * w + c16) * HST + ks * 32 + 8 * hq);
      const bf16x8 bb = *(const bf16x8*)(Ke + (16 * j + c16) * HST + ks * 32 + 8 * hq);
      x = MFMA16(a, bb, x);
    }
#pragma unroll
    for (int r = 0; r < 4; ++r) {
      const bool ok = (j < w) || (c16 <= 4 * hq + r);
      Am[(16 * w + 4 * hq + r) * 72 + 16 * j + c16] = f2bf(ok ? x[r] : 0.f);
    }
  }
  if ((w & 1) == 0) {
#pragma unroll
    for (int r = 0; r < 4; ++r) Am[(16 * w + 4 * hq + r) * 72 + 16 * (w + 1) + c16] = 0;
  }
  __syncthreads();
  bf16x8 vf[2][2];
#pragma unroll
  for (int ks = 0; ks < 2; ++ks)
#pragma unroll
    for (int et = 0; et < 2; ++et) {
      const u16* base = Vv + (32 * ks + 8 * hq + tq) * HST + 32 * w + 16 * et + 4 * tp;
      vf[ks][et] = cat8(tr_read(base), tr_read(base + 4 * HST));
    }
  {
    f32x4 o[4][2];
#pragma unroll
    for (int tt = 0; tt < 4; ++tt)
#pragma unroll
      for (int et = 0; et < 2; ++et) o[tt][et] = f32x4{0.f, 0.f, 0.f, 0.f};
#pragma unroll
    for (int tt = 0; tt < 4; ++tt)
#pragma unroll
      for (int ks = 0; ks <= (tt >> 1); ++ks) {
        const bf16x8 a = *(const bf16x8*)(Am + (16 * tt + c16) * 72 + 32 * ks + 8 * hq);
#pragma unroll
        for (int et = 0; et < 2; ++et) o[tt][et] = MFMA16(a, vf[ks][et], o[tt][et]);
      }
    float* oraw = (float*)(p.ws + W_ORAW);
#pragma unroll
    for (int tt = 0; tt < 4; ++tt)
#pragma unroll
      for (int et = 0; et < 2; ++et)
#pragma unroll
        for (int r = 0; r < 4; ++r) oraw[(tok0 + 16 * tt + 4 * hq + r) * 512 + h * 128 + 32 * w + 16 * et + c16] = o[tt][et][r];
  }
  float* dst = (float*)(p.ws + W_DST) + (size_t)it * 128 * 128;
#pragma unroll
  for (int dt = 0; dt < 8; ++dt) {
    bf16x8 kt[2];
#pragma unroll
    for (int ks = 0; ks < 2; ++ks) {
      const u16* base = Ke + (32 * ks + 8 * hq + tq) * HST + 16 * dt + 4 * tp;
      kt[ks] = cat8(tr_read(base), tr_read(base + 4 * HST));
    }
    f32x4 sc2;
#pragma unroll
    for (int r = 0; r < 4; ++r) sc2[r] = __expf(G63[16 * dt + 4 * hq + r] - Rr[16 * dt + 4 * hq + r]);
#pragma unroll
    for (int et = 0; et < 2; ++et) {
      f32x4 dd = f32x4{0.f, 0.f, 0.f, 0.f};
      dd = MFMA16(kt[0], vf[0][et], dd); dd = MFMA16(kt[1], vf[1][et], dd);
      *(float4*)(dst + (size_t)(32 * w + 16 * et + c16) * 128 + 16 * dt + 4 * hq) = make_float4(dd[0] * sc2[0], dd[1] * sc2[1], dd[2] * sc2[2], dd[3] * sc2[3]);
    }
  }
  if (tid < 128) ((float*)(p.ws + W_DEC))[(size_t)it * 128 + tid] = __expf(G63[tid]);
}

constexpr int H2_ITEMS = 8 * 4 * 128 * 32 / 256;
DI void hgrn_h2_item(const Params& p, int it) {
  const int gt = it * 256 + otid(), bh = gt >> 12, e = (gt >> 5) & 127, dq = gt & 31;
  const float* dst = (const float*)(p.ws + W_DST); const float* dec = (const float*)(p.ws + W_DEC); u16* spt = (u16*)(p.ws + W_SPT);
  float4 s = make_float4(0.f, 0.f, 0.f, 0.f);
#pragma unroll 4
  for (int c = 0; c < 32; ++c) {
    const size_t idx = ((size_t)(bh * 32 + c) * 128 + e) * 128 + dq * 4;
    const float4 d4 = *(const float4*)(dst + idx);
    const float4 k4 = *(const float4*)(dec + (size_t)(bh * 32 + c) * 128 + dq * 4);
    *(uint2*)(spt + idx) = make_uint2(pk2(s.x, s.y), pk2(s.z, s.w));
    s.x = k4.x * s.x + d4.x; s.y = k4.y * s.y + d4.y; s.z = k4.z * s.z + d4.z; s.w = k4.w * s.w + d4.w;
  }
  float* So = p.out + O_PHG + (size_t)bh * 128 * 128;
  So[(size_t)(dq * 4 + 0) * 128 + e] = s.x; So[(size_t)(dq * 4 + 1) * 128 + e] = s.y;
  So[(size_t)(dq * 4 + 2) * 128 + e] = s.z; So[(size_t)(dq * 4 + 3) * 128 + e] = s.w;
}

DI void hgrn_h3_item(const Params& p, int it) {
  const int c = it & 31, h = (it >> 5) & 3, b = it >> 7;
  const int tid = otid(), lane = tid & 63, w = tid >> 6, c16 = lane & 15, hq = lane >> 4;
  const size_t tok0 = (size_t)b * 2048 + c * 64 + 16 * w;
  const u16* qg = (const u16*)(p.ws + W_QG) + (tok0 + c16) * 512 + h * 128 + 8 * hq;
  bf16x8 af[4];
#pragma unroll
  for (int ks = 0; ks < 4; ++ks) af[ks] = *(const bf16x8*)(qg + 32 * ks);
  const float* oraw = (const float*)(p.ws + W_ORAW) + (tok0 + 4 * hq) * 512 + h * 128 + c16;
  const u16* spt = (const u16*)(p.ws + W_SPT) + ((size_t)it * 128 + c16) * 128 + 8 * hq;
  f32x4 acc[8];
#pragma unroll
  for (int et = 0; et < 8; ++et) {
#pragma unroll
    for (int r = 0; r < 4; ++r) acc[et][r] = oraw[(size_t)r * 512 + 16 * et];
#pragma unroll
    for (int ks = 0; ks < 4; ++ks) {
      const bf16x8 bfr = *(const bf16x8*)(spt + (size_t)(16 * et) * 128 + 32 * ks);
      acc[et] = MFMA16(af[ks], bfr, acc[et]);
    }
  }
  const u16* zb = (const u16*)(p.ws + W_ZB) + (tok0 + 4 * hq) * 512 + h * 128 + c16;
  u16* ob = (u16*)(p.ws + W_OB) + (tok0 + 4 * hq) * 512 + h * 128 + c16;
#pragma unroll
  for (int r = 0; r < 4; ++r) {
    float v = 0.f;
#pragma unroll
    for (int et = 0; et < 8; ++et) v += acc[et][r] * acc[et][r];
    v += __shfl_xor(v, 1); v += __shfl_xor(v, 2); v += __shfl_xor(v, 4); v += __shfl_xor(v, 8);
    const float rs = rsqrtf(v * (1.f / 128.f) + 1e-6f);
#pragma unroll
    for (int et = 0; et < 8; ++et)
      ob[(size_t)r * 512 + 16 * et] = f2bf(acc[et][r] * rs * p.hg_norm_g[h * 128 + 16 * et + c16] * bf2f(zb[(size_t)r * 512 + 16 * et]));
  }
}

typedef __attribute__((address_space(3))) const float lds_cf;
template <int NR>
DI void sa_scores(const float* qrows_, const float4 (&kk)[16], float (&sc)[NR]) {
  lds_cf* qrows = (lds_cf*)qrows_; asm volatile("" : "+v"(qrows));
#pragma unroll
  for (int r = 0; r < NR; ++r) {
    float a0 = 0.f, a1 = 0.f;
#pragma unroll
    for (int dq = 0; dq < 16; dq += 2) {
      const f32x4 q0 = *(const __attribute__((address_space(3))) f32x4*)(qrows + r * 64 + dq * 4), q1 = *(const __attribute__((address_space(3))) f32x4*)(qrows + r * 64 + dq * 4 + 4);
      a0 += q0[0] * kk[dq].x + q0[1] * kk[dq].y + q0[2] * kk[dq].z + q0[3] * kk[dq].w;
      a1 += q1[0] * kk[dq + 1].x + q1[1] * kk[dq + 1].y + q1[2] * kk[dq + 1].z + q1[3] * kk[dq + 1].w;
    }
    sc[r] = a0 + a1;
    asm volatile("" : "+v"(sc[r]) :: "memory");
  }
}
DI void sa_load_f32(const float* rowp, bool ok, float4 (&kk)[16]) {
#pragma unroll
  for (int i = 0; i < 16; ++i) kk[i] = ok ? ((const float4*)rowp)[i] : make_float4(0.f, 0.f, 0.f, 0.f);
}
template <int NR>
DI void sa_softmax(float* P, int nk, int row, int sub) {
  float m = -3.0e38f;
  for (int k = sub; k < nk; k += 16) m = fmaxf(m, P[k * NR + row]);
  m = fmaxf(m, __shfl_xor(m, 1)); m = fmaxf(m, __shfl_xor(m, 2)); m = fmaxf(m, __shfl_xor(m, 4)); m = fmaxf(m, __shfl_xor(m, 8));
  float l = 0.f;
  for (int k = sub; k < nk; k += 16) { const float sv = P[k * NR + row]; const float pv = (sv > -1.0e38f) ? __builtin_amdgcn_exp2f(sv - m) : 0.f; P[k * NR + row] = pv; l += pv; }
  l += __shfl_xor(l, 1); l += __shfl_xor(l, 2); l += __shfl_xor(l, 4); l += __shfl_xor(l, 8);
  const float inv = (l > 0.f) ? 1.f / l : 0.f;
  for (int k = sub; k < nk; k += 16) P[k * NR + row] *= inv;
}

DI void sample_attn_item(const Params& p, int it, char* lds) {
  const int b = it >> 1, g = it & 1, tid = otid(), lane = tid & 63, w = __builtin_amdgcn_readfirstlane(tid >> 6);
  float* qs = (float*)lds;
  float* Sc = qs + 1024;
  float* obuf = Sc + 9216;
  float* ofin = obuf + 4096;
  float* imp = ofin + 1024;
  int* sel = (int*)(imp + 4 * 33);
  float* btab = (float*)(sel + 32);
  int* pts = (int*)(btab + 4 * 129);
  __syncthreads();
  if (tid < 16) pts[tid] = p.pt[b * 16 + tid];
  for (int i = tid; i < 1024; i += 256) { const int row = i >> 6, dd = i & 63, t = row >> 2, r = row & 3;
    qs[i] = bf2f(((const u16*)(p.ws + W_Q))[(size_t)(NTP + b * 4 + t) * 512 + (g * 4 + r) * 64 + dd]); }
  for (int i = tid; i < 4 * 129; i += 256) { const int r = i / 129, rel = i % 129; const int bk = rel < 128 ? T5B[rel] : 31; btab[i] = p.rel_bias[bk * 8 + g * 4 + r] * LOG2E; }
  __syncthreads();
  const int seq = BATCH + b;
  const float* gate = (const float*)(p.ws + W_GATE) + (size_t)(NTP + b * 4) * 24;
  const int srow = tid >> 4, ssub = tid & 15;
  if (w < 2) {
    const int n = 64 * w + lane; const bool okn = n < 127;
    float4 kk[16];
    const uint4* kp = (const uint4*)((const u16*)(p.ws + W_KCMP) + ((size_t)(seq * 2 + g) * 128 + n) * 64);
#pragma unroll
    for (int i = 0; i < 8; ++i) { const uint4 u = kp[i]; kk[2 * i] = make_float4(bflo(u.x), bfhi(u.x), bflo(u.y), bfhi(u.y)); kk[2 * i + 1] = make_float4(bflo(u.z), bfhi(u.z), bflo(u.w), bfhi(u.w)); }
    float sc[16]; sa_scores<16>(qs, kk, sc);
#pragma unroll
    for (int r = 0; r < 16; ++r) { const int rel = PAST + (r >> 2) - (16 * n + 31); sc[r] = okn ? sc[r] + btab[(r & 3) * 129 + (rel < 128 ? rel : 128)] : -3.0e38f; }
#pragma unroll
    for (int r4 = 0; r4 < 4; ++r4) *(float4*)(Sc + n * 16 + 4 * r4) = make_float4(sc[4 * r4], sc[4 * r4 + 1], sc[4 * r4 + 2], sc[4 * r4 + 3]);
  }
  __syncthreads();
  sa_softmax<16>(Sc, 128, srow, ssub);
  __syncthreads();
  {
    float o[16];
#pragma unroll
    for (int r = 0; r < 16; ++r) o[r] = 0.f;
    const u16* vc = (const u16*)(p.ws + W_VCMP) + (size_t)(seq * 2 + g) * 128 * 64 + lane;
    float vv[32];
#pragma unroll
    for (int i = 0; i < 32; ++i) { const int n = 32 * w + i; vv[i] = (n < 127) ? bf2f(vc[(size_t)n * 64]) : 0.f; }
#pragma unroll
    for (int i = 0; i < 32; ++i) {
      const int n = 32 * w + i; const float v = vv[i];
#pragma unroll
      for (int r4 = 0; r4 < 4; ++r4) { const float4 p4 = *(const float4*)(Sc + n * 16 + 4 * r4); o[4 * r4] += p4.x * v; o[4 * r4 + 1] += p4.y * v; o[4 * r4 + 2] += p4.z * v; o[4 * r4 + 3] += p4.w * v; }
    }
#pragma unroll
    for (int r = 0; r < 16; ++r) obuf[(w * 16 + r) * 64 + lane] = o[r];
  }
  if (tid < 4 * 33) {
    const int t = tid / 33, j = tid % 33; float sm = 0.f;
    for (int u = -1; u <= 3; ++u) { const int n = 4 * j + u; if (n >= 0 && n < 127) { const float4 p4 = *(const float4*)(Sc + n * 16 + 4 * t); sm += (p4.x + p4.y + p4.z + p4.w) * ((u == -1 || u == 3) ? 1.f : 2.f); } }
    imp[tid] = sm;
  }
  __syncthreads();
  for (int i = tid; i < 1024; i += 256) { const int row = i >> 6; ofin[i] = gate[(row >> 2) * 24 + g * 4 + (row & 3)] * (obuf[i] + obuf[1024 + i] + obuf[2048 + i] + obuf[3072 + i]); }
  if (tid < 4) {
    const int t = tid; int* sl = sel + t * 8; sl[0] = 0; sl[1] = 31; sl[2] = 32;
    unsigned taken = 0u;
    for (int c = 0; c < 5; ++c) {
      float best = -1.f; int bi = 1;
      for (int j = 1; j <= 30; ++j) { const float v = imp[t * 33 + j]; if (!((taken >> j) & 1u) && v > best) { best = v; bi = j; } }
      taken |= 1u << bi; sl[3 + c] = bi;
    }
  }
  __syncthreads();
  {
    float* P = Sc + w * 2048;
    const int t = w; const int* sl = sel + t * 8;
    const float* fresh_k = p.out + O_SCK + 2 * (size_t)NTS * 128 + (size_t)(b * 4) * 128 + g * 64;
    const float* fresh_v = p.out + O_SCK + 3 * (size_t)NTS * 128 + (size_t)(b * 4) * 128 + g * 64;
    float4 kk[16], kn[16];
    { const int blk = sl[0]; const float* kbase; bool okk;
      if (blk < 32) { kbase = p.csk + (((size_t)pts[blk >> 1] * 128 + (blk & 1) * 64) * 2 + g) * 64; okk = true; } else { kbase = fresh_k; okk = lane < 4; }
      sa_load_f32(kbase + (size_t)(okk ? lane : 0) * 128, okk, kk); }
    for (int jj = 0; jj < 8; ++jj) {
      const int blk = sl[jj];
      if (jj < 7) {
        const int bn = sl[jj + 1]; const float* kbase; bool okn;
        if (bn < 32) { kbase = p.csk + (((size_t)pts[bn >> 1] * 128 + (bn & 1) * 64) * 2 + g) * 64; okn = true; } else { kbase = fresh_k; okn = lane < 4; }
        sa_load_f32(kbase + (size_t)(okn ? lane : 0) * 128, okn, kn);
      }
      const bool okk = (blk < 32) || (lane < 4);
      float sc[4]; sa_scores<4>(qs + 4 * t * 64, kk, sc);
      const int rel = PAST + t - (blk * 64 + lane);
      const bool ok = okk && rel >= 0;
      const int bi = rel < 0 ? 0 : (rel < 128 ? rel : 128);
      *(float4*)(P + (jj * 64 + lane) * 4) = make_float4(ok ? sc[0] + btab[bi] : -3.0e38f, ok ? sc[1] + btab[129 + bi] : -3.0e38f,
                                                        ok ? sc[2] + btab[258 + bi] : -3.0e38f, ok ? sc[3] + btab[387 + bi] : -3.0e38f);
#pragma unroll
      for (int i = 0; i < 16; ++i) kk[i] = kn[i];
    }
    __syncthreads();
    sa_softmax<4>(P, 512, lane >> 4, lane & 15);
    __syncthreads();
    float o[4] = {0.f, 0.f, 0.f, 0.f};
    for (int jj = 0; jj < 8; ++jj) {
      const int blk = sl[jj];
      const float* vbase; int ns;
      if (blk < 32) { vbase = p.csv + (((size_t)pts[blk >> 1] * 128 + (blk & 1) * 64) * 2 + g) * 64; ns = 64; }
      else { vbase = fresh_v; ns = 4; }
#pragma unroll 1
      for (int s0 = 0; s0 < ns; s0 += 32) {
        float vv[32];
#pragma unroll
        for (int i = 0; i < 32; ++i) vv[i] = (s0 + i < ns) ? vbase[(size_t)(s0 + i) * 128 + lane] : 0.f;
#pragma unroll
        for (int i = 0; i < 32; ++i) {
          const float4 p4 = *(const float4*)(P + (jj * 64 + s0 + i) * 4);
          o[0] += p4.x * vv[i]; o[1] += p4.y * vv[i]; o[2] += p4.z * vv[i]; o[3] += p4.w * vv[i];
        }
      }
    }
#pragma unroll
    for (int r = 0; r < 4; ++r) ofin[(4 * t + r) * 64 + lane] += gate[t * 24 + 8 + g * 4 + r] * o[r];
  }
  __syncthreads();
  {
    const float* fresh_k = p.out + O_SWK + ((size_t)b * 512 + 508) * 128 + g * 64;
    const float* fresh_v = p.out + O_SWK + (size_t)DEC_BATCH * 512 * 128 + ((size_t)b * 512 + 508) * 128 + g * 64;
    for (int j = w; j < 9; j += 4) {
      const int key = j * 64 + lane; const bool okk = key < 516;
      const float* rowp = (key < 512) ? (p.swk + ((size_t)b * 512 + key) * 128 + g * 64) : (fresh_k + (size_t)(okk ? key - 512 : 0) * 128);
      float4 kk[16]; sa_load_f32(rowp, okk, kk);
      float sc[16]; sa_scores<16>(qs, kk, sc);
#pragma unroll
      for (int r = 0; r < 16; ++r) {
        const int rel = PAST + (r >> 2) - (PAST - 512 + key);
        const bool ok = okk && rel >= 0 && rel < 512;
        sc[r] = ok ? sc[r] + btab[(r & 3) * 129 + (rel < 128 ? rel : 128)] : -3.0e38f;
      }
#pragma unroll
      for (int r4 = 0; r4 < 4; ++r4) *(float4*)(Sc + key * 16 + 4 * r4) = make_float4(sc[4 * r4], sc[4 * r4 + 1], sc[4 * r4 + 2], sc[4 * r4 + 3]);
    }
    __syncthreads();
    sa_softmax<16>(Sc, 576, srow, ssub);
    __syncthreads();
    float o[16];
#pragma unroll
    for (int r = 0; r < 16; ++r) o[r] = 0.f;
    const float* vst = p.swv + (size_t)b * 512 * 128 + g * 64 + lane;
#pragma unroll 1
    for (int k0 = 129 * w; k0 < 129 * w + 129; k0 += 32) {
      float vv[32];
#pragma unroll
      for (int i = 0; i < 32; ++i) { const int key = k0 + i; vv[i] = (key >= 129 * w + 129 || key >= 516) ? 0.f : ((key < 512) ? vst[(size_t)key * 128] : fresh_v[(size_t)(key - 512) * 128 + lane]); }
#pragma unroll
      for (int i = 0; i < 32; ++i) {
        const int key = (k0 + i < 576) ? k0 + i : 575; const float v = (k0 + i < 129 * w + 129) ? vv[i] : 0.f;
#pragma unroll
        for (int r4 = 0; r4 < 4; ++r4) { const float4 p4 = *(const float4*)(Sc + key * 16 + 4 * r4); o[4 * r4] += p4.x * v; o[4 * r4 + 1] += p4.y * v; o[4 * r4 + 2] += p4.z * v; o[4 * r4 + 3] += p4.w * v; }
      }
    }
#pragma unroll
    for (int r = 0; r < 16; ++r) obuf[(w * 16 + r) * 64 + lane] = o[r];
  }
  __syncthreads();
  for (int i = tid; i < 1024; i += 256) {
    const int row = i >> 6, dd = i & 63, t = row >> 2, r = row & 3, hd = g * 4 + r; const size_t tok = (size_t)(NTP + b * 4 + t);
    const float o = ofin[i] + gate[t * 24 + 16 + hd] * (obuf[i] + obuf[1024 + i] + obuf[2048 + i] + obuf[3072 + i]);
    ((u16*)(p.ws + W_OA))[tok * 512 + hd * 64 + dd] = f2bf(o * bf2f(((const u16*)(p.ws + W_ZA))[tok * 512 + hd * 64 + dd]));
  }
  __syncthreads();
}

constexpr int P2_HP = BATCH * 4 * 32;
constexpr int P2_CMP = BATCH * 2 * 2;
constexpr int P2_SA = DEC_BATCH * 2;
constexpr int P2_HS = DEC_BATCH * 4;
constexpr int P2_TOTAL = P2_HP + P2_CMP + P2_SA + P2_HS;
DI void phase2_item(const Params& p, int it, char* lds) {
  if (it < P2_SA) { sample_attn_item(p, it, lds); return; }
  it -= P2_SA;
  if (it < P2_CMP) {
    const int kv = it & 1, g = (it >> 1) & 1, b = it >> 2;
    LoadCellBf16 al{(const u16*)(p.ws + W_KV) + (size_t)kv * NT * 128 + (size_t)b * 2048 * 128 + g * 64};
    comp_tile(p, al, b, g, kv, lds); return;
  }
  it -= P2_CMP;
  if (it < P2_HP) { hgrn_h1_item(p, it, lds); return; }
  it -= P2_HP;
  hgrn_sample_item(p, it, lds);
}

constexpr int AKS = 72, AVS = 68, ACS = 132;
DI bf16x8 pack8(const f32x16& x, int s2) {
  uint4 u; u.x = pk2(x[8 * s2], x[8 * s2 + 1]); u.y = pk2(x[8 * s2 + 2], x[8 * s2 + 3]);
  u.z = pk2(x[8 * s2 + 4], x[8 * s2 + 5]); u.w = pk2(x[8 * s2 + 6], x[8 * s2 + 7]);
  return __builtin_bit_cast(bf16x8, u);
}
DI void zero16(f32x16& x) {
#pragma unroll
  for (int i = 0; i < 16; ++i) x[i] = 0.f;
}

template <bool WIN, bool FAST>
DI void attn_tile(const u16* Kt, const u16* Vt, const float* brel_r, float cfar, const bf16x8 (&qf)[4], int qpos, int kpos0, bool lane_on,
                  float& m_run, float& l_run, f32x16 (&oacc)[2], int ql, int hh) {
  f32x16 sacc[2];
#pragma unroll
  for (int kt = 0; kt < 2; ++kt) {
    zero16(sacc[kt]);
#pragma unroll
    for (int ks = 0; ks < 4; ++ks) {
      const bf16x8 kf = *(const bf16x8*)(Kt + (32 * kt + ql) * AKS + 16 * ks + 8 * hh);
      sacc[kt] = MFMA32(kf, qf[ks], sacc[kt]);
    }
  }
  float mt = -1.0e30f;
  if (FAST) {
#pragma unroll
    for (int kt = 0; kt < 2; ++kt)
#pragma unroll
      for (int i = 0; i < 16; ++i) mt = fmaxf(mt, sacc[kt][i]);
    mt = lane_on ? mt + cfar : -1.0e30f;
  } else {
#pragma unroll
    for (int kt = 0; kt < 2; ++kt)
#pragma unroll
      for (int i = 0; i < 16; ++i) {
        const int rel = qpos - (kpos0 + 32 * kt + crow(i, hh));
        const bool ok = lane_on && rel >= 0 && (!WIN || rel < 512);
        const float sv = sacc[kt][i] + brel_r[rel < 0 ? 0 : (rel < 128 ? rel : 128)];
        sacc[kt][i] = ok ? sv : -1.0e30f;
        mt = fmaxf(mt, sacc[kt][i]);
      }
  }
  mt = fmaxf(mt, __shfl_xor(mt, 32));
  const float mn = fmaxf(m_run, mt);
  if (!__all(mn == m_run)) {
    const float alpha = __builtin_amdgcn_exp2f(m_run - mn);
    l_run *= alpha;
#pragma unroll
    for (int dt = 0; dt < 2; ++dt)
#pragma unroll
      for (int i = 0; i < 16; ++i) oacc[dt][i] *= alpha;
  }
  m_run = mn;
  float ls = 0.f;
  if (FAST) {
    const float dsh = lane_on ? cfar - mn : -1.0e30f;
#pragma unroll
    for (int kt = 0; kt < 2; ++kt)
#pragma unroll
      for (int i = 0; i < 16; ++i) { const float pv = __builtin_amdgcn_exp2f(sacc[kt][i] + dsh); sacc[kt][i] = pv; ls += pv; }
  } else {
#pragma unroll
    for (int kt = 0; kt < 2; ++kt)
#pragma unroll
      for (int i = 0; i < 16; ++i) {
        const float pv = (sacc[kt][i] > -1.0e29f) ? __builtin_amdgcn_exp2f(sacc[kt][i] - mn) : 0.f;
        sacc[kt][i] = pv; ls += pv;
      }
  }
  l_run += ls;
#pragma unroll
  for (int kt = 0; kt < 2; ++kt)
#pragma unroll
    for (int s2 = 0; s2 < 2; ++s2) {
      const bf16x8 pf = pack8(sacc[kt], s2);
#pragma unroll
      for (int dt = 0; dt < 2; ++dt) {
        const u16* vp = Vt + (32 * dt + ql) * AVS + 32 * kt + 16 * s2 + 4 * hh;
        const bf16x8 vf = cat8(*(const s16x4*)vp, *(const s16x4*)(vp + 8));
        oacc[dt] = MFMA32(vf, pf, oacc[dt]);
      }
    }
}

DI void attn_load_tile(u16* Kt, u16* Vt, const u16* ksrc  , const u16* vtsrc  ) {
  const int tid = otid512();
  {
    const int idx = tid, rw = idx >> 3, ch = idx & 7;
    *(uint4*)(Kt + rw * AKS + ch * 8) = *(const uint4*)(ksrc + (size_t)rw * 128 + ch * 8);
    const uint4 v = *(const uint4*)(vtsrc + (size_t)rw * 2048 + ch * 8);
    *(uint2*)(Vt + rw * AVS + ch * 8) = make_uint2(v.x, v.y);
    *(uint2*)(Vt + rw * AVS + ch * 8 + 4) = make_uint2(v.z, v.w);
  }
}

DI void prompt_attn_item(const Params& p, int it, char* lds) {
  const int qt = (it < 256) ? (31 - (it & 31)) : (it & 31), g = (it >> 5) & 1, b = (it >> 6) & 3 | ((it >> 8) << 2);
  const int t0 = qt * 64;
  const int tid = otid512(), lane = tid & 63, w = tid >> 6, ql = lane & 31, hh = lane >> 5, tl = ql >> 2, r = ql & 3;
  const int qpos = t0 + 8 * w + tl, head = g * 4 + r;
  const size_t tok = (size_t)b * 2048 + qpos;
  u16* Kt = (u16*)lds;
  u16* Vt = Kt + 128 * AKS;
  float* brel = (float*)(Vt + 64 * ACS);
  unsigned* wmask = (unsigned*)(brel + 4 * 129);
  const u16* Qb = (const u16*)(p.ws + W_Q);
  __syncthreads();
  for (int i = tid; i < 4 * 129; i += 512) { const int rr = i / 129, rel = i % 129; const int bk = rel < 128 ? T5B[rel] : 31; brel[i] = p.rel_bias[bk * 8 + g * 4 + rr] * LOG2E; }
  bf16x8 qf[4];
#pragma unroll
  for (int ks = 0; ks < 4; ++ks) qf[ks] = *(const bf16x8*)(Qb + tok * 512 + head * 64 + 16 * ks + 8 * hh);
  const float* gt = (const float*)(p.ws + W_GATE) + tok * 24;
  const float* brel_r = brel + r * 129;
  const float cfar = p.rel_bias[31 * 8 + head] * LOG2E;
  f32x16 of[2];
  unsigned selm;
  {
#pragma unroll
    for (int i = 0; i < 2; ++i) {
      const int idx = tid + 512 * i;
      { const int n = idx >> 3, ch = idx & 7;
        *(uint4*)(Kt + n * AKS + ch * 8) = *(const uint4*)((const u16*)(p.ws + W_KCMP) + ((size_t)(b * 2 + g) * 128 + n) * 64 + ch * 8); }
      { const int dd = idx >> 4, ch = idx & 15;
        const uint4 v = *(const uint4*)((const u16*)(p.ws + W_VCMPT) + ((size_t)(b * 2 + g) * 64 + dd) * 128 + ch * 8);
        *(uint2*)(Vt + dd * ACS + ch * 8) = make_uint2(v.x, v.y); *(uint2*)(Vt + dd * ACS + ch * 8 + 4) = make_uint2(v.z, v.w); }
    }
    __syncthreads();
    f32x16 sacc[4];
#pragma unroll
    for (int kt = 0; kt < 4; ++kt) {
      zero16(sacc[kt]);
#pragma unroll
      for (int ks = 0; ks < 4; ++ks) {
        const bf16x8 kf = *(const bf16x8*)(Kt + (32 * kt + ql) * AKS + 16 * ks + 8 * hh);
        sacc[kt] = MFMA32(kf, qf[ks], sacc[kt]);
      }
    }
    float mt = -1.0e30f;
#pragma unroll
    for (int kt = 0; kt < 4; ++kt)
#pragma unroll
      for (int i = 0; i < 16; ++i) {
        const int n = 32 * kt + crow(i, hh);
        const int rel = qpos - (16 * n + 31);
        const bool ok = rel >= 0 && n < 127;
        const float sv = sacc[kt][i] + brel_r[rel < 0 ? 0 : (rel < 128 ? rel : 128)];
        sacc[kt][i] = ok ? sv : -1.0e30f;
        mt = fmaxf(mt, sacc[kt][i]);
      }
    mt = fmaxf(mt, __shfl_xor(mt, 32));
    float ls = 0.f;
#pragma unroll
    for (int kt = 0; kt < 4; ++kt)
#pragma unroll
      for (int i = 0; i < 16; ++i) { const float pv = (sacc[kt][i] > -1.0e29f) ? __builtin_amdgcn_exp2f(sacc[kt][i] - mt) : 0.f; sacc[kt][i] = pv; ls += pv; }
    ls += __shfl_xor(ls, 32);
    const float inv = ls > 0.f ? 1.f / ls : 0.f;
#pragma unroll
    for (int kt = 0; kt < 4; ++kt)
#pragma unroll
      for (int i = 0; i < 16; ++i) sacc[kt][i] *= inv;
    f32x16 oc[2]; zero16(oc[0]); zero16(oc[1]);
#pragma unroll
    for (int kt = 0; kt < 4; ++kt)
#pragma unroll
      for (int s2 = 0; s2 < 2; ++s2) {
        const bf16x8 pf = pack8(sacc[kt], s2);
#pragma unroll
        for (int dt = 0; dt < 2; ++dt) {
          const u16* vp = Vt + (32 * dt + ql) * ACS + 32 * kt + 16 * s2 + 4 * hh;
          const bf16x8 vf = cat8(*(const s16x4*)vp, *(const s16x4*)(vp + 8));
          oc[dt] = MFMA32(vf, pf, oc[dt]);
        }
      }
    const float g0 = gt[head];
#pragma unroll
    for (int dt = 0; dt < 2; ++dt)
#pragma unroll
      for (int i = 0; i < 16; ++i) of[dt][i] = g0 * oc[dt][i];
    float im[16], cm[16];
#pragma unroll
    for (int kt = 0; kt < 4; ++kt)
#pragma unroll
      for (int q4 = 0; q4 < 4; ++q4) {
        const float p0 = sacc[kt][4 * q4], p1 = sacc[kt][4 * q4 + 1], p2 = sacc[kt][4 * q4 + 2], p3 = sacc[kt][4 * q4 + 3];
        im[4 * kt + q4] = 2.f * (p0 + p1 + p2) + p3; cm[4 * kt + q4] = p3;
      }
#pragma unroll
    for (int m = 0; m < 16; ++m) cm[m] = __shfl_xor(cm[m], 32);
#pragma unroll
    for (int m = 15; m >= 0; --m) im[m] += hh ? cm[m] : (m > 0 ? cm[m - 1] : 0.f);
#pragma unroll
    for (int m = 0; m < 16; ++m) { im[m] += __shfl_xor(im[m], 1); im[m] += __shfl_xor(im[m], 2); }
    float ev[16], od[16];
#pragma unroll
    for (int m = 0; m < 16; ++m) { const float ot = __shfl_xor(im[m], 32); ev[m] = hh ? ot : im[m]; od[m] = hh ? im[m] : ot; }
    const int cur = qpos >> 6;
    if (cur < 8) selm = (2u << cur) - 1u;
    else {
      selm = 1u | (1u << cur) | (1u << (cur - 1));
      for (int c = 0; c < 5; ++c) {
        float best = -1.f;
#pragma unroll
        for (int J = 0; J < 32; ++J) { const float v = (J <= cur && !((selm >> J) & 1u)) ? ((J & 1) ? od[J >> 1] : ev[J >> 1]) : -1.f; best = fmaxf(best, v); }
        int bi = 32;
#pragma unroll
        for (int J = 31; J >= 0; --J) { const float v = (J <= cur && !((selm >> J) & 1u)) ? ((J & 1) ? od[J >> 1] : ev[J >> 1]) : -1.f; if (v == best) bi = J; }
        if (best >= 0.f) selm |= 1u << bi;
      }
    }
    unsigned um = selm;
    um |= __shfl_xor(um, 4); um |= __shfl_xor(um, 8); um |= __shfl_xor(um, 16);
    if (lane == 0) wmask[w] = um;
  }
  __syncthreads();
  const unsigned un = wmask[0] | wmask[1] | wmask[2] | wmask[3] | wmask[4] | wmask[5] | wmask[6] | wmask[7];
  {
    const u16* ks = (const u16*)(p.ws + W_KV) + (size_t)2 * NT * 128 + (size_t)b * 2048 * 128 + g * 64;
    const u16* vts = (const u16*)(p.ws + W_VST) + (size_t)(b * 2 + g) * 64 * 2048;
    const u16* kw = (const u16*)(p.ws + W_KV) + (size_t)4 * NT * 128 + (size_t)b * 2048 * 128 + g * 64;
    const u16* vtw = (const u16*)(p.ws + W_VWT) + (size_t)(b * 2 + g) * 64 * 2048;
    const int rw = tid >> 3, ch = tid & 7;
    uint4 kreg, vreg;
#define ATT_PREFETCH(kb, vb, j_) do { kreg = *(const uint4*)((kb) + ((size_t)(j_) * 64 + rw) * 128 + ch * 8); vreg = *(const uint4*)((vb) + (size_t)rw * 2048 + (j_) * 64 + ch * 8); } while (0)
#define ATT_COMMIT() do { *(uint4*)(Kt + rw * AKS + ch * 8) = kreg; *(uint2*)(Vt + rw * AVS + ch * 8) = make_uint2(vreg.x, vreg.y); *(uint2*)(Vt + rw * AVS + ch * 8 + 4) = make_uint2(vreg.z, vreg.w); } while (0)
    const int jlo = (t0 >= 511) ? ((t0 - 511) >> 6) : 0, jhi = (t0 + 63) >> 6;
    {
      float m_run = -1.0e30f, l_run = 0.f; f32x16 oacc[2]; zero16(oacc[0]); zero16(oacc[1]);
      unsigned rem = un;
      int j = __builtin_ctz(rem); rem &= rem - 1u;
      ATT_PREFETCH(ks, vts, j);
      for (;;) {
        __syncthreads();
        ATT_COMMIT();
        __syncthreads();
        const int jn = rem ? __builtin_ctz(rem) : -1;
        if (jn >= 0) { rem &= rem - 1u; ATT_PREFETCH(ks, vts, jn); } else { ATT_PREFETCH(kw, vtw, jlo); }
        const bool on = (selm >> j) & 1u;
        if (__ballot(on) != 0ull) {
          if (64 * j + 63 + 128 <= t0 + 8 * w) attn_tile<false, true>(Kt, Vt, brel_r, cfar, qf, qpos, j * 64, on, m_run, l_run, oacc, ql, hh);
          else attn_tile<false, false>(Kt, Vt, brel_r, cfar, qf, qpos, j * 64, on, m_run, l_run, oacc, ql, hh);
        }
        if (jn < 0) break;
        j = jn;
      }
      l_run += __shfl_xor(l_run, 32);
      const float sc = gt[8 + head] * (l_run > 0.f ? 1.f / l_run : 0.f);
#pragma unroll
      for (int dt = 0; dt < 2; ++dt)
#pragma unroll
        for (int i = 0; i < 16; ++i) of[dt][i] += sc * oacc[dt][i];
    }
    {
      float m_run = -1.0e30f, l_run = 0.f; f32x16 oacc[2]; zero16(oacc[0]); zero16(oacc[1]);
      for (int j = jlo; j <= jhi; ++j) {
        __syncthreads();
        ATT_COMMIT();
        __syncthreads();
        if (j < jhi) ATT_PREFETCH(kw, vtw, j + 1);
        if (64 * j + 63 + 128 <= t0 + 8 * w && 64 * j + 511 >= t0 + 8 * w + 7) attn_tile<true, true>(Kt, Vt, brel_r, cfar, qf, qpos, j * 64, true, m_run, l_run, oacc, ql, hh);
        else attn_tile<true, false>(Kt, Vt, brel_r, cfar, qf, qpos, j * 64, true, m_run, l_run, oacc, ql, hh);
      }
      l_run += __shfl_xor(l_run, 32);
      const float sc = gt[16 + head] * (l_run > 0.f ? 1.f / l_run : 0.f);
#pragma unroll
      for (int dt = 0; dt < 2; ++dt)
#pragma unroll
        for (int i = 0; i < 16; ++i) of[dt][i] += sc * oacc[dt][i];
    }
#undef ATT_PREFETCH
#undef ATT_COMMIT
  }
  {
    const u16* za = (const u16*)(p.ws + W_ZA) + tok * 512 + head * 64; u16* oa = (u16*)(p.ws + W_OA) + tok * 512 + head * 64;
#pragma unroll
    for (int dt = 0; dt < 2; ++dt)
#pragma unroll
      for (int q4 = 0; q4 < 4; ++q4) {
        const int dd = 32 * dt + 8 * q4 + 4 * hh;
        const uint2 z = *(const uint2*)(za + dd);
        uint2 o; o.x = pk2(of[dt][4 * q4] * bflo(z.x), of[dt][4 * q4 + 1] * bfhi(z.x)); o.y = pk2(of[dt][4 * q4 + 2] * bflo(z.y), of[dt][4 * q4 + 3] * bfhi(z.y));
        *(uint2*)(oa + dd) = o;
      }
  }
}
constexpr int P3_FIN = BATCH * 4 * 32;
constexpr int P3_ATT = BATCH * 2 * 32;
constexpr int P3_TOTAL = P3_FIN + P3_ATT;

constexpr int P4_TOTAL = G1_MT * 16;
DI void merge_a_tile(const Params& p, int it, char* lds) {
  const int tm = it >> 4, tn = it & 15;
  f32x16 aa[2][1], ab[2][1]; zero_acc<1>(aa); zero_acc<1>(ab);
  gemm_glds<1>(aa, (const u16*)(p.ws + W_OA) + (size_t)tm * 128 * 512, 512, (const u16*)(p.ws + W_WBAT) + (size_t)tn * 64 * 512, 512, 8, lds);
  gemm_glds<1>(ab, (const u16*)(p.ws + W_OB) + (size_t)tm * 128 * 512, 512, (const u16*)(p.ws + W_WBBT) + (size_t)tn * 64 * 512, 512, 8, lds);
  const int tid = otid(), lane = tid & 63, wave = tid >> 6, wm = wave >> 1, wn = wave & 1, r = lane & 31, h = lane >> 5;
#pragma unroll
  for (int mi = 0; mi < 2; ++mi) {
    const int c = tn * 64 + wn * 32 + r;
#pragma unroll
    for (int i = 0; i < 16; ++i) {
      const size_t off = (size_t)(tm * 128 + wm * 64 + mi * 32 + crow(i, h)) * 1024 + c;
      const float y = bf2f(((const u16*)(p.ws + W_SA))[off]) * aa[mi][0][i] + bf2f(((const u16*)(p.ws + W_SB))[off]) * ab[mi][0][i];
      ((u16*)(p.ws + W_Y))[off] = f2bf(y);
    }
  }
}
constexpr int P5_TOTAL = G1_MT * 8;
DI void merge_b_tile(const Params& p, int it, char* lds) {
  const int tm = it >> 3, tn = it & 7;
  f32x16 acc[2][2]; zero_acc<2>(acc);
  gemm_glds<2>(acc, (const u16*)(p.ws + W_Y) + (size_t)tm * 128 * 1024, 1024, (const u16*)(p.ws + W_WOUTT) + (size_t)tn * 128 * 1024, 1024, 16, lds);
  const int tid = otid(), lane = tid & 63, wave = tid >> 6, wm = wave >> 1, wn = wave & 1, r = lane & 31, h = lane >> 5;
  const float* xin = (tm < 128) ? p.x_prompt : (p.x_sample - (size_t)NTP * 1024);
#pragma unroll
  for (int mi = 0; mi < 2; ++mi) {
#pragma unroll
    for (int i = 0; i < 16; ++i) {
      const size_t row = (size_t)(tm * 128 + wm * 64 + mi * 32 + crow(i, h));
      float ss = 0.f;
#pragma unroll
      for (int ni = 0; ni < 2; ++ni) {
        const int c = tn * 128 + wn * 64 + ni * 32 + r;
        const float hv = acc[mi][ni][i] + xin[row * 1024 + c];
        p.out[row * 1024 + c] = hv; ss += hv * hv;
      }
      ss += __shfl_xor(ss, 1); ss += __shfl_xor(ss, 2); ss += __shfl_xor(ss, 4); ss += __shfl_xor(ss, 8); ss += __shfl_xor(ss, 16);
      if (r == 0) ((float*)(p.ws + W_SS))[row * 16 + tn * 2 + wn] = ss;
    }
  }
}
constexpr int P6_TOTAL = NT / 4;
DI void final_norm_item(const Params& p, int it) {
  const int tid_ = otid(), lane = tid_ & 63, wave = tid_ >> 6; const size_t row = (size_t)it * 4 + wave;
  const float* ssp = (const float*)(p.ws + W_SS) + row * 16;
  float ss = 0.f;
#pragma unroll
  for (int i = 0; i < 16; ++i) ss += ssp[i];
  const float rs = rsqrtf(ss * (1.f / 1024.f) + 1e-6f);
  float* o = p.out + row * 1024;
#pragma unroll
  for (int i = 0; i < 4; ++i) {
    float4 v = *(float4*)(o + (i * 64 + lane) * 4); const float4 gg = *(const float4*)(p.final_g + (i * 64 + lane) * 4);
    v.x *= rs * gg.x; v.y *= rs * gg.y; v.z *= rs * gg.z; v.w *= rs * gg.w;
    *(float4*)(o + (i * 64 + lane) * 4) = v;
  }
}


#define XB_TMO      128
#define XB_XCNT(j)  (256  + 64 * (j))
#define XB_XSUB(j)  (1280 + 64 * (j))
#define XB_XGEN(j)  (2304 + 64 * (j))
#define XB_TOP      3328
#define XB_TOPGEN   3392
#define XCD_BAR_WORDS 3456
#define XB_SPIN_CAP (1u << 18)
#define LAS __attribute__((address_space(3)))
DI unsigned xb_ld(unsigned* p)              { return __hip_atomic_load(p, __ATOMIC_RELAXED, __HIP_MEMORY_SCOPE_AGENT); }
DI unsigned xb_add(unsigned* p, unsigned v) { return __hip_atomic_fetch_add(p, v, __ATOMIC_RELAXED, __HIP_MEMORY_SCOPE_AGENT); }
DI unsigned xb_xcc_id() { return (unsigned)__builtin_amdgcn_s_getreg((3 << 11) | 20) & 0xFu; }
#define XB_SPIN(cond, bar) do { unsigned _sp = 0; while (cond) { __builtin_amdgcn_s_sleep(1); \
    if ((++_sp & 255u) == 0u) { if (xb_ld(&(bar)[XB_TMO])) break; if (_sp > XB_SPIN_CAP) { atomicAdd(&(bar)[XB_TMO], 1u); break; } } } } while (0)
struct XcdBarrier { unsigned* bar; unsigned x; unsigned nloc, nx; };
DI XcdBarrier xcd_barrier_post(unsigned* bar) {
  XcdBarrier b; b.bar = bar; b.x = xb_xcc_id(); b.nloc = 0u; b.nx = 0u;
  if (threadIdx.x == 0) (void)xb_add(&bar[XB_XCNT(b.x)], 1u);
  return b;
}
DI void xcd_barrier_complete(unsigned* bar, unsigned x, unsigned& nloc, unsigned& nx) {
  const unsigned G = gridDim.x * gridDim.y * gridDim.z;
  unsigned sum, cnt, mine, sp = 0u;
  for (;;) {
    sum = 0u; cnt = 0u; mine = 0u;
#pragma unroll
    for (unsigned j = 0; j < 16; ++j) { const unsigned c = xb_ld(&bar[XB_XCNT(j)]); sum += c; cnt += (c > 0u) ? 1u : 0u; mine = (j == x) ? c : mine; }
    if (sum == G) break;
    __builtin_amdgcn_s_sleep(1);
    if ((++sp & 255u) == 0u) { if (xb_ld(&bar[XB_TMO])) break; if (sp > XB_SPIN_CAP) { atomicAdd(&bar[XB_TMO], 1u); break; } }
  }
  nloc = mine > 0u ? mine : 1u; nx = cnt > 0u ? cnt : 1u;
}
DI void xcd_barrier(XcdBarrier& b) {
  asm volatile("s_waitcnt vmcnt(0)" ::: "memory");
  __syncthreads();
  if (threadIdx.x == 0) {
    unsigned* bar = b.bar;
    __builtin_amdgcn_s_waitcnt(0);
    unsigned nloc = b.nloc, nx = b.nx;
    if (nloc == 0u) { xcd_barrier_complete(bar, b.x, nloc, nx); b.nloc = nloc; b.nx = nx; }
    const unsigned old = xb_add(&bar[XB_XSUB(b.x)], 1u);
    const unsigned gen = old / nloc;
    if (old + 1u == (gen + 1u) * nloc) {
      __builtin_amdgcn_fence(__ATOMIC_RELEASE, "agent");
      asm volatile("s_waitcnt vmcnt(0)" ::: "memory");
      const unsigned og = xb_add(&bar[XB_TOP], 1u);
      const unsigned tg = og / nx;
      if (og + 1u == (tg + 1u) * nx) xb_add(&bar[XB_TOPGEN], 1u);
      else XB_SPIN(xb_ld(&bar[XB_TOPGEN]) == tg, bar);
      __builtin_amdgcn_fence(__ATOMIC_ACQUIRE, "agent");
      xb_add(&bar[XB_XGEN(b.x)], 1u);
      asm volatile("s_waitcnt vmcnt(0)" ::: "memory");
    } else {
      XB_SPIN(xb_ld(&bar[XB_XGEN(b.x)]) == gen, bar);
      __builtin_amdgcn_fence(__ATOMIC_ACQUIRE, "agent");
      asm volatile("s_waitcnt vmcnt(0)" ::: "memory");
    }
  }
  __syncthreads();
}


template <int PH>
DI void run_phase(const Params& p, char* lds_all) {
  const int half = __builtin_amdgcn_readfirstlane(threadIdx.x >> 8);
  const int vb = blockIdx.x * 2 + half, nvb = gridDim.x * 2;
  char* lds = lds_all + half * 65536;
  if (PH == 0) { for (int it = vb; it < P0_TOTAL; it += nvb) phase0_item(p, it, lds); }
  if (PH == 1) {
    for (int it = vb; it < P1_CMP; it += nvb) phase1_item(p, it, lds);
    const int x = blockIdx.x & 7, nli = (gridDim.x >> 3) * 2;
    constexpr int NSN = (G1_NT + 7) / 8, NS = ((G1_MT + 7) / 8) * NSN;
    for (int S = x; S < NS; S += 8)
      for (int li = (blockIdx.x >> 3) * 2 + half; li < 64; li += nli) {
        const int tm = (S / NSN) * 8 + (li & 7), tn = (S % NSN) * 8 + (li >> 3);
        const bool ok = tm < G1_MT && tn < G1_NT;
        proj_tile(p, ok ? tm : 0, ok ? tn : 0, lds, ok);
      }
  }
  if (PH == 2) { for (int it = vb; it < P2_TOTAL; it += nvb) phase2_item(p, it, lds); }
  if (PH == 7) { for (int it = vb; it < H2_ITEMS; it += nvb) hgrn_h2_item(p, it); }
  if (PH == 3) {
    for (int it = vb; it < P3_FIN; it += nvb) hgrn_h3_item(p, it);
    for (int it = blockIdx.x; it < P3_ATT; it += gridDim.x) prompt_attn_item(p, it, lds_all);
  }
  if (PH == 4) { for (int it = vb; it < P4_TOTAL; it += nvb) merge_a_tile(p, it, lds); }
  if (PH == 5) { for (int it = vb; it < P5_TOTAL; it += nvb) merge_b_tile(p, it, lds); }
  if (PH == 6) { for (int it = vb; it < P6_TOTAL; it += nvb) final_norm_item(p, it); }
}

constexpr int LDS_DYN = 128 * 1024;
__global__ void __launch_bounds__(512, 2) k_mega(Params p) {
  extern __shared__ __attribute__((aligned(16))) char lds[];
  XcdBarrier bar = xcd_barrier_post((unsigned*)(p.ws + W_BAR));
  run_phase<0>(p, lds); xcd_barrier(bar);
  run_phase<1>(p, lds); xcd_barrier(bar);
  run_phase<2>(p, lds); xcd_barrier(bar);
  run_phase<7>(p, lds); xcd_barrier(bar);
  run_phase<3>(p, lds); xcd_barrier(bar);
  run_phase<4>(p, lds); xcd_barrier(bar);
  run_phase<5>(p, lds); xcd_barrier(bar);
  run_phase<6>(p, lds);
}

extern "C" void kernel_launch(void* const* d_in, const int* in_sizes, int n_in, void* d_out, int out_size,
                              void* d_ws, size_t ws_size, hipStream_t stream) {
  Params p{};
  p.x_prompt = (const float*)d_in[0]; p.x_sample = (const float*)d_in[1];
  p.cck = (const float*)d_in[2]; p.ccv = (const float*)d_in[3]; p.csk = (const float*)d_in[4]; p.csv = (const float*)d_in[5];
  p.swk = (const float*)d_in[6]; p.swv = (const float*)d_in[7]; p.shg = (const float*)d_in[8]; p.pt = (const int*)d_in[9];
  p.norm_g = (const float*)d_in[10]; p.w_in = (const float*)d_in[11];
  p.pos_k = (const float*)d_in[12]; p.w1_k = (const float*)d_in[13]; p.w2_k = (const float*)d_in[14];
  p.pos_v = (const float*)d_in[15]; p.w1_v = (const float*)d_in[16]; p.w2_v = (const float*)d_in[17];
  p.rel_bias = (const float*)d_in[18]; p.hg_lower = (const float*)d_in[19]; p.hg_norm_g = (const float*)d_in[20];
  p.w_ba = (const float*)d_in[21]; p.w_bb = (const float*)d_in[22]; p.w_out = (const float*)d_in[23]; p.final_g = (const float*)d_in[24];
  p.out = (float*)d_out; p.ws = (char*)d_ws;
  if ((size_t)out_size != O_END || ws_size < W_END) { fprintf(stderr, "kernel_launch: unexpected sizes out=%d ws=%zu (need %zu / %zu)\n", out_size, ws_size, (size_t)O_END, (size_t)W_END); return; }
  static int grid_blocks = 0;
  if (!grid_blocks) {
    int dev = 0, cus = 0, per_cu = 0;
    hipGetDevice(&dev);
    hipDeviceGetAttribute(&cus, hipDeviceAttributeMultiprocessorCount, dev);
    hipFuncSetAttribute((const void*)k_mega, hipFuncAttributeMaxDynamicSharedMemorySize, LDS_DYN);
    hipOccupancyMaxActiveBlocksPerMultiprocessor(&per_cu, k_mega, 512, LDS_DYN);
    if (per_cu < 1) fprintf(stderr, "kernel_launch: occupancy query reports %d blocks per CU\n", per_cu);
    grid_blocks = cus;
  }
  hipMemsetAsync((char*)d_ws + W_BAR, 0, XCD_BAR_WORDS * 4, stream);
  void* args[] = {&p};
  hipError_t e = hipLaunchCooperativeKernel((void*)k_mega, dim3(grid_blocks), dim3(512), args, LDS_DYN, stream);
  if (e != hipSuccess) fprintf(stderr, "cooperative launch failed: %s (grid %d)\n", hipGetErrorString(e), grid_blocks);
}
```

```cpp
#include <hip/hip_runtime.h>
#include <hip/hip_cooperative_groups.h>
#include <cstdio>
namespace cg = cooperative_groups;

#define DI __device__ __forceinline__
typedef unsigned short u16;
typedef __attribute__((ext_vector_type(8))) short bf16x8;
typedef __attribute__((ext_vector_type(4))) short s16x4;
typedef __attribute__((ext_vector_type(16))) float f32x16;
typedef __attribute__((ext_vector_type(4))) float f32x4;
typedef __attribute__((ext_vector_type(2))) float f32x2;
typedef __attribute__((ext_vector_type(2))) __bf16 bf16x2v;
#define MFMA32(a, b, c) __builtin_amdgcn_mfma_f32_32x32x16_bf16((a), (b), (c), 0, 0, 0)
#define MFMA16(a, b, c) __builtin_amdgcn_mfma_f32_16x16x32_bf16((a), (b), (c), 0, 0, 0)

constexpr int D_MODEL = 1024, BATCH = 8, SEQ = 2048, DEC_BATCH = 128, DEC_SEQ = 4, PAST = 2048;
constexpr int NTP = BATCH * SEQ;
constexpr int NTS = DEC_BATCH * DEC_SEQ;
constexpr int NT = NTP + NTS;
constexpr int IN_COLS = 5912, NPAD = 6016;
constexpr int NSEQ = BATCH + DEC_BATCH;

constexpr size_t O_YP = 0;
constexpr size_t O_YS = O_YP + (size_t)NTP * 1024;
constexpr size_t O_PCK = O_YS + (size_t)NTS * 1024;
constexpr size_t O_PWK = O_PCK + 4 * (size_t)NTP * 128;
constexpr size_t O_PHG = O_PWK + 2 * (size_t)BATCH * 512 * 128;
constexpr size_t O_SCK = O_PHG + (size_t)BATCH * 4 * 128 * 128;
constexpr size_t O_SWK = O_SCK + 4 * (size_t)NTS * 128;
constexpr size_t O_SHG = O_SWK + 2 * (size_t)DEC_BATCH * 512 * 128;
constexpr size_t O_END = O_SHG + (size_t)DEC_BATCH * 4 * 128 * 128;

constexpr size_t al256(size_t x) { return (x + 255) & ~(size_t)255; }
constexpr size_t W_WINT = 0;
constexpr size_t W_WBAT = al256(W_WINT + (size_t)NPAD * 1024 * 2);
constexpr size_t W_WBBT = al256(W_WBAT + (size_t)1024 * 512 * 2);
constexpr size_t W_WOUTT = al256(W_WBBT + (size_t)1024 * 512 * 2);
constexpr size_t W_W1T = al256(W_WOUTT + (size_t)1024 * 1024 * 2);
constexpr size_t W_C1 = al256(W_W1T + (size_t)2 * 128 * 1024 * 2);
constexpr size_t W_XN = al256(W_C1 + 2 * 64 * 4);
constexpr size_t W_Q = al256(W_XN + (size_t)NT * 1024 * 2);
constexpr size_t W_KV = al256(W_Q + (size_t)NT * 512 * 2);
constexpr size_t W_VST = al256(W_KV + (size_t)6 * NT * 128 * 2);
constexpr size_t W_VWT = al256(W_VST + (size_t)8 * 2 * 64 * 2048 * 2);
constexpr size_t W_GATE = al256(W_VWT + (size_t)8 * 2 * 64 * 2048 * 2);
constexpr size_t W_ZA = al256(W_GATE + (size_t)NT * 24 * 4);
constexpr size_t W_QB = al256(W_ZA + (size_t)NT * 512 * 2);
constexpr size_t W_KB = al256(W_QB + (size_t)NT * 512 * 2);
constexpr size_t W_GB = al256(W_KB + (size_t)NT * 512 * 2);
constexpr size_t W_VB = al256(W_GB + (size_t)NT * 512 * 4);
constexpr size_t W_ZB = al256(W_VB + (size_t)NT * 512 * 2);
constexpr size_t W_SA = al256(W_ZB + (size_t)NT * 512 * 2);
constexpr size_t W_SB = al256(W_SA + (size_t)NT * 1024 * 2);
constexpr size_t W_KCMP = al256(W_SB + (size_t)NT * 1024 * 2);
constexpr size_t W_VCMP = al256(W_KCMP + (size_t)NSEQ * 2 * 128 * 64 * 2);
constexpr size_t W_VCMPT = al256(W_VCMP + (size_t)NSEQ * 2 * 128 * 64 * 2);
constexpr size_t W_OA = al256(W_VCMPT + (size_t)8 * 2 * 64 * 128 * 2);
constexpr size_t W_OB = al256(W_OA + (size_t)NT * 512 * 2);
constexpr size_t W_Y = al256(W_OB + (size_t)NT * 512 * 2);
constexpr size_t W_SS = al256(W_Y + (size_t)NT * 1024 * 2);
constexpr size_t W_ORAW = al256(W_SS + (size_t)NT * 32 * 4);
constexpr size_t W_OSS = al256(W_ORAW + (size_t)NTP * 512 * 4);
constexpr size_t W_QG = al256(W_OSS + (size_t)NTP * 8 * 4);
constexpr size_t W_DST = al256(W_QG + (size_t)NTP * 512 * 2);
constexpr size_t W_DEC = al256(W_DST + (size_t)1024 * 128 * 128 * 4);
constexpr size_t W_SPT = al256(W_DEC + (size_t)1024 * 128 * 4);
constexpr size_t W_BAR = al256(W_SPT + (size_t)1024 * 128 * 128 * 2);
constexpr size_t W_END = al256(W_BAR + 3456 * 4);

struct Params {
  const float* x_prompt; const float* x_sample;
  const float* cck; const float* ccv; const float* csk; const float* csv;
  const float* swk; const float* swv; const float* shg; const int* pt;
  const float* norm_g; const float* w_in;
  const float* pos_k; const float* w1_k; const float* w2_k;
  const float* pos_v; const float* w1_v; const float* w2_v;
  const float* rel_bias; const float* hg_lower; const float* hg_norm_g;
  const float* w_ba; const float* w_bb; const float* w_out; const float* final_g;
  float* out; char* ws;
};

DI unsigned pk2(float a, float b) { f32x2 v = {a, b}; bf16x2v r = __builtin_convertvector(v, bf16x2v); return __builtin_bit_cast(unsigned, r); }
DI u16 f2bf(float a) { return (u16)(pk2(a, 0.f) & 0xffffu); }
DI float bf2f(u16 v) { return __uint_as_float(((unsigned)v) << 16); }
DI float bflo(unsigned v) { return __uint_as_float(v << 16); }
DI float bfhi(unsigned v) { return __uint_as_float(v & 0xffff0000u); }
constexpr float LOG2E = 1.4426950408889634f;
DI float sigmoidf_(float x) { return 1.f / (1.f + __expf(-x)); }
DI float siluf_(float x) { return x / (1.f + __expf(-x)); }
DI int otid() { int t = threadIdx.x & 255; asm volatile("" : "+v"(t)); return t; }
DI int otid512() { int t = threadIdx.x; asm volatile("" : "+v"(t)); return t; }
DI int crow(int reg, int h) { return (reg & 3) + 8 * (reg >> 2) + 4 * h; }
DI float wave_sum(float v) {
#pragma unroll
  for (int o = 32; o >= 1; o >>= 1) v += __shfl_xor(v, o);
  return v;
}
DI float wave_max(float v) {
#pragma unroll
  for (int o = 32; o >= 1; o >>= 1) v = fmaxf(v, __shfl_xor(v, o));
  return v;
}

__device__ const unsigned char T5B[128] = {
  0,1,2,3,4,5,6,7,8,9,10,11,12,13,14,15,
  16,16,16,17,17,18,18,18,19,19,19,20,20,20,20,21,
  21,21,21,22,22,22,22,22,23,23,23,23,23,23,24,24,
  24,24,24,24,25,25,25,25,25,25,25,26,26,26,26,26,
  26,26,26,27,27,27,27,27,27,27,27,27,27,28,28,28,
  28,28,28,28,28,28,28,29,29,29,29,29,29,29,29,29,
  29,29,29,30,30,30,30,30,30,30,30,30,30,30,30,30,
  30,31,31,31,31,31,31,31,31,31,31,31,31,31,31,31};

DI void transpose_tile(const float* __restrict__ src, int ldsrc, int K, int N, int k0, int n0,
                       u16* __restrict__ dst, int lddst, int dst_row_off, int dst_k0, int winperm, float* tl) {
  const int tid = otid();
  __syncthreads();
  {
    const int n = tid & 63, kb = tid >> 6;
#pragma unroll
    for (int i = 0; i < 16; ++i) {
      const int kk = kb + 4 * i;
      const int nc = (n0 + n < N) ? n0 + n : N - 1, kc = (k0 + kk < K) ? k0 + kk : K - 1;
      tl[kk * 65 + n] = src[(size_t)kc * ldsrc + nc];
    }
  }
  __syncthreads();
  {
    const int k = (tid & 31) * 2, nb = tid >> 5;
#pragma unroll
    for (int i = 0; i < 8; ++i) {
      const int nn = nb + 8 * i;
      int n = n0 + nn;
      if (n < N) {
        if (winperm) n = (n < 1280) ? n : ((n < 1304) ? (5888 + n - 1280) : (n - 24));
        const unsigned v = pk2(tl[k * 65 + nn], tl[(k + 1) * 65 + nn]);
        *(unsigned*)(dst + (size_t)(dst_row_off + n) * lddst + dst_k0 + k) = v;
      }
    }
  }
}

constexpr int P0_WIN = 16 * 93;
constexpr int P0_WBA = 8 * 16, P0_WBB = 8 * 16, P0_WOUT = 16 * 16, P0_W1 = 32 * 2;
constexpr int P0_TR = P0_WIN + P0_WBA + P0_WBB + P0_WOUT + P0_W1;
constexpr int P0_C1 = 2;
constexpr int P0_NORM = NT / 4;
constexpr int P0_WCP = 2 * DEC_BATCH * 8;
constexpr int P0_PAD = NPAD - IN_COLS;
constexpr int P0_TOTAL = P0_TR + P0_C1 + P0_NORM + P0_WCP + P0_PAD;

DI void phase0_item(const Params& p, int it, char* lds) {
  const int tid = otid(), lane = tid & 63, wave = tid >> 6;
  float* tl = (float*)lds;
  if (it < P0_TR) {
    if (it < P0_WIN) {
      const int kt = it / 93, nt = it % 93;
      transpose_tile(p.w_in, IN_COLS, 1024, IN_COLS, kt * 64, nt * 64, (u16*)(p.ws + W_WINT), 1024, 0, kt * 64, 1, tl);
      return;
    }
    it -= P0_WIN;
    if (it < P0_WBA) { const int kt = it / 16, nt = it % 16;
      transpose_tile(p.w_ba, 1024, 512, 1024, kt * 64, nt * 64, (u16*)(p.ws + W_WBAT), 512, 0, kt * 64, 0, tl); return; }
    it -= P0_WBA;
    if (it < P0_WBB) { const int kt = it / 16, nt = it % 16;
      transpose_tile(p.w_bb, 1024, 512, 1024, kt * 64, nt * 64, (u16*)(p.ws + W_WBBT), 512, 0, kt * 64, 0, tl); return; }
    it -= P0_WBB;
    if (it < P0_WOUT) { const int kt = it / 16, nt = it % 16;
      transpose_tile(p.w_out, 1024, 1024, 1024, kt * 64, nt * 64, (u16*)(p.ws + W_WOUTT), 1024, 0, kt * 64, 0, tl); return; }
    it -= P0_WOUT;
    { const int kv = it >> 5, kt = it & 31;
      const float* w1 = kv ? p.w1_v : p.w1_k;
      transpose_tile(w1, 64, 2048, 64, kt * 64, 0, (u16*)(p.ws + W_W1T) + (size_t)kv * 128 * 1024, 1024,
                     (kt >= 16) ? 64 : 0, (kt & 15) * 64, 0, tl); return; }
  }
  it -= P0_TR;
  if (it < P0_C1) {
    const float* pos = it ? p.pos_v : p.pos_k; const float* w1 = it ? p.w1_v : p.w1_k;
    const int j = tid & 63, part = tid >> 6;
    float s = 0.f;
    for (int i = part * 512; i < part * 512 + 512; ++i) s += pos[i] * w1[(size_t)i * 64 + j];
    __syncthreads();
    tl[part * 64 + j] = s;
    __syncthreads();
    if (tid < 64) ((float*)(p.ws + W_C1))[it * 64 + tid] = tl[tid] + tl[64 + tid] + tl[128 + tid] + tl[192 + tid];
    return;
  }
  it -= P0_C1;
  if (it < P0_NORM) {
    const int row = it * 4 + wave;
    const float* x = (row < NTP) ? (p.x_prompt + (size_t)row * 1024) : (p.x_sample + (size_t)(row - NTP) * 1024);
    float4 v[4]; float ss = 0.f;
#pragma unroll
    for (int i = 0; i < 4; ++i) { v[i] = *(const float4*)(x + (i * 64 + lane) * 4); ss += v[i].x * v[i].x + v[i].y * v[i].y + v[i].z * v[i].z + v[i].w * v[i].w; }
    ss = wave_sum(ss);
    const float rs = rsqrtf(ss * (1.f / 1024.f) + 1e-6f);
    u16* xn = (u16*)(p.ws + W_XN) + (size_t)row * 1024;
#pragma unroll
    for (int i = 0; i < 4; ++i) {
      const float4 g = *(const float4*)(p.norm_g + (i * 64 + lane) * 4);
      uint2 o; o.x = pk2(v[i].x * rs * g.x, v[i].y * rs * g.y); o.y = pk2(v[i].z * rs * g.z, v[i].w * rs * g.w);
      *(uint2*)(xn + (i * 64 + lane) * 4) = o;
    }
    return;
  }
  it -= P0_NORM;
  if (it < P0_WCP) {
    const int sl = it & 7, b = (it >> 3) % DEC_BATCH, kv = it / (8 * DEC_BATCH);
    const float4* src = (const float4*)((kv ? p.swv : p.swk) + ((size_t)b * 512 + 4) * 128) + sl * 64 * 32;
    float4* dst = (float4*)(p.out + O_SWK + (size_t)kv * DEC_BATCH * 512 * 128 + (size_t)b * 512 * 128) + sl * 64 * 32;
    const int n = (sl == 7 ? 60 : 64) * 32;
    const float4* __restrict__ sp = src; float4* __restrict__ dp = dst;
#pragma unroll
    for (int i = 0; i < 8; ++i) { const int idx = (tid + 256 * i < n) ? tid + 256 * i : n - 1; dp[idx] = sp[idx]; }
    return;
  }
  it -= P0_WCP;
  { u16* d = (u16*)(p.ws + W_WINT) + (size_t)(IN_COLS + it) * 1024; *(uint2*)(d + tid * 4) = make_uint2(0u, 0u); }
}

constexpr int GST = 72;
struct LoadBf16 {
  const u16* base; int ld;
  DI uint4 load(int row, int ch, int kt) const { return *(const uint4*)(base + (size_t)row * ld + kt * 64 + ch * 8); }
};
struct LoadCellBf16 {
  const u16* base;
  DI uint4 load(int row, int ch, int kt) const { return *(const uint4*)(base + (size_t)(row * 16 + kt) * 128 + ch * 8); }
};
struct LoadCellPage {
  const float* cache; const int* pt; int g;
  DI uint4 load(int row, int ch, int kt) const {
    const int pos = row * 16 + kt; const int page = pt[pos >> 7];
    const float* s = cache + (((size_t)page * 128 + (pos & 127)) * 2 + g) * 64 + ch * 8;
    const float4 a = *(const float4*)s, b = *(const float4*)(s + 4);
    uint4 r; r.x = pk2(a.x, a.y); r.y = pk2(a.z, a.w); r.z = pk2(b.x, b.y); r.w = pk2(b.z, b.w); return r;
  }
};

template <int NI, class AL, class BL>
DI void gemm_main(f32x16 (&acc)[2][NI], const AL& al, const BL& bl, int nkt, char* lds) {
  u16* sA = (u16*)lds; u16* sB = sA + 128 * GST;
  const int tid = otid(), lane = tid & 63, wave = tid >> 6, wm = wave >> 1, wn = wave & 1;
  const int lrow = tid >> 3, lch = tid & 7, r = lane & 31, h = lane >> 5;
  uint4 ra[4], rb[2 * NI];
#pragma unroll
  for (int i = 0; i < 4; ++i) ra[i] = al.load(lrow + 32 * i, lch, 0);
#pragma unroll
  for (int i = 0; i < 2 * NI; ++i) rb[i] = bl.load(lrow + 32 * i, lch, 0);
  for (int kt = 0; kt < nkt; ++kt) {
    __syncthreads();
#pragma unroll
    for (int i = 0; i < 4; ++i) *(uint4*)(sA + (lrow + 32 * i) * GST + lch * 8) = ra[i];
#pragma unroll
    for (int i = 0; i < 2 * NI; ++i) *(uint4*)(sB + (lrow + 32 * i) * GST + lch * 8) = rb[i];
    __syncthreads();
    if (kt + 1 < nkt) {
#pragma unroll
      for (int i = 0; i < 4; ++i) ra[i] = al.load(lrow + 32 * i, lch, kt + 1);
#pragma unroll
      for (int i = 0; i < 2 * NI; ++i) rb[i] = bl.load(lrow + 32 * i, lch, kt + 1);
    }
#pragma unroll
    for (int s = 0; s < 4; ++s) {
      bf16x8 a[2], bb[NI];
#pragma unroll
      for (int mi = 0; mi < 2; ++mi) a[mi] = *(const bf16x8*)(sA + (wm * 64 + mi * 32 + r) * GST + s * 16 + 8 * h);
#pragma unroll
      for (int ni = 0; ni < NI; ++ni) bb[ni] = *(const bf16x8*)(sB + (wn * 32 * NI + ni * 32 + r) * GST + s * 16 + 8 * h);
#pragma unroll
      for (int mi = 0; mi < 2; ++mi)
#pragma unroll
        for (int ni = 0; ni < NI; ++ni) acc[mi][ni] = MFMA32(a[mi], bb[ni], acc[mi][ni]);
    }
  }
}

typedef __attribute__((address_space(1))) const unsigned gptr_t;
typedef __attribute__((address_space(3))) unsigned lptr_t;
template <int NI>
DI void gemm_glds(f32x16 (&acc)[2][NI], const u16* A, int lda, const u16* B, int ldb, int nkt, char* lds) {
  const int tid = otid(), lane = tid & 63, wave = tid >> 6, wm = wave >> 1, wn = wave & 1;
  const int r = lane & 31, h = lane >> 5;
  const int lr = (wave << 3) + (lane >> 3);
  const int lc = (lane & 7) ^ ((lane >> 3) & 7) ^ (wave & 1);
  const u16* ga = A + (size_t)lr * lda + lc * 8;
  const u16* gb = B + (size_t)lr * ldb + lc * 8;
  const int sw = (lane & 7) ^ ((lane >> 3) & 1);
  constexpr int STAGE = 16384 + 8192 * NI;
#define GLDS_ISSUE(buf, kt_) do { \
    char* sa_ = lds + (buf) * STAGE + tid * 16; \
    _Pragma("unroll") for (int i_ = 0; i_ < 4; ++i_) \
      __builtin_amdgcn_global_load_lds((gptr_t*)(ga + (size_t)(32 * i_) * lda + (kt_) * 64), (lptr_t*)(sa_ + i_ * 4096), 16, 0, 0); \
    _Pragma("unroll") for (int i_ = 0; i_ < 2 * NI; ++i_) \
      __builtin_amdgcn_global_load_lds((gptr_t*)(gb + (size_t)(32 * i_) * ldb + (kt_) * 64), (lptr_t*)(sa_ + 16384 + i_ * 4096), 16, 0, 0); \
  } while (0)
  __syncthreads();
  GLDS_ISSUE(0, 0);
#pragma unroll 1
  for (int kt = 0; kt < nkt; ++kt) {
    asm volatile("s_waitcnt vmcnt(0)" ::: "memory");
    __syncthreads();
    if (kt + 1 < nkt) GLDS_ISSUE((kt + 1) & 1, kt + 1);
    const char* sA = lds + (kt & 1) * STAGE; const char* sB = sA + 16384;
#pragma unroll
    for (int s = 0; s < 4; ++s) {
      const int co = ((2 * s + h) ^ sw) << 4;
      bf16x8 a[2], bb[NI];
#pragma unroll
      for (int mi = 0; mi < 2; ++mi) a[mi] = *(const bf16x8*)(sA + (wm * 64 + mi * 32 + r) * 128 + co);
#pragma unroll
      for (int ni = 0; ni < NI; ++ni) bb[ni] = *(const bf16x8*)(sB + (wn * 32 * NI + ni * 32 + r) * 128 + co);
#pragma unroll
      for (int mi = 0; mi < 2; ++mi)
#pragma unroll
        for (int ni = 0; ni < NI; ++ni) acc[mi][ni] = MFMA32(a[mi], bb[ni], acc[mi][ni]);
    }
  }
#undef GLDS_ISSUE
  __syncthreads();
}
template <int NI>
DI void zero_acc(f32x16 (&acc)[2][NI]) {
#pragma unroll
  for (int a = 0; a < 2; ++a)
#pragma unroll
    for (int b = 0; b < NI; ++b)
#pragma unroll
      for (int i = 0; i < 16; ++i) acc[a][b][i] = 0.f;
}

constexpr int G1_MT = NT / 128, G1_NT = NPAD / 128;
constexpr int P1_GEMM = G1_MT * G1_NT;
constexpr int P1_CMP = DEC_BATCH * 2 * 2;
constexpr int P1_TOTAL = P1_CMP + P1_GEMM;

DI void proj_tile(const Params& p, int tm, int tn, char* lds, bool store_ok) {
  f32x16 acc[2][2]; zero_acc<2>(acc);
  gemm_glds<2>(acc, (const u16*)(p.ws + W_XN) + (size_t)tm * 128 * 1024, 1024, (const u16*)(p.ws + W_WINT) + (size_t)tn * 128 * 1024, 1024, 16, lds);
  const int tid = otid(), lane = tid & 63, wave = tid >> 6, wm = wave >> 1, wn = wave & 1, r = lane & 31, h = lane >> 5;
  const bool samp = tm >= 128;
  if (!store_ok) return;
#pragma unroll
  for (int mi = 0; mi < 2; ++mi)
#pragma unroll
    for (int ni = 0; ni < 2; ++ni) {
      const int c = wn * 64 + ni * 32 + r;
      const int row0 = tm * 128 + wm * 64 + mi * 32;
      if (tn < 4) {
        u16* d = (u16*)(p.ws + W_Q) + tn * 128 + c;
#pragma unroll
        for (int i = 0; i < 16; ++i) d[(size_t)(row0 + crow(i, h)) * 512] = f2bf(acc[mi][ni][i] * (0.125f * LOG2E));
      } else if (tn < 10) {
        const int kvg = tn - 4;
        u16* d = (u16*)(p.ws + W_KV) + (size_t)kvg * NT * 128 + c;
#pragma unroll
        for (int i = 0; i < 16; ++i) {
          const int row = row0 + crow(i, h); const float v = acc[mi][ni][i];
          d[(size_t)row * 128] = f2bf(v);
          if (!samp) {
            if (kvg < 4) p.out[O_PCK + (size_t)kvg * NTP * 128 + (size_t)row * 128 + c] = v;
            else { const int t = row & 2047, b = row >> 11;
              if (t >= 1536) p.out[O_PWK + (size_t)(kvg - 4) * BATCH * 512 * 128 + ((size_t)b * 512 + t - 1536) * 128 + c] = v; }
          } else {
            const int srow = row - NTP;
            if (kvg < 4) p.out[O_SCK + (size_t)kvg * NTS * 128 + (size_t)srow * 128 + c] = v;
            else p.out[O_SWK + (size_t)(kvg - 4) * DEC_BATCH * 512 * 128 + ((size_t)(srow >> 2) * 512 + 508 + (srow & 3)) * 128 + c] = v;
          }
        }
        if (!samp && (kvg == 3 || kvg == 5)) {
          u16* vt = (u16*)(p.ws + (kvg == 3 ? W_VST : W_VWT));
          const int b = row0 >> 11, t0 = row0 & 2047, g = c >> 6, dd = c & 63;
          u16* drow = vt + ((size_t)(b * 2 + g) * 64 + dd) * 2048 + t0;
#pragma unroll
          for (int q = 0; q < 4; ++q) {
            uint2 o; o.x = pk2(acc[mi][ni][4 * q], acc[mi][ni][4 * q + 1]); o.y = pk2(acc[mi][ni][4 * q + 2], acc[mi][ni][4 * q + 3]);
            *(uint2*)(drow + 8 * q + 4 * h) = o;
          }
        }
      } else if (tn < 14 || (tn >= 26 && tn < 30)) {
        const bool isA = tn < 14; const int cc = (isA ? tn - 10 : tn - 26) * 128 + c;
        u16* d = (u16*)(p.ws + (isA ? W_ZA : W_ZB)) + cc;
#pragma unroll
        for (int i = 0; i < 16; ++i) d[(size_t)(row0 + crow(i, h)) * 512] = f2bf(siluf_(acc[mi][ni][i]));
      } else if (tn < 18 || (tn >= 22 && tn < 26)) {
        const bool isQ = tn < 18; const int cc = (isQ ? tn - 14 : tn - 22) * 128 + c;
        u16* d = (u16*)(p.ws + (isQ ? W_QB : W_VB)) + cc;
#pragma unroll
        for (int i = 0; i < 16; ++i) d[(size_t)(row0 + crow(i, h)) * 512] = f2bf(acc[mi][ni][i]);
      } else if (tn < 22) {
        const int cc = (tn - 18) * 128 + c;
        const float a0 = p.hg_lower[cc], a1 = p.hg_lower[512 + cc];
        const float lb = 1.f / (1.f + __expf(a1 - a0));
        u16* dk = (u16*)(p.ws + W_KB) + cc; float* dg = (float*)(p.ws + W_GB) + cc;
#pragma unroll
        for (int i = 0; i < 16; ++i) {
          const size_t row = row0 + crow(i, h);
          const float sg = sigmoidf_(acc[mi][ni][i]);
          const float f = lb + (1.f - lb) * sg;
          dg[row * 512] = __logf(f);
          dk[row * 512] = f2bf((1.f - lb) * (1.f - sg));
        }
      } else if (tn < 46) {
        const bool isA = tn < 38; const int cc = (isA ? tn - 30 : tn - 38) * 128 + c;
        u16* d = (u16*)(p.ws + (isA ? W_SA : W_SB)) + cc;
#pragma unroll
        for (int i = 0; i < 16; ++i) d[(size_t)(row0 + crow(i, h)) * 1024] = f2bf(sigmoidf_(acc[mi][ni][i]));
      } else {
        if (c < 24) {
          float* d = (float*)(p.ws + W_GATE) + c;
#pragma unroll
          for (int i = 0; i < 16; ++i) d[(size_t)(row0 + crow(i, h)) * 24] = sigmoidf_(acc[mi][ni][i]);
        }
      }
    }
}

template <class AL>
DI void comp_tile(const Params& p, const AL& al, int seq, int g, int kv, char* lds) {
  f32x16 acc[2][2]; zero_acc<2>(acc);
  LoadBf16 bl{(const u16*)(p.ws + W_W1T) + (size_t)kv * 128 * 1024, 1024};
  gemm_main<2>(acc, al, bl, 16, lds);
  const int tid = otid(), lane = tid & 63, wave = tid >> 6, wm = wave >> 1, wn = wave & 1, r = lane & 31, h = lane >> 5;
  float* T = (float*)lds;
  float* w2s = T + 128 * 65;
  const float* c1 = (const float*)(p.ws + W_C1) + kv * 64;
  const float* w2 = kv ? p.w2_v : p.w2_k;
  __syncthreads();
  for (int i = tid; i < 4096; i += 256) w2s[i] = w2[i];
  if (wn == 1) {
#pragma unroll
    for (int mi = 0; mi < 2; ++mi)
#pragma unroll
      for (int ni = 0; ni < 2; ++ni)
#pragma unroll
        for (int i = 0; i < 16; ++i) T[(wm * 64 + mi * 32 + crow(i, h)) * 65 + ni * 32 + r] = acc[mi][ni][i];
  }
  __syncthreads();
  if (wn == 0) {
    const float c1v[2] = {c1[r], c1[32 + r]};
#pragma unroll
    for (int mi = 0; mi < 2; ++mi)
#pragma unroll
      for (int ni = 0; ni < 2; ++ni)
#pragma unroll
        for (int i = 0; i < 16; ++i) {
          const int n = wm * 64 + mi * 32 + crow(i, h), j = ni * 32 + r;
          const float hv = siluf_(acc[mi][ni][i] + T[((n < 127) ? n + 1 : 127) * 65 + j] + c1v[ni]);
          acc[mi][ni][i] = (n < 127) ? hv : 0.f;
        }
  }
  __syncthreads();
  if (wn == 0) {
#pragma unroll
    for (int mi = 0; mi < 2; ++mi)
#pragma unroll
      for (int ni = 0; ni < 2; ++ni)
#pragma unroll
        for (int i = 0; i < 16; ++i) T[(wm * 64 + mi * 32 + crow(i, h)) * 65 + ni * 32 + r] = acc[mi][ni][i];
  }
  __syncthreads();
  {
    const int n = tid >> 1, eh = tid & 1;
    float o[32];
#pragma unroll
    for (int e = 0; e < 32; ++e) o[e] = 0.f;
#pragma unroll 2
    for (int j = 0; j < 64; ++j) {
      const float hv = T[n * 65 + j];
#pragma unroll
      for (int e = 0; e < 32; ++e) o[e] += hv * w2s[j * 64 + eh * 32 + e];
    }
    u16* dst = (u16*)(p.ws + (kv ? W_VCMP : W_KCMP)) + ((size_t)(seq * 2 + g) * 128 + n) * 64 + eh * 32;
#pragma unroll
    for (int e = 0; e < 32; e += 2) *(unsigned*)(dst + e) = pk2(o[e], o[e + 1]);
    if (kv == 1 && seq < BATCH) {
      u16* dt = (u16*)(p.ws + W_VCMPT) + ((size_t)(seq * 2 + g) * 64 + eh * 32) * 128 + n;
#pragma unroll
      for (int e = 0; e < 32; ++e) dt[(size_t)e * 128] = f2bf(o[e]);
    }
  }
  __syncthreads();
}

DI void phase1_item(const Params& p, int it, char* lds) {
  if (it < P1_CMP) {
    const int kv = it & 1, g = (it >> 1) & 1, b = it >> 2;
    LoadCellPage al{kv ? p.ccv : p.cck, p.pt + b * 16, g};
    comp_tile(p, al, BATCH + b, g, kv, lds);
    return;
  }
  it -= P1_CMP;
  const int tm = it / G1_NT, tn = it % G1_NT;
  proj_tile(p, tm, tn, lds, true);
}


DI void hgrn_sample_item(const Params& p, int it, char* lds) {
  const int b = it >> 2, h = it & 3, tid = otid(), lane = tid & 63, wave = tid >> 6;
  float* sf = (float*)lds; float* sk = sf + 512; float* sq = sk + 512; float* sv = sq + 512; float* so = sv + 512;
  __syncthreads();
  for (int i = tid; i < 512; i += 256) {
    const int t = i >> 7, c = i & 127; const size_t off = (size_t)(NTP + b * 4 + t) * 512 + h * 128 + c;
    sf[i] = __expf(((const float*)(p.ws + W_GB))[off]);
    sk[i] = bf2f(((const u16*)(p.ws + W_KB))[off]);
    sq[i] = bf2f(((const u16*)(p.ws + W_QB))[off]);
    sv[i] = bf2f(((const u16*)(p.ws + W_VB))[off]);
  }
  __syncthreads();
  const int e = tid & 127, dh = tid >> 7;
  const float* S0 = p.shg + (size_t)(b * 4 + h) * 128 * 128;
  float* S1 = p.out + O_SHG + (size_t)(b * 4 + h) * 128 * 128;
  const float v0 = sv[e], v1 = sv[128 + e], v2 = sv[256 + e], v3 = sv[384 + e];
  float o0 = 0.f, o1 = 0.f, o2 = 0.f, o3 = 0.f;
#pragma unroll 16
  for (int d = dh * 64; d < dh * 64 + 64; ++d) {
    float st = S0[(size_t)d * 128 + e];
    st = sf[d] * st + sk[d] * v0;             o0 += sq[d] * st;
    st = sf[128 + d] * st + sk[128 + d] * v1; o1 += sq[128 + d] * st;
    st = sf[256 + d] * st + sk[256 + d] * v2; o2 += sq[256 + d] * st;
    st = sf[384 + d] * st + sk[384 + d] * v3; o3 += sq[384 + d] * st;
    S1[(size_t)d * 128 + e] = st;
  }
  so[(dh * 4 + 0) * 128 + e] = o0; so[(dh * 4 + 1) * 128 + e] = o1; so[(dh * 4 + 2) * 128 + e] = o2; so[(dh * 4 + 3) * 128 + e] = o3;
  __syncthreads();
  {
    const int t = wave; const size_t row = (size_t)(NTP + b * 4 + t);
    const float a0 = so[t * 128 + lane] + so[(4 + t) * 128 + lane];
    const float a1 = so[t * 128 + 64 + lane] + so[(4 + t) * 128 + 64 + lane];
    const float ss = wave_sum(a0 * a0 + a1 * a1);
    const float rs = rsqrtf(ss * (1.f / 128.f) + 1e-6f);
    const u16* zb = (const u16*)(p.ws + W_ZB) + row * 512 + h * 128; u16* ob = (u16*)(p.ws + W_OB) + row * 512 + h * 128;
    ob[lane] = f2bf(a0 * rs * p.hg_norm_g[h * 128 + lane] * bf2f(zb[lane]));
    ob[64 + lane] = f2bf(a1 * rs * p.hg_norm_g[h * 128 + 64 + lane] * bf2f(zb[64 + lane]));
  }
}

typedef __attribute__((address_space(3))) s16x4 lds_s16x4;
DI s16x4 tr_read(const u16* ptr) { return __builtin_amdgcn_ds_read_tr16_b64_v4i16((lds_s16x4*)ptr); }
DI bf16x8 cat8(s16x4 lo, s16x4 hi) { return __builtin_shufflevector(lo, hi, 0, 1, 2, 3, 4, 5, 6, 7); }
constexpr int HST = 136;

DI void hgrn_h1_item(const Params& p, int it, char* lds) {
  const int c = it & 31, h = (it >> 5) & 3, b = it >> 7;
  const int tid = otid(), lane = tid & 63, w = __builtin_amdgcn_readfirstlane(tid >> 6), half = tid >> 7;
  const int c16 = lane & 15, hq = lane >> 4, tq = c16 >> 2, tp = c16 & 3;
  const int d = tid & 127, col = h * 128 + d;
  u16* Qe = (u16*)lds; u16* Ke = Qe + 64 * HST; u16* Vv = Ke + 64 * HST; u16* Am = Vv + 64 * HST;
  float* Rr = (float*)(Am + 64 * 72); float* G63 = Rr + 128;
  const u16* qB = (const u16*)(p.ws + W_QB); const u16* kB = (const u16*)(p.ws + W_KB); const u16* vB = (const u16*)(p.ws + W_VB);
  const float* gB = (const float*)(p.ws + W_GB);
  const size_t tok0 = (size_t)b * 2048 + c * 64;
  __syncthreads();
  float G[32];
  {
    float run = 0.f;
#pragma unroll
    for (int i = 0; i < 32; ++i) { run += gB[(tok0 + half * 32 + i) * 512 + col]; G[i] = run; }
    if (half == 0) Rr[d] = run;
  }
#pragma unroll
  for (int i = 0; i < 4; ++i) {
    const int idx = tid + 256 * i, s_ = idx >> 4, cc = idx & 15;
    *(uint4*)(Vv + s_ * HST + cc * 8) = *(const uint4*)(vB + (tok0 + s_) * 512 + h * 128 + cc * 8);
  }
  __syncthreads();
  {
    const float R = Rr[d];
    const float base = half ? R : 0.f;
    u16* qg = (u16*)(p.ws + W_QG);
#pragma unroll
    for (int i = 0; i < 32; ++i) {
      const int t = half * 32 + i;
      const float gt = base + G[i];
      const float q = bf2f(qB[(tok0 + t) * 512 + col]), k = bf2f(kB[(tok0 + t) * 512 + col]);
      const float dq = fminf(fmaxf(gt - R, -80.f), 80.f);
      Qe[t * HST + d] = f2bf(q * __expf(dq));
      Ke[t * HST + d] = f2bf(k * __expf(-dq));
      qg[(tok0 + t) * 512 + col] = f2bf(q * __expf(gt));
    }
    if (half == 1) G63[d] = base + G[31];
  }
  __syncthreads();
  for (int j = 0; j <= w; ++j) {
    f32x4 x = f32x4{0.f, 0.f, 0.f, 0.f};
#pragma unroll
    for (int ks = 0; ks < 4; ++ks) {
      const bf16x8 a = *(const bf16x8*)(Qe + (16 * w + c16) * HST + ks * 32 + 8 * hq);
      const bf16x8 bb = *(const bf16x8*)(Ke + (16 * j + c16) * HST + ks * 32 + 8 * hq);
      x = MFMA16(a, bb, x);
    }
#pragma unroll
    for (int r = 0; r < 4; ++r) {
      const bool ok = (j < w) || (c16 <= 4 * hq + r);
      Am[(16 * w + 4 * hq + r) * 72 + 16 * j + c16] = f2bf(ok ? x[r] : 0.f);
    }
  }
  if ((w & 1) == 0) {
#pragma unroll
    for (int r = 0; r < 4; ++r) Am[(16 * w + 4 * hq + r) * 72 + 16 * (w + 1) + c16] = 0;
  }
  __syncthreads();
  bf16x8 vf[2][2];
#pragma unroll
  for (int ks = 0; ks < 2; ++ks)
#pragma unroll
    for (int et = 0; et < 2; ++et) {
      const u16* base = Vv + (32 * ks + 8 * hq + tq) * HST + 32 * w + 16 * et + 4 * tp;
      vf[ks][et] = cat8(tr_read(base), tr_read(base + 4 * HST));
    }
  {
    f32x4 o[4][2];
#pragma unroll
    for (int tt = 0; tt < 4; ++tt)
#pragma unroll
      for (int et = 0; et < 2; ++et) o[tt][et] = f32x4{0.f, 0.f, 0.f, 0.f};
#pragma unroll
    for (int tt = 0; tt < 4; ++tt)
#pragma unroll
      for (int ks = 0; ks <= (tt >> 1); ++ks) {
        const bf16x8 a = *(const bf16x8*)(Am + (16 * tt + c16) * 72 + 32 * ks + 8 * hq);
#pragma unroll
        for (int et = 0; et < 2; ++et) o[tt][et] = MFMA16(a, vf[ks][et], o[tt][et]);
      }
    float* oraw = (float*)(p.ws + W_ORAW);
#pragma unroll
    for (int tt = 0; tt < 4; ++tt)
#pragma unroll
      for (int et = 0; et < 2; ++et)
#pragma unroll
        for (int r = 0; r < 4; ++r) oraw[(tok0 + 16 * tt + 4 * hq + r) * 512 + h * 128 + 32 * w + 16 * et + c16] = o[tt][et][r];
  }
  float* dst = (float*)(p.ws + W_DST) + (size_t)it * 128 * 128;
#pragma unroll
  for (int dt = 0; dt < 8; ++dt) {
    bf16x8 kt[2];
#pragma unroll
    for (int ks = 0; ks < 2; ++ks) {
      const u16* base = Ke + (32 * ks + 8 * hq + tq) * HST + 16 * dt + 4 * tp;
      kt[ks] = cat8(tr_read(base), tr_read(base + 4 * HST));
    }
    f32x4 sc2;
#pragma unroll
    for (int r = 0; r < 4; ++r) sc2[r] = __expf(G63[16 * dt + 4 * hq + r] - Rr[16 * dt + 4 * hq + r]);
#pragma unroll
    for (int et = 0; et < 2; ++et) {
      f32x4 dd = f32x4{0.f, 0.f, 0.f, 0.f};
      dd = MFMA16(kt[0], vf[0][et], dd); dd = MFMA16(kt[1], vf[1][et], dd);
      *(float4*)(dst + (size_t)(32 * w + 16 * et + c16) * 128 + 16 * dt + 4 * hq) = make_float4(dd[0] * sc2[0], dd[1] * sc2[1], dd[2] * sc2[2], dd[3] * sc2[3]);
    }
  }
  if (tid < 128) ((float*)(p.ws + W_DEC))[(size_t)it * 128 + tid] = __expf(G63[tid]);
}

constexpr int H2_ITEMS = 8 * 4 * 128 * 32 / 256;
DI void hgrn_h2_item(const Params& p, int it) {
  const int gt = it * 256 + otid(), bh = gt >> 12, e = (gt >> 5) & 127, dq = gt & 31;
  const float* dst = (const float*)(p.ws + W_DST); const float* dec = (const float*)(p.ws + W_DEC); u16* spt = (u16*)(p.ws + W_SPT);
  float4 s = make_float4(0.f, 0.f, 0.f, 0.f);
#pragma unroll 4
  for (int c = 0; c < 32; ++c) {
    const size_t idx = ((size_t)(bh * 32 + c) * 128 + e) * 128 + dq * 4;
    const float4 d4 = *(const float4*)(dst + idx);
    const float4 k4 = *(const float4*)(dec + (size_t)(bh * 32 + c) * 128 + dq * 4);
    *(uint2*)(spt + idx) = make_uint2(pk2(s.x, s.y), pk2(s.z, s.w));
    s.x = k4.x * s.x + d4.x; s.y = k4.y * s.y + d4.y; s.z = k4.z * s.z + d4.z; s.w = k4.w * s.w + d4.w;
  }
  float* So = p.out + O_PHG + (size_t)bh * 128 * 128;
  So[(size_t)(dq * 4 + 0) * 128 + e] = s.x; So[(size_t)(dq * 4 + 1) * 128 + e] = s.y;
  So[(size_t)(dq * 4 + 2) * 128 + e] = s.z; So[(size_t)(dq * 4 + 3) * 128 + e] = s.w;
}

DI void hgrn_h3_item(const Params& p, int it) {
  const int c = it & 31, h = (it >> 5) & 3, b = it >> 7;
  const int tid = otid(), lane = tid & 63, w = tid >> 6, c16 = lane & 15, hq = lane >> 4;
  const size_t tok0 = (size_t)b * 2048 + c * 64 + 16 * w;
  const u16* qg = (const u16*)(p.ws + W_QG) + (tok0 + c16) * 512 + h * 128 + 8 * hq;
  bf16x8 af[4];
#pragma unroll
  for (int ks = 0; ks < 4; ++ks) af[ks] = *(const bf16x8*)(qg + 32 * ks);
  const float* oraw = (const float*)(p.ws + W_ORAW) + (tok0 + 4 * hq) * 512 + h * 128 + c16;
  const u16* spt = (const u16*)(p.ws + W_SPT) + ((size_t)it * 128 + c16) * 128 + 8 * hq;
  f32x4 acc[8];
#pragma unroll
  for (int et = 0; et < 8; ++et) {
#pragma unroll
    for (int r = 0; r < 4; ++r) acc[et][r] = oraw[(size_t)r * 512 + 16 * et];
#pragma unroll
    for (int ks = 0; ks < 4; ++ks) {
      const bf16x8 bfr = *(const bf16x8*)(spt + (size_t)(16 * et) * 128 + 32 * ks);
      acc[et] = MFMA16(af[ks], bfr, acc[et]);
    }
  }
  const u16* zb = (const u16*)(p.ws + W_ZB) + (tok0 + 4 * hq) * 512 + h * 128 + c16;
  u16* ob = (u16*)(p.ws + W_OB) + (tok0 + 4 * hq) * 512 + h * 128 + c16;
#pragma unroll
  for (int r = 0; r < 4; ++r) {
    float v = 0.f;
#pragma unroll
    for (int et = 0; et < 8; ++et) v += acc[et][r] * acc[et][r];
    v += __shfl_xor(v, 1); v += __shfl_xor(v, 2); v += __shfl_xor(v, 4); v += __shfl_xor(v, 8);
    const float rs = rsqrtf(v * (1.f / 128.f) + 1e-6f);
#pragma unroll
    for (int et = 0; et < 8; ++et)
      ob[(size_t)r * 512 + 16 * et] = f2bf(acc[et][r] * rs * p.hg_norm_g[h * 128 + 16 * et + c16] * bf2f(zb[(size_t)r * 512 + 16 * et]));
  }
}

typedef __attribute__((address_space(3))) const float lds_cf;
template <int NR>
DI void sa_scores(const float* qrows_, const float4 (&kk)[16], float (&sc)[NR]) {
  lds_cf* qrows = (lds_cf*)qrows_; asm volatile("" : "+v"(qrows));
#pragma unroll
  for (int r = 0; r < NR; ++r) {
    float a0 = 0.f, a1 = 0.f;
#pragma unroll
    for (int dq = 0; dq < 16; dq += 2) {
      const f32x4 q0 = *(const __attribute__((address_space(3))) f32x4*)(qrows + r * 64 + dq * 4), q1 = *(const __attribute__((address_space(3))) f32x4*)(qrows + r * 64 + dq * 4 + 4);
      a0 += q0[0] * kk[dq].x + q0[1] * kk[dq].y + q0[2] * kk[dq].z + q0[3] * kk[dq].w;
      a1 += q1[0] * kk[dq + 1].x + q1[1] * kk[dq + 1].y + q1[2] * kk[dq + 1].z + q1[3] * kk[dq + 1].w;
    }
    sc[r] = a0 + a1;
    asm volatile("" : "+v"(sc[r]) :: "memory");
  }
}
DI void sa_load_f32(const float* rowp, bool ok, float4 (&kk)[16]) {
#pragma unroll
  for (int i = 0; i < 16; ++i) kk[i] = ok ? ((const float4*)rowp)[i] : make_float4(0.f, 0.f, 0.f, 0.f);
}
template <int NR>
DI void sa_softmax(float* P, int nk, int row, int sub) {
  float m = -3.0e38f;
  for (int k = sub; k < nk; k += 16) m = fmaxf(m, P[k * NR + row]);
  m = fmaxf(m, __shfl_xor(m, 1)); m = fmaxf(m, __shfl_xor(m, 2)); m = fmaxf(m, __shfl_xor(m, 4)); m = fmaxf(m, __shfl_xor(m, 8));
  float l = 0.f;
  for (int k = sub; k < nk; k += 16) { const float sv = P[k * NR + row]; const float pv = (sv > -1.0e38f) ? __builtin_amdgcn_exp2f(sv - m) : 0.f; P[k * NR + row] = pv; l += pv; }
  l += __shfl_xor(l, 1); l += __shfl_xor(l, 2); l += __shfl_xor(l, 4); l += __shfl_xor(l, 8);
  const float inv = (l > 0.f) ? 1.f / l : 0.f;
  for (int k = sub; k < nk; k += 16) P[k * NR + row] *= inv;
}

DI void sa_load_bf16(const u16* rowp, bool ok, float4 (&kk)[16]) {
#pragma unroll
  for (int i = 0; i < 8; ++i) {
    const uint4 u = ok ? ((const uint4*)rowp)[i] : make_uint4(0u, 0u, 0u, 0u);
    kk[2 * i] = make_float4(bflo(u.x), bfhi(u.x), bflo(u.y), bfhi(u.y)); kk[2 * i + 1] = make_float4(bflo(u.z), bfhi(u.z), bflo(u.w), bfhi(u.w));
  }
}
template <class VRow>
DI void sa_pv(const float* P, int k0, int k1, const VRow& vrow, int lane, float (&o)[4]) {
#pragma unroll 1
  for (int kb = k0; kb < k1; kb += 32) {
    float vv[32];
#pragma unroll
    for (int i = 0; i < 32; ++i) vv[i] = vrow((kb + i < k1) ? kb + i : k1 - 1, lane);
#pragma unroll
    for (int i = 0; i < 32; ++i) {
      const int key = (kb + i < k1) ? kb + i : k1 - 1;
      const float4 p4 = *(const float4*)(P + key * 4); const float v = (kb + i < k1) ? vv[i] : 0.f;
      o[0] += p4.x * v; o[1] += p4.y * v; o[2] += p4.z * v; o[3] += p4.w * v;
    }
  }
}
template <int CTRL> DI float dppf(float v) { return __builtin_bit_cast(float, __builtin_amdgcn_update_dpp(0, __builtin_bit_cast(int, v), CTRL, 0xF, 0xF, false)); }
DI float red16(float v) { v += dppf<0xB1>(v); v += dppf<0x4E>(v); v += dppf<0x141>(v); v += dppf<0x140>(v); return v; }
template <class KRow, class Fin>
DI void sa_tile4(const float4 (&q4)[4], float* Pdst, const KRow& krow, const Fin& fin, int lane) {
  const int chunk = lane & 15, k4 = lane >> 4;
  float4 kv[16];
#pragma unroll
  for (int i = 0; i < 16; ++i) kv[i] = krow(4 * i + k4, chunk);
#pragma unroll
  for (int i = 0; i < 16; ++i) {
    float sr[4];
#pragma unroll
    for (int r = 0; r < 4; ++r) sr[r] = red16(q4[r].x * kv[i].x + q4[r].y * kv[i].y + q4[r].z * kv[i].z + q4[r].w * kv[i].w);
    const float mine = (chunk == 0) ? sr[0] : ((chunk == 1) ? sr[1] : ((chunk == 2) ? sr[2] : sr[3]));
    const float fv = fin(4 * i + k4, chunk & 3, mine);
    if (chunk < 4) Pdst[(4 * i + k4) * 4 + chunk] = fv;
  }
}
DI void sample_attn_item(const Params& p, int it, char* lds) {
  const int t = it & 3, g = (it >> 2) & 1, b = it >> 3, tid = otid(), lane = tid & 63, w = __builtin_amdgcn_readfirstlane(tid >> 6);
  float* qs = (float*)lds;
  float* Pc = qs + 256;
  float* Pw = Pc + 512;
  float* Ps = Pw + 2304;
  float* obuf = Ps + 2048;
  float* imp = obuf + 3072;
  int* sel = (int*)(imp + 36);
  int* pts = sel + 8;
  float* btab = (float*)(pts + 16);
  const size_t tok = (size_t)(NTP + b * 4 + t);
  const int qpos = PAST + t, seq = BATCH + b;
  __syncthreads();
  qs[tid] = bf2f(((const u16*)(p.ws + W_Q))[tok * 512 + (g * 4 + (tid >> 6)) * 64 + lane]);
  for (int i = tid; i < 4 * 129; i += 256) { const int r = i / 129, rel = i % 129; const int bk = rel < 128 ? T5B[rel] : 31; btab[i] = p.rel_bias[bk * 8 + g * 4 + r] * LOG2E; }
  if (tid < 16) pts[tid] = p.pt[b * 16 + tid];
  __syncthreads();
  const float* fresh_wk = p.out + O_SWK + ((size_t)b * 512 + 508) * 128 + g * 64;
  const float* fresh_wv = p.out + O_SWK + (size_t)DEC_BATCH * 512 * 128 + ((size_t)b * 512 + 508) * 128 + g * 64;
  const float* fresh_sk = p.out + O_SCK + 2 * (size_t)NTS * 128 + (size_t)(b * 4) * 128 + g * 64;
  const float* fresh_sv = p.out + O_SCK + 3 * (size_t)NTS * 128 + (size_t)(b * 4) * 128 + g * 64;
  float4 q4[4];
#pragma unroll
  for (int r = 0; r < 4; ++r) q4[r] = *(const float4*)(qs + r * 64 + (lane & 15) * 4);
  for (int ti = w; ti < 11; ti += 4) {
    if (ti < 2) {
      const u16* kc = (const u16*)(p.ws + W_KCMP) + (size_t)(seq * 2 + g) * 128 * 64;
      sa_tile4(q4, Pc + ti * 256,
               [&](int k, int c) { const int n = 64 * ti + k; const uint2 u = *(const uint2*)(kc + (size_t)n * 64 + c * 4); return make_float4(bflo(u.x), bfhi(u.x), bflo(u.y), bfhi(u.y)); },
               [&](int k, int r, float sv) { const int n = 64 * ti + k; const int rel = qpos - (16 * n + 31); return (n < 127) ? sv + btab[r * 129 + (rel < 128 ? rel : 128)] : -3.0e38f; }, lane);
    } else {
      const int k0 = (ti - 2) * 64;
      sa_tile4(q4, Pw + k0 * 4,
               [&](int k, int c) { const int key = (k0 + k < 516) ? k0 + k : 515;
                 const float* rp = (key < 512) ? (p.swk + ((size_t)b * 512 + key) * 128 + g * 64) : (fresh_wk + (size_t)(key - 512) * 128);
                 return *(const float4*)(rp + c * 4); },
               [&](int k, int r, float sv) { const int key = k0 + k; const int rel = qpos - (PAST - 512 + key);
                 const bool ok = key < 516 && rel >= 0 && rel < 512; return ok ? sv + btab[r * 129 + (rel < 128 ? rel : 128)] : -3.0e38f; }, lane);
    }
  }
  __syncthreads();
  if (w == 0) {
    sa_softmax<4>(Pc, 128, lane >> 4, lane & 15);
    if (lane < 33) {
      const int j = lane; float sm = 0.f;
      for (int u = -1; u <= 3; ++u) { const int n = 4 * j + u; if (n >= 0 && n < 127) { const float4 p4 = *(const float4*)(Pc + n * 4); sm += (p4.x + p4.y + p4.z + p4.w) * ((u == -1 || u == 3) ? 1.f : 2.f); } }
      imp[j] = sm;
    }
    if (lane == 0) {
      sel[0] = 0; sel[1] = 31; sel[2] = 32;
      unsigned taken = 0u;
      for (int c = 0; c < 5; ++c) {
        float best = -1.f; int bi = 1;
        for (int j = 1; j <= 30; ++j) { const float v = imp[j]; if (!((taken >> j) & 1u) && v > best) { best = v; bi = j; } }
        taken |= 1u << bi; sel[3 + c] = bi;
      }
    }
  } else if (w == 1) {
    sa_softmax<4>(Pw, 576, lane >> 4, lane & 15);
  }
  __syncthreads();
  for (int jj = w; jj < 8; jj += 4) {
    const int blk = sel[jj];
    const float* kbase = (blk < 32) ? (p.csk + (((size_t)pts[blk >> 1] * 128 + (blk & 1) * 64) * 2 + g) * 64) : fresh_sk;
    sa_tile4(q4, Ps + jj * 256,
             [&](int k, int c) { const int kk = (blk < 32) ? k : (k & 3); return *(const float4*)(kbase + (size_t)kk * 128 + c * 4); },
             [&](int k, int r, float sv) { const int rel = qpos - (blk * 64 + k); const bool ok = (blk < 32 || k < 4) && rel >= 0;
               return ok ? sv + btab[r * 129 + (rel < 0 ? 0 : (rel < 128 ? rel : 128))] : -3.0e38f; }, lane);
  }
  {
    float oc[4] = {0.f, 0.f, 0.f, 0.f}, ow[4] = {0.f, 0.f, 0.f, 0.f};
    const u16* vc = (const u16*)(p.ws + W_VCMP) + (size_t)(seq * 2 + g) * 128 * 64;
    sa_pv(Pc, 32 * w, (32 * w + 32 < 127) ? 32 * w + 32 : 127, [&](int k, int l) { return bf2f(vc[(size_t)k * 64 + l]); }, lane, oc);
    const float* vst = p.swv + (size_t)b * 512 * 128 + g * 64;
    sa_pv(Pw, 129 * w, 129 * w + 129, [&](int k, int l) { const float* rp = (k < 512) ? (vst + (size_t)k * 128) : (fresh_wv + (size_t)(k - 512) * 128); return rp[l]; }, lane, ow);
#pragma unroll
    for (int r = 0; r < 4; ++r) { obuf[((0 * 4 + w) * 4 + r) * 64 + lane] = oc[r]; obuf[((1 * 4 + w) * 4 + r) * 64 + lane] = ow[r]; }
  }
  __syncthreads();
  if (w == 0) sa_softmax<4>(Ps, 512, lane >> 4, lane & 15);
  __syncthreads();
  {
    float os[4] = {0.f, 0.f, 0.f, 0.f};
    for (int jj = 2 * w; jj < 2 * w + 2; ++jj) {
      const int blk = sel[jj];
      const float* vbase; int ns;
      if (blk < 32) { vbase = p.csv + (((size_t)pts[blk >> 1] * 128 + (blk & 1) * 64) * 2 + g) * 64; ns = 64; } else { vbase = fresh_sv; ns = 4; }
      sa_pv(Ps + jj * 64 * 4, 0, ns, [&](int k, int l) { return vbase[(size_t)k * 128 + l]; }, lane, os);
    }
#pragma unroll
    for (int r = 0; r < 4; ++r) obuf[((2 * 4 + w) * 4 + r) * 64 + lane] = os[r];
  }
  __syncthreads();
  {
    const int r = tid >> 6, hd = g * 4 + r;
    const float* gt = (const float*)(p.ws + W_GATE) + tok * 24;
    float o = 0.f;
#pragma unroll
    for (int br = 0; br < 3; ++br) {
      float a = 0.f;
#pragma unroll
      for (int ww = 0; ww < 4; ++ww) a += obuf[((br * 4 + ww) * 4 + r) * 64 + lane];
      o += gt[(br == 0 ? 0 : (br == 1 ? 16 : 8)) + hd] * a;
    }
    ((u16*)(p.ws + W_OA))[tok * 512 + hd * 64 + lane] = f2bf(o * bf2f(((const u16*)(p.ws + W_ZA))[tok * 512 + hd * 64 + lane]));
  }
}

constexpr int P2_HP = BATCH * 4 * 32;
constexpr int P2_CMP = BATCH * 2 * 2;
constexpr int P2_SA = DEC_BATCH * 2 * 4;
constexpr int P2_HS = DEC_BATCH * 4;
constexpr int P2_TOTAL = P2_HP + P2_CMP + P2_SA + P2_HS;
DI void phase2_item(const Params& p, int it, char* lds) {
  if (it < P2_SA) { sample_attn_item(p, it, lds); return; }
  it -= P2_SA;
  if (it < P2_CMP) {
    const int kv = it & 1, g = (it >> 1) & 1, b = it >> 2;
    LoadCellBf16 al{(const u16*)(p.ws + W_KV) + (size_t)kv * NT * 128 + (size_t)b * 2048 * 128 + g * 64};
    comp_tile(p, al, b, g, kv, lds); return;
  }
  it -= P2_CMP;
  if (it < P2_HP) { hgrn_h1_item(p, it, lds); return; }
  it -= P2_HP;
  hgrn_sample_item(p, it, lds);
}

constexpr int AKS = 72, AVS = 68, ACS = 132;
DI bf16x8 pack8(const f32x16& x, int s2) {
  uint4 u; u.x = pk2(x[8 * s2], x[8 * s2 + 1]); u.y = pk2(x[8 * s2 + 2], x[8 * s2 + 3]);
  u.z = pk2(x[8 * s2 + 4], x[8 * s2 + 5]); u.w = pk2(x[8 * s2 + 6], x[8 * s2 + 7]);
  return __builtin_bit_cast(bf16x8, u);
}
DI void zero16(f32x16& x) {
#pragma unroll
  for (int i = 0; i < 16; ++i) x[i] = 0.f;
}

template <bool WIN, bool FAST>
DI void attn_tile(const u16* Kt, const u16* Vt, const float* brel_r, float cfar, const bf16x8 (&qf)[4], int qpos, int kpos0, bool lane_on,
                  float& m_run, float& l_run, f32x16 (&oacc)[2], int ql, int hh) {
  f32x16 sacc[2];
#pragma unroll
  for (int kt = 0; kt < 2; ++kt) {
    zero16(sacc[kt]);
#pragma unroll
    for (int ks = 0; ks < 4; ++ks) {
      const bf16x8 kf = *(const bf16x8*)(Kt + (32 * kt + ql) * AKS + 16 * ks + 8 * hh);
      sacc[kt] = MFMA32(kf, qf[ks], sacc[kt]);
    }
  }
  float mt = -1.0e30f;
  if (FAST) {
#pragma unroll
    for (int kt = 0; kt < 2; ++kt)
#pragma unroll
      for (int i = 0; i < 16; ++i) mt = fmaxf(mt, sacc[kt][i]);
    mt = lane_on ? mt + cfar : -1.0e30f;
  } else {
#pragma unroll
    for (int kt = 0; kt < 2; ++kt)
#pragma unroll
      for (int i = 0; i < 16; ++i) {
        const int rel = qpos - (kpos0 + 32 * kt + crow(i, hh));
        const bool ok = lane_on && rel >= 0 && (!WIN || rel < 512);
        const float sv = sacc[kt][i] + brel_r[rel < 0 ? 0 : (rel < 128 ? rel : 128)];
        sacc[kt][i] = ok ? sv : -1.0e30f;
        mt = fmaxf(mt, sacc[kt][i]);
      }
  }
  mt = fmaxf(mt, __shfl_xor(mt, 32));
  const float mn = fmaxf(m_run, mt);
  if (!__all(mn == m_run)) {
    const float alpha = __builtin_amdgcn_exp2f(m_run - mn);
    l_run *= alpha;
#pragma unroll
    for (int dt = 0; dt < 2; ++dt)
#pragma unroll
      for (int i = 0; i < 16; ++i) oacc[dt][i] *= alpha;
  }
  m_run = mn;
  float ls = 0.f;
  if (FAST) {
    const float dsh = lane_on ? cfar - mn : -1.0e30f;
#pragma unroll
    for (int kt = 0; kt < 2; ++kt)
#pragma unroll
      for (int i = 0; i < 16; ++i) { const float pv = __builtin_amdgcn_exp2f(sacc[kt][i] + dsh); sacc[kt][i] = pv; ls += pv; }
  } else {
#pragma unroll
    for (int kt = 0; kt < 2; ++kt)
#pragma unroll
      for (int i = 0; i < 16; ++i) {
        const float pv = (sacc[kt][i] > -1.0e29f) ? __builtin_amdgcn_exp2f(sacc[kt][i] - mn) : 0.f;
        sacc[kt][i] = pv; ls += pv;
      }
  }
  l_run += ls;
#pragma unroll
  for (int kt = 0; kt < 2; ++kt)
#pragma unroll
    for (int s2 = 0; s2 < 2; ++s2) {
      const bf16x8 pf = pack8(sacc[kt], s2);
#pragma unroll
      for (int dt = 0; dt < 2; ++dt) {
        const u16* vp = Vt + (32 * dt + ql) * AVS + 32 * kt + 16 * s2 + 4 * hh;
        const bf16x8 vf = cat8(*(const s16x4*)vp, *(const s16x4*)(vp + 8));
        oacc[dt] = MFMA32(vf, pf, oacc[dt]);
      }
    }
}

DI void attn_load_tile(u16* Kt, u16* Vt, const u16* ksrc  , const u16* vtsrc  ) {
  const int tid = otid512();
  {
    const int idx = tid, rw = idx >> 3, ch = idx & 7;
    *(uint4*)(Kt + rw * AKS + ch * 8) = *(const uint4*)(ksrc + (size_t)rw * 128 + ch * 8);
    const uint4 v = *(const uint4*)(vtsrc + (size_t)rw * 2048 + ch * 8);
    *(uint2*)(Vt + rw * AVS + ch * 8) = make_uint2(v.x, v.y);
    *(uint2*)(Vt + rw * AVS + ch * 8 + 4) = make_uint2(v.z, v.w);
  }
}

DI void prompt_attn_item(const Params& p, int it, char* lds) {
  const int qt = (it < 256) ? (31 - (it & 31)) : (it & 31), g = (it >> 5) & 1, b = (it >> 6) & 3 | ((it >> 8) << 2);
  const int t0 = qt * 64;
  const int tid = otid512(), lane = tid & 63, w = tid >> 6, ql = lane & 31, hh = lane >> 5, tl = ql >> 2, r = ql & 3;
  const int qpos = t0 + 8 * w + tl, head = g * 4 + r;
  const size_t tok = (size_t)b * 2048 + qpos;
  u16* Kt = (u16*)lds;
  u16* Vt = Kt + 128 * AKS;
  float* brel = (float*)(Vt + 64 * ACS);
  unsigned* wmask = (unsigned*)(brel + 4 * 129);
  const u16* Qb = (const u16*)(p.ws + W_Q);
  __syncthreads();
  for (int i = tid; i < 4 * 129; i += 512) { const int rr = i / 129, rel = i % 129; const int bk = rel < 128 ? T5B[rel] : 31; brel[i] = p.rel_bias[bk * 8 + g * 4 + rr] * LOG2E; }
  bf16x8 qf[4];
#pragma unroll
  for (int ks = 0; ks < 4; ++ks) qf[ks] = *(const bf16x8*)(Qb + tok * 512 + head * 64 + 16 * ks + 8 * hh);
  const float* gt = (const float*)(p.ws + W_GATE) + tok * 24;
  const float* brel_r = brel + r * 129;
  const float cfar = p.rel_bias[31 * 8 + head] * LOG2E;
  f32x16 of[2];
  unsigned selm;
  {
#pragma unroll
    for (int i = 0; i < 2; ++i) {
      const int idx = tid + 512 * i;
      { const int n = idx >> 3, ch = idx & 7;
        *(uint4*)(Kt + n * AKS + ch * 8) = *(const uint4*)((const u16*)(p.ws + W_KCMP) + ((size_t)(b * 2 + g) * 128 + n) * 64 + ch * 8); }
      { const int dd = idx >> 4, ch = idx & 15;
        const uint4 v = *(const uint4*)((const u16*)(p.ws + W_VCMPT) + ((size_t)(b * 2 + g) * 64 + dd) * 128 + ch * 8);
        *(uint2*)(Vt + dd * ACS + ch * 8) = make_uint2(v.x, v.y); *(uint2*)(Vt + dd * ACS + ch * 8 + 4) = make_uint2(v.z, v.w); }
    }
    __syncthreads();
    f32x16 sacc[4];
#pragma unroll
    for (int kt = 0; kt < 4; ++kt) {
      zero16(sacc[kt]);
#pragma unroll
      for (int ks = 0; ks < 4; ++ks) {
        const bf16x8 kf = *(const bf16x8*)(Kt + (32 * kt + ql) * AKS + 16 * ks + 8 * hh);
        sacc[kt] = MFMA32(kf, qf[ks], sacc[kt]);
      }
    }
    float mt = -1.0e30f;
#pragma unroll
    for (int kt = 0; kt < 4; ++kt)
#pragma unroll
      for (int i = 0; i < 16; ++i) {
        const int n = 32 * kt + crow(i, hh);
        const int rel = qpos - (16 * n + 31);
        const bool ok = rel >= 0 && n < 127;
        const float sv = sacc[kt][i] + brel_r[rel < 0 ? 0 : (rel < 128 ? rel : 128)];
        sacc[kt][i] = ok ? sv : -1.0e30f;
        mt = fmaxf(mt, sacc[kt][i]);
      }
    mt = fmaxf(mt, __shfl_xor(mt, 32));
    float ls = 0.f;
#pragma unroll
    for (int kt = 0; kt < 4; ++kt)
#pragma unroll
      for (int i = 0; i < 16; ++i) { const float pv = (sacc[kt][i] > -1.0e29f) ? __builtin_amdgcn_exp2f(sacc[kt][i] - mt) : 0.f; sacc[kt][i] = pv; ls += pv; }
    ls += __shfl_xor(ls, 32);
    const float inv = ls > 0.f ? 1.f / ls : 0.f;
#pragma unroll
    for (int kt = 0; kt < 4; ++kt)
#pragma unroll
      for (int i = 0; i < 16; ++i) sacc[kt][i] *= inv;
    f32x16 oc[2]; zero16(oc[0]); zero16(oc[1]);
#pragma unroll
    for (int kt = 0; kt < 4; ++kt)
#pragma unroll
      for (int s2 = 0; s2 < 2; ++s2) {
        const bf16x8 pf = pack8(sacc[kt], s2);
#pragma unroll
        for (int dt = 0; dt < 2; ++dt) {
          const u16* vp = Vt + (32 * dt + ql) * ACS + 32 * kt + 16 * s2 + 4 * hh;
          const bf16x8 vf = cat8(*(const s16x4*)vp, *(const s16x4*)(vp + 8));
          oc[dt] = MFMA32(vf, pf, oc[dt]);
        }
      }
    const float g0 = gt[head];
#pragma unroll
    for (int dt = 0; dt < 2; ++dt)
#pragma unroll
      for (int i = 0; i < 16; ++i) of[dt][i] = g0 * oc[dt][i];
    float im[16], cm[16];
#pragma unroll
    for (int kt = 0; kt < 4; ++kt)
#pragma unroll
      for (int q4 = 0; q4 < 4; ++q4) {
        const float p0 = sacc[kt][4 * q4], p1 = sacc[kt][4 * q4 + 1], p2 = sacc[kt][4 * q4 + 2], p3 = sacc[kt][4 * q4 + 3];
        im[4 * kt + q4] = 2.f * (p0 + p1 + p2) + p3; cm[4 * kt + q4] = p3;
      }
#pragma unroll
    for (int m = 0; m < 16; ++m) cm[m] = __shfl_xor(cm[m], 32);
#pragma unroll
    for (int m = 15; m >= 0; --m) im[m] += hh ? cm[m] : (m > 0 ? cm[m - 1] : 0.f);
#pragma unroll
    for (int m = 0; m < 16; ++m) { im[m] += __shfl_xor(im[m], 1); im[m] += __shfl_xor(im[m], 2); }
    float ev[16], od[16];
#pragma unroll
    for (int m = 0; m < 16; ++m) { const float ot = __shfl_xor(im[m], 32); ev[m] = hh ? ot : im[m]; od[m] = hh ? im[m] : ot; }
    const int cur = qpos >> 6;
    if (cur < 8) selm = (2u << cur) - 1u;
    else {
      selm = 1u | (1u << cur) | (1u << (cur - 1));
      for (int c = 0; c < 5; ++c) {
        float best = -1.f;
#pragma unroll
        for (int J = 0; J < 32; ++J) { const float v = (J <= cur && !((selm >> J) & 1u)) ? ((J & 1) ? od[J >> 1] : ev[J >> 1]) : -1.f; best = fmaxf(best, v); }
        int bi = 32;
#pragma unroll
        for (int J = 31; J >= 0; --J) { const float v = (J <= cur && !((selm >> J) & 1u)) ? ((J & 1) ? od[J >> 1] : ev[J >> 1]) : -1.f; if (v == best) bi = J; }
        if (best >= 0.f) selm |= 1u << bi;
      }
    }
    unsigned um = selm;
    um |= __shfl_xor(um, 4); um |= __shfl_xor(um, 8); um |= __shfl_xor(um, 16);
    if (lane == 0) wmask[w] = um;
  }
  __syncthreads();
  const unsigned un = wmask[0] | wmask[1] | wmask[2] | wmask[3] | wmask[4] | wmask[5] | wmask[6] | wmask[7];
  {
    const u16* ks = (const u16*)(p.ws + W_KV) + (size_t)2 * NT * 128 + (size_t)b * 2048 * 128 + g * 64;
    const u16* vts = (const u16*)(p.ws + W_VST) + (size_t)(b * 2 + g) * 64 * 2048;
    const u16* kw = (const u16*)(p.ws + W_KV) + (size_t)4 * NT * 128 + (size_t)b * 2048 * 128 + g * 64;
    const u16* vtw = (const u16*)(p.ws + W_VWT) + (size_t)(b * 2 + g) * 64 * 2048;
    const int rw = tid >> 3, ch = tid & 7;
    uint4 kreg, vreg;
#define ATT_PREFETCH(kb, vb, j_) do { kreg = *(const uint4*)((kb) + ((size_t)(j_) * 64 + rw) * 128 + ch * 8); vreg = *(const uint4*)((vb) + (size_t)rw * 2048 + (j_) * 64 + ch * 8); } while (0)
#define ATT_COMMIT() do { *(uint4*)(Kt + rw * AKS + ch * 8) = kreg; *(uint2*)(Vt + rw * AVS + ch * 8) = make_uint2(vreg.x, vreg.y); *(uint2*)(Vt + rw * AVS + ch * 8 + 4) = make_uint2(vreg.z, vreg.w); } while (0)
    const int jlo = (t0 >= 511) ? ((t0 - 511) >> 6) : 0, jhi = (t0 + 63) >> 6;
    {
      float m_run = -1.0e30f, l_run = 0.f; f32x16 oacc[2]; zero16(oacc[0]); zero16(oacc[1]);
      unsigned rem = un;
      int j = __builtin_ctz(rem); rem &= rem - 1u;
      ATT_PREFETCH(ks, vts, j);
      for (;;) {
        __syncthreads();
        ATT_COMMIT();
        __syncthreads();
        const int jn = rem ? __builtin_ctz(rem) : -1;
        if (jn >= 0) { rem &= rem - 1u; ATT_PREFETCH(ks, vts, jn); } else { ATT_PREFETCH(kw, vtw, jlo); }
        const bool on = (selm >> j) & 1u;
        if (__ballot(on) != 0ull) {
          if (64 * j + 63 + 128 <= t0 + 8 * w) attn_tile<false, true>(Kt, Vt, brel_r, cfar, qf, qpos, j * 64, on, m_run, l_run, oacc, ql, hh);
          else attn_tile<false, false>(Kt, Vt, brel_r, cfar, qf, qpos, j * 64, on, m_run, l_run, oacc, ql, hh);
        }
        if (jn < 0) break;
        j = jn;
      }
      l_run += __shfl_xor(l_run, 32);
      const float sc = gt[8 + head] * (l_run > 0.f ? 1.f / l_run : 0.f);
#pragma unroll
      for (int dt = 0; dt < 2; ++dt)
#pragma unroll
        for (int i = 0; i < 16; ++i) of[dt][i] += sc * oacc[dt][i];
    }
    {
      float m_run = -1.0e30f, l_run = 0.f; f32x16 oacc[2]; zero16(oacc[0]); zero16(oacc[1]);
      for (int j = jlo; j <= jhi; ++j) {
        __syncthreads();
        ATT_COMMIT();
        __syncthreads();
        if (j < jhi) ATT_PREFETCH(kw, vtw, j + 1);
        if (64 * j + 63 + 128 <= t0 + 8 * w && 64 * j + 511 >= t0 + 8 * w + 7) attn_tile<true, true>(Kt, Vt, brel_r, cfar, qf, qpos, j * 64, true, m_run, l_run, oacc, ql, hh);
        else attn_tile<true, false>(Kt, Vt, brel_r, cfar, qf, qpos, j * 64, true, m_run, l_run, oacc, ql, hh);
      }
      l_run += __shfl_xor(l_run, 32);
      const float sc = gt[16 + head] * (l_run > 0.f ? 1.f / l_run : 0.f);
#pragma unroll
      for (int dt = 0; dt < 2; ++dt)
#pragma unroll
        for (int i = 0; i < 16; ++i) of[dt][i] += sc * oacc[dt][i];
    }
#undef ATT_PREFETCH
#undef ATT_COMMIT
  }
  {
    const u16* za = (const u16*)(p.ws + W_ZA) + tok * 512 + head * 64; u16* oa = (u16*)(p.ws + W_OA) + tok * 512 + head * 64;
#pragma unroll
    for (int dt = 0; dt < 2; ++dt)
#pragma unroll
      for (int q4 = 0; q4 < 4; ++q4) {
        const int dd = 32 * dt + 8 * q4 + 4 * hh;
        const uint2 z = *(const uint2*)(za + dd);
        uint2 o; o.x = pk2(of[dt][4 * q4] * bflo(z.x), of[dt][4 * q4 + 1] * bfhi(z.x)); o.y = pk2(of[dt][4 * q4 + 2] * bflo(z.y), of[dt][4 * q4 + 3] * bfhi(z.y));
        *(uint2*)(oa + dd) = o;
      }
  }
}
constexpr int P3_FIN = BATCH * 4 * 32;
constexpr int P3_ATT = BATCH * 2 * 32;
constexpr int P3_TOTAL = P3_FIN + P3_ATT;

constexpr int P4_TOTAL = 128 * 8 + 4 * 16;
template <int NI>
DI void merge_a_tile_t(const Params& p, int tm, int tn, char* lds) {
  f32x16 aa[2][NI], ab[2][NI]; zero_acc<NI>(aa); zero_acc<NI>(ab);
  gemm_glds<NI>(aa, (const u16*)(p.ws + W_OA) + (size_t)tm * 128 * 512, 512, (const u16*)(p.ws + W_WBAT) + (size_t)tn * 64 * NI * 512, 512, 8, lds);
  gemm_glds<NI>(ab, (const u16*)(p.ws + W_OB) + (size_t)tm * 128 * 512, 512, (const u16*)(p.ws + W_WBBT) + (size_t)tn * 64 * NI * 512, 512, 8, lds);
  const int tid = otid(), lane = tid & 63, wave = tid >> 6, wm = wave >> 1, wn = wave & 1, r = lane & 31, h = lane >> 5;
#pragma unroll
  for (int mi = 0; mi < 2; ++mi)
#pragma unroll
    for (int ni = 0; ni < NI; ++ni) {
      const int c = tn * 64 * NI + wn * 32 * NI + ni * 32 + r;
#pragma unroll
      for (int i = 0; i < 16; ++i) {
        const size_t off = (size_t)(tm * 128 + wm * 64 + mi * 32 + crow(i, h)) * 1024 + c;
        const float y = bf2f(((const u16*)(p.ws + W_SA))[off]) * aa[mi][ni][i] + bf2f(((const u16*)(p.ws + W_SB))[off]) * ab[mi][ni][i];
        ((u16*)(p.ws + W_Y))[off] = f2bf(y);
      }
    }
}
DI void merge_a_tile(const Params& p, int it, char* lds) {
  if (it < 1024) merge_a_tile_t<2>(p, it >> 3, it & 7, lds);
  else { it -= 1024; merge_a_tile_t<1>(p, 128 + (it >> 4), it & 15, lds); }
}
constexpr int P5_TOTAL = 128 * 8 + 4 * 16;
template <int NI>
DI void merge_b_tile_t(const Params& p, int tm, int tn, char* lds) {
  f32x16 acc[2][NI]; zero_acc<NI>(acc);
  gemm_glds<NI>(acc, (const u16*)(p.ws + W_Y) + (size_t)tm * 128 * 1024, 1024, (const u16*)(p.ws + W_WOUTT) + (size_t)tn * 64 * NI * 1024, 1024, 16, lds);
  const int tid = otid(), lane = tid & 63, wave = tid >> 6, wm = wave >> 1, wn = wave & 1, r = lane & 31, h = lane >> 5;
  const float* xin = (tm < 128) ? p.x_prompt : (p.x_sample - (size_t)NTP * 1024);
#pragma unroll
  for (int mi = 0; mi < 2; ++mi) {
#pragma unroll
    for (int i = 0; i < 16; ++i) {
      const size_t row = (size_t)(tm * 128 + wm * 64 + mi * 32 + crow(i, h));
#pragma unroll
      for (int ni = 0; ni < NI; ++ni) {
        const int c = tn * 64 * NI + wn * 32 * NI + ni * 32 + r;
        p.out[row * 1024 + c] = acc[mi][ni][i] + xin[row * 1024 + c];
      }
    }
  }
}
DI void merge_b_tile(const Params& p, int it, char* lds) {
  if (it < 1024) merge_b_tile_t<2>(p, it >> 3, it & 7, lds);
  else { it -= 1024; merge_b_tile_t<1>(p, 128 + (it >> 4), it & 15, lds); }
}
constexpr int P6_TOTAL = NT / 4;
DI void final_norm_item(const Params& p, int it) {
  const int tid_ = otid(), lane = tid_ & 63, wave = tid_ >> 6; const size_t row = (size_t)it * 4 + wave;
  float* o = p.out + row * 1024;
  float4 v[4]; float ss = 0.f;
#pragma unroll
  for (int i = 0; i < 4; ++i) { v[i] = *(const float4*)(o + (i * 64 + lane) * 4); ss += v[i].x * v[i].x + v[i].y * v[i].y + v[i].z * v[i].z + v[i].w * v[i].w; }
  ss = wave_sum(ss);
  const float rs = rsqrtf(ss * (1.f / 1024.f) + 1e-6f);
#pragma unroll
  for (int i = 0; i < 4; ++i) {
    const float4 gg = *(const float4*)(p.final_g + (i * 64 + lane) * 4);
    *(float4*)(o + (i * 64 + lane) * 4) = make_float4(v[i].x * rs * gg.x, v[i].y * rs * gg.y, v[i].z * rs * gg.z, v[i].w * rs * gg.w);
  }
}

#define XB_TMO      128
#define XB_XCNT(j)  (256  + 64 * (j))
#define XB_XSUB(j)  (1280 + 64 * (j))
#define XB_XGEN(j)  (2304 + 64 * (j))
#define XB_TOP      3328
#define XB_TOPGEN   3392
#define XCD_BAR_WORDS 3456
#define XB_SPIN_CAP (1u << 18)
#define LAS __attribute__((address_space(3)))
DI unsigned xb_ld(unsigned* p)              { return __hip_atomic_load(p, __ATOMIC_RELAXED, __HIP_MEMORY_SCOPE_AGENT); }
DI unsigned xb_add(unsigned* p, unsigned v) { return __hip_atomic_fetch_add(p, v, __ATOMIC_RELAXED, __HIP_MEMORY_SCOPE_AGENT); }
DI unsigned xb_xcc_id() { return (unsigned)__builtin_amdgcn_s_getreg((3 << 11) | 20) & 0xFu; }
#define XB_SPIN(cond, bar) do { unsigned _sp = 0; while (cond) { __builtin_amdgcn_s_sleep(1); \
    if ((++_sp & 255u) == 0u) { if (xb_ld(&(bar)[XB_TMO])) break; if (_sp > XB_SPIN_CAP) { atomicAdd(&(bar)[XB_TMO], 1u); break; } } } } while (0)
struct XcdBarrier { unsigned* bar; unsigned x; unsigned nloc, nx; };
DI XcdBarrier xcd_barrier_post(unsigned* bar) {
  XcdBarrier b; b.bar = bar; b.x = xb_xcc_id(); b.nloc = 0u; b.nx = 0u;
  if (threadIdx.x == 0) (void)xb_add(&bar[XB_XCNT(b.x)], 1u);
  return b;
}
DI void xcd_barrier_complete(unsigned* bar, unsigned x, unsigned& nloc, unsigned& nx) {
  const unsigned G = gridDim.x * gridDim.y * gridDim.z;
  unsigned sum, cnt, mine, sp = 0u;
  for (;;) {
    sum = 0u; cnt = 0u; mine = 0u;
#pragma unroll
    for (unsigned j = 0; j < 16; ++j) { const unsigned c = xb_ld(&bar[XB_XCNT(j)]); sum += c; cnt += (c > 0u) ? 1u : 0u; mine = (j == x) ? c : mine; }
    if (sum == G) break;
    __builtin_amdgcn_s_sleep(1);
    if ((++sp & 255u) == 0u) { if (xb_ld(&bar[XB_TMO])) break; if (sp > XB_SPIN_CAP) { atomicAdd(&bar[XB_TMO], 1u); break; } }
  }
  nloc = mine > 0u ? mine : 1u; nx = cnt > 0u ? cnt : 1u;
}
DI void xcd_barrier(XcdBarrier& b) {
  asm volatile("s_waitcnt vmcnt(0)" ::: "memory");
  __syncthreads();
  if (threadIdx.x == 0) {
    unsigned* bar = b.bar;
    __builtin_amdgcn_s_waitcnt(0);
    unsigned nloc = b.nloc, nx = b.nx;
    if (nloc == 0u) { xcd_barrier_complete(bar, b.x, nloc, nx); b.nloc = nloc; b.nx = nx; }
    const unsigned old = xb_add(&bar[XB_XSUB(b.x)], 1u);
    const unsigned gen = old / nloc;
    if (old + 1u == (gen + 1u) * nloc) {
      __builtin_amdgcn_fence(__ATOMIC_RELEASE, "agent");
      asm volatile("s_waitcnt vmcnt(0)" ::: "memory");
      const unsigned og = xb_add(&bar[XB_TOP], 1u);
      const unsigned tg = og / nx;
      if (og + 1u == (tg + 1u) * nx) xb_add(&bar[XB_TOPGEN], 1u);
      else XB_SPIN(xb_ld(&bar[XB_TOPGEN]) == tg, bar);
      __builtin_amdgcn_fence(__ATOMIC_ACQUIRE, "agent");
      xb_add(&bar[XB_XGEN(b.x)], 1u);
      asm volatile("s_waitcnt vmcnt(0)" ::: "memory");
    } else {
      XB_SPIN(xb_ld(&bar[XB_XGEN(b.x)]) == gen, bar);
      __builtin_amdgcn_fence(__ATOMIC_ACQUIRE, "agent");
      asm volatile("s_waitcnt vmcnt(0)" ::: "memory");
    }
  }
  __syncthreads();
}


template <int PH>
DI void run_phase(const Params& p, char* lds_all) {
  const int half = __builtin_amdgcn_readfirstlane(threadIdx.x >> 8);
  const int vb = blockIdx.x * 2 + half, nvb = gridDim.x * 2;
  char* lds = lds_all + half * 65536;
  if (PH == 0) { for (int it = vb; it < P0_TOTAL; it += nvb) phase0_item(p, it, lds); }
  if (PH == 1) {
    for (int it = vb; it < P1_CMP; it += nvb) phase1_item(p, it, lds);
    const int x = blockIdx.x & 7, nli = (gridDim.x >> 3) * 2;
    constexpr int NSN = (G1_NT + 7) / 8, NS = ((G1_MT + 7) / 8) * NSN;
    for (int S = x; S < NS; S += 8)
      for (int li = (blockIdx.x >> 3) * 2 + half; li < 64; li += nli) {
        const int tm = (S / NSN) * 8 + (li & 7), tn = (S % NSN) * 8 + (li >> 3);
        const bool ok = tm < G1_MT && tn < G1_NT;
        proj_tile(p, ok ? tm : 0, ok ? tn : 0, lds, ok);
      }
  }
  if (PH == 2) { for (int it = vb; it < P2_TOTAL; it += nvb) phase2_item(p, it, lds); }
  if (PH == 7) { for (int it = vb; it < H2_ITEMS; it += nvb) hgrn_h2_item(p, it); }
  if (PH == 3) {
    for (int it = vb; it < P3_FIN; it += nvb) hgrn_h3_item(p, it);
    for (int it = blockIdx.x; it < P3_ATT; it += gridDim.x) prompt_attn_item(p, it, lds_all);
  }
  if (PH == 4) { for (int it = vb; it < P4_TOTAL; it += nvb) merge_a_tile(p, it, lds); }
  if (PH == 5) { for (int it = vb; it < P5_TOTAL; it += nvb) merge_b_tile(p, it, lds); }
  if (PH == 6) { for (int it = vb; it < P6_TOTAL; it += nvb) final_norm_item(p, it); }
}

constexpr int LDS_DYN = 128 * 1024;
__global__ void __launch_bounds__(512, 2) k_mega(Params p) {
  extern __shared__ __attribute__((aligned(16))) char lds[];
  XcdBarrier bar = xcd_barrier_post((unsigned*)(p.ws + W_BAR));
  run_phase<0>(p, lds); xcd_barrier(bar);
  run_phase<1>(p, lds); xcd_barrier(bar);
  run_phase<2>(p, lds); xcd_barrier(bar);
  run_phase<7>(p, lds); xcd_barrier(bar);
  run_phase<3>(p, lds); xcd_barrier(bar);
  run_phase<4>(p, lds); xcd_barrier(bar);
  run_phase<5>(p, lds); xcd_barrier(bar);
  run_phase<6>(p, lds);
}

extern "C" void kernel_launch(void* const* d_in, const int* in_sizes, int n_in, void* d_out, int out_size,
                              void* d_ws, size_t ws_size, hipStream_t stream) {
  Params p{};
  p.x_prompt = (const float*)d_in[0]; p.x_sample = (const float*)d_in[1];
  p.cck = (const float*)d_in[2]; p.ccv = (const float*)d_in[3]; p.csk = (const float*)d_in[4]; p.csv = (const float*)d_in[5];
  p.swk = (const float*)d_in[6]; p.swv = (const float*)d_in[7]; p.shg = (const float*)d_in[8]; p.pt = (const int*)d_in[9];
  p.norm_g = (const float*)d_in[10]; p.w_in = (const float*)d_in[11];
  p.pos_k = (const float*)d_in[12]; p.w1_k = (const float*)d_in[13]; p.w2_k = (const float*)d_in[14];
  p.pos_v = (const float*)d_in[15]; p.w1_v = (const float*)d_in[16]; p.w2_v = (const float*)d_in[17];
  p.rel_bias = (const float*)d_in[18]; p.hg_lower = (const float*)d_in[19]; p.hg_norm_g = (const float*)d_in[20];
  p.w_ba = (const float*)d_in[21]; p.w_bb = (const float*)d_in[22]; p.w_out = (const float*)d_in[23]; p.final_g = (const float*)d_in[24];
  p.out = (float*)d_out; p.ws = (char*)d_ws;
  if ((size_t)out_size != O_END || ws_size < W_END) { fprintf(stderr, "kernel_launch: unexpected sizes out=%d ws=%zu (need %zu / %zu)\n", out_size, ws_size, (size_t)O_END, (size_t)W_END); return; }
  static int grid_blocks = 0;
  if (!grid_blocks) {
    int dev = 0, cus = 0, per_cu = 0;
    hipGetDevice(&dev);
    hipDeviceGetAttribute(&cus, hipDeviceAttributeMultiprocessorCount, dev);
    hipFuncSetAttribute((const void*)k_mega, hipFuncAttributeMaxDynamicSharedMemorySize, LDS_DYN);
    hipOccupancyMaxActiveBlocksPerMultiprocessor(&per_cu, k_mega, 512, LDS_DYN);
    if (per_cu < 1) fprintf(stderr, "kernel_launch: occupancy query reports %d blocks per CU\n", per_cu);
    grid_blocks = cus;
  }
  hipMemsetAsync((char*)d_ws + W_BAR, 0, XCD_BAR_WORDS * 4, stream);
  void* args[] = {&p};
  hipError_t e = hipLaunchCooperativeKernel((void*)k_mega, dim3(grid_blocks), dim3(512), args, LDS_DYN, stream);
  if (e != hipSuccess) fprintf(stderr, "cooperative launch failed: %s (grid %d)\n", hipGetErrorString(e), grid_blocks);
}
```

```cpp
#include <hip/hip_runtime.h>
#include <hip/hip_cooperative_groups.h>
#include <cstdio>
namespace cg = cooperative_groups;

#define DI __device__ __forceinline__
typedef unsigned short u16;
typedef __attribute__((ext_vector_type(8))) short bf16x8;
typedef __attribute__((ext_vector_type(4))) short s16x4;
typedef __attribute__((ext_vector_type(16))) float f32x16;
typedef __attribute__((ext_vector_type(4))) float f32x4;
typedef __attribute__((ext_vector_type(2))) float f32x2;
typedef __attribute__((ext_vector_type(2))) __bf16 bf16x2v;
#define MFMA32(a, b, c) __builtin_amdgcn_mfma_f32_32x32x16_bf16((a), (b), (c), 0, 0, 0)
#define MFMA16(a, b, c) __builtin_amdgcn_mfma_f32_16x16x32_bf16((a), (b), (c), 0, 0, 0)

constexpr int D_MODEL = 1024, BATCH = 8, SEQ = 2048, DEC_BATCH = 128, DEC_SEQ = 4, PAST = 2048;
constexpr int NTP = BATCH * SEQ;
constexpr int NTS = DEC_BATCH * DEC_SEQ;
constexpr int NT = NTP + NTS;
constexpr int IN_COLS = 5912, NPAD = 6144;
constexpr int NSEQ = BATCH + DEC_BATCH;

constexpr size_t O_YP = 0;
constexpr size_t O_YS = O_YP + (size_t)NTP * 1024;
constexpr size_t O_PCK = O_YS + (size_t)NTS * 1024;
constexpr size_t O_PWK = O_PCK + 4 * (size_t)NTP * 128;
constexpr size_t O_PHG = O_PWK + 2 * (size_t)BATCH * 512 * 128;
constexpr size_t O_SCK = O_PHG + (size_t)BATCH * 4 * 128 * 128;
constexpr size_t O_SWK = O_SCK + 4 * (size_t)NTS * 128;
constexpr size_t O_SHG = O_SWK + 2 * (size_t)DEC_BATCH * 512 * 128;
constexpr size_t O_END = O_SHG + (size_t)DEC_BATCH * 4 * 128 * 128;

constexpr size_t al256(size_t x) { return (x + 255) & ~(size_t)255; }
constexpr size_t W_WINT = 0;
constexpr size_t W_WBAT = al256(W_WINT + (size_t)NPAD * 1024 * 2);
constexpr size_t W_WBBT = al256(W_WBAT + (size_t)1024 * 512 * 2);
constexpr size_t W_WOUTT = al256(W_WBBT + (size_t)1024 * 512 * 2);
constexpr size_t W_W1T = al256(W_WOUTT + (size_t)1024 * 1024 * 2);
constexpr size_t W_C1 = al256(W_W1T + (size_t)2 * 128 * 1024 * 2);
constexpr size_t W_XN = al256(W_C1 + 2 * 64 * 4);
constexpr size_t W_Q = al256(W_XN + (size_t)NT * 1024 * 2);
constexpr size_t W_KV = al256(W_Q + (size_t)NT * 512 * 2);
constexpr size_t W_VST = al256(W_KV + (size_t)6 * NT * 128 * 2);
constexpr size_t W_VWT = al256(W_VST + (size_t)8 * 2 * 64 * 2048 * 2);
constexpr size_t W_GATE = al256(W_VWT + (size_t)8 * 2 * 64 * 2048 * 2);
constexpr size_t W_ZA = al256(W_GATE + (size_t)NT * 24 * 4);
constexpr size_t W_QB = al256(W_ZA + (size_t)NT * 512 * 2);
constexpr size_t W_KB = al256(W_QB + (size_t)NT * 512 * 2);
constexpr size_t W_GB = al256(W_KB + (size_t)NT * 512 * 2);
constexpr size_t W_VB = al256(W_GB + (size_t)NT * 512 * 4);
constexpr size_t W_ZB = al256(W_VB + (size_t)NT * 512 * 2);
constexpr size_t W_SA = al256(W_ZB + (size_t)NT * 512 * 2);
constexpr size_t W_SB = al256(W_SA + (size_t)NT * 1024 * 2);
constexpr size_t W_KCMP = al256(W_SB + (size_t)NT * 1024 * 2);
constexpr size_t W_VCMP = al256(W_KCMP + (size_t)NSEQ * 2 * 128 * 64 * 2);
constexpr size_t W_VCMPT = al256(W_VCMP + (size_t)NSEQ * 2 * 128 * 64 * 2);
constexpr size_t W_OA = al256(W_VCMPT + (size_t)8 * 2 * 64 * 128 * 2);
constexpr size_t W_OB = al256(W_OA + (size_t)NT * 512 * 2);
constexpr size_t W_Y = al256(W_OB + (size_t)NT * 512 * 2);
constexpr size_t W_SS = al256(W_Y + (size_t)NT * 1024 * 2);
constexpr size_t W_ORAW = al256(W_SS + (size_t)NT * 32 * 4);
constexpr size_t W_OSS = al256(W_ORAW + (size_t)NTP * 512 * 4);
constexpr size_t W_QG = al256(W_OSS + (size_t)NTP * 8 * 4);
constexpr size_t W_DST = al256(W_QG + (size_t)NTP * 512 * 2);
constexpr size_t W_DEC = al256(W_DST + (size_t)1024 * 128 * 128 * 4);
constexpr size_t W_SPT = al256(W_DEC + (size_t)1024 * 128 * 4);
constexpr size_t W_BAR = al256(W_SPT + (size_t)1024 * 128 * 128 * 2);
constexpr size_t W_END = al256(W_BAR + 3456 * 4);

struct Params {
  const float* x_prompt; const float* x_sample;
  const float* cck; const float* ccv; const float* csk; const float* csv;
  const float* swk; const float* swv; const float* shg; const int* pt;
  const float* norm_g; const float* w_in;
  const float* pos_k; const float* w1_k; const float* w2_k;
  const float* pos_v; const float* w1_v; const float* w2_v;
  const float* rel_bias; const float* hg_lower; const float* hg_norm_g;
  const float* w_ba; const float* w_bb; const float* w_out; const float* final_g;
  float* out; char* ws;
};

DI unsigned pk2(float a, float b) { f32x2 v = {a, b}; bf16x2v r = __builtin_convertvector(v, bf16x2v); return __builtin_bit_cast(unsigned, r); }
DI u16 f2bf(float a) { return (u16)(pk2(a, 0.f) & 0xffffu); }
DI float bf2f(u16 v) { return __uint_as_float(((unsigned)v) << 16); }
DI float bflo(unsigned v) { return __uint_as_float(v << 16); }
DI float bfhi(unsigned v) { return __uint_as_float(v & 0xffff0000u); }
constexpr float LOG2E = 1.4426950408889634f;
DI float sigmoidf_(float x) { return 1.f / (1.f + __expf(-x)); }
DI float siluf_(float x) { return x / (1.f + __expf(-x)); }
DI int otid() { int t = threadIdx.x & 255; asm volatile("" : "+v"(t)); return t; }
DI int otid512() { int t = threadIdx.x; asm volatile("" : "+v"(t)); return t; }
DI int crow(int reg, int h) { return (reg & 3) + 8 * (reg >> 2) + 4 * h; }
DI float wave_sum(float v) {
#pragma unroll
  for (int o = 32; o >= 1; o >>= 1) v += __shfl_xor(v, o);
  return v;
}
DI float wave_max(float v) {
#pragma unroll
  for (int o = 32; o >= 1; o >>= 1) v = fmaxf(v, __shfl_xor(v, o));
  return v;
}

__device__ const unsigned char T5B[128] = {
  0,1,2,3,4,5,6,7,8,9,10,11,12,13,14,15,
  16,16,16,17,17,18,18,18,19,19,19,20,20,20,20,21,
  21,21,21,22,22,22,22,22,23,23,23,23,23,23,24,24,
  24,24,24,24,25,25,25,25,25,25,25,26,26,26,26,26,
  26,26,26,27,27,27,27,27,27,27,27,27,27,28,28,28,
  28,28,28,28,28,28,28,29,29,29,29,29,29,29,29,29,
  29,29,29,30,30,30,30,30,30,30,30,30,30,30,30,30,
  30,31,31,31,31,31,31,31,31,31,31,31,31,31,31,31};

DI void transpose_tile(const float* __restrict__ src, int ldsrc, int K, int N, int k0, int n0,
                       u16* __restrict__ dst, int lddst, int dst_row_off, int dst_k0, int winperm, float* tl) {
  const int tid = otid();
  __syncthreads();
  {
    const int n = tid & 63, kb = tid >> 6;
#pragma unroll
    for (int i = 0; i < 16; ++i) {
      const int kk = kb + 4 * i;
      const int nc = (n0 + n < N) ? n0 + n : N - 1, kc = (k0 + kk < K) ? k0 + kk : K - 1;
      tl[kk * 65 + n] = src[(size_t)kc * ldsrc + nc];
    }
  }
  __syncthreads();
  {
    const int k = (tid & 31) * 2, nb = tid >> 5;
#pragma unroll
    for (int i = 0; i < 8; ++i) {
      const int nn = nb + 8 * i;
      int n = n0 + nn;
      if (n < N) {
        if (winperm) n = (n < 1280) ? n : ((n < 1304) ? (5888 + n - 1280) : (n - 24));
        const unsigned v = pk2(tl[k * 65 + nn], tl[(k + 1) * 65 + nn]);
        *(unsigned*)(dst + (size_t)(dst_row_off + n) * lddst + dst_k0 + k) = v;
      }
    }
  }
}

constexpr int P0_WIN = 16 * 93;
constexpr int P0_WBA = 8 * 16, P0_WBB = 8 * 16, P0_WOUT = 16 * 16, P0_W1 = 32 * 2;
constexpr int P0_TR = P0_WIN + P0_WBA + P0_WBB + P0_WOUT + P0_W1;
constexpr int P0_C1 = 2;
constexpr int P0_NORM = NT / 4;
constexpr int P0_WCP = 2 * DEC_BATCH * 8;
constexpr int P0_PAD = NPAD - IN_COLS;
constexpr int P0_TOTAL = P0_TR + P0_C1 + P0_NORM + P0_WCP + P0_PAD;

DI void phase0_item(const Params& p, int it, char* lds) {
  const int tid = otid(), lane = tid & 63, wave = tid >> 6;
  float* tl = (float*)lds;
  if (it < P0_TR) {
    if (it < P0_WIN) {
      const int kt = it / 93, nt = it % 93;
      transpose_tile(p.w_in, IN_COLS, 1024, IN_COLS, kt * 64, nt * 64, (u16*)(p.ws + W_WINT), 1024, 0, kt * 64, 1, tl);
      return;
    }
    it -= P0_WIN;
    if (it < P0_WBA) { const int kt = it / 16, nt = it % 16;
      transpose_tile(p.w_ba, 1024, 512, 1024, kt * 64, nt * 64, (u16*)(p.ws + W_WBAT), 512, 0, kt * 64, 0, tl); return; }
    it -= P0_WBA;
    if (it < P0_WBB) { const int kt = it / 16, nt = it % 16;
      transpose_tile(p.w_bb, 1024, 512, 1024, kt * 64, nt * 64, (u16*)(p.ws + W_WBBT), 512, 0, kt * 64, 0, tl); return; }
    it -= P0_WBB;
    if (it < P0_WOUT) { const int kt = it / 16, nt = it % 16;
      transpose_tile(p.w_out, 1024, 1024, 1024, kt * 64, nt * 64, (u16*)(p.ws + W_WOUTT), 1024, 0, kt * 64, 0, tl); return; }
    it -= P0_WOUT;
    { const int kv = it >> 5, kt = it & 31;
      const float* w1 = kv ? p.w1_v : p.w1_k;
      transpose_tile(w1, 64, 2048, 64, kt * 64, 0, (u16*)(p.ws + W_W1T) + (size_t)kv * 128 * 1024, 1024,
                     (kt >= 16) ? 64 : 0, (kt & 15) * 64, 0, tl); return; }
  }
  it -= P0_TR;
  if (it < P0_C1) {
    const float* pos = it ? p.pos_v : p.pos_k; const float* w1 = it ? p.w1_v : p.w1_k;
    const int j = tid & 63, part = tid >> 6;
    float s = 0.f;
    for (int i = part * 512; i < part * 512 + 512; ++i) s += pos[i] * w1[(size_t)i * 64 + j];
    __syncthreads();
    tl[part * 64 + j] = s;
    __syncthreads();
    if (tid < 64) ((float*)(p.ws + W_C1))[it * 64 + tid] = tl[tid] + tl[64 + tid] + tl[128 + tid] + tl[192 + tid];
    return;
  }
  it -= P0_C1;
  if (it < P0_NORM) {
    const int row = it * 4 + wave;
    const float* x = (row < NTP) ? (p.x_prompt + (size_t)row * 1024) : (p.x_sample + (size_t)(row - NTP) * 1024);
    float4 v[4]; float ss = 0.f;
#pragma unroll
    for (int i = 0; i < 4; ++i) { v[i] = *(const float4*)(x + (i * 64 + lane) * 4); ss += v[i].x * v[i].x + v[i].y * v[i].y + v[i].z * v[i].z + v[i].w * v[i].w; }
    ss = wave_sum(ss);
    const float rs = rsqrtf(ss * (1.f / 1024.f) + 1e-6f);
    u16* xn = (u16*)(p.ws + W_XN) + (size_t)row * 1024;
#pragma unroll
    for (int i = 0; i < 4; ++i) {
      const float4 g = *(const float4*)(p.norm_g + (i * 64 + lane) * 4);
      uint2 o; o.x = pk2(v[i].x * rs * g.x, v[i].y * rs * g.y); o.y = pk2(v[i].z * rs * g.z, v[i].w * rs * g.w);
      *(uint2*)(xn + (i * 64 + lane) * 4) = o;
    }
    return;
  }
  it -= P0_NORM;
  if (it < P0_WCP) {
    const int sl = it & 7, b = (it >> 3) % DEC_BATCH, kv = it / (8 * DEC_BATCH);
    const float4* src = (const float4*)((kv ? p.swv : p.swk) + ((size_t)b * 512 + 4) * 128) + sl * 64 * 32;
    float4* dst = (float4*)(p.out + O_SWK + (size_t)kv * DEC_BATCH * 512 * 128 + (size_t)b * 512 * 128) + sl * 64 * 32;
    const int n = (sl == 7 ? 60 : 64) * 32;
    const float4* __restrict__ sp = src; float4* __restrict__ dp = dst;
#pragma unroll
    for (int i = 0; i < 8; ++i) { const int idx = (tid + 256 * i < n) ? tid + 256 * i : n - 1; dp[idx] = sp[idx]; }
    return;
  }
  it -= P0_WCP;
  { u16* d = (u16*)(p.ws + W_WINT) + (size_t)(IN_COLS + it) * 1024; *(uint2*)(d + tid * 4) = make_uint2(0u, 0u); }
}

constexpr int GST = 72;
struct LoadBf16 {
  const u16* base; int ld;
  DI uint4 load(int row, int ch, int kt) const { return *(const uint4*)(base + (size_t)row * ld + kt * 64 + ch * 8); }
};
struct LoadCellBf16 {
  const u16* base;
  DI uint4 load(int row, int ch, int kt) const { return *(const uint4*)(base + (size_t)(row * 16 + kt) * 128 + ch * 8); }
};
struct LoadCellPage {
  const float* cache; const int* pt; int g;
  DI uint4 load(int row, int ch, int kt) const {
    const int pos = row * 16 + kt; const int page = pt[pos >> 7];
    const float* s = cache + (((size_t)page * 128 + (pos & 127)) * 2 + g) * 64 + ch * 8;
    const float4 a = *(const float4*)s, b = *(const float4*)(s + 4);
    uint4 r; r.x = pk2(a.x, a.y); r.y = pk2(a.z, a.w); r.z = pk2(b.x, b.y); r.w = pk2(b.z, b.w); return r;
  }
};

template <int NI, class AL, class BL>
DI void gemm_main(f32x16 (&acc)[2][NI], const AL& al, const BL& bl, int nkt, char* lds) {
  u16* sA = (u16*)lds; u16* sB = sA + 128 * GST;
  const int tid = otid(), lane = tid & 63, wave = tid >> 6, wm = wave >> 1, wn = wave & 1;
  const int lrow = tid >> 3, lch = tid & 7, r = lane & 31, h = lane >> 5;
  uint4 ra[4], rb[2 * NI];
#pragma unroll
  for (int i = 0; i < 4; ++i) ra[i] = al.load(lrow + 32 * i, lch, 0);
#pragma unroll
  for (int i = 0; i < 2 * NI; ++i) rb[i] = bl.load(lrow + 32 * i, lch, 0);
  for (int kt = 0; kt < nkt; ++kt) {
    __syncthreads();
#pragma unroll
    for (int i = 0; i < 4; ++i) *(uint4*)(sA + (lrow + 32 * i) * GST + lch * 8) = ra[i];
#pragma unroll
    for (int i = 0; i < 2 * NI; ++i) *(uint4*)(sB + (lrow + 32 * i) * GST + lch * 8) = rb[i];
    __syncthreads();
    if (kt + 1 < nkt) {
#pragma unroll
      for (int i = 0; i < 4; ++i) ra[i] = al.load(lrow + 32 * i, lch, kt + 1);
#pragma unroll
      for (int i = 0; i < 2 * NI; ++i) rb[i] = bl.load(lrow + 32 * i, lch, kt + 1);
    }
#pragma unroll
    for (int s = 0; s < 4; ++s) {
      bf16x8 a[2], bb[NI];
#pragma unroll
      for (int mi = 0; mi < 2; ++mi) a[mi] = *(const bf16x8*)(sA + (wm * 64 + mi * 32 + r) * GST + s * 16 + 8 * h);
#pragma unroll
      for (int ni = 0; ni < NI; ++ni) bb[ni] = *(const bf16x8*)(sB + (wn * 32 * NI + ni * 32 + r) * GST + s * 16 + 8 * h);
#pragma unroll
      for (int mi = 0; mi < 2; ++mi)
#pragma unroll
        for (int ni = 0; ni < NI; ++ni) acc[mi][ni] = MFMA32(a[mi], bb[ni], acc[mi][ni]);
    }
  }
}

typedef __attribute__((address_space(1))) const unsigned gptr_t;
typedef __attribute__((address_space(3))) unsigned lptr_t;
template <int NI>
DI void gemm_glds(f32x16 (&acc)[2][NI], const u16* A, int lda, const u16* B, int ldb, int nkt, char* lds) {
  const int tid = otid(), lane = tid & 63, wave = tid >> 6, wm = wave >> 1, wn = wave & 1;
  const int r = lane & 31, h = lane >> 5;
  const int lr = (wave << 3) + (lane >> 3);
  const int lc = (lane & 7) ^ ((lane >> 3) & 7) ^ (wave & 1);
  const u16* ga = A + (size_t)lr * lda + lc * 8;
  const u16* gb = B + (size_t)lr * ldb + lc * 8;
  const int sw = (lane & 7) ^ ((lane >> 3) & 1);
  constexpr int STAGE = 16384 + 8192 * NI;
#define GLDS_ISSUE(buf, kt_) do { \
    char* sa_ = lds + (buf) * STAGE + tid * 16; \
    _Pragma("unroll") for (int i_ = 0; i_ < 4; ++i_) \
      __builtin_amdgcn_global_load_lds((gptr_t*)(ga + (size_t)(32 * i_) * lda + (kt_) * 64), (lptr_t*)(sa_ + i_ * 4096), 16, 0, 0); \
    _Pragma("unroll") for (int i_ = 0; i_ < 2 * NI; ++i_) \
      __builtin_amdgcn_global_load_lds((gptr_t*)(gb + (size_t)(32 * i_) * ldb + (kt_) * 64), (lptr_t*)(sa_ + 16384 + i_ * 4096), 16, 0, 0); \
  } while (0)
  __syncthreads();
  GLDS_ISSUE(0, 0);
#pragma unroll 1
  for (int kt = 0; kt < nkt; ++kt) {
    asm volatile("s_waitcnt vmcnt(0)" ::: "memory");
    __syncthreads();
    if (kt + 1 < nkt) GLDS_ISSUE((kt + 1) & 1, kt + 1);
    const char* sA = lds + (kt & 1) * STAGE; const char* sB = sA + 16384;
#pragma unroll
    for (int s = 0; s < 4; ++s) {
      const int co = ((2 * s + h) ^ sw) << 4;
      bf16x8 a[2], bb[NI];
#pragma unroll
      for (int mi = 0; mi < 2; ++mi) a[mi] = *(const bf16x8*)(sA + (wm * 64 + mi * 32 + r) * 128 + co);
#pragma unroll
      for (int ni = 0; ni < NI; ++ni) bb[ni] = *(const bf16x8*)(sB + (wn * 32 * NI + ni * 32 + r) * 128 + co);
#pragma unroll
      for (int mi = 0; mi < 2; ++mi)
#pragma unroll
        for (int ni = 0; ni < NI; ++ni) acc[mi][ni] = MFMA32(a[mi], bb[ni], acc[mi][ni]);
    }
  }
#undef GLDS_ISSUE
  __syncthreads();
}
template <int NI>
DI void zero_acc(f32x16 (&acc)[2][NI]) {
#pragma unroll
  for (int a = 0; a < 2; ++a)
#pragma unroll
    for (int b = 0; b < NI; ++b)
#pragma unroll
      for (int i = 0; i < 16; ++i) acc[a][b][i] = 0.f;
}

constexpr int G1_MT = NT / 128, G1_NT = NPAD / 128;
constexpr int P1_GEMM = G1_MT * G1_NT;
constexpr int P1_CMP = DEC_BATCH * 2 * 2;
constexpr int P1_TOTAL = P1_CMP + P1_GEMM;

DI void proj_tile(const Params& p, int tm, int tn, char* lds, bool store_ok) {
  f32x16 acc[2][2]; zero_acc<2>(acc);
  gemm_glds<2>(acc, (const u16*)(p.ws + W_XN) + (size_t)tm * 128 * 1024, 1024, (const u16*)(p.ws + W_WINT) + (size_t)tn * 128 * 1024, 1024, 16, lds);
  const int tid = otid(), lane = tid & 63, wave = tid >> 6, wm = wave >> 1, wn = wave & 1, r = lane & 31, h = lane >> 5;
  const bool samp = tm >= 128;
  if (!store_ok) return;
#pragma unroll
  for (int mi = 0; mi < 2; ++mi)
#pragma unroll
    for (int ni = 0; ni < 2; ++ni) {
      const int c = wn * 64 + ni * 32 + r;
      const int row0 = tm * 128 + wm * 64 + mi * 32;
      if (tn < 4) {
        u16* d = (u16*)(p.ws + W_Q) + tn * 128 + c;
#pragma unroll
        for (int i = 0; i < 16; ++i) d[(size_t)(row0 + crow(i, h)) * 512] = f2bf(acc[mi][ni][i] * (0.125f * LOG2E));
      } else if (tn < 10) {
        const int kvg = tn - 4;
        u16* d = (u16*)(p.ws + W_KV) + (size_t)kvg * NT * 128 + c;
#pragma unroll
        for (int i = 0; i < 16; ++i) {
          const int row = row0 + crow(i, h); const float v = acc[mi][ni][i];
          d[(size_t)row * 128] = f2bf(v);
          if (!samp) {
            if (kvg < 4) p.out[O_PCK + (size_t)kvg * NTP * 128 + (size_t)row * 128 + c] = v;
            else { const int t = row & 2047, b = row >> 11;
              if (t >= 1536) p.out[O_PWK + (size_t)(kvg - 4) * BATCH * 512 * 128 + ((size_t)b * 512 + t - 1536) * 128 + c] = v; }
          } else {
            const int srow = row - NTP;
            if (kvg < 4) p.out[O_SCK + (size_t)kvg * NTS * 128 + (size_t)srow * 128 + c] = v;
            else p.out[O_SWK + (size_t)(kvg - 4) * DEC_BATCH * 512 * 128 + ((size_t)(srow >> 2) * 512 + 508 + (srow & 3)) * 128 + c] = v;
          }
        }
        if (!samp && (kvg == 3 || kvg == 5)) {
          u16* vt = (u16*)(p.ws + (kvg == 3 ? W_VST : W_VWT));
          const int b = row0 >> 11, t0 = row0 & 2047, g = c >> 6, dd = c & 63;
          u16* drow = vt + ((size_t)(b * 2 + g) * 64 + dd) * 2048 + t0;
#pragma unroll
          for (int q = 0; q < 4; ++q) {
            uint2 o; o.x = pk2(acc[mi][ni][4 * q], acc[mi][ni][4 * q + 1]); o.y = pk2(acc[mi][ni][4 * q + 2], acc[mi][ni][4 * q + 3]);
            *(uint2*)(drow + 8 * q + 4 * h) = o;
          }
        }
      } else if (tn < 14 || (tn >= 26 && tn < 30)) {
        const bool isA = tn < 14; const int cc = (isA ? tn - 10 : tn - 26) * 128 + c;
        u16* d = (u16*)(p.ws + (isA ? W_ZA : W_ZB)) + cc;
#pragma unroll
        for (int i = 0; i < 16; ++i) d[(size_t)(row0 + crow(i, h)) * 512] = f2bf(siluf_(acc[mi][ni][i]));
      } else if (tn < 18 || (tn >= 22 && tn < 26)) {
        const bool isQ = tn < 18; const int cc = (isQ ? tn - 14 : tn - 22) * 128 + c;
        u16* d = (u16*)(p.ws + (isQ ? W_QB : W_VB)) + cc;
#pragma unroll
        for (int i = 0; i < 16; ++i) d[(size_t)(row0 + crow(i, h)) * 512] = f2bf(acc[mi][ni][i]);
      } else if (tn < 22) {
        const int cc = (tn - 18) * 128 + c;
        const float a0 = p.hg_lower[cc], a1 = p.hg_lower[512 + cc];
        const float lb = 1.f / (1.f + __expf(a1 - a0));
        u16* dk = (u16*)(p.ws + W_KB) + cc; float* dg = (float*)(p.ws + W_GB) + cc;
#pragma unroll
        for (int i = 0; i < 16; ++i) {
          const size_t row = row0 + crow(i, h);
          const float sg = sigmoidf_(acc[mi][ni][i]);
          const float f = lb + (1.f - lb) * sg;
          dg[row * 512] = __logf(f);
          dk[row * 512] = f2bf((1.f - lb) * (1.f - sg));
        }
      } else if (tn < 46) {
        const bool isA = tn < 38; const int cc = (isA ? tn - 30 : tn - 38) * 128 + c;
        u16* d = (u16*)(p.ws + (isA ? W_SA : W_SB)) + cc;
#pragma unroll
        for (int i = 0; i < 16; ++i) d[(size_t)(row0 + crow(i, h)) * 1024] = f2bf(sigmoidf_(acc[mi][ni][i]));
      } else {
        if (c < 24) {
          float* d = (float*)(p.ws + W_GATE) + c;
#pragma unroll
          for (int i = 0; i < 16; ++i) d[(size_t)(row0 + crow(i, h)) * 24] = sigmoidf_(acc[mi][ni][i]);
        }
      }
    }
}

template <class AL>
DI void comp_tile(const Params& p, const AL& al, int seq, int g, int kv, char* lds) {
  f32x16 acc[2][2]; zero_acc<2>(acc);
  LoadBf16 bl{(const u16*)(p.ws + W_W1T) + (size_t)kv * 128 * 1024, 1024};
  gemm_main<2>(acc, al, bl, 16, lds);
  const int tid = otid(), lane = tid & 63, wave = tid >> 6, wm = wave >> 1, wn = wave & 1, r = lane & 31, h = lane >> 5;
  float* T = (float*)lds;
  float* w2s = T + 128 * 65;
  const float* c1 = (const float*)(p.ws + W_C1) + kv * 64;
  const float* w2 = kv ? p.w2_v : p.w2_k;
  __syncthreads();
  for (int i = tid; i < 4096; i += 256) w2s[i] = w2[i];
  if (wn == 1) {
#pragma unroll
    for (int mi = 0; mi < 2; ++mi)
#pragma unroll
      for (int ni = 0; ni < 2; ++ni)
#pragma unroll
        for (int i = 0; i < 16; ++i) T[(wm * 64 + mi * 32 + crow(i, h)) * 65 + ni * 32 + r] = acc[mi][ni][i];
  }
  __syncthreads();
  if (wn == 0) {
    const float c1v[2] = {c1[r], c1[32 + r]};
#pragma unroll
    for (int mi = 0; mi < 2; ++mi)
#pragma unroll
      for (int ni = 0; ni < 2; ++ni)
#pragma unroll
        for (int i = 0; i < 16; ++i) {
          const int n = wm * 64 + mi * 32 + crow(i, h), j = ni * 32 + r;
          const float hv = siluf_(acc[mi][ni][i] + T[((n < 127) ? n + 1 : 127) * 65 + j] + c1v[ni]);
          acc[mi][ni][i] = (n < 127) ? hv : 0.f;
        }
  }
  __syncthreads();
  if (wn == 0) {
#pragma unroll
    for (int mi = 0; mi < 2; ++mi)
#pragma unroll
      for (int ni = 0; ni < 2; ++ni)
#pragma unroll
        for (int i = 0; i < 16; ++i) T[(wm * 64 + mi * 32 + crow(i, h)) * 65 + ni * 32 + r] = acc[mi][ni][i];
  }
  __syncthreads();
  {
    const int n = tid >> 1, eh = tid & 1;
    float o[32];
#pragma unroll
    for (int e = 0; e < 32; ++e) o[e] = 0.f;
#pragma unroll 2
    for (int j = 0; j < 64; ++j) {
      const float hv = T[n * 65 + j];
#pragma unroll
      for (int e = 0; e < 32; ++e) o[e] += hv * w2s[j * 64 + eh * 32 + e];
    }
    u16* dst = (u16*)(p.ws + (kv ? W_VCMP : W_KCMP)) + ((size_t)(seq * 2 + g) * 128 + n) * 64 + eh * 32;
#pragma unroll
    for (int e = 0; e < 32; e += 2) *(unsigned*)(dst + e) = pk2(o[e], o[e + 1]);
    if (kv == 1 && seq < BATCH) {
      u16* dt = (u16*)(p.ws + W_VCMPT) + ((size_t)(seq * 2 + g) * 64 + eh * 32) * 128 + n;
#pragma unroll
      for (int e = 0; e < 32; ++e) dt[(size_t)e * 128] = f2bf(o[e]);
    }
  }
  __syncthreads();
}

DI void phase1_item(const Params& p, int it, char* lds) {
  if (it < P1_CMP) {
    const int kv = it & 1, g = (it >> 1) & 1, b = it >> 2;
    LoadCellPage al{kv ? p.ccv : p.cck, p.pt + b * 16, g};
    comp_tile(p, al, BATCH + b, g, kv, lds);
    return;
  }
  it -= P1_CMP;
  const int tm = it / G1_NT, tn = it % G1_NT;
  proj_tile(p, tm, tn, lds, true);
}


DI void hgrn_sample_item(const Params& p, int it, char* lds) {
  const int b = it >> 2, h = it & 3, tid = otid(), lane = tid & 63, wave = tid >> 6;
  float* sf = (float*)lds; float* sk = sf + 512; float* sq = sk + 512; float* sv = sq + 512; float* so = sv + 512;
  __syncthreads();
  for (int i = tid; i < 512; i += 256) {
    const int t = i >> 7, c = i & 127; const size_t off = (size_t)(NTP + b * 4 + t) * 512 + h * 128 + c;
    sf[i] = __expf(((const float*)(p.ws + W_GB))[off]);
    sk[i] = bf2f(((const u16*)(p.ws + W_KB))[off]);
    sq[i] = bf2f(((const u16*)(p.ws + W_QB))[off]);
    sv[i] = bf2f(((const u16*)(p.ws + W_VB))[off]);
  }
  __syncthreads();
  const int e = tid & 127, dh = tid >> 7;
  const float* S0 = p.shg + (size_t)(b * 4 + h) * 128 * 128;
  float* S1 = p.out + O_SHG + (size_t)(b * 4 + h) * 128 * 128;
  const float v0 = sv[e], v1 = sv[128 + e], v2 = sv[256 + e], v3 = sv[384 + e];
  float o0 = 0.f, o1 = 0.f, o2 = 0.f, o3 = 0.f;
#pragma unroll 16
  for (int d = dh * 64; d < dh * 64 + 64; ++d) {
    float st = S0[(size_t)d * 128 + e];
    st = sf[d] * st + sk[d] * v0;             o0 += sq[d] * st;
    st = sf[128 + d] * st + sk[128 + d] * v1; o1 += sq[128 + d] * st;
    st = sf[256 + d] * st + sk[256 + d] * v2; o2 += sq[256 + d] * st;
    st = sf[384 + d] * st + sk[384 + d] * v3; o3 += sq[384 + d] * st;
    S1[(size_t)d * 128 + e] = st;
  }
  so[(dh * 4 + 0) * 128 + e] = o0; so[(dh * 4 + 1) * 128 + e] = o1; so[(dh * 4 + 2) * 128 + e] = o2; so[(dh * 4 + 3) * 128 + e] = o3;
  __syncthreads();
  {
    const int t = wave; const size_t row = (size_t)(NTP + b * 4 + t);
    const float a0 = so[t * 128 + lane] + so[(4 + t) * 128 + lane];
    const float a1 = so[t * 128 + 64 + lane] + so[(4 + t) * 128 + 64 + lane];
    const float ss = wave_sum(a0 * a0 + a1 * a1);
    const float rs = rsqrtf(ss * (1.f / 128.f) + 1e-6f);
    const u16* zb = (const u16*)(p.ws + W_ZB) + row * 512 + h * 128; u16* ob = (u16*)(p.ws + W_OB) + row * 512 + h * 128;
    ob[lane] = f2bf(a0 * rs * p.hg_norm_g[h * 128 + lane] * bf2f(zb[lane]));
    ob[64 + lane] = f2bf(a1 * rs * p.hg_norm_g[h * 128 + 64 + lane] * bf2f(zb[64 + lane]));
  }
}

typedef __attribute__((address_space(3))) s16x4 lds_s16x4;
DI s16x4 tr_read(const u16* ptr) { return __builtin_amdgcn_ds_read_tr16_b64_v4i16((lds_s16x4*)ptr); }
DI bf16x8 cat8(s16x4 lo, s16x4 hi) { return __builtin_shufflevector(lo, hi, 0, 1, 2, 3, 4, 5, 6, 7); }
constexpr int HST = 136;

DI void hgrn_h1_item(const Params& p, int it, char* lds) {
  const int c = it & 31, h = (it >> 5) & 3, b = it >> 7;
  const int tid = otid(), lane = tid & 63, w = __builtin_amdgcn_readfirstlane(tid >> 6), half = tid >> 7;
  const int c16 = lane & 15, hq = lane >> 4, tq = c16 >> 2, tp = c16 & 3;
  const int d = tid & 127, col = h * 128 + d;
  u16* Qe = (u16*)lds; u16* Ke = Qe + 64 * HST; u16* Vv = Ke + 64 * HST; u16* Am = Vv + 64 * HST;
  float* Rr = (float*)(Am + 64 * 72); float* G63 = Rr + 128;
  const u16* qB = (const u16*)(p.ws + W_QB); const u16* kB = (const u16*)(p.ws + W_KB); const u16* vB = (const u16*)(p.ws + W_VB);
  const float* gB = (const float*)(p.ws + W_GB);
  const size_t tok0 = (size_t)b * 2048 + c * 64;
  __syncthreads();
  float G[32];
  {
    float run = 0.f;
#pragma unroll
    for (int i = 0; i < 32; ++i) { run += gB[(tok0 + half * 32 + i) * 512 + col]; G[i] = run; }
    if (half == 0) Rr[d] = run;
  }
#pragma unroll
  for (int i = 0; i < 4; ++i) {
    const int idx = tid + 256 * i, s_ = idx >> 4, cc = idx & 15;
    *(uint4*)(Vv + s_ * HST + cc * 8) = *(const uint4*)(vB + (tok0 + s_) * 512 + h * 128 + cc * 8);
  }
  __syncthreads();
  {
    const float R = Rr[d];
    const float base = half ? R : 0.f;
    u16* qg = (u16*)(p.ws + W_QG);
#pragma unroll
    for (int i = 0; i < 32; ++i) {
      const int t = half * 32 + i;
      const float gt = base + G[i];
      const float q = bf2f(qB[(tok0 + t) * 512 + col]), k = bf2f(kB[(tok0 + t) * 512 + col]);
      const float dq = fminf(fmaxf(gt - R, -80.f), 80.f);
      Qe[t * HST + d] = f2bf(q * __expf(dq));
      Ke[t * HST + d] = f2bf(k * __expf(-dq));
      qg[(tok0 + t) * 512 + col] = f2bf(q * __expf(gt));
    }
    if (half == 1) G63[d] = base + G[31];
  }
  __syncthreads();
  for (int j = 0; j <= w; ++j) {
    f32x4 x = f32x4{0.f, 0.f, 0.f, 0.f};
#pragma unroll
    for (int ks = 0; ks < 4; ++ks) {
      const bf16x8 a = *(const bf16x8*)(Qe + (16 * w + c16) * HST + ks * 32 + 8 * hq);
      const bf16x8 bb = *(const bf16x8*)(Ke + (16 * j + c16) * HST + ks * 32 + 8 * hq);
      x = MFMA16(a, bb, x);
    }
#pragma unroll
    for (int r = 0; r < 4; ++r) {
      const bool ok = (j < w) || (c16 <= 4 * hq + r);
      Am[(16 * w + 4 * hq + r) * 72 + 16 * j + c16] = f2bf(ok ? x[r] : 0.f);
    }
  }
  if ((w & 1) == 0) {
#pragma unroll
    for (int r = 0; r < 4; ++r) Am[(16 * w + 4 * hq + r) * 72 + 16 * (w + 1) + c16] = 0;
  }
  __syncthreads();
  bf16x8 vf[2][2];
#pragma unroll
  for (int ks = 0; ks < 2; ++ks)
#pragma unroll
    for (int et = 0; et < 2; ++et) {
      const u16* base = Vv + (32 * ks + 8 * hq + tq) * HST + 32 * w + 16 * et + 4 * tp;
      vf[ks][et] = cat8(tr_read(base), tr_read(base + 4 * HST));
    }
  {
    f32x4 o[4][2];
#pragma unroll
    for (int tt = 0; tt < 4; ++tt)
#pragma unroll
      for (int et = 0; et < 2; ++et) o[tt][et] = f32x4{0.f, 0.f, 0.f, 0.f};
#pragma unroll
    for (int tt = 0; tt < 4; ++tt)
#pragma unroll
      for (int ks = 0; ks <= (tt >> 1); ++ks) {
        const bf16x8 a = *(const bf16x8*)(Am + (16 * tt + c16) * 72 + 32 * ks + 8 * hq);
#pragma unroll
        for (int et = 0; et < 2; ++et) o[tt][et] = MFMA16(a, vf[ks][et], o[tt][et]);
      }
    float* oraw = (float*)(p.ws + W_ORAW);
#pragma unroll
    for (int tt = 0; tt < 4; ++tt)
#pragma unroll
      for (int et = 0; et < 2; ++et)
#pragma unroll
        for (int r = 0; r < 4; ++r) oraw[(tok0 + 16 * tt + 4 * hq + r) * 512 + h * 128 + 32 * w + 16 * et + c16] = o[tt][et][r];
  }
  float* dst = (float*)(p.ws + W_DST) + (size_t)it * 128 * 128;
#pragma unroll
  for (int dt = 0; dt < 8; ++dt) {
    bf16x8 kt[2];
#pragma unroll
    for (int ks = 0; ks < 2; ++ks) {
      const u16* base = Ke + (32 * ks + 8 * hq + tq) * HST + 16 * dt + 4 * tp;
      kt[ks] = cat8(tr_read(base), tr_read(base + 4 * HST));
    }
    f32x4 sc2;
#pragma unroll
    for (int r = 0; r < 4; ++r) sc2[r] = __expf(G63[16 * dt + 4 * hq + r] - Rr[16 * dt + 4 * hq + r]);
#pragma unroll
    for (int et = 0; et < 2; ++et) {
      f32x4 dd = f32x4{0.f, 0.f, 0.f, 0.f};
      dd = MFMA16(kt[0], vf[0][et], dd); dd = MFMA16(kt[1], vf[1][et], dd);
      *(float4*)(dst + (size_t)(32 * w + 16 * et + c16) * 128 + 16 * dt + 4 * hq) = make_float4(dd[0] * sc2[0], dd[1] * sc2[1], dd[2] * sc2[2], dd[3] * sc2[3]);
    }
  }
  if (tid < 128) ((float*)(p.ws + W_DEC))[(size_t)it * 128 + tid] = __expf(G63[tid]);
}

constexpr int H2_ITEMS = 8 * 4 * 128 * 32 / 256;
DI void hgrn_h2_item(const Params& p, int it) {
  const int gt = it * 256 + otid(), bh = gt >> 12, e = (gt >> 5) & 127, dq = gt & 31;
  const float* dst = (const float*)(p.ws + W_DST); const float* dec = (const float*)(p.ws + W_DEC); u16* spt = (u16*)(p.ws + W_SPT);
  float4 s = make_float4(0.f, 0.f, 0.f, 0.f);
#pragma unroll 4
  for (int c = 0; c < 32; ++c) {
    const size_t idx = ((size_t)(bh * 32 + c) * 128 + e) * 128 + dq * 4;
    const float4 d4 = *(const float4*)(dst + idx);
    const float4 k4 = *(const float4*)(dec + (size_t)(bh * 32 + c) * 128 + dq * 4);
    *(uint2*)(spt + idx) = make_uint2(pk2(s.x, s.y), pk2(s.z, s.w));
    s.x = k4.x * s.x + d4.x; s.y = k4.y * s.y + d4.y; s.z = k4.z * s.z + d4.z; s.w = k4.w * s.w + d4.w;
  }
  float* So = p.out + O_PHG + (size_t)bh * 128 * 128;
  So[(size_t)(dq * 4 + 0) * 128 + e] = s.x; So[(size_t)(dq * 4 + 1) * 128 + e] = s.y;
  So[(size_t)(dq * 4 + 2) * 128 + e] = s.z; So[(size_t)(dq * 4 + 3) * 128 + e] = s.w;
}

DI void hgrn_h3_item(const Params& p, int it) {
  const int c = it & 31, h = (it >> 5) & 3, b = it >> 7;
  const int tid = otid(), lane = tid & 63, w = tid >> 6, c16 = lane & 15, hq = lane >> 4;
  const size_t tok0 = (size_t)b * 2048 + c * 64 + 16 * w;
  const u16* qg = (const u16*)(p.ws + W_QG) + (tok0 + c16) * 512 + h * 128 + 8 * hq;
  bf16x8 af[4];
#pragma unroll
  for (int ks = 0; ks < 4; ++ks) af[ks] = *(const bf16x8*)(qg + 32 * ks);
  const float* oraw = (const float*)(p.ws + W_ORAW) + (tok0 + 4 * hq) * 512 + h * 128 + c16;
  const u16* spt = (const u16*)(p.ws + W_SPT) + ((size_t)it * 128 + c16) * 128 + 8 * hq;
  f32x4 acc[8];
#pragma unroll
  for (int et = 0; et < 8; ++et) {
#pragma unroll
    for (int r = 0; r < 4; ++r) acc[et][r] = oraw[(size_t)r * 512 + 16 * et];
#pragma unroll
    for (int ks = 0; ks < 4; ++ks) {
      const bf16x8 bfr = *(const bf16x8*)(spt + (size_t)(16 * et) * 128 + 32 * ks);
      acc[et] = MFMA16(af[ks], bfr, acc[et]);
    }
  }
  const u16* zb = (const u16*)(p.ws + W_ZB) + (tok0 + 4 * hq) * 512 + h * 128 + c16;
  u16* ob = (u16*)(p.ws + W_OB) + (tok0 + 4 * hq) * 512 + h * 128 + c16;
#pragma unroll
  for (int r = 0; r < 4; ++r) {
    float v = 0.f;
#pragma unroll
    for (int et = 0; et < 8; ++et) v += acc[et][r] * acc[et][r];
    v += __shfl_xor(v, 1); v += __shfl_xor(v, 2); v += __shfl_xor(v, 4); v += __shfl_xor(v, 8);
    const float rs = rsqrtf(v * (1.f / 128.f) + 1e-6f);
#pragma unroll
    for (int et = 0; et < 8; ++et)
      ob[(size_t)r * 512 + 16 * et] = f2bf(acc[et][r] * rs * p.hg_norm_g[h * 128 + 16 * et + c16] * bf2f(zb[(size_t)r * 512 + 16 * et]));
  }
}

typedef __attribute__((address_space(3))) const float lds_cf;
template <int NR>
DI void sa_scores(const float* qrows_, const float4 (&kk)[16], float (&sc)[NR]) {
  lds_cf* qrows = (lds_cf*)qrows_; asm volatile("" : "+v"(qrows));
#pragma unroll
  for (int r = 0; r < NR; ++r) {
    float a0 = 0.f, a1 = 0.f;
#pragma unroll
    for (int dq = 0; dq < 16; dq += 2) {
      const f32x4 q0 = *(const __attribute__((address_space(3))) f32x4*)(qrows + r * 64 + dq * 4), q1 = *(const __attribute__((address_space(3))) f32x4*)(qrows + r * 64 + dq * 4 + 4);
      a0 += q0[0] * kk[dq].x + q0[1] * kk[dq].y + q0[2] * kk[dq].z + q0[3] * kk[dq].w;
      a1 += q1[0] * kk[dq + 1].x + q1[1] * kk[dq + 1].y + q1[2] * kk[dq + 1].z + q1[3] * kk[dq + 1].w;
    }
    sc[r] = a0 + a1;
    asm volatile("" : "+v"(sc[r]) :: "memory");
  }
}
DI void sa_load_f32(const float* rowp, bool ok, float4 (&kk)[16]) {
#pragma unroll
  for (int i = 0; i < 16; ++i) kk[i] = ok ? ((const float4*)rowp)[i] : make_float4(0.f, 0.f, 0.f, 0.f);
}
template <int NR>
DI void sa_softmax(float* P, int nk, int row, int sub) {
  float m = -3.0e38f;
  for (int k = sub; k < nk; k += 16) m = fmaxf(m, P[k * NR + row]);
  m = fmaxf(m, __shfl_xor(m, 1)); m = fmaxf(m, __shfl_xor(m, 2)); m = fmaxf(m, __shfl_xor(m, 4)); m = fmaxf(m, __shfl_xor(m, 8));
  float l = 0.f;
  for (int k = sub; k < nk; k += 16) { const float sv = P[k * NR + row]; const float pv = (sv > -1.0e38f) ? __builtin_amdgcn_exp2f(sv - m) : 0.f; P[k * NR + row] = pv; l += pv; }
  l += __shfl_xor(l, 1); l += __shfl_xor(l, 2); l += __shfl_xor(l, 4); l += __shfl_xor(l, 8);
  const float inv = (l > 0.f) ? 1.f / l : 0.f;
  for (int k = sub; k < nk; k += 16) P[k * NR + row] *= inv;
}

DI void sa_load_bf16(const u16* rowp, bool ok, float4 (&kk)[16]) {
#pragma unroll
  for (int i = 0; i < 8; ++i) {
    const uint4 u = ok ? ((const uint4*)rowp)[i] : make_uint4(0u, 0u, 0u, 0u);
    kk[2 * i] = make_float4(bflo(u.x), bfhi(u.x), bflo(u.y), bfhi(u.y)); kk[2 * i + 1] = make_float4(bflo(u.z), bfhi(u.z), bflo(u.w), bfhi(u.w));
  }
}
template <class VRow>
DI void sa_pv(const float* P, int k0, int k1, const VRow& vrow, int lane, float (&o)[4]) {
#pragma unroll 1
  for (int kb = k0; kb < k1; kb += 32) {
    float vv[32];
#pragma unroll
    for (int i = 0; i < 32; ++i) vv[i] = vrow((kb + i < k1) ? kb + i : k1 - 1, lane);
#pragma unroll
    for (int i = 0; i < 32; ++i) {
      const int key = (kb + i < k1) ? kb + i : k1 - 1;
      const float4 p4 = *(const float4*)(P + key * 4); const float v = (kb + i < k1) ? vv[i] : 0.f;
      o[0] += p4.x * v; o[1] += p4.y * v; o[2] += p4.z * v; o[3] += p4.w * v;
    }
  }
}
template <int CTRL> DI float dppf(float v) { return __builtin_bit_cast(float, __builtin_amdgcn_update_dpp(0, __builtin_bit_cast(int, v), CTRL, 0xF, 0xF, false)); }
DI float red16(float v) { v += dppf<0xB1>(v); v += dppf<0x4E>(v); v += dppf<0x141>(v); v += dppf<0x140>(v); return v; }
template <class KRow, class Fin>
DI void sa_tile4(const float4 (&q4)[4], float* Pdst, const KRow& krow, const Fin& fin, int lane) {
  const int chunk = lane & 15, k4 = lane >> 4;
  float4 kv[16];
#pragma unroll
  for (int i = 0; i < 16; ++i) kv[i] = krow(4 * i + k4, chunk);
#pragma unroll
  for (int i = 0; i < 16; ++i) {
    float sr[4];
#pragma unroll
    for (int r = 0; r < 4; ++r) sr[r] = red16(q4[r].x * kv[i].x + q4[r].y * kv[i].y + q4[r].z * kv[i].z + q4[r].w * kv[i].w);
    const float mine = (chunk == 0) ? sr[0] : ((chunk == 1) ? sr[1] : ((chunk == 2) ? sr[2] : sr[3]));
    const float fv = fin(4 * i + k4, chunk & 3, mine);
    if (chunk < 4) Pdst[(4 * i + k4) * 4 + chunk] = fv;
  }
}
DI void sample_attn_item(const Params& p, int it, char* lds) {
  const int t = it & 3, g = (it >> 2) & 1, b = it >> 3, tid = otid(), lane = tid & 63, w = __builtin_amdgcn_readfirstlane(tid >> 6);
  float* qs = (float*)lds;
  float* Pc = qs + 256;
  float* Pw = Pc + 512;
  float* Ps = Pw + 2304;
  float* obuf = Ps + 2048;
  float* imp = obuf + 3072;
  int* sel = (int*)(imp + 36);
  int* pts = sel + 8;
  float* btab = (float*)(pts + 16);
  const size_t tok = (size_t)(NTP + b * 4 + t);
  const int qpos = PAST + t, seq = BATCH + b;
  __syncthreads();
  qs[tid] = bf2f(((const u16*)(p.ws + W_Q))[tok * 512 + (g * 4 + (tid >> 6)) * 64 + lane]);
  for (int i = tid; i < 4 * 129; i += 256) { const int r = i / 129, rel = i % 129; const int bk = rel < 128 ? T5B[rel] : 31; btab[i] = p.rel_bias[bk * 8 + g * 4 + r] * LOG2E; }
  if (tid < 16) pts[tid] = p.pt[b * 16 + tid];
  __syncthreads();
  const float* fresh_wk = p.out + O_SWK + ((size_t)b * 512 + 508) * 128 + g * 64;
  const float* fresh_wv = p.out + O_SWK + (size_t)DEC_BATCH * 512 * 128 + ((size_t)b * 512 + 508) * 128 + g * 64;
  const float* fresh_sk = p.out + O_SCK + 2 * (size_t)NTS * 128 + (size_t)(b * 4) * 128 + g * 64;
  const float* fresh_sv = p.out + O_SCK + 3 * (size_t)NTS * 128 + (size_t)(b * 4) * 128 + g * 64;
  float4 q4[4];
#pragma unroll
  for (int r = 0; r < 4; ++r) q4[r] = *(const float4*)(qs + r * 64 + (lane & 15) * 4);
  for (int ti = w; ti < 11; ti += 4) {
    if (ti < 2) {
      const u16* kc = (const u16*)(p.ws + W_KCMP) + (size_t)(seq * 2 + g) * 128 * 64;
      sa_tile4(q4, Pc + ti * 256,
               [&](int k, int c) { const int n = 64 * ti + k; const uint2 u = *(const uint2*)(kc + (size_t)n * 64 + c * 4); return make_float4(bflo(u.x), bfhi(u.x), bflo(u.y), bfhi(u.y)); },
               [&](int k, int r, float sv) { const int n = 64 * ti + k; const int rel = qpos - (16 * n + 31); return (n < 127) ? sv + btab[r * 129 + (rel < 128 ? rel : 128)] : -3.0e38f; }, lane);
    } else {
      const int k0 = (ti - 2) * 64;
      sa_tile4(q4, Pw + k0 * 4,
               [&](int k, int c) { const int key = (k0 + k < 516) ? k0 + k : 515;
                 const float* rp = (key < 512) ? (p.swk + ((size_t)b * 512 + key) * 128 + g * 64) : (fresh_wk + (size_t)(key - 512) * 128);
                 return *(const float4*)(rp + c * 4); },
               [&](int k, int r, float sv) { const int key = k0 + k; const int rel = qpos - (PAST - 512 + key);
                 const bool ok = key < 516 && rel >= 0 && rel < 512; return ok ? sv + btab[r * 129 + (rel < 128 ? rel : 128)] : -3.0e38f; }, lane);
    }
  }
  __syncthreads();
  if (w == 0) {
    sa_softmax<4>(Pc, 128, lane >> 4, lane & 15);
    if (lane < 33) {
      const int j = lane; float sm = 0.f;
      for (int u = -1; u <= 3; ++u) { const int n = 4 * j + u; if (n >= 0 && n < 127) { const float4 p4 = *(const float4*)(Pc + n * 4); sm += (p4.x + p4.y + p4.z + p4.w) * ((u == -1 || u == 3) ? 1.f : 2.f); } }
      imp[j] = sm;
    }
    if (lane == 0) {
      sel[0] = 0; sel[1] = 31; sel[2] = 32;
      unsigned taken = 0u;
      for (int c = 0; c < 5; ++c) {
        float best = -1.f; int bi = 1;
        for (int j = 1; j <= 30; ++j) { const float v = imp[j]; if (!((taken >> j) & 1u) && v > best) { best = v; bi = j; } }
        taken |= 1u << bi; sel[3 + c] = bi;
      }
    }
  } else if (w == 1) {
    sa_softmax<4>(Pw, 576, lane >> 4, lane & 15);
  }
  __syncthreads();
  for (int jj = w; jj < 8; jj += 4) {
    const int blk = sel[jj];
    const float* kbase = (blk < 32) ? (p.csk + (((size_t)pts[blk >> 1] * 128 + (blk & 1) * 64) * 2 + g) * 64) : fresh_sk;
    sa_tile4(q4, Ps + jj * 256,
             [&](int k, int c) { const int kk = (blk < 32) ? k : (k & 3); return *(const float4*)(kbase + (size_t)kk * 128 + c * 4); },
             [&](int k, int r, float sv) { const int rel = qpos - (blk * 64 + k); const bool ok = (blk < 32 || k < 4) && rel >= 0;
               return ok ? sv + btab[r * 129 + (rel < 0 ? 0 : (rel < 128 ? rel : 128))] : -3.0e38f; }, lane);
  }
  {
    float oc[4] = {0.f, 0.f, 0.f, 0.f}, ow[4] = {0.f, 0.f, 0.f, 0.f};
    const u16* vc = (const u16*)(p.ws + W_VCMP) + (size_t)(seq * 2 + g) * 128 * 64;
    sa_pv(Pc, 32 * w, (32 * w + 32 < 127) ? 32 * w + 32 : 127, [&](int k, int l) { return bf2f(vc[(size_t)k * 64 + l]); }, lane, oc);
    const float* vst = p.swv + (size_t)b * 512 * 128 + g * 64;
    sa_pv(Pw, 129 * w, 129 * w + 129, [&](int k, int l) { const float* rp = (k < 512) ? (vst + (size_t)k * 128) : (fresh_wv + (size_t)(k - 512) * 128); return rp[l]; }, lane, ow);
#pragma unroll
    for (int r = 0; r < 4; ++r) { obuf[((0 * 4 + w) * 4 + r) * 64 + lane] = oc[r]; obuf[((1 * 4 + w) * 4 + r) * 64 + lane] = ow[r]; }
  }
  __syncthreads();
  if (w == 0) sa_softmax<4>(Ps, 512, lane >> 4, lane & 15);
  __syncthreads();
  {
    float os[4] = {0.f, 0.f, 0.f, 0.f};
    for (int jj = 2 * w; jj < 2 * w + 2; ++jj) {
      const int blk = sel[jj];
      const float* vbase; int ns;
      if (blk < 32) { vbase = p.csv + (((size_t)pts[blk >> 1] * 128 + (blk & 1) * 64) * 2 + g) * 64; ns = 64; } else { vbase = fresh_sv; ns = 4; }
      sa_pv(Ps + jj * 64 * 4, 0, ns, [&](int k, int l) { return vbase[(size_t)k * 128 + l]; }, lane, os);
    }
#pragma unroll
    for (int r = 0; r < 4; ++r) obuf[((2 * 4 + w) * 4 + r) * 64 + lane] = os[r];
  }
  __syncthreads();
  {
    const int r = tid >> 6, hd = g * 4 + r;
    const float* gt = (const float*)(p.ws + W_GATE) + tok * 24;
    float o = 0.f;
#pragma unroll
    for (int br = 0; br < 3; ++br) {
      float a = 0.f;
#pragma unroll
      for (int ww = 0; ww < 4; ++ww) a += obuf[((br * 4 + ww) * 4 + r) * 64 + lane];
      o += gt[(br == 0 ? 0 : (br == 1 ? 16 : 8)) + hd] * a;
    }
    ((u16*)(p.ws + W_OA))[tok * 512 + hd * 64 + lane] = f2bf(o * bf2f(((const u16*)(p.ws + W_ZA))[tok * 512 + hd * 64 + lane]));
  }
}

constexpr int P2_HP = BATCH * 4 * 32;
constexpr int P2_CMP = BATCH * 2 * 2;
constexpr int P2_SA = DEC_BATCH * 2 * 4;
constexpr int P2_HS = DEC_BATCH * 4;
constexpr int P2_TOTAL = P2_HP + P2_CMP + P2_SA + P2_HS;
DI void phase2_item(const Params& p, int it, char* lds) {
  if (it < P2_SA) { sample_attn_item(p, it, lds); return; }
  it -= P2_SA;
  if (it < P2_CMP) {
    const int kv = it & 1, g = (it >> 1) & 1, b = it >> 2;
    LoadCellBf16 al{(const u16*)(p.ws + W_KV) + (size_t)kv * NT * 128 + (size_t)b * 2048 * 128 + g * 64};
    comp_tile(p, al, b, g, kv, lds); return;
  }
  it -= P2_CMP;
  if (it < P2_HP) { hgrn_h1_item(p, it, lds); return; }
  it -= P2_HP;
  hgrn_sample_item(p, it, lds);
}

constexpr int AKS = 72, AVS = 68, ACS = 132;
DI bf16x8 pack8(const f32x16& x, int s2) {
  uint4 u; u.x = pk2(x[8 * s2], x[8 * s2 + 1]); u.y = pk2(x[8 * s2 + 2], x[8 * s2 + 3]);
  u.z = pk2(x[8 * s2 + 4], x[8 * s2 + 5]); u.w = pk2(x[8 * s2 + 6], x[8 * s2 + 7]);
  return __builtin_bit_cast(bf16x8, u);
}
DI void zero16(f32x16& x) {
#pragma unroll
  for (int i = 0; i < 16; ++i) x[i] = 0.f;
}

template <bool WIN, bool FAST>
DI void attn_tile(const u16* Kt, const u16* Vt, const float* brel_r, float cfar, const bf16x8 (&qf)[4], int qpos, int kpos0, bool lane_on,
                  float& m_run, float& l_run, f32x16 (&oacc)[2], int ql, int hh) {
  f32x16 sacc[2];
#pragma unroll
  for (int kt = 0; kt < 2; ++kt) {
    zero16(sacc[kt]);
#pragma unroll
    for (int ks = 0; ks < 4; ++ks) {
      const bf16x8 kf = *(const bf16x8*)(Kt + (32 * kt + ql) * AKS + 16 * ks + 8 * hh);
      sacc[kt] = MFMA32(kf, qf[ks], sacc[kt]);
    }
  }
  float mt = -1.0e30f;
  if (FAST) {
#pragma unroll
    for (int kt = 0; kt < 2; ++kt)
#pragma unroll
      for (int i = 0; i < 16; ++i) mt = fmaxf(mt, sacc[kt][i]);
    mt = lane_on ? mt + cfar : -1.0e30f;
  } else {
#pragma unroll
    for (int kt = 0; kt < 2; ++kt)
#pragma unroll
      for (int i = 0; i < 16; ++i) {
        const int rel = qpos - (kpos0 + 32 * kt + crow(i, hh));
        const bool ok = lane_on && rel >= 0 && (!WIN || rel < 512);
        const float sv = sacc[kt][i] + brel_r[rel < 0 ? 0 : (rel < 128 ? rel : 128)];
        sacc[kt][i] = ok ? sv : -1.0e30f;
        mt = fmaxf(mt, sacc[kt][i]);
      }
  }
  mt = fmaxf(mt, __shfl_xor(mt, 32));
  const float mn = fmaxf(m_run, mt);
  if (!__all(mn == m_run)) {
    const float alpha = __builtin_amdgcn_exp2f(m_run - mn);
    l_run *= alpha;
#pragma unroll
    for (int dt = 0; dt < 2; ++dt)
#pragma unroll
      for (int i = 0; i < 16; ++i) oacc[dt][i] *= alpha;
  }
  m_run = mn;
  float ls = 0.f;
  if (FAST) {
    const float dsh = lane_on ? cfar - mn : -1.0e30f;
#pragma unroll
    for (int kt = 0; kt < 2; ++kt)
#pragma unroll
      for (int i = 0; i < 16; ++i) { const float pv = __builtin_amdgcn_exp2f(sacc[kt][i] + dsh); sacc[kt][i] = pv; ls += pv; }
  } else {
#pragma unroll
    for (int kt = 0; kt < 2; ++kt)
#pragma unroll
      for (int i = 0; i < 16; ++i) {
        const float pv = (sacc[kt][i] > -1.0e29f) ? __builtin_amdgcn_exp2f(sacc[kt][i] - mn) : 0.f;
        sacc[kt][i] = pv; ls += pv;
      }
  }
  l_run += ls;
#pragma unroll
  for (int kt = 0; kt < 2; ++kt)
#pragma unroll
    for (int s2 = 0; s2 < 2; ++s2) {
      const bf16x8 pf = pack8(sacc[kt], s2);
#pragma unroll
      for (int dt = 0; dt < 2; ++dt) {
        const u16* vp = Vt + (32 * dt + ql) * AVS + 32 * kt + 16 * s2 + 4 * hh;
        const bf16x8 vf = cat8(*(const s16x4*)vp, *(const s16x4*)(vp + 8));
        oacc[dt] = MFMA32(vf, pf, oacc[dt]);
      }
    }
}

DI void attn_load_tile(u16* Kt, u16* Vt, const u16* ksrc  , const u16* vtsrc  ) {
  const int tid = otid512();
  {
    const int idx = tid, rw = idx >> 3, ch = idx & 7;
    *(uint4*)(Kt + rw * AKS + ch * 8) = *(const uint4*)(ksrc + (size_t)rw * 128 + ch * 8);
    const uint4 v = *(const uint4*)(vtsrc + (size_t)rw * 2048 + ch * 8);
    *(uint2*)(Vt + rw * AVS + ch * 8) = make_uint2(v.x, v.y);
    *(uint2*)(Vt + rw * AVS + ch * 8 + 4) = make_uint2(v.z, v.w);
  }
}

DI void prompt_attn_item(const Params& p, int it, char* lds) {
  const int qt = (it < 256) ? (31 - (it & 31)) : (it & 31), g = (it >> 5) & 1, b = (it >> 6) & 3 | ((it >> 8) << 2);
  const int t0 = qt * 64;
  const int tid = otid512(), lane = tid & 63, w = tid >> 6, ql = lane & 31, hh = lane >> 5, tl = ql >> 2, r = ql & 3;
  const int qpos = t0 + 8 * w + tl, head = g * 4 + r;
  const size_t tok = (size_t)b * 2048 + qpos;
  u16* Kt = (u16*)lds;
  u16* Vt = Kt + 128 * AKS;
  float* brel = (float*)(Vt + 64 * ACS);
  unsigned* wmask = (unsigned*)(brel + 4 * 129);
  const u16* Qb = (const u16*)(p.ws + W_Q);
  __syncthreads();
  for (int i = tid; i < 4 * 129; i += 512) { const int rr = i / 129, rel = i % 129; const int bk = rel < 128 ? T5B[rel] : 31; brel[i] = p.rel_bias[bk * 8 + g * 4 + rr] * LOG2E; }
  bf16x8 qf[4];
#pragma unroll
  for (int ks = 0; ks < 4; ++ks) qf[ks] = *(const bf16x8*)(Qb + tok * 512 + head * 64 + 16 * ks + 8 * hh);
  const float* gt = (const float*)(p.ws + W_GATE) + tok * 24;
  const float* brel_r = brel + r * 129;
  const float cfar = p.rel_bias[31 * 8 + head] * LOG2E;
  f32x16 of[2];
  unsigned selm;
  {
#pragma unroll
    for (int i = 0; i < 2; ++i) {
      const int idx = tid + 512 * i;
      { const int n = idx >> 3, ch = idx & 7;
        *(uint4*)(Kt + n * AKS + ch * 8) = *(const uint4*)((const u16*)(p.ws + W_KCMP) + ((size_t)(b * 2 + g) * 128 + n) * 64 + ch * 8); }
      { const int dd = idx >> 4, ch = idx & 15;
        const uint4 v = *(const uint4*)((const u16*)(p.ws + W_VCMPT) + ((size_t)(b * 2 + g) * 64 + dd) * 128 + ch * 8);
        *(uint2*)(Vt + dd * ACS + ch * 8) = make_uint2(v.x, v.y); *(uint2*)(Vt + dd * ACS + ch * 8 + 4) = make_uint2(v.z, v.w); }
    }
    __syncthreads();
    f32x16 sacc[4];
#pragma unroll
    for (int kt = 0; kt < 4; ++kt) {
      zero16(sacc[kt]);
#pragma unroll
      for (int ks = 0; ks < 4; ++ks) {
        const bf16x8 kf = *(const bf16x8*)(Kt + (32 * kt + ql) * AKS + 16 * ks + 8 * hh);
        sacc[kt] = MFMA32(kf, qf[ks], sacc[kt]);
      }
    }
    float mt = -1.0e30f;
#pragma unroll
    for (int kt = 0; kt < 4; ++kt)
#pragma unroll
      for (int i = 0; i < 16; ++i) {
        const int n = 32 * kt + crow(i, hh);
        const int rel = qpos - (16 * n + 31);
        const bool ok = rel >= 0 && n < 127;
        const float sv = sacc[kt][i] + brel_r[rel < 0 ? 0 : (rel < 128 ? rel : 128)];
        sacc[kt][i] = ok ? sv : -1.0e30f;
        mt = fmaxf(mt, sacc[kt][i]);
      }
    mt = fmaxf(mt, __shfl_xor(mt, 32));
    float ls = 0.f;
#pragma unroll
    for (int kt = 0; kt < 4; ++kt)
#pragma unroll
      for (int i = 0; i < 16; ++i) { const float pv = (sacc[kt][i] > -1.0e29f) ? __builtin_amdgcn_exp2f(sacc[kt][i] - mt) : 0.f; sacc[kt][i] = pv; ls += pv; }
    ls += __shfl_xor(ls, 32);
    const float inv = ls > 0.f ? 1.f / ls : 0.f;
#pragma unroll
    for (int kt = 0; kt < 4; ++kt)
#pragma unroll
      for (int i = 0; i < 16; ++i) sacc[kt][i] *= inv;
    f32x16 oc[2]; zero16(oc[0]); zero16(oc[1]);
#pragma unroll
    for (int kt = 0; kt < 4; ++kt)
#pragma unroll
      for (int s2 = 0; s2 < 2; ++s2) {
        const bf16x8 pf = pack8(sacc[kt], s2);
#pragma unroll
        for (int dt = 0; dt < 2; ++dt) {
          const u16* vp = Vt + (32 * dt + ql) * ACS + 32 * kt + 16 * s2 + 4 * hh;
          const bf16x8 vf = cat8(*(const s16x4*)vp, *(const s16x4*)(vp + 8));
          oc[dt] = MFMA32(vf, pf, oc[dt]);
        }
      }
    const float g0 = gt[head];
#pragma unroll
    for (int dt = 0; dt < 2; ++dt)
#pragma unroll
      for (int i = 0; i < 16; ++i) of[dt][i] = g0 * oc[dt][i];
    float im[16], cm[16];
#pragma unroll
    for (int kt = 0; kt < 4; ++kt)
#pragma unroll
      for (int q4 = 0; q4 < 4; ++q4) {
        const float p0 = sacc[kt][4 * q4], p1 = sacc[kt][4 * q4 + 1], p2 = sacc[kt][4 * q4 + 2], p3 = sacc[kt][4 * q4 + 3];
        im[4 * kt + q4] = 2.f * (p0 + p1 + p2) + p3; cm[4 * kt + q4] = p3;
      }
#pragma unroll
    for (int m = 0; m < 16; ++m) cm[m] = __shfl_xor(cm[m], 32);
#pragma unroll
    for (int m = 15; m >= 0; --m) im[m] += hh ? cm[m] : (m > 0 ? cm[m - 1] : 0.f);
#pragma unroll
    for (int m = 0; m < 16; ++m) { im[m] += __shfl_xor(im[m], 1); im[m] += __shfl_xor(im[m], 2); }
    float ev[16], od[16];
#pragma unroll
    for (int m = 0; m < 16; ++m) { const float ot = __shfl_xor(im[m], 32); ev[m] = hh ? ot : im[m]; od[m] = hh ? im[m] : ot; }
    const int cur = qpos >> 6;
    if (cur < 8) selm = (2u << cur) - 1u;
    else {
      selm = 1u | (1u << cur) | (1u << (cur - 1));
      for (int c = 0; c < 5; ++c) {
        float best = -1.f;
#pragma unroll
        for (int J = 0; J < 32; ++J) { const float v = (J <= cur && !((selm >> J) & 1u)) ? ((J & 1) ? od[J >> 1] : ev[J >> 1]) : -1.f; best = fmaxf(best, v); }
        int bi = 32;
#pragma unroll
        for (int J = 31; J >= 0; --J) { const float v = (J <= cur && !((selm >> J) & 1u)) ? ((J & 1) ? od[J >> 1] : ev[J >> 1]) : -1.f; if (v == best) bi = J; }
        if (best >= 0.f) selm |= 1u << bi;
      }
    }
    unsigned um = selm;
    um |= __shfl_xor(um, 4); um |= __shfl_xor(um, 8); um |= __shfl_xor(um, 16);
    if (lane == 0) wmask[w] = um;
  }
  __syncthreads();
  const unsigned un = wmask[0] | wmask[1] | wmask[2] | wmask[3] | wmask[4] | wmask[5] | wmask[6] | wmask[7];
  {
    const u16* ks = (const u16*)(p.ws + W_KV) + (size_t)2 * NT * 128 + (size_t)b * 2048 * 128 + g * 64;
    const u16* vts = (const u16*)(p.ws + W_VST) + (size_t)(b * 2 + g) * 64 * 2048;
    const u16* kw = (const u16*)(p.ws + W_KV) + (size_t)4 * NT * 128 + (size_t)b * 2048 * 128 + g * 64;
    const u16* vtw = (const u16*)(p.ws + W_VWT) + (size_t)(b * 2 + g) * 64 * 2048;
    const int rw = tid >> 3, ch = tid & 7;
    uint4 kreg, vreg;
#define ATT_PREFETCH(kb, vb, j_) do { kreg = *(const uint4*)((kb) + ((size_t)(j_) * 64 + rw) * 128 + ch * 8); vreg = *(const uint4*)((vb) + (size_t)rw * 2048 + (j_) * 64 + ch * 8); } while (0)
#define ATT_COMMIT() do { *(uint4*)(Kt + rw * AKS + ch * 8) = kreg; *(uint2*)(Vt + rw * AVS + ch * 8) = make_uint2(vreg.x, vreg.y); *(uint2*)(Vt + rw * AVS + ch * 8 + 4) = make_uint2(vreg.z, vreg.w); } while (0)
    const int jlo = (t0 >= 511) ? ((t0 - 511) >> 6) : 0, jhi = (t0 + 63) >> 6;
    {
      float m_run = -1.0e30f, l_run = 0.f; f32x16 oacc[2]; zero16(oacc[0]); zero16(oacc[1]);
      unsigned rem = un;
      int j = __builtin_ctz(rem); rem &= rem - 1u;
      ATT_PREFETCH(ks, vts, j);
      for (;;) {
        __syncthreads();
        ATT_COMMIT();
        __syncthreads();
        const int jn = rem ? __builtin_ctz(rem) : -1;
        if (jn >= 0) { rem &= rem - 1u; ATT_PREFETCH(ks, vts, jn); } else { ATT_PREFETCH(kw, vtw, jlo); }
        const bool on = (selm >> j) & 1u;
        if (__ballot(on) != 0ull) {
          if (64 * j + 63 + 128 <= t0 + 8 * w) attn_tile<false, true>(Kt, Vt, brel_r, cfar, qf, qpos, j * 64, on, m_run, l_run, oacc, ql, hh);
          else attn_tile<false, false>(Kt, Vt, brel_r, cfar, qf, qpos, j * 64, on, m_run, l_run, oacc, ql, hh);
        }
        if (jn < 0) break;
        j = jn;
      }
      l_run += __shfl_xor(l_run, 32);
      const float sc = gt[8 + head] * (l_run > 0.f ? 1.f / l_run : 0.f);
#pragma unroll
      for (int dt = 0; dt < 2; ++dt)
#pragma unroll
        for (int i = 0; i < 16; ++i) of[dt][i] += sc * oacc[dt][i];
    }
    {
      float m_run = -1.0e30f, l_run = 0.f; f32x16 oacc[2]; zero16(oacc[0]); zero16(oacc[1]);
      for (int j = jlo; j <= jhi; ++j) {
        __syncthreads();
        ATT_COMMIT();
        __syncthreads();
        if (j < jhi) ATT_PREFETCH(kw, vtw, j + 1);
        if (64 * j + 63 + 128 <= t0 + 8 * w && 64 * j + 511 >= t0 + 8 * w + 7) attn_tile<true, true>(Kt, Vt, brel_r, cfar, qf, qpos, j * 64, true, m_run, l_run, oacc, ql, hh);
        else attn_tile<true, false>(Kt, Vt, brel_r, cfar, qf, qpos, j * 64, true, m_run, l_run, oacc, ql, hh);
      }
      l_run += __shfl_xor(l_run, 32);
      const float sc = gt[16 + head] * (l_run > 0.f ? 1.f / l_run : 0.f);
#pragma unroll
      for (int dt = 0; dt < 2; ++dt)
#pragma unroll
        for (int i = 0; i < 16; ++i) of[dt][i] += sc * oacc[dt][i];
    }
#undef ATT_PREFETCH
#undef ATT_COMMIT
  }
  {
    const u16* za = (const u16*)(p.ws + W_ZA) + tok * 512 + head * 64; u16* oa = (u16*)(p.ws + W_OA) + tok * 512 + head * 64;
#pragma unroll
    for (int dt = 0; dt < 2; ++dt)
#pragma unroll
      for (int q4 = 0; q4 < 4; ++q4) {
        const int dd = 32 * dt + 8 * q4 + 4 * hh;
        const uint2 z = *(const uint2*)(za + dd);
        uint2 o; o.x = pk2(of[dt][4 * q4] * bflo(z.x), of[dt][4 * q4 + 1] * bfhi(z.x)); o.y = pk2(of[dt][4 * q4 + 2] * bflo(z.y), of[dt][4 * q4 + 3] * bfhi(z.y));
        *(uint2*)(oa + dd) = o;
      }
  }
}
constexpr int P3_FIN = BATCH * 4 * 32;
constexpr int P3_ATT = BATCH * 2 * 32;
constexpr int P3_TOTAL = P3_FIN + P3_ATT;

constexpr int P4_TOTAL = 128 * 8 + 4 * 16;
template <int NI>
DI void merge_a_tile_t(const Params& p, int tm, int tn, char* lds) {
  f32x16 aa[2][NI], ab[2][NI]; zero_acc<NI>(aa); zero_acc<NI>(ab);
  gemm_glds<NI>(aa, (const u16*)(p.ws + W_OA) + (size_t)tm * 128 * 512, 512, (const u16*)(p.ws + W_WBAT) + (size_t)tn * 64 * NI * 512, 512, 8, lds);
  gemm_glds<NI>(ab, (const u16*)(p.ws + W_OB) + (size_t)tm * 128 * 512, 512, (const u16*)(p.ws + W_WBBT) + (size_t)tn * 64 * NI * 512, 512, 8, lds);
  const int tid = otid(), lane = tid & 63, wave = tid >> 6, wm = wave >> 1, wn = wave & 1, r = lane & 31, h = lane >> 5;
#pragma unroll
  for (int mi = 0; mi < 2; ++mi)
#pragma unroll
    for (int ni = 0; ni < NI; ++ni) {
      const int c = tn * 64 * NI + wn * 32 * NI + ni * 32 + r;
#pragma unroll
      for (int i = 0; i < 16; ++i) {
        const size_t off = (size_t)(tm * 128 + wm * 64 + mi * 32 + crow(i, h)) * 1024 + c;
        const float y = bf2f(((const u16*)(p.ws + W_SA))[off]) * aa[mi][ni][i] + bf2f(((const u16*)(p.ws + W_SB))[off]) * ab[mi][ni][i];
        ((u16*)(p.ws + W_Y))[off] = f2bf(y);
      }
    }
}
DI void merge_a_tile(const Params& p, int it, char* lds) {
  if (it < 1024) merge_a_tile_t<2>(p, it >> 3, it & 7, lds);
  else { it -= 1024; merge_a_tile_t<1>(p, 128 + (it >> 4), it & 15, lds); }
}
constexpr int P5_TOTAL = 128 * 8 + 4 * 16;
template <int NI>
DI void merge_b_tile_t(const Params& p, int tm, int tn, char* lds) {
  f32x16 acc[2][NI]; zero_acc<NI>(acc);
  gemm_glds<NI>(acc, (const u16*)(p.ws + W_Y) + (size_t)tm * 128 * 1024, 1024, (const u16*)(p.ws + W_WOUTT) + (size_t)tn * 64 * NI * 1024, 1024, 16, lds);
  const int tid = otid(), lane = tid & 63, wave = tid >> 6, wm = wave >> 1, wn = wave & 1, r = lane & 31, h = lane >> 5;
  const float* xin = (tm < 128) ? p.x_prompt : (p.x_sample - (size_t)NTP * 1024);
#pragma unroll
  for (int mi = 0; mi < 2; ++mi) {
#pragma unroll
    for (int i = 0; i < 16; ++i) {
      const size_t row = (size_t)(tm * 128 + wm * 64 + mi * 32 + crow(i, h));
#pragma unroll
      for (int ni = 0; ni < NI; ++ni) {
        const int c = tn * 64 * NI + wn * 32 * NI + ni * 32 + r;
        p.out[row * 1024 + c] = acc[mi][ni][i] + xin[row * 1024 + c];
      }
    }
  }
}
DI void merge_b_tile(const Params& p, int it, char* lds) {
  if (it < 1024) merge_b_tile_t<2>(p, it >> 3, it & 7, lds);
  else { it -= 1024; merge_b_tile_t<1>(p, 128 + (it >> 4), it & 15, lds); }
}
constexpr int P6_TOTAL = NT / 4;
DI void final_norm_item(const Params& p, int it) {
  const int tid_ = otid(), lane = tid_ & 63, wave = tid_ >> 6; const size_t row = (size_t)it * 4 + wave;
  float* o = p.out + row * 1024;
  float4 v[4]; float ss = 0.f;
#pragma unroll
  for (int i = 0; i < 4; ++i) { v[i] = *(const float4*)(o + (i * 64 + lane) * 4); ss += v[i].x * v[i].x + v[i].y * v[i].y + v[i].z * v[i].z + v[i].w * v[i].w; }
  ss = wave_sum(ss);
  const float rs = rsqrtf(ss * (1.f / 1024.f) + 1e-6f);
#pragma unroll
  for (int i = 0; i < 4; ++i) {
    const float4 gg = *(const float4*)(p.final_g + (i * 64 + lane) * 4);
    *(float4*)(o + (i * 64 + lane) * 4) = make_float4(v[i].x * rs * gg.x, v[i].y * rs * gg.y, v[i].z * rs * gg.z, v[i].w * rs * gg.w);
  }
}

namespace pg8 {
#define PG8_LAS __attribute__((address_space(3)))
typedef unsigned short bf16_t;
typedef short bf16x8 __attribute__((ext_vector_type(8)));
typedef float f32x4 __attribute__((ext_vector_type(4)));
typedef unsigned u32x4 __attribute__((ext_vector_type(4)));
constexpr int BM = 256, BK = 64, HALF = 128, HTB = HALF * BK * 2  , STAGE_BYTES = 8 * HTB, NXCD = 8, WGM = 8;

__host__ __device__ __forceinline__ int lds_byte(int r, int c) { const int st = (r >> 4) * 2 + (c >> 5), rr = r & 15, cc = c & 31, ob = rr * 64 + cc * 2; return st * 1024 + (ob ^ (((ob >> 9) & 1) << 5)); }
__host__ __device__ __forceinline__ void stage_rc(int b, int& R, int& C) { const int st = b / 1024, sb = b % 1024, swz = sb ^ (((sb >> 9) & 1) << 5); R = (st >> 1) * 16 + swz / 64; C = (st & 1) * 32 + (swz % 64) / 2; }
__host__ __device__ __forceinline__ int perm32(int rho) { const int n = rho >> 4, i = rho & 15; return 8 * (i >> 2) + 4 * n + (i & 3); }

struct Unit { int pm, pn; };
struct Gemm { const bf16_t* A; const bf16_t* Bt; int M, N, K; };

struct StaticOrder {
    int nM, nN, nwg, G, c;
    __host__ __device__ void init(int M, int N, int G_, int c_) { nM = M / BM; nN = N / BM; nwg = nM * nN; G = G_; c = c_; }
    __host__ __device__ bool next(int i, Unit& u) const {
        const long L = (long)i * G + c; if (L >= nwg) return false;
        int wgid = (int)L; { const int q = nwg / NXCD, r = nwg % NXCD, xcd = wgid % NXCD, off = wgid / NXCD; wgid = (xcd < r ? xcd * (q + 1) : r * (q + 1) + (xcd - r) * q) + off; }
        const int nig = WGM * nN, gid = wgid / nig, fm = gid * WGM, gsz = (nM - fm) < WGM ? (nM - fm) : WGM;
        u.pm = fm + ((wgid % nig) % gsz); u.pn = (wgid % nig) / gsz; return true;
    }
    __device__ __forceinline__ void a_ready(const Unit&) const {}
    __device__ __forceinline__ void done(const Unit&) const {}
};

template <class Epi, class Sched, bool STAMP = false>
__device__ __forceinline__ void gemm_phase(PG8_LAS unsigned char* lds, const Gemm g, const Sched& S, const Epi& E, unsigned long long* stamps) {
    int tid_ = threadIdx.x; asm volatile("" : "+v"(tid_));
    const int tid = tid_, wid = __builtin_amdgcn_readfirstlane(tid >> 6), lane = tid & 63, wr = wid >> 2, wc = wid & 3, fr = lane & 15, fq = lane >> 4;
    const int K = g.K, nt = K / BK;
    int ts_lo = 0, ts_hi = 0, nts = 0; const unsigned long long rt_entry = STAMP ? (unsigned long long)wall_clock64() : 0ull;
#define PG8_STAMP() do { if (STAMP && wid == 0 && nts < 64) { const unsigned long long _c = (unsigned long long)clock64(); \
        ts_lo = (lane == nts) ? (int)(unsigned)_c : ts_lo; ts_hi = (lane == nts) ? (int)(unsigned)(_c >> 32) : ts_hi; ++nts; } } while (0)
    PG8_STAMP();
    unsigned voffA[2], voffB[2];
#pragma unroll
    for (int i = 0; i < 2; ++i) { int R, C; stage_rc(tid * 16 + i * 8192, R, C); const int Rb = Epi::PERM ? ((R & ~31) + perm32(R & 31)) : R;
        voffA[i] = (unsigned)(R * K + C) * 2u; voffB[i] = (unsigned)(Rb * K + C) * 2u; }
    const size_t kstep = (size_t)(BK * 2);
    const size_t hstep = (size_t)HALF * K * 2;
    const size_t tstep = 2 * hstep;
    const unsigned ldsw = (unsigned)wid * 1024u;
    const int aoff = lds_byte(wr * 64 + fr, fq * 8), boff = lds_byte(wc * 32 + fr, fq * 8);
#define PG8_SA(b, h) (((b) * 2 + (h)) * HTB)
#define PG8_SB(b, h) ((4 + (b) * 2 + (h)) * HTB)
#define PG8_STAGE(bufoff, gbase, voff) do { _Pragma("unroll") for (int _i = 0; _i < 2; ++_i) \
        __builtin_amdgcn_global_load_lds((const unsigned*)((const char*)(gbase) + (voff)[_i]), (PG8_LAS unsigned*)(lds + (bufoff) + ldsw + _i * 8192), 16, 0, 0); } while (0)
#define PG8_LDA(dst, b, h) do { _Pragma("unroll") for (int m = 0; m < 4; ++m) _Pragma("unroll") for (int k = 0; k < 2; ++k) dst[m][k] = *(const PG8_LAS bf16x8*)(lds + PG8_SA(b, h) + aoff + m * 2048 + k * 1024); } while (0)
#define PG8_LDB(dst, b, h) do { _Pragma("unroll") for (int n = 0; n < 2; ++n) _Pragma("unroll") for (int k = 0; k < 2; ++k) dst[n][k] = *(const PG8_LAS bf16x8*)(lds + PG8_SB(b, h) + boff + n * 2048 + k * 1024); } while (0)
#define PG8_MMA(ai, bj, At, Bt) do { __builtin_amdgcn_s_setprio(1); _Pragma("unroll") for (int m = 0; m < 4; ++m) _Pragma("unroll") for (int n = 0; n < 2; ++n) _Pragma("unroll") for (int k = 0; k < 2; ++k) \
        acc[ai][bj][m][n] = __builtin_amdgcn_mfma_f32_16x16x32_bf16(Bt[n][k], At[m][k], acc[ai][bj][m][n], 0, 0, 0); __builtin_amdgcn_s_setprio(0); } while (0)
#define PG8_WAIT_V(n) asm volatile("s_waitcnt vmcnt(" #n ")" ::: "memory")
#define PG8_WAIT_L(n) asm volatile("s_waitcnt lgkmcnt(" #n ")" ::: "memory")
#define PG8_BAR __builtin_amdgcn_s_barrier()
#define PG8_SCHED __builtin_amdgcn_sched_barrier(0)
    Unit cur, nxt; int ui = 0;
    if (!S.next(0, cur)) return;
    f32x4 acc[2][2][4][2];
#pragma unroll
    for (int a = 0; a < 2; ++a)
#pragma unroll
        for (int b = 0; b < 2; ++b)
#pragma unroll
            for (int m = 0; m < 4; ++m)
#pragma unroll
                for (int n = 0; n < 2; ++n) acc[a][b][m][n] = (f32x4){0.f, 0.f, 0.f, 0.f};
    bf16x8 At[4][2], B0[2][2], B1[2][2];
    const char* cA = (const char*)g.A + (size_t)cur.pm * tstep; const char* cB = (const char*)g.Bt + (size_t)cur.pn * tstep;
    S.a_ready(cur);
    PG8_STAGE(PG8_SB(0, 0), cB, voffB); PG8_STAGE(PG8_SA(0, 0), cA, voffA); PG8_STAGE(PG8_SB(0, 1), cB + hstep, voffB); PG8_STAGE(PG8_SA(0, 1), cA + hstep, voffA);
    if (wr == 1) PG8_BAR;
    PG8_WAIT_V(4); PG8_BAR;
    PG8_STAGE(PG8_SB(1, 0), cB + kstep, voffB); PG8_STAGE(PG8_SA(1, 0), cA + kstep, voffA); PG8_STAGE(PG8_SB(1, 1), cB + hstep + kstep, voffB);
    PG8_WAIT_V(6); PG8_BAR;
    PG8_STAMP();
    for (;;) {
        const bool has_next = S.next(ui + 1, nxt);
        const char* nA = has_next ? (const char*)g.A + (size_t)nxt.pm * tstep : cA; const char* nB = has_next ? (const char*)g.Bt + (size_t)nxt.pn * tstep : cB;
        for (int t = 0; t < nt; t += 2) {
            const bool last = (t == nt - 2);
            const char* a1 = cA + (size_t)(t + 1) * kstep;
            const char* a2 = last ? nA : cA + (size_t)(t + 2) * kstep; const char* b2 = last ? nB : cB + (size_t)(t + 2) * kstep;
            const char* a3 = a2 + kstep; const char* b3 = b2 + kstep;
            if (last && has_next) S.a_ready(nxt);
            PG8_LDB(B0, 0, 0); PG8_SCHED; PG8_LDA(At, 0, 0); PG8_STAGE(PG8_SA(1, 1), a1 + hstep, voffA);
            PG8_WAIT_L(8); PG8_BAR; PG8_WAIT_L(0); PG8_MMA(0, 0, At, B0); PG8_BAR; PG8_SCHED;
            PG8_LDB(B1, 0, 1); PG8_STAGE(PG8_SB(0, 0), b2, voffB);
            PG8_BAR; PG8_WAIT_L(0); PG8_MMA(0, 1, At, B1); PG8_BAR;
            PG8_LDA(At, 0, 1); PG8_STAGE(PG8_SA(0, 0), a2, voffA);
            PG8_BAR; PG8_WAIT_L(0); PG8_MMA(1, 0, At, B0); PG8_BAR; PG8_SCHED;
            PG8_STAGE(PG8_SB(0, 1), b2 + hstep, voffB);
            PG8_WAIT_V(6); PG8_BAR; PG8_MMA(1, 1, At, B1); PG8_BAR;
            PG8_LDB(B0, 1, 0); PG8_SCHED; PG8_LDA(At, 1, 0); PG8_STAGE(PG8_SA(0, 1), a2 + hstep, voffA);
            PG8_WAIT_L(8); PG8_BAR; PG8_WAIT_L(0); PG8_MMA(0, 0, At, B0); PG8_BAR; PG8_SCHED;
            PG8_LDB(B1, 1, 1); PG8_STAGE(PG8_SB(1, 0), b3, voffB);
            PG8_BAR; PG8_WAIT_L(0); PG8_MMA(0, 1, At, B1); PG8_BAR;
            PG8_LDA(At, 1, 1); PG8_STAGE(PG8_SA(1, 0), a3, voffA);
            PG8_BAR; PG8_WAIT_L(0); PG8_MMA(1, 0, At, B0); PG8_BAR; PG8_SCHED;
            PG8_STAGE(PG8_SB(1, 1), b3 + hstep, voffB);
            PG8_WAIT_V(6); PG8_BAR; PG8_MMA(1, 1, At, B1); PG8_BAR;
        }
        PG8_STAMP();
        if constexpr (!Epi::AFTER_DRAIN) { E(acc, cur, wr, wc, fr, fq); S.done(cur); }
        PG8_STAMP();
        if (!has_next) break;
#pragma unroll
        for (int a = 0; a < 2; ++a)
#pragma unroll
            for (int b = 0; b < 2; ++b)
#pragma unroll
                for (int m = 0; m < 4; ++m)
#pragma unroll
                    for (int n = 0; n < 2; ++n) acc[a][b][m][n] = (f32x4){0.f, 0.f, 0.f, 0.f};
        cur = nxt; cA = nA; cB = nB; ++ui;
    }
    PG8_WAIT_V(0);
    if (wr == 0) PG8_BAR;
    PG8_BAR;
    if constexpr (Epi::AFTER_DRAIN) { E.fused(acc, cur, wr, wc, fr, fq, lds, wid, lane); S.done(cur); }
    PG8_STAMP();
    if (STAMP && wid == 0) { stamps[lane] = lane < nts ? (((unsigned long long)(unsigned)ts_hi << 32) | (unsigned)ts_lo) : 0ull;
        if (lane == 62) stamps[62] = rt_entry; if (lane == 63) stamps[63] = (unsigned long long)wall_clock64(); }
#undef PG8_STAMP
#undef PG8_SA
#undef PG8_SB
#undef PG8_STAGE
#undef PG8_LDA
#undef PG8_LDB
#undef PG8_MMA
#undef PG8_WAIT_V
#undef PG8_WAIT_L
#undef PG8_BAR
#undef PG8_SCHED
}
}


DI uint4 pack8f(const float (&v)[8]) { uint4 u; u.x = pk2(v[0], v[1]); u.y = pk2(v[2], v[3]); u.z = pk2(v[4], v[5]); u.w = pk2(v[6], v[7]); return u; }
struct EpiProj {
  static constexpr bool PERM = true, AFTER_DRAIN = false;
  Params p;
  DI void operator()(const pg8::f32x4 (&acc)[2][2][4][2], const pg8::Unit& u, int wr, int wc, int fr, int fq) const {
    const bool samp = u.pm >= NTP / 256;
#pragma unroll
    for (int bj = 0; bj < 2; ++bj) {
      const int tn = 2 * u.pn + bj;
      const int c = wc * 32 + 8 * fq;
      if (tn >= 47 || (tn == 46 && c >= 24)) continue;
      float lb[8];
      if (tn >= 18 && tn < 22) {
#pragma unroll
        for (int j = 0; j < 8; ++j) { const int cc = (tn - 18) * 128 + c + j; lb[j] = 1.f / (1.f + __expf(p.hg_lower[512 + cc] - p.hg_lower[cc])); }
      }
#pragma unroll
      for (int ai = 0; ai < 2; ++ai)
#pragma unroll
        for (int m = 0; m < 4; ++m) {
          const size_t row = (size_t)(u.pm * 256 + ai * 128 + wr * 64 + m * 16 + fr);
          float v[8];
#pragma unroll
          for (int j = 0; j < 4; ++j) { v[j] = acc[ai][bj][m][0][j]; v[4 + j] = acc[ai][bj][m][1][j]; }
          if (tn < 4) {
#pragma unroll
            for (int j = 0; j < 8; ++j) v[j] *= 0.125f * LOG2E;
            *(uint4*)((u16*)(p.ws + W_Q) + row * 512 + tn * 128 + c) = pack8f(v);
          } else if (tn < 10) {
            const int kvg = tn - 4;
            *(uint4*)((u16*)(p.ws + W_KV) + (size_t)kvg * NT * 128 + row * 128 + c) = pack8f(v);
            float* dst = nullptr;
            if (!samp) {
              if (kvg < 4) dst = p.out + O_PCK + (size_t)kvg * NTP * 128 + row * 128 + c;
              else { const int t = (int)row & 2047, b = (int)row >> 11; if (t >= 1536) dst = p.out + O_PWK + (size_t)(kvg - 4) * BATCH * 512 * 128 + ((size_t)b * 512 + t - 1536) * 128 + c; }
            } else {
              const int srow = (int)row - NTP;
              if (kvg < 4) dst = p.out + O_SCK + (size_t)kvg * NTS * 128 + (size_t)srow * 128 + c;
              else dst = p.out + O_SWK + (size_t)(kvg - 4) * DEC_BATCH * 512 * 128 + ((size_t)(srow >> 2) * 512 + 508 + (srow & 3)) * 128 + c;
            }
            if (dst) { *(float4*)dst = make_float4(v[0], v[1], v[2], v[3]); *(float4*)(dst + 4) = make_float4(v[4], v[5], v[6], v[7]); }
            if (!samp && (kvg == 3 || kvg == 5)) {
              u16* vt = (u16*)(p.ws + (kvg == 3 ? W_VST : W_VWT));
              const int b = (int)row >> 11, t = (int)row & 2047, g = c >> 6, dd = c & 63;
#pragma unroll
              for (int j = 0; j < 8; ++j) vt[((size_t)(b * 2 + g) * 64 + dd + j) * 2048 + t] = f2bf(v[j]);
            }
          } else if (tn < 14 || (tn >= 26 && tn < 30)) {
            const bool isA = tn < 14;
#pragma unroll
            for (int j = 0; j < 8; ++j) v[j] = siluf_(v[j]);
            *(uint4*)((u16*)(p.ws + (isA ? W_ZA : W_ZB)) + row * 512 + (isA ? tn - 10 : tn - 26) * 128 + c) = pack8f(v);
          } else if (tn < 18 || (tn >= 22 && tn < 26)) {
            const bool isQ = tn < 18;
            *(uint4*)((u16*)(p.ws + (isQ ? W_QB : W_VB)) + row * 512 + (isQ ? tn - 14 : tn - 22) * 128 + c) = pack8f(v);
          } else if (tn < 22) {
            float gg[8], kk[8];
#pragma unroll
            for (int j = 0; j < 8; ++j) { const float sg = sigmoidf_(v[j]); gg[j] = __logf(lb[j] + (1.f - lb[j]) * sg); kk[j] = (1.f - lb[j]) * (1.f - sg); }
            float* dg = (float*)(p.ws + W_GB) + row * 512 + (tn - 18) * 128 + c;
            *(float4*)dg = make_float4(gg[0], gg[1], gg[2], gg[3]); *(float4*)(dg + 4) = make_float4(gg[4], gg[5], gg[6], gg[7]);
            *(uint4*)((u16*)(p.ws + W_KB) + row * 512 + (tn - 18) * 128 + c) = pack8f(kk);
          } else if (tn < 46) {
            const bool isA = tn < 38;
#pragma unroll
            for (int j = 0; j < 8; ++j) v[j] = sigmoidf_(v[j]);
            *(uint4*)((u16*)(p.ws + (isA ? W_SA : W_SB)) + row * 1024 + (isA ? tn - 30 : tn - 38) * 128 + c) = pack8f(v);
          } else {
            float* dgt = (float*)(p.ws + W_GATE) + row * 24 + c;
            *(float4*)dgt = make_float4(sigmoidf_(v[0]), sigmoidf_(v[1]), sigmoidf_(v[2]), sigmoidf_(v[3]));
            *(float4*)(dgt + 4) = make_float4(sigmoidf_(v[4]), sigmoidf_(v[5]), sigmoidf_(v[6]), sigmoidf_(v[7]));
          }
        }
    }
  }
};


struct EpiOut {
  static constexpr bool PERM = false, AFTER_DRAIN = false;
  const float* x; float* out;
  DI void operator()(const pg8::f32x4 (&acc)[2][2][4][2], const pg8::Unit& u, int wr, int wc, int fr, int fq) const {
#pragma unroll
    for (int ai = 0; ai < 2; ++ai)
#pragma unroll
      for (int m = 0; m < 4; ++m) {
        const size_t rowoff = (size_t)(u.pm * 256 + ai * 128 + wr * 64 + m * 16 + fr) * 1024 + u.pn * 256 + wc * 32 + 4 * fq;
#pragma unroll
        for (int bj = 0; bj < 2; ++bj)
#pragma unroll
          for (int n = 0; n < 2; ++n) {
            const size_t off = rowoff + bj * 128 + n * 16;
            const float4 xv = *(const float4*)(x + off);
            *(float4*)(out + off) = make_float4(acc[ai][bj][m][n][0] + xv.x, acc[ai][bj][m][n][1] + xv.y, acc[ai][bj][m][n][2] + xv.z, acc[ai][bj][m][n][3] + xv.w);
          }
      }
  }
};


template <bool SECOND>
struct EpiMerge {
  static constexpr bool PERM = true, AFTER_DRAIN = false;
  const u16* gate; u16* Y;
  DI void operator()(const pg8::f32x4 (&acc)[2][2][4][2], const pg8::Unit& u, int wr, int wc, int fr, int fq) const {
#pragma unroll
    for (int ai = 0; ai < 2; ++ai)
#pragma unroll
      for (int m = 0; m < 4; ++m) {
        const size_t rowoff = (size_t)(u.pm * 256 + ai * 128 + wr * 64 + m * 16 + fr) * 1024 + u.pn * 256 + wc * 32 + 8 * fq;
#pragma unroll
        for (int bj = 0; bj < 2; ++bj) {
          const size_t off = rowoff + bj * 128;
          const uint4 gv = *(const uint4*)(gate + off);
          float v[8];
          v[0] = bflo(gv.x) * acc[ai][bj][m][0][0]; v[1] = bfhi(gv.x) * acc[ai][bj][m][0][1]; v[2] = bflo(gv.y) * acc[ai][bj][m][0][2]; v[3] = bfhi(gv.y) * acc[ai][bj][m][0][3];
          v[4] = bflo(gv.z) * acc[ai][bj][m][1][0]; v[5] = bfhi(gv.z) * acc[ai][bj][m][1][1]; v[6] = bflo(gv.w) * acc[ai][bj][m][1][2]; v[7] = bfhi(gv.w) * acc[ai][bj][m][1][3];
          if (SECOND) {
            const uint4 yv = *(const uint4*)(Y + off);
            v[0] += bflo(yv.x); v[1] += bfhi(yv.x); v[2] += bflo(yv.y); v[3] += bfhi(yv.y); v[4] += bflo(yv.z); v[5] += bfhi(yv.z); v[6] += bflo(yv.w); v[7] += bfhi(yv.w);
          }
          *(uint4*)(Y + off) = pack8f(v);
        }
      }
  }
};

#define XB_TMO      128
#define XB_XCNT(j)  (256  + 64 * (j))
#define XB_XSUB(j)  (1280 + 64 * (j))
#define XB_XGEN(j)  (2304 + 64 * (j))
#define XB_TOP      3328
#define XB_TOPGEN   3392
#define XCD_BAR_WORDS 3456
#define XB_SPIN_CAP (1u << 18)
#define LAS __attribute__((address_space(3)))
DI unsigned xb_ld(unsigned* p)              { return __hip_atomic_load(p, __ATOMIC_RELAXED, __HIP_MEMORY_SCOPE_AGENT); }
DI unsigned xb_add(unsigned* p, unsigned v) { return __hip_atomic_fetch_add(p, v, __ATOMIC_RELAXED, __HIP_MEMORY_SCOPE_AGENT); }
DI unsigned xb_xcc_id() { return (unsigned)__builtin_amdgcn_s_getreg((3 << 11) | 20) & 0xFu; }
#define XB_SPIN(cond, bar) do { unsigned _sp = 0; while (cond) { __builtin_amdgcn_s_sleep(1); \
    if ((++_sp & 255u) == 0u) { if (xb_ld(&(bar)[XB_TMO])) break; if (_sp > XB_SPIN_CAP) { atomicAdd(&(bar)[XB_TMO], 1u); break; } } } } while (0)
struct XcdBarrier { unsigned* bar; unsigned x; volatile LAS unsigned* st; };
DI XcdBarrier xcd_barrier_post(unsigned* bar, volatile LAS unsigned* st) {
  XcdBarrier b; b.bar = bar; b.x = xb_xcc_id(); b.st = st;
  if (threadIdx.x == 0) (void)xb_add(&bar[XB_XCNT(b.x)], 1u);
  return b;
}
DI void xcd_barrier_complete(unsigned* bar, unsigned x, unsigned& nloc, unsigned& nx) {
  const unsigned G = gridDim.x * gridDim.y * gridDim.z;
  unsigned sum, cnt, mine, sp = 0u;
  for (;;) {
    sum = 0u; cnt = 0u; mine = 0u;
#pragma unroll
    for (unsigned j = 0; j < 16; ++j) { const unsigned c = xb_ld(&bar[XB_XCNT(j)]); sum += c; cnt += (c > 0u) ? 1u : 0u; mine = (j == x) ? c : mine; }
    if (sum == G) break;
    __builtin_amdgcn_s_sleep(1);
    if ((++sp & 255u) == 0u) { if (xb_ld(&bar[XB_TMO])) break; if (sp > XB_SPIN_CAP) { atomicAdd(&bar[XB_TMO], 1u); break; } }
  }
  nloc = mine > 0u ? mine : 1u; nx = cnt > 0u ? cnt : 1u;
}
DI void xcd_barrier(XcdBarrier& b) {
  asm volatile("s_waitcnt vmcnt(0)" ::: "memory");
  __syncthreads();
  if (threadIdx.x == 0) {
    unsigned* bar = b.bar;
    __builtin_amdgcn_s_waitcnt(0);
    unsigned nloc = b.st[0], nx = b.st[1];
    if (nloc == 0u) { xcd_barrier_complete(bar, b.x, nloc, nx); b.st[0] = nloc; b.st[1] = nx; }
    const unsigned old = xb_add(&bar[XB_XSUB(b.x)], 1u);
    const unsigned gen = old / nloc;
    if (old + 1u == (gen + 1u) * nloc) {
      __builtin_amdgcn_fence(__ATOMIC_RELEASE, "agent");
      asm volatile("s_waitcnt vmcnt(0)" ::: "memory");
      const unsigned og = xb_add(&bar[XB_TOP], 1u);
      const unsigned tg = og / nx;
      if (og + 1u == (tg + 1u) * nx) xb_add(&bar[XB_TOPGEN], 1u);
      else XB_SPIN(xb_ld(&bar[XB_TOPGEN]) == tg, bar);
      __builtin_amdgcn_fence(__ATOMIC_ACQUIRE, "agent");
      xb_add(&bar[XB_XGEN(b.x)], 1u);
      asm volatile("s_waitcnt vmcnt(0)" ::: "memory");
    } else {
      XB_SPIN(xb_ld(&bar[XB_XGEN(b.x)]) == gen, bar);
      __builtin_amdgcn_fence(__ATOMIC_ACQUIRE, "agent");
      asm volatile("s_waitcnt vmcnt(0)" ::: "memory");
    }
  }
  __syncthreads();
}


template <int PH>
DI void run_phase(const Params& p, char* lds_all) {
  const int half = __builtin_amdgcn_readfirstlane(threadIdx.x >> 8);
  const int vb = blockIdx.x * 2 + half, nvb = gridDim.x * 2;
  char* lds = lds_all + half * 65536;
  if (PH == 0) { for (int it = vb; it < P0_TOTAL; it += nvb) phase0_item(p, it, lds); }
  if (PH == 1) {
    for (int it = vb; it < P1_CMP; it += nvb) phase1_item(p, it, lds);
    __syncthreads();
    pg8::StaticOrder S; S.init(NT, NPAD, gridDim.x, blockIdx.x);
    const pg8::Gemm gm{(const pg8::bf16_t*)(p.ws + W_XN), (const pg8::bf16_t*)(p.ws + W_WINT), NT, NPAD, 1024};
    const EpiProj E{p};
    pg8::gemm_phase<EpiProj, pg8::StaticOrder, false>((PG8_LAS unsigned char*)lds_all, gm, S, E, nullptr);
  }
  if (PH == 2) { for (int it = vb; it < P2_TOTAL; it += nvb) phase2_item(p, it, lds); }
  if (PH == 7) { for (int it = vb; it < H2_ITEMS; it += nvb) hgrn_h2_item(p, it); }
  if (PH == 3) {
    for (int it = vb; it < P3_FIN; it += nvb) hgrn_h3_item(p, it);
    for (int it = blockIdx.x; it < P3_ATT; it += gridDim.x) prompt_attn_item(p, it, lds_all);
  }
  if (PH == 4) {
    for (int it = vb; it < 64; it += nvb) merge_a_tile_t<1>(p, 128 + (it >> 4), it & 15, lds);
    __syncthreads();
    pg8::StaticOrder S; S.init(NTP, 1024, gridDim.x, blockIdx.x);
    { const pg8::Gemm gm{(const pg8::bf16_t*)(p.ws + W_OA), (const pg8::bf16_t*)(p.ws + W_WBAT), NTP, 1024, 512};
      const EpiMerge<false> E{(const u16*)(p.ws + W_SA), (u16*)(p.ws + W_Y)};
      pg8::gemm_phase<EpiMerge<false>, pg8::StaticOrder, false>((PG8_LAS unsigned char*)lds_all, gm, S, E, nullptr); }
    { const pg8::Gemm gm{(const pg8::bf16_t*)(p.ws + W_OB), (const pg8::bf16_t*)(p.ws + W_WBBT), NTP, 1024, 512};
      const EpiMerge<true> E{(const u16*)(p.ws + W_SB), (u16*)(p.ws + W_Y)};
      pg8::gemm_phase<EpiMerge<true>, pg8::StaticOrder, false>((PG8_LAS unsigned char*)lds_all, gm, S, E, nullptr); }
  }
  if (PH == 5) {
    for (int it = vb; it < 64; it += nvb) merge_b_tile_t<1>(p, 128 + (it >> 4), it & 15, lds);
    __syncthreads();
    pg8::StaticOrder S; S.init(NTP, 1024, gridDim.x, blockIdx.x);
    const pg8::Gemm gm{(const pg8::bf16_t*)(p.ws + W_Y), (const pg8::bf16_t*)(p.ws + W_WOUTT), NTP, 1024, 1024};
    const EpiOut E{p.x_prompt, p.out};
    pg8::gemm_phase<EpiOut, pg8::StaticOrder, false>((PG8_LAS unsigned char*)lds_all, gm, S, E, nullptr);
  }
  if (PH == 6) { for (int it = vb; it < P6_TOTAL; it += nvb) final_norm_item(p, it); }
}

constexpr int LDS_DYN = 128 * 1024 + 16;
__global__ void __launch_bounds__(512, 2) k_mega(Params p) {
  extern __shared__ __attribute__((aligned(16))) char lds[];
  volatile LAS unsigned* st = (volatile LAS unsigned*)(lds + 128 * 1024);
  if (threadIdx.x == 0) { st[0] = 0u; st[1] = 0u; }
  __syncthreads();
  XcdBarrier bar = xcd_barrier_post((unsigned*)(p.ws + W_BAR), st);
  run_phase<0>(p, lds); xcd_barrier(bar);
  run_phase<1>(p, lds); xcd_barrier(bar);
  run_phase<2>(p, lds); xcd_barrier(bar);
  run_phase<7>(p, lds); xcd_barrier(bar);
  run_phase<3>(p, lds); xcd_barrier(bar);
  run_phase<4>(p, lds); xcd_barrier(bar);
  run_phase<5>(p, lds); xcd_barrier(bar);
  run_phase<6>(p, lds);
}

extern "C" void kernel_launch(void* const* d_in, const int* in_sizes, int n_in, void* d_out, int out_size,
                              void* d_ws, size_t ws_size, hipStream_t stream) {
  Params p{};
  p.x_prompt = (const float*)d_in[0]; p.x_sample = (const float*)d_in[1];
  p.cck = (const float*)d_in[2]; p.ccv = (const float*)d_in[3]; p.csk = (const float*)d_in[4]; p.csv = (const float*)d_in[5];
  p.swk = (const float*)d_in[6]; p.swv = (const float*)d_in[7]; p.shg = (const float*)d_in[8]; p.pt = (const int*)d_in[9];
  p.norm_g = (const float*)d_in[10]; p.w_in = (const float*)d_in[11];
  p.pos_k = (const float*)d_in[12]; p.w1_k = (const float*)d_in[13]; p.w2_k = (const float*)d_in[14];
  p.pos_v = (const float*)d_in[15]; p.w1_v = (const float*)d_in[16]; p.w2_v = (const float*)d_in[17];
  p.rel_bias = (const float*)d_in[18]; p.hg_lower = (const float*)d_in[19]; p.hg_norm_g = (const float*)d_in[20];
  p.w_ba = (const float*)d_in[21]; p.w_bb = (const float*)d_in[22]; p.w_out = (const float*)d_in[23]; p.final_g = (const float*)d_in[24];
  p.out = (float*)d_out; p.ws = (char*)d_ws;
  if ((size_t)out_size != O_END || ws_size < W_END) { fprintf(stderr, "kernel_launch: unexpected sizes out=%d ws=%zu (need %zu / %zu)\n", out_size, ws_size, (size_t)O_END, (size_t)W_END); return; }
  static int grid_blocks = 0;
  if (!grid_blocks) {
    int dev = 0, cus = 0, per_cu = 0;
    hipGetDevice(&dev);
    hipDeviceGetAttribute(&cus, hipDeviceAttributeMultiprocessorCount, dev);
    hipFuncSetAttribute((const void*)k_mega, hipFuncAttributeMaxDynamicSharedMemorySize, LDS_DYN);
    hipOccupancyMaxActiveBlocksPerMultiprocessor(&per_cu, k_mega, 512, LDS_DYN);
    if (per_cu < 1) fprintf(stderr, "kernel_launch: occupancy query reports %d blocks per CU\n", per_cu);
    grid_blocks = cus;
  }
  hipMemsetAsync((char*)d_ws + W_BAR, 0, XCD_BAR_WORDS * 4, stream);
  void* args[] = {&p};
  hipError_t e = hipLaunchCooperativeKernel((void*)k_mega, dim3(grid_blocks), dim3(512), args, LDS_DYN, stream);
  if (e != hipSuccess) fprintf(stderr, "cooperative launch failed: %s (grid %d)\n", hipGetErrorString(e), grid_blocks);
}
```

```cpp
#include <hip/hip_runtime.h>
#include <hip/hip_cooperative_groups.h>
#include <cstdio>
namespace cg = cooperative_groups;

#define DI __device__ __forceinline__
typedef unsigned short u16;
typedef __attribute__((ext_vector_type(8))) short bf16x8;
typedef __attribute__((ext_vector_type(4))) short s16x4;
typedef __attribute__((ext_vector_type(16))) float f32x16;
typedef __attribute__((ext_vector_type(4))) float f32x4;
typedef __attribute__((ext_vector_type(2))) float f32x2;
typedef __attribute__((ext_vector_type(2))) __bf16 bf16x2v;
#define MFMA32(a, b, c) __builtin_amdgcn_mfma_f32_32x32x16_bf16((a), (b), (c), 0, 0, 0)
#define MFMA16(a, b, c) __builtin_amdgcn_mfma_f32_16x16x32_bf16((a), (b), (c), 0, 0, 0)

constexpr int D_MODEL = 1024, BATCH = 8, SEQ = 2048, DEC_BATCH = 128, DEC_SEQ = 4, PAST = 2048;
constexpr int NTP = BATCH * SEQ;
constexpr int NTS = DEC_BATCH * DEC_SEQ;
constexpr int NT = NTP + NTS;
constexpr int IN_COLS = 5912, NPAD = 6144;
constexpr int NSEQ = BATCH + DEC_BATCH;

constexpr size_t O_YP = 0;
constexpr size_t O_YS = O_YP + (size_t)NTP * 1024;
constexpr size_t O_PCK = O_YS + (size_t)NTS * 1024;
constexpr size_t O_PWK = O_PCK + 4 * (size_t)NTP * 128;
constexpr size_t O_PHG = O_PWK + 2 * (size_t)BATCH * 512 * 128;
constexpr size_t O_SCK = O_PHG + (size_t)BATCH * 4 * 128 * 128;
constexpr size_t O_SWK = O_SCK + 4 * (size_t)NTS * 128;
constexpr size_t O_SHG = O_SWK + 2 * (size_t)DEC_BATCH * 512 * 128;
constexpr size_t O_END = O_SHG + (size_t)DEC_BATCH * 4 * 128 * 128;

constexpr size_t al256(size_t x) { return (x + 255) & ~(size_t)255; }
constexpr size_t W_WINT = 0;
constexpr size_t W_WBAT = al256(W_WINT + (size_t)NPAD * 1024 * 2);
constexpr size_t W_WBBT = al256(W_WBAT + (size_t)1024 * 512 * 2);
constexpr size_t W_WOUTT = al256(W_WBBT + (size_t)1024 * 512 * 2);
constexpr size_t W_W1T = al256(W_WOUTT + (size_t)1024 * 1024 * 2);
constexpr size_t W_C1 = al256(W_W1T + (size_t)2 * 128 * 1024 * 2);
constexpr size_t W_XN = al256(W_C1 + 2 * 64 * 4);
constexpr size_t W_Q = al256(W_XN + (size_t)NT * 1024 * 2);
constexpr size_t W_KV = al256(W_Q + (size_t)NT * 512 * 2);
constexpr size_t W_VST = al256(W_KV + (size_t)6 * NT * 128 * 2);
constexpr size_t W_VWT = al256(W_VST + (size_t)8 * 2 * 64 * 2048 * 2);
constexpr size_t W_GATE = al256(W_VWT + (size_t)8 * 2 * 64 * 2048 * 2);
constexpr size_t W_ZA = al256(W_GATE + (size_t)NT * 24 * 4);
constexpr size_t W_QB = al256(W_ZA + (size_t)NT * 512 * 2);
constexpr size_t W_KB = al256(W_QB + (size_t)NT * 512 * 2);
constexpr size_t W_GB = al256(W_KB + (size_t)NT * 512 * 2);
constexpr size_t W_VB = al256(W_GB + (size_t)NT * 512 * 4);
constexpr size_t W_ZB = al256(W_VB + (size_t)NT * 512 * 2);
constexpr size_t W_SA = al256(W_ZB + (size_t)NT * 512 * 2);
constexpr size_t W_SB = al256(W_SA + (size_t)NT * 1024 * 2);
constexpr size_t W_KCMP = al256(W_SB + (size_t)NT * 1024 * 2);
constexpr size_t W_VCMP = al256(W_KCMP + (size_t)NSEQ * 2 * 128 * 64 * 2);
constexpr size_t W_VCMPT = al256(W_VCMP + (size_t)NSEQ * 2 * 128 * 64 * 2);
constexpr size_t W_OA = al256(W_VCMPT + (size_t)8 * 2 * 64 * 128 * 2);
constexpr size_t W_OB = al256(W_OA + (size_t)NT * 512 * 2);
constexpr size_t W_Y = al256(W_OB + (size_t)NT * 512 * 2);
constexpr size_t W_SS = al256(W_Y + (size_t)NT * 1024 * 2);
constexpr size_t W_ORAW = al256(W_SS + (size_t)NT * 32 * 4);
constexpr size_t W_OSS = al256(W_ORAW + (size_t)NTP * 512 * 4);
constexpr size_t W_QG = al256(W_OSS + (size_t)NTP * 8 * 4);
constexpr size_t W_DST = al256(W_QG + (size_t)NTP * 512 * 2);
constexpr size_t W_DEC = al256(W_DST + (size_t)1024 * 128 * 128 * 4);
constexpr size_t W_SPT = al256(W_DEC + (size_t)1024 * 128 * 4);
constexpr size_t W_BAR = al256(W_SPT + (size_t)1024 * 128 * 128 * 2);
constexpr size_t W_END = al256(W_BAR + 3456 * 4);

struct Params {
  const float* x_prompt; const float* x_sample;
  const float* cck; const float* ccv; const float* csk; const float* csv;
  const float* swk; const float* swv; const float* shg; const int* pt;
  const float* norm_g; const float* w_in;
  const float* pos_k; const float* w1_k; const float* w2_k;
  const float* pos_v; const float* w1_v; const float* w2_v;
  const float* rel_bias; const float* hg_lower; const float* hg_norm_g;
  const float* w_ba; const float* w_bb; const float* w_out; const float* final_g;
  float* out; char* ws;
};

DI unsigned pk2(float a, float b) { f32x2 v = {a, b}; bf16x2v r = __builtin_convertvector(v, bf16x2v); return __builtin_bit_cast(unsigned, r); }
DI u16 f2bf(float a) { return (u16)(pk2(a, 0.f) & 0xffffu); }
DI float bf2f(u16 v) { return __uint_as_float(((unsigned)v) << 16); }
DI float bflo(unsigned v) { return __uint_as_float(v << 16); }
DI float bfhi(unsigned v) { return __uint_as_float(v & 0xffff0000u); }
constexpr float LOG2E = 1.4426950408889634f;
DI float sigmoidf_(float x) { return 1.f / (1.f + __expf(-x)); }
DI float siluf_(float x) { return x / (1.f + __expf(-x)); }
DI int otid() { int t = threadIdx.x & 255; asm volatile("" : "+v"(t)); return t; }
DI int otid512() { int t = threadIdx.x; asm volatile("" : "+v"(t)); return t; }
DI int crow(int reg, int h) { return (reg & 3) + 8 * (reg >> 2) + 4 * h; }
DI float wave_sum(float v) {
#pragma unroll
  for (int o = 32; o >= 1; o >>= 1) v += __shfl_xor(v, o);
  return v;
}
DI float wave_max(float v) {
#pragma unroll
  for (int o = 32; o >= 1; o >>= 1) v = fmaxf(v, __shfl_xor(v, o));
  return v;
}

__device__ const unsigned char T5B[128] = {
  0,1,2,3,4,5,6,7,8,9,10,11,12,13,14,15,
  16,16,16,17,17,18,18,18,19,19,19,20,20,20,20,21,
  21,21,21,22,22,22,22,22,23,23,23,23,23,23,24,24,
  24,24,24,24,25,25,25,25,25,25,25,26,26,26,26,26,
  26,26,26,27,27,27,27,27,27,27,27,27,27,28,28,28,
  28,28,28,28,28,28,28,29,29,29,29,29,29,29,29,29,
  29,29,29,30,30,30,30,30,30,30,30,30,30,30,30,30,
  30,31,31,31,31,31,31,31,31,31,31,31,31,31,31,31};

DI void transpose_tile(const float* __restrict__ src, int ldsrc, int K, int N, int k0, int n0,
                       u16* __restrict__ dst, int lddst, int dst_row_off, int dst_k0, int winperm, float* tl) {
  const int tid = otid();
  __syncthreads();
  {
    const int n = tid & 63, kb = tid >> 6;
#pragma unroll
    for (int i = 0; i < 16; ++i) {
      const int kk = kb + 4 * i;
      const int nc = (n0 + n < N) ? n0 + n : N - 1, kc = (k0 + kk < K) ? k0 + kk : K - 1;
      tl[kk * 65 + n] = src[(size_t)kc * ldsrc + nc];
    }
  }
  __syncthreads();
  {
    const int k = (tid & 31) * 2, nb = tid >> 5;
#pragma unroll
    for (int i = 0; i < 8; ++i) {
      const int nn = nb + 8 * i;
      int n = n0 + nn;
      if (n < N) {
        if (winperm) n = (n < 1280) ? n : ((n < 1304) ? (5888 + n - 1280) : (n - 24));
        const unsigned v = pk2(tl[k * 65 + nn], tl[(k + 1) * 65 + nn]);
        *(unsigned*)(dst + (size_t)(dst_row_off + n) * lddst + dst_k0 + k) = v;
      }
    }
  }
}

constexpr int P0_WIN = 16 * 93;
constexpr int P0_WBA = 8 * 16, P0_WBB = 8 * 16, P0_WOUT = 16 * 16, P0_W1 = 32 * 2;
constexpr int P0_TR = P0_WIN + P0_WBA + P0_WBB + P0_WOUT + P0_W1;
constexpr int P0_C1 = 2;
constexpr int P0_NORM = NT / 8;
constexpr int P0_WCP = 2 * DEC_BATCH * 8;
constexpr int P0_PAD = NPAD - IN_COLS;
constexpr int P0_TOTAL = P0_TR + P0_C1 + P0_NORM + P0_WCP + P0_PAD;

DI void phase0_item(const Params& p, int it, char* lds) {
  const int tid = otid(), lane = tid & 63, wave = tid >> 6;
  float* tl = (float*)lds;
  if (it < P0_TR) {
    if (it < P0_WIN) {
      const int kt = it / 93, nt = it % 93;
      transpose_tile(p.w_in, IN_COLS, 1024, IN_COLS, kt * 64, nt * 64, (u16*)(p.ws + W_WINT), 1024, 0, kt * 64, 1, tl);
      return;
    }
    it -= P0_WIN;
    if (it < P0_WBA) { const int kt = it / 16, nt = it % 16;
      transpose_tile(p.w_ba, 1024, 512, 1024, kt * 64, nt * 64, (u16*)(p.ws + W_WBAT), 512, 0, kt * 64, 0, tl); return; }
    it -= P0_WBA;
    if (it < P0_WBB) { const int kt = it / 16, nt = it % 16;
      transpose_tile(p.w_bb, 1024, 512, 1024, kt * 64, nt * 64, (u16*)(p.ws + W_WBBT), 512, 0, kt * 64, 0, tl); return; }
    it -= P0_WBB;
    if (it < P0_WOUT) { const int kt = it / 16, nt = it % 16;
      transpose_tile(p.w_out, 1024, 1024, 1024, kt * 64, nt * 64, (u16*)(p.ws + W_WOUTT), 1024, 0, kt * 64, 0, tl); return; }
    it -= P0_WOUT;
    { const int kv = it >> 5, kt = it & 31;
      const float* w1 = kv ? p.w1_v : p.w1_k;
      transpose_tile(w1, 64, 2048, 64, kt * 64, 0, (u16*)(p.ws + W_W1T) + (size_t)kv * 128 * 1024, 1024,
                     (kt >= 16) ? 64 : 0, (kt & 15) * 64, 0, tl); return; }
  }
  it -= P0_TR;
  if (it < P0_C1) {
    const float* pos = it ? p.pos_v : p.pos_k; const float* w1 = it ? p.w1_v : p.w1_k;
    const int j = tid & 63, part = tid >> 6;
    float s = 0.f;
    for (int i = part * 512; i < part * 512 + 512; ++i) s += pos[i] * w1[(size_t)i * 64 + j];
    __syncthreads();
    tl[part * 64 + j] = s;
    __syncthreads();
    if (tid < 64) ((float*)(p.ws + W_C1))[it * 64 + tid] = tl[tid] + tl[64 + tid] + tl[128 + tid] + tl[192 + tid];
    return;
  }
  it -= P0_C1;
  if (it < P0_NORM) {
#pragma unroll
    for (int rr = 0; rr < 2; ++rr) {
      const int row = it * 8 + wave * 2 + rr;
      const float* x = (row < NTP) ? (p.x_prompt + (size_t)row * 1024) : (p.x_sample + (size_t)(row - NTP) * 1024);
      float4 v[4]; float ss = 0.f;
#pragma unroll
      for (int i = 0; i < 4; ++i) { v[i] = *(const float4*)(x + (i * 64 + lane) * 4); ss += v[i].x * v[i].x + v[i].y * v[i].y + v[i].z * v[i].z + v[i].w * v[i].w; }
      ss = wave_sum(ss);
      const float rs = rsqrtf(ss * (1.f / 1024.f) + 1e-6f);
      u16* xn = (u16*)(p.ws + W_XN) + (size_t)row * 1024;
#pragma unroll
      for (int i = 0; i < 4; ++i) {
        const float4 g = *(const float4*)(p.norm_g + (i * 64 + lane) * 4);
        uint2 o; o.x = pk2(v[i].x * rs * g.x, v[i].y * rs * g.y); o.y = pk2(v[i].z * rs * g.z, v[i].w * rs * g.w);
        *(uint2*)(xn + (i * 64 + lane) * 4) = o;
      }
    }
    return;
  }
  it -= P0_NORM;
  if (it < P0_WCP) {
    const int sl = it & 7, b = (it >> 3) % DEC_BATCH, kv = it / (8 * DEC_BATCH);
    const float4* src = (const float4*)((kv ? p.swv : p.swk) + ((size_t)b * 512 + 4) * 128) + sl * 64 * 32;
    float4* dst = (float4*)(p.out + O_SWK + (size_t)kv * DEC_BATCH * 512 * 128 + (size_t)b * 512 * 128) + sl * 64 * 32;
    const int n = (sl == 7 ? 60 : 64) * 32;
    const float4* __restrict__ sp = src; float4* __restrict__ dp = dst;
#pragma unroll
    for (int i = 0; i < 8; ++i) { const int idx = (tid + 256 * i < n) ? tid + 256 * i : n - 1; dp[idx] = sp[idx]; }
    return;
  }
  it -= P0_WCP;
  { u16* d = (u16*)(p.ws + W_WINT) + (size_t)(IN_COLS + it) * 1024; *(uint2*)(d + tid * 4) = make_uint2(0u, 0u); }
}

constexpr int GST = 72;
struct LoadBf16 {
  const u16* base; int ld;
  DI uint4 load(int row, int ch, int kt) const { return *(const uint4*)(base + (size_t)row * ld + kt * 64 + ch * 8); }
};
struct LoadCellBf16 {
  const u16* base;
  DI uint4 load(int row, int ch, int kt) const { return *(const uint4*)(base + (size_t)(row * 16 + kt) * 128 + ch * 8); }
};
struct LoadCellPage {
  const float* cache; const int* pt; int g;
  DI uint4 load(int row, int ch, int kt) const {
    const int pos = row * 16 + kt; const int page = pt[pos >> 7];
    const float* s = cache + (((size_t)page * 128 + (pos & 127)) * 2 + g) * 64 + ch * 8;
    const float4 a = *(const float4*)s, b = *(const float4*)(s + 4);
    uint4 r; r.x = pk2(a.x, a.y); r.y = pk2(a.z, a.w); r.z = pk2(b.x, b.y); r.w = pk2(b.z, b.w); return r;
  }
};

template <int NI, class AL, class BL>
DI void gemm_main(f32x16 (&acc)[2][NI], const AL& al, const BL& bl, int nkt, char* lds) {
  u16* sA = (u16*)lds; u16* sB = sA + 128 * GST;
  const int tid = otid(), lane = tid & 63, wave = tid >> 6, wm = wave >> 1, wn = wave & 1;
  const int lrow = tid >> 3, lch = tid & 7, r = lane & 31, h = lane >> 5;
  uint4 ra[4], rb[2 * NI];
#pragma unroll
  for (int i = 0; i < 4; ++i) ra[i] = al.load(lrow + 32 * i, lch, 0);
#pragma unroll
  for (int i = 0; i < 2 * NI; ++i) rb[i] = bl.load(lrow + 32 * i, lch, 0);
  for (int kt = 0; kt < nkt; ++kt) {
    __syncthreads();
#pragma unroll
    for (int i = 0; i < 4; ++i) *(uint4*)(sA + (lrow + 32 * i) * GST + lch * 8) = ra[i];
#pragma unroll
    for (int i = 0; i < 2 * NI; ++i) *(uint4*)(sB + (lrow + 32 * i) * GST + lch * 8) = rb[i];
    __syncthreads();
    if (kt + 1 < nkt) {
#pragma unroll
      for (int i = 0; i < 4; ++i) ra[i] = al.load(lrow + 32 * i, lch, kt + 1);
#pragma unroll
      for (int i = 0; i < 2 * NI; ++i) rb[i] = bl.load(lrow + 32 * i, lch, kt + 1);
    }
#pragma unroll
    for (int s = 0; s < 4; ++s) {
      bf16x8 a[2], bb[NI];
#pragma unroll
      for (int mi = 0; mi < 2; ++mi) a[mi] = *(const bf16x8*)(sA + (wm * 64 + mi * 32 + r) * GST + s * 16 + 8 * h);
#pragma unroll
      for (int ni = 0; ni < NI; ++ni) bb[ni] = *(const bf16x8*)(sB + (wn * 32 * NI + ni * 32 + r) * GST + s * 16 + 8 * h);
#pragma unroll
      for (int mi = 0; mi < 2; ++mi)
#pragma unroll
        for (int ni = 0; ni < NI; ++ni) acc[mi][ni] = MFMA32(a[mi], bb[ni], acc[mi][ni]);
    }
  }
}

typedef __attribute__((address_space(1))) const unsigned gptr_t;
typedef __attribute__((address_space(3))) unsigned lptr_t;
template <int NI>
DI void gemm_glds(f32x16 (&acc)[2][NI], const u16* A, int lda, const u16* B, int ldb, int nkt, char* lds) {
  const int tid = otid(), lane = tid & 63, wave = tid >> 6, wm = wave >> 1, wn = wave & 1;
  const int r = lane & 31, h = lane >> 5;
  const int lr = (wave << 3) + (lane >> 3);
  const int lc = (lane & 7) ^ ((lane >> 3) & 7) ^ (wave & 1);
  const u16* ga = A + (size_t)lr * lda + lc * 8;
  const u16* gb = B + (size_t)lr * ldb + lc * 8;
  const int sw = (lane & 7) ^ ((lane >> 3) & 1);
  constexpr int STAGE = 16384 + 8192 * NI;
#define GLDS_ISSUE(buf, kt_) do { \
    char* sa_ = lds + (buf) * STAGE + tid * 16; \
    _Pragma("unroll") for (int i_ = 0; i_ < 4; ++i_) \
      __builtin_amdgcn_global_load_lds((gptr_t*)(ga + (size_t)(32 * i_) * lda + (kt_) * 64), (lptr_t*)(sa_ + i_ * 4096), 16, 0, 0); \
    _Pragma("unroll") for (int i_ = 0; i_ < 2 * NI; ++i_) \
      __builtin_amdgcn_global_load_lds((gptr_t*)(gb + (size_t)(32 * i_) * ldb + (kt_) * 64), (lptr_t*)(sa_ + 16384 + i_ * 4096), 16, 0, 0); \
  } while (0)
  __syncthreads();
  GLDS_ISSUE(0, 0);
#pragma unroll 1
  for (int kt = 0; kt < nkt; ++kt) {
    asm volatile("s_waitcnt vmcnt(0)" ::: "memory");
    __syncthreads();
    if (kt + 1 < nkt) GLDS_ISSUE((kt + 1) & 1, kt + 1);
    const char* sA = lds + (kt & 1) * STAGE; const char* sB = sA + 16384;
#pragma unroll
    for (int s = 0; s < 4; ++s) {
      const int co = ((2 * s + h) ^ sw) << 4;
      bf16x8 a[2], bb[NI];
#pragma unroll
      for (int mi = 0; mi < 2; ++mi) a[mi] = *(const bf16x8*)(sA + (wm * 64 + mi * 32 + r) * 128 + co);
#pragma unroll
      for (int ni = 0; ni < NI; ++ni) bb[ni] = *(const bf16x8*)(sB + (wn * 32 * NI + ni * 32 + r) * 128 + co);
#pragma unroll
      for (int mi = 0; mi < 2; ++mi)
#pragma unroll
        for (int ni = 0; ni < NI; ++ni) acc[mi][ni] = MFMA32(a[mi], bb[ni], acc[mi][ni]);
    }
  }
#undef GLDS_ISSUE
  __syncthreads();
}
template <int NI>
DI void zero_acc(f32x16 (&acc)[2][NI]) {
#pragma unroll
  for (int a = 0; a < 2; ++a)
#pragma unroll
    for (int b = 0; b < NI; ++b)
#pragma unroll
      for (int i = 0; i < 16; ++i) acc[a][b][i] = 0.f;
}

constexpr int G1_MT = NT / 128, G1_NT = NPAD / 128;
constexpr int P1_GEMM = G1_MT * G1_NT;
constexpr int P1_CMP = DEC_BATCH * 2 * 2;
constexpr int P1_TOTAL = P1_CMP + P1_GEMM;

DI void proj_tile(const Params& p, int tm, int tn, char* lds, bool store_ok) {
  f32x16 acc[2][2]; zero_acc<2>(acc);
  gemm_glds<2>(acc, (const u16*)(p.ws + W_XN) + (size_t)tm * 128 * 1024, 1024, (const u16*)(p.ws + W_WINT) + (size_t)tn * 128 * 1024, 1024, 16, lds);
  const int tid = otid(), lane = tid & 63, wave = tid >> 6, wm = wave >> 1, wn = wave & 1, r = lane & 31, h = lane >> 5;
  const bool samp = tm >= 128;
  if (!store_ok) return;
#pragma unroll
  for (int mi = 0; mi < 2; ++mi)
#pragma unroll
    for (int ni = 0; ni < 2; ++ni) {
      const int c = wn * 64 + ni * 32 + r;
      const int row0 = tm * 128 + wm * 64 + mi * 32;
      if (tn < 4) {
        u16* d = (u16*)(p.ws + W_Q) + tn * 128 + c;
#pragma unroll
        for (int i = 0; i < 16; ++i) d[(size_t)(row0 + crow(i, h)) * 512] = f2bf(acc[mi][ni][i] * (0.125f * LOG2E));
      } else if (tn < 10) {
        const int kvg = tn - 4;
        u16* d = (u16*)(p.ws + W_KV) + (size_t)kvg * NT * 128 + c;
#pragma unroll
        for (int i = 0; i < 16; ++i) {
          const int row = row0 + crow(i, h); const float v = acc[mi][ni][i];
          d[(size_t)row * 128] = f2bf(v);
          if (!samp) {
            if (kvg < 4) p.out[O_PCK + (size_t)kvg * NTP * 128 + (size_t)row * 128 + c] = v;
            else { const int t = row & 2047, b = row >> 11;
              if (t >= 1536) p.out[O_PWK + (size_t)(kvg - 4) * BATCH * 512 * 128 + ((size_t)b * 512 + t - 1536) * 128 + c] = v; }
          } else {
            const int srow = row - NTP;
            if (kvg < 4) p.out[O_SCK + (size_t)kvg * NTS * 128 + (size_t)srow * 128 + c] = v;
            else p.out[O_SWK + (size_t)(kvg - 4) * DEC_BATCH * 512 * 128 + ((size_t)(srow >> 2) * 512 + 508 + (srow & 3)) * 128 + c] = v;
          }
        }
        if (!samp && (kvg == 3 || kvg == 5)) {
          u16* vt = (u16*)(p.ws + (kvg == 3 ? W_VST : W_VWT));
          const int b = row0 >> 11, t0 = row0 & 2047, g = c >> 6, dd = c & 63;
          u16* drow = vt + ((size_t)(b * 2 + g) * 64 + dd) * 2048 + t0;
#pragma unroll
          for (int q = 0; q < 4; ++q) {
            uint2 o; o.x = pk2(acc[mi][ni][4 * q], acc[mi][ni][4 * q + 1]); o.y = pk2(acc[mi][ni][4 * q + 2], acc[mi][ni][4 * q + 3]);
            *(uint2*)(drow + 8 * q + 4 * h) = o;
          }
        }
      } else if (tn < 14 || (tn >= 26 && tn < 30)) {
        const bool isA = tn < 14; const int cc = (isA ? tn - 10 : tn - 26) * 128 + c;
        u16* d = (u16*)(p.ws + (isA ? W_ZA : W_ZB)) + cc;
#pragma unroll
        for (int i = 0; i < 16; ++i) d[(size_t)(row0 + crow(i, h)) * 512] = f2bf(siluf_(acc[mi][ni][i]));
      } else if (tn < 18 || (tn >= 22 && tn < 26)) {
        const bool isQ = tn < 18; const int cc = (isQ ? tn - 14 : tn - 22) * 128 + c;
        u16* d = (u16*)(p.ws + (isQ ? W_QB : W_VB)) + cc;
#pragma unroll
        for (int i = 0; i < 16; ++i) d[(size_t)(row0 + crow(i, h)) * 512] = f2bf(acc[mi][ni][i]);
      } else if (tn < 22) {
        const int cc = (tn - 18) * 128 + c;
        const float a0 = p.hg_lower[cc], a1 = p.hg_lower[512 + cc];
        const float lb = 1.f / (1.f + __expf(a1 - a0));
        u16* dk = (u16*)(p.ws + W_KB) + cc; float* dg = (float*)(p.ws + W_GB) + cc;
#pragma unroll
        for (int i = 0; i < 16; ++i) {
          const size_t row = row0 + crow(i, h);
          const float sg = sigmoidf_(acc[mi][ni][i]);
          const float f = lb + (1.f - lb) * sg;
          dg[row * 512] = __logf(f);
          dk[row * 512] = f2bf((1.f - lb) * (1.f - sg));
        }
      } else if (tn < 46) {
        const bool isA = tn < 38; const int cc = (isA ? tn - 30 : tn - 38) * 128 + c;
        u16* d = (u16*)(p.ws + (isA ? W_SA : W_SB)) + cc;
#pragma unroll
        for (int i = 0; i < 16; ++i) d[(size_t)(row0 + crow(i, h)) * 1024] = f2bf(sigmoidf_(acc[mi][ni][i]));
      } else {
        if (c < 24) {
          float* d = (float*)(p.ws + W_GATE) + c;
#pragma unroll
          for (int i = 0; i < 16; ++i) d[(size_t)(row0 + crow(i, h)) * 24] = sigmoidf_(acc[mi][ni][i]);
        }
      }
    }
}

template <class AL>
DI void comp_tile(const Params& p, const AL& al, int seq, int g, int kv, char* lds) {
  f32x16 acc[2][2]; zero_acc<2>(acc);
  LoadBf16 bl{(const u16*)(p.ws + W_W1T) + (size_t)kv * 128 * 1024, 1024};
  gemm_main<2>(acc, al, bl, 16, lds);
  const int tid = otid(), lane = tid & 63, wave = tid >> 6, wm = wave >> 1, wn = wave & 1, r = lane & 31, h = lane >> 5;
  float* T = (float*)lds;
  float* w2s = T + 128 * 65;
  const float* c1 = (const float*)(p.ws + W_C1) + kv * 64;
  const float* w2 = kv ? p.w2_v : p.w2_k;
  __syncthreads();
  for (int i = tid; i < 4096; i += 256) w2s[i] = w2[i];
  if (wn == 1) {
#pragma unroll
    for (int mi = 0; mi < 2; ++mi)
#pragma unroll
      for (int ni = 0; ni < 2; ++ni)
#pragma unroll
        for (int i = 0; i < 16; ++i) T[(wm * 64 + mi * 32 + crow(i, h)) * 65 + ni * 32 + r] = acc[mi][ni][i];
  }
  __syncthreads();
  if (wn == 0) {
    const float c1v[2] = {c1[r], c1[32 + r]};
#pragma unroll
    for (int mi = 0; mi < 2; ++mi)
#pragma unroll
      for (int ni = 0; ni < 2; ++ni)
#pragma unroll
        for (int i = 0; i < 16; ++i) {
          const int n = wm * 64 + mi * 32 + crow(i, h), j = ni * 32 + r;
          const float hv = siluf_(acc[mi][ni][i] + T[((n < 127) ? n + 1 : 127) * 65 + j] + c1v[ni]);
          acc[mi][ni][i] = (n < 127) ? hv : 0.f;
        }
  }
  __syncthreads();
  if (wn == 0) {
#pragma unroll
    for (int mi = 0; mi < 2; ++mi)
#pragma unroll
      for (int ni = 0; ni < 2; ++ni)
#pragma unroll
        for (int i = 0; i < 16; ++i) T[(wm * 64 + mi * 32 + crow(i, h)) * 65 + ni * 32 + r] = acc[mi][ni][i];
  }
  __syncthreads();
  {
    const int n = tid >> 1, eh = tid & 1;
    float o[32];
#pragma unroll
    for (int e = 0; e < 32; ++e) o[e] = 0.f;
#pragma unroll 2
    for (int j = 0; j < 64; ++j) {
      const float hv = T[n * 65 + j];
#pragma unroll
      for (int e = 0; e < 32; ++e) o[e] += hv * w2s[j * 64 + eh * 32 + e];
    }
    u16* dst = (u16*)(p.ws + (kv ? W_VCMP : W_KCMP)) + ((size_t)(seq * 2 + g) * 128 + n) * 64 + eh * 32;
#pragma unroll
    for (int e = 0; e < 32; e += 2) *(unsigned*)(dst + e) = pk2(o[e], o[e + 1]);
  }
  __syncthreads();
}

DI void phase1_item(const Params& p, int it, char* lds) {
  if (it < P1_CMP) {
    const int kv = it & 1, g = (it >> 1) & 1, b = it >> 2;
    LoadCellPage al{kv ? p.ccv : p.cck, p.pt + b * 16, g};
    comp_tile(p, al, BATCH + b, g, kv, lds);
    return;
  }
  it -= P1_CMP;
  const int tm = it / G1_NT, tn = it % G1_NT;
  proj_tile(p, tm, tn, lds, true);
}


DI void hgrn_sample_item(const Params& p, int it, char* lds) {
  const int b = it >> 2, h = it & 3, tid = otid(), lane = tid & 63, wave = tid >> 6;
  float* sf = (float*)lds; float* sk = sf + 512; float* sq = sk + 512; float* sv = sq + 512; float* so = sv + 512;
  __syncthreads();
  for (int i = tid; i < 512; i += 256) {
    const int t = i >> 7, c = i & 127; const size_t off = (size_t)(NTP + b * 4 + t) * 512 + h * 128 + c;
    sf[i] = __expf(((const float*)(p.ws + W_GB))[off]);
    sk[i] = bf2f(((const u16*)(p.ws + W_KB))[off]);
    sq[i] = bf2f(((const u16*)(p.ws + W_QB))[off]);
    sv[i] = bf2f(((const u16*)(p.ws + W_VB))[off]);
  }
  __syncthreads();
  const int e = tid & 127, dh = tid >> 7;
  const float* S0 = p.shg + (size_t)(b * 4 + h) * 128 * 128;
  float* S1 = p.out + O_SHG + (size_t)(b * 4 + h) * 128 * 128;
  const float v0 = sv[e], v1 = sv[128 + e], v2 = sv[256 + e], v3 = sv[384 + e];
  float o0 = 0.f, o1 = 0.f, o2 = 0.f, o3 = 0.f;
#pragma unroll 16
  for (int d = dh * 64; d < dh * 64 + 64; ++d) {
    float st = S0[(size_t)d * 128 + e];
    st = sf[d] * st + sk[d] * v0;             o0 += sq[d] * st;
    st = sf[128 + d] * st + sk[128 + d] * v1; o1 += sq[128 + d] * st;
    st = sf[256 + d] * st + sk[256 + d] * v2; o2 += sq[256 + d] * st;
    st = sf[384 + d] * st + sk[384 + d] * v3; o3 += sq[384 + d] * st;
    S1[(size_t)d * 128 + e] = st;
  }
  so[(dh * 4 + 0) * 128 + e] = o0; so[(dh * 4 + 1) * 128 + e] = o1; so[(dh * 4 + 2) * 128 + e] = o2; so[(dh * 4 + 3) * 128 + e] = o3;
  __syncthreads();
  {
    const int t = wave; const size_t row = (size_t)(NTP + b * 4 + t);
    const float a0 = so[t * 128 + lane] + so[(4 + t) * 128 + lane];
    const float a1 = so[t * 128 + 64 + lane] + so[(4 + t) * 128 + 64 + lane];
    const float ss = wave_sum(a0 * a0 + a1 * a1);
    const float rs = rsqrtf(ss * (1.f / 128.f) + 1e-6f);
    const u16* zb = (const u16*)(p.ws + W_ZB) + row * 512 + h * 128; u16* ob = (u16*)(p.ws + W_OB) + row * 512 + h * 128;
    ob[lane] = f2bf(a0 * rs * p.hg_norm_g[h * 128 + lane] * bf2f(zb[lane]));
    ob[64 + lane] = f2bf(a1 * rs * p.hg_norm_g[h * 128 + 64 + lane] * bf2f(zb[64 + lane]));
  }
}

typedef __attribute__((address_space(3))) s16x4 lds_s16x4;
DI s16x4 tr_read(const u16* ptr) { return __builtin_amdgcn_ds_read_tr16_b64_v4i16((lds_s16x4*)ptr); }
DI bf16x8 cat8(s16x4 lo, s16x4 hi) { return __builtin_shufflevector(lo, hi, 0, 1, 2, 3, 4, 5, 6, 7); }
constexpr int HST = 136;

DI void hgrn_h1_item(const Params& p, int it, char* lds) {
  const int c = it & 31, h = (it >> 5) & 3, b = it >> 7;
  const int tid = otid(), lane = tid & 63, w = __builtin_amdgcn_readfirstlane(tid >> 6), half = tid >> 7;
  const int c16 = lane & 15, hq = lane >> 4, tq = c16 >> 2, tp = c16 & 3;
  const int d = tid & 127, col = h * 128 + d;
  u16* Qe = (u16*)lds; u16* Ke = Qe + 64 * HST; u16* Vv = Ke + 64 * HST; u16* Am = Vv + 64 * HST;
  float* Rr = (float*)(Am + 64 * 72); float* G63 = Rr + 128;
  const u16* qB = (const u16*)(p.ws + W_QB); const u16* kB = (const u16*)(p.ws + W_KB); const u16* vB = (const u16*)(p.ws + W_VB);
  const float* gB = (const float*)(p.ws + W_GB);
  const size_t tok0 = (size_t)b * 2048 + c * 64;
  __syncthreads();
  float G[32];
  {
    float run = 0.f;
#pragma unroll
    for (int i = 0; i < 32; ++i) { run += gB[(tok0 + half * 32 + i) * 512 + col]; G[i] = run; }
    if (half == 0) Rr[d] = run;
  }
#pragma unroll
  for (int i = 0; i < 4; ++i) {
    const int idx = tid + 256 * i, s_ = idx >> 4, cc = idx & 15;
    *(uint4*)(Vv + s_ * HST + cc * 8) = *(const uint4*)(vB + (tok0 + s_) * 512 + h * 128 + cc * 8);
  }
  __syncthreads();
  {
    const float R = Rr[d];
    const float base = half ? R : 0.f;
    u16* qg = (u16*)(p.ws + W_QG);
#pragma unroll
    for (int i = 0; i < 32; ++i) {
      const int t = half * 32 + i;
      const float gt = base + G[i];
      const float q = bf2f(qB[(tok0 + t) * 512 + col]), k = bf2f(kB[(tok0 + t) * 512 + col]);
      const float dq = fminf(fmaxf(gt - R, -80.f), 80.f);
      Qe[t * HST + d] = f2bf(q * __expf(dq));
      Ke[t * HST + d] = f2bf(k * __expf(-dq));
      qg[(tok0 + t) * 512 + col] = f2bf(q * __expf(gt));
    }
    if (half == 1) G63[d] = base + G[31];
  }
  __syncthreads();
  for (int j = 0; j <= w; ++j) {
    f32x4 x = f32x4{0.f, 0.f, 0.f, 0.f};
#pragma unroll
    for (int ks = 0; ks < 4; ++ks) {
      const bf16x8 a = *(const bf16x8*)(Qe + (16 * w + c16) * HST + ks * 32 + 8 * hq);
      const bf16x8 bb = *(const bf16x8*)(Ke + (16 * j + c16) * HST + ks * 32 + 8 * hq);
      x = MFMA16(a, bb, x);
    }
#pragma unroll
    for (int r = 0; r < 4; ++r) {
      const bool ok = (j < w) || (c16 <= 4 * hq + r);
      Am[(16 * w + 4 * hq + r) * 72 + 16 * j + c16] = f2bf(ok ? x[r] : 0.f);
    }
  }
  if ((w & 1) == 0) {
#pragma unroll
    for (int r = 0; r < 4; ++r) Am[(16 * w + 4 * hq + r) * 72 + 16 * (w + 1) + c16] = 0;
  }
  __syncthreads();
  bf16x8 vf[2][2];
#pragma unroll
  for (int ks = 0; ks < 2; ++ks)
#pragma unroll
    for (int et = 0; et < 2; ++et) {
      const u16* base = Vv + (32 * ks + 8 * hq + tq) * HST + 32 * w + 16 * et + 4 * tp;
      vf[ks][et] = cat8(tr_read(base), tr_read(base + 4 * HST));
    }
  {
    f32x4 o[4][2];
#pragma unroll
    for (int tt = 0; tt < 4; ++tt)
#pragma unroll
      for (int et = 0; et < 2; ++et) o[tt][et] = f32x4{0.f, 0.f, 0.f, 0.f};
#pragma unroll
    for (int tt = 0; tt < 4; ++tt)
#pragma unroll
      for (int ks = 0; ks <= (tt >> 1); ++ks) {
        const bf16x8 a = *(const bf16x8*)(Am + (16 * tt + c16) * 72 + 32 * ks + 8 * hq);
#pragma unroll
        for (int et = 0; et < 2; ++et) o[tt][et] = MFMA16(a, vf[ks][et], o[tt][et]);
      }
    float* oraw = (float*)(p.ws + W_ORAW);
#pragma unroll
    for (int tt = 0; tt < 4; ++tt)
#pragma unroll
      for (int et = 0; et < 2; ++et)
#pragma unroll
        for (int r = 0; r < 4; ++r) oraw[(tok0 + 16 * tt + 4 * hq + r) * 512 + h * 128 + 32 * w + 16 * et + c16] = o[tt][et][r];
  }
  float* dst = (float*)(p.ws + W_DST) + (size_t)it * 128 * 128;
#pragma unroll
  for (int dt = 0; dt < 8; ++dt) {
    bf16x8 kt[2];
#pragma unroll
    for (int ks = 0; ks < 2; ++ks) {
      const u16* base = Ke + (32 * ks + 8 * hq + tq) * HST + 16 * dt + 4 * tp;
      kt[ks] = cat8(tr_read(base), tr_read(base + 4 * HST));
    }
    f32x4 sc2;
#pragma unroll
    for (int r = 0; r < 4; ++r) sc2[r] = __expf(G63[16 * dt + 4 * hq + r] - Rr[16 * dt + 4 * hq + r]);
#pragma unroll
    for (int et = 0; et < 2; ++et) {
      f32x4 dd = f32x4{0.f, 0.f, 0.f, 0.f};
      dd = MFMA16(kt[0], vf[0][et], dd); dd = MFMA16(kt[1], vf[1][et], dd);
      *(float4*)(dst + (size_t)(32 * w + 16 * et + c16) * 128 + 16 * dt + 4 * hq) = make_float4(dd[0] * sc2[0], dd[1] * sc2[1], dd[2] * sc2[2], dd[3] * sc2[3]);
    }
  }
  if (tid < 128) ((float*)(p.ws + W_DEC))[(size_t)it * 128 + tid] = __expf(G63[tid]);
}

constexpr int H2_ITEMS = 8 * 4 * 128 * 32 / 256;
DI void hgrn_h2_item(const Params& p, int it) {
  const int gt = it * 256 + otid(), bh = gt >> 12, e = (gt >> 5) & 127, dq = gt & 31;
  const float* dst = (const float*)(p.ws + W_DST); const float* dec = (const float*)(p.ws + W_DEC); u16* spt = (u16*)(p.ws + W_SPT);
  float4 s = make_float4(0.f, 0.f, 0.f, 0.f);
#pragma unroll 16
  for (int c = 0; c < 32; ++c) {
    const size_t idx = ((size_t)(bh * 32 + c) * 128 + e) * 128 + dq * 4;
    const float4 d4 = *(const float4*)(dst + idx);
    const float4 k4 = *(const float4*)(dec + (size_t)(bh * 32 + c) * 128 + dq * 4);
    *(uint2*)(spt + idx) = make_uint2(pk2(s.x, s.y), pk2(s.z, s.w));
    s.x = k4.x * s.x + d4.x; s.y = k4.y * s.y + d4.y; s.z = k4.z * s.z + d4.z; s.w = k4.w * s.w + d4.w;
  }
  float* So = p.out + O_PHG + (size_t)bh * 128 * 128;
  So[(size_t)(dq * 4 + 0) * 128 + e] = s.x; So[(size_t)(dq * 4 + 1) * 128 + e] = s.y;
  So[(size_t)(dq * 4 + 2) * 128 + e] = s.z; So[(size_t)(dq * 4 + 3) * 128 + e] = s.w;
}

DI void hgrn_h3_item(const Params& p, int it) {
  const int c = it & 31, h = (it >> 5) & 3, b = it >> 7;
  const int tid = otid(), lane = tid & 63, w = tid >> 6, c16 = lane & 15, hq = lane >> 4;
  const size_t tok0 = (size_t)b * 2048 + c * 64 + 16 * w;
  const u16* qg = (const u16*)(p.ws + W_QG) + (tok0 + c16) * 512 + h * 128 + 8 * hq;
  bf16x8 af[4];
#pragma unroll
  for (int ks = 0; ks < 4; ++ks) af[ks] = *(const bf16x8*)(qg + 32 * ks);
  const float* oraw = (const float*)(p.ws + W_ORAW) + (tok0 + 4 * hq) * 512 + h * 128 + c16;
  const u16* spt = (const u16*)(p.ws + W_SPT) + ((size_t)it * 128 + c16) * 128 + 8 * hq;
  f32x4 acc[8];
#pragma unroll
  for (int et = 0; et < 8; ++et) {
#pragma unroll
    for (int r = 0; r < 4; ++r) acc[et][r] = oraw[(size_t)r * 512 + 16 * et];
#pragma unroll
    for (int ks = 0; ks < 4; ++ks) {
      const bf16x8 bfr = *(const bf16x8*)(spt + (size_t)(16 * et) * 128 + 32 * ks);
      acc[et] = MFMA16(af[ks], bfr, acc[et]);
    }
  }
  const u16* zb = (const u16*)(p.ws + W_ZB) + (tok0 + 4 * hq) * 512 + h * 128 + c16;
  u16* ob = (u16*)(p.ws + W_OB) + (tok0 + 4 * hq) * 512 + h * 128 + c16;
#pragma unroll
  for (int r = 0; r < 4; ++r) {
    float v = 0.f;
#pragma unroll
    for (int et = 0; et < 8; ++et) v += acc[et][r] * acc[et][r];
    v += __shfl_xor(v, 1); v += __shfl_xor(v, 2); v += __shfl_xor(v, 4); v += __shfl_xor(v, 8);
    const float rs = rsqrtf(v * (1.f / 128.f) + 1e-6f);
#pragma unroll
    for (int et = 0; et < 8; ++et)
      ob[(size_t)r * 512 + 16 * et] = f2bf(acc[et][r] * rs * p.hg_norm_g[h * 128 + 16 * et + c16] * bf2f(zb[(size_t)r * 512 + 16 * et]));
  }
}

typedef __attribute__((address_space(3))) const float lds_cf;
template <int NR>
DI void sa_scores(const float* qrows_, const float4 (&kk)[16], float (&sc)[NR]) {
  lds_cf* qrows = (lds_cf*)qrows_; asm volatile("" : "+v"(qrows));
#pragma unroll
  for (int r = 0; r < NR; ++r) {
    float a0 = 0.f, a1 = 0.f;
#pragma unroll
    for (int dq = 0; dq < 16; dq += 2) {
      const f32x4 q0 = *(const __attribute__((address_space(3))) f32x4*)(qrows + r * 64 + dq * 4), q1 = *(const __attribute__((address_space(3))) f32x4*)(qrows + r * 64 + dq * 4 + 4);
      a0 += q0[0] * kk[dq].x + q0[1] * kk[dq].y + q0[2] * kk[dq].z + q0[3] * kk[dq].w;
      a1 += q1[0] * kk[dq + 1].x + q1[1] * kk[dq + 1].y + q1[2] * kk[dq + 1].z + q1[3] * kk[dq + 1].w;
    }
    sc[r] = a0 + a1;
    asm volatile("" : "+v"(sc[r]) :: "memory");
  }
}
DI void sa_load_f32(const float* rowp, bool ok, float4 (&kk)[16]) {
#pragma unroll
  for (int i = 0; i < 16; ++i) kk[i] = ok ? ((const float4*)rowp)[i] : make_float4(0.f, 0.f, 0.f, 0.f);
}
template <int NR>
DI void sa_softmax(float* P, int nk, int row, int sub) {
  float m = -3.0e38f;
  for (int k = sub; k < nk; k += 16) m = fmaxf(m, P[k * NR + row]);
  m = fmaxf(m, __shfl_xor(m, 1)); m = fmaxf(m, __shfl_xor(m, 2)); m = fmaxf(m, __shfl_xor(m, 4)); m = fmaxf(m, __shfl_xor(m, 8));
  float l = 0.f;
  for (int k = sub; k < nk; k += 16) { const float sv = P[k * NR + row]; const float pv = (sv > -1.0e38f) ? __builtin_amdgcn_exp2f(sv - m) : 0.f; P[k * NR + row] = pv; l += pv; }
  l += __shfl_xor(l, 1); l += __shfl_xor(l, 2); l += __shfl_xor(l, 4); l += __shfl_xor(l, 8);
  const float inv = (l > 0.f) ? 1.f / l : 0.f;
  for (int k = sub; k < nk; k += 16) P[k * NR + row] *= inv;
}

DI void sa_load_bf16(const u16* rowp, bool ok, float4 (&kk)[16]) {
#pragma unroll
  for (int i = 0; i < 8; ++i) {
    const uint4 u = ok ? ((const uint4*)rowp)[i] : make_uint4(0u, 0u, 0u, 0u);
    kk[2 * i] = make_float4(bflo(u.x), bfhi(u.x), bflo(u.y), bfhi(u.y)); kk[2 * i + 1] = make_float4(bflo(u.z), bfhi(u.z), bflo(u.w), bfhi(u.w));
  }
}
template <class VRow>
DI void sa_pv(const float* P, int k0, int k1, const VRow& vrow, int lane, float (&o)[4]) {
#pragma unroll 1
  for (int kb = k0; kb < k1; kb += 32) {
    float vv[32];
#pragma unroll
    for (int i = 0; i < 32; ++i) vv[i] = vrow((kb + i < k1) ? kb + i : k1 - 1, lane);
#pragma unroll
    for (int i = 0; i < 32; ++i) {
      const int key = (kb + i < k1) ? kb + i : k1 - 1;
      const float4 p4 = *(const float4*)(P + key * 4); const float v = (kb + i < k1) ? vv[i] : 0.f;
      o[0] += p4.x * v; o[1] += p4.y * v; o[2] += p4.z * v; o[3] += p4.w * v;
    }
  }
}
template <int CTRL> DI float dppf(float v) { return __builtin_bit_cast(float, __builtin_amdgcn_update_dpp(0, __builtin_bit_cast(int, v), CTRL, 0xF, 0xF, false)); }
DI float red16(float v) { v += dppf<0xB1>(v); v += dppf<0x4E>(v); v += dppf<0x141>(v); v += dppf<0x140>(v); return v; }
template <class KRow, class Fin>
DI void sa_tile4(const float4 (&q4)[4], float* Pdst, const KRow& krow, const Fin& fin, int lane) {
  const int chunk = lane & 15, k4 = lane >> 4;
  float4 kv[16];
#pragma unroll
  for (int i = 0; i < 16; ++i) kv[i] = krow(4 * i + k4, chunk);
#pragma unroll
  for (int i = 0; i < 16; ++i) {
    float sr[4];
#pragma unroll
    for (int r = 0; r < 4; ++r) sr[r] = red16(q4[r].x * kv[i].x + q4[r].y * kv[i].y + q4[r].z * kv[i].z + q4[r].w * kv[i].w);
    const float mine = (chunk == 0) ? sr[0] : ((chunk == 1) ? sr[1] : ((chunk == 2) ? sr[2] : sr[3]));
    const float fv = fin(4 * i + k4, chunk & 3, mine);
    if (chunk < 4) Pdst[(4 * i + k4) * 4 + chunk] = fv;
  }
}
DI void sa_softmax_row(float* P, int nk, int row, int lane) {
  float m = -3.0e38f;
  for (int k = lane; k < nk; k += 64) m = fmaxf(m, P[k * 4 + row]);
  m = wave_max(m);
  float l = 0.f;
  for (int k = lane; k < nk; k += 64) { const float sv = P[k * 4 + row]; const float pv = (sv > -1.0e38f) ? __builtin_amdgcn_exp2f(sv - m) : 0.f; P[k * 4 + row] = pv; l += pv; }
  l = wave_sum(l);
  const float inv = (l > 0.f) ? 1.f / l : 0.f;
  for (int k = lane; k < nk; k += 64) P[k * 4 + row] *= inv;
}
DI void sample_attn_item(const Params& p, int it, char* lds) {
  const int t = it & 3, g = (it >> 2) & 1, b = it >> 3, tid = otid(), lane = tid & 63, w = __builtin_amdgcn_readfirstlane(tid >> 6);
  float* qs = (float*)lds;
  float* Pc = qs + 256;
  float* Pw = Pc + 512;
  float* Ps = Pw + 2304;
  float* obuf = Ps + 2048;
  float* imp = obuf + 3072;
  int* sel = (int*)(imp + 36);
  int* pts = sel + 8;
  float* btab = (float*)(pts + 16);
  const size_t tok = (size_t)(NTP + b * 4 + t);
  const int qpos = PAST + t, seq = BATCH + b;
  __syncthreads();
  qs[tid] = bf2f(((const u16*)(p.ws + W_Q))[tok * 512 + (g * 4 + (tid >> 6)) * 64 + lane]);
  for (int i = tid; i < 4 * 129; i += 256) { const int r = i / 129, rel = i % 129; const int bk = rel < 128 ? T5B[rel] : 31; btab[i] = p.rel_bias[bk * 8 + g * 4 + r] * LOG2E; }
  if (tid < 16) pts[tid] = p.pt[b * 16 + tid];
  __syncthreads();
  const float* fresh_wk = p.out + O_SWK + ((size_t)b * 512 + 508) * 128 + g * 64;
  const float* fresh_wv = p.out + O_SWK + (size_t)DEC_BATCH * 512 * 128 + ((size_t)b * 512 + 508) * 128 + g * 64;
  const float* fresh_sk = p.out + O_SCK + 2 * (size_t)NTS * 128 + (size_t)(b * 4) * 128 + g * 64;
  const float* fresh_sv = p.out + O_SCK + 3 * (size_t)NTS * 128 + (size_t)(b * 4) * 128 + g * 64;
  float4 q4[4];
#pragma unroll
  for (int r = 0; r < 4; ++r) q4[r] = *(const float4*)(qs + r * 64 + (lane & 15) * 4);
  for (int ti = w; ti < 11; ti += 4) {
    if (ti < 2) {
      const u16* kc = (const u16*)(p.ws + W_KCMP) + (size_t)(seq * 2 + g) * 128 * 64;
      sa_tile4(q4, Pc + ti * 256,
               [&](int k, int c) { const int n = 64 * ti + k; const uint2 u = *(const uint2*)(kc + (size_t)n * 64 + c * 4); return make_float4(bflo(u.x), bfhi(u.x), bflo(u.y), bfhi(u.y)); },
               [&](int k, int r, float sv) { const int n = 64 * ti + k; const int rel = qpos - (16 * n + 31); return (n < 127) ? sv + btab[r * 129 + (rel < 128 ? rel : 128)] : -3.0e38f; }, lane);
    } else {
      const int k0 = (ti - 2) * 64;
      sa_tile4(q4, Pw + k0 * 4,
               [&](int k, int c) { const int key = (k0 + k < 516) ? k0 + k : 515;
                 const float* rp = (key < 512) ? (p.swk + ((size_t)b * 512 + key) * 128 + g * 64) : (fresh_wk + (size_t)(key - 512) * 128);
                 return *(const float4*)(rp + c * 4); },
               [&](int k, int r, float sv) { const int key = k0 + k; const int rel = qpos - (PAST - 512 + key);
                 const bool ok = key < 516 && rel >= 0 && rel < 512; return ok ? sv + btab[r * 129 + (rel < 128 ? rel : 128)] : -3.0e38f; }, lane);
    }
  }
  __syncthreads();
  sa_softmax_row(Pc, 128, w, lane);
  sa_softmax_row(Pw, 576, w, lane);
  __syncthreads();
  if (w == 0) {
    if (lane < 33) {
      const int j = lane; float sm = 0.f;
      for (int u = -1; u <= 3; ++u) { const int n = 4 * j + u; if (n >= 0 && n < 127) { const float4 p4 = *(const float4*)(Pc + n * 4); sm += (p4.x + p4.y + p4.z + p4.w) * ((u == -1 || u == 3) ? 1.f : 2.f); } }
      imp[j] = sm;
    }
    if (lane == 0) {
      sel[0] = 0; sel[1] = 31; sel[2] = 32;
      unsigned taken = 0u;
      for (int c = 0; c < 5; ++c) {
        float best = -1.f; int bi = 1;
        for (int j = 1; j <= 30; ++j) { const float v = imp[j]; if (!((taken >> j) & 1u) && v > best) { best = v; bi = j; } }
        taken |= 1u << bi; sel[3 + c] = bi;
      }
    }
  }
  __syncthreads();
  for (int jj = w; jj < 8; jj += 4) {
    const int blk = sel[jj];
    const float* kbase = (blk < 32) ? (p.csk + (((size_t)pts[blk >> 1] * 128 + (blk & 1) * 64) * 2 + g) * 64) : fresh_sk;
    sa_tile4(q4, Ps + jj * 256,
             [&](int k, int c) { const int kk = (blk < 32) ? k : (k & 3); return *(const float4*)(kbase + (size_t)kk * 128 + c * 4); },
             [&](int k, int r, float sv) { const int rel = qpos - (blk * 64 + k); const bool ok = (blk < 32 || k < 4) && rel >= 0;
               return ok ? sv + btab[r * 129 + (rel < 0 ? 0 : (rel < 128 ? rel : 128))] : -3.0e38f; }, lane);
  }
  {
    float oc[4] = {0.f, 0.f, 0.f, 0.f}, ow[4] = {0.f, 0.f, 0.f, 0.f};
    const u16* vc = (const u16*)(p.ws + W_VCMP) + (size_t)(seq * 2 + g) * 128 * 64;
    sa_pv(Pc, 32 * w, (32 * w + 32 < 127) ? 32 * w + 32 : 127, [&](int k, int l) { return bf2f(vc[(size_t)k * 64 + l]); }, lane, oc);
    const float* vst = p.swv + (size_t)b * 512 * 128 + g * 64;
    sa_pv(Pw, 129 * w, 129 * w + 129, [&](int k, int l) { const float* rp = (k < 512) ? (vst + (size_t)k * 128) : (fresh_wv + (size_t)(k - 512) * 128); return rp[l]; }, lane, ow);
#pragma unroll
    for (int r = 0; r < 4; ++r) { obuf[((0 * 4 + w) * 4 + r) * 64 + lane] = oc[r]; obuf[((1 * 4 + w) * 4 + r) * 64 + lane] = ow[r]; }
  }
  __syncthreads();
  sa_softmax_row(Ps, 512, w, lane);
  __syncthreads();
  {
    float os[4] = {0.f, 0.f, 0.f, 0.f};
    for (int jj = 2 * w; jj < 2 * w + 2; ++jj) {
      const int blk = sel[jj];
      const float* vbase; int ns;
      if (blk < 32) { vbase = p.csv + (((size_t)pts[blk >> 1] * 128 + (blk & 1) * 64) * 2 + g) * 64; ns = 64; } else { vbase = fresh_sv; ns = 4; }
      sa_pv(Ps + jj * 64 * 4, 0, ns, [&](int k, int l) { return vbase[(size_t)k * 128 + l]; }, lane, os);
    }
#pragma unroll
    for (int r = 0; r < 4; ++r) obuf[((2 * 4 + w) * 4 + r) * 64 + lane] = os[r];
  }
  __syncthreads();
  {
    const int r = tid >> 6, hd = g * 4 + r;
    const float* gt = (const float*)(p.ws + W_GATE) + tok * 24;
    float o = 0.f;
#pragma unroll
    for (int br = 0; br < 3; ++br) {
      float a = 0.f;
#pragma unroll
      for (int ww = 0; ww < 4; ++ww) a += obuf[((br * 4 + ww) * 4 + r) * 64 + lane];
      o += gt[(br == 0 ? 0 : (br == 1 ? 16 : 8)) + hd] * a;
    }
    ((u16*)(p.ws + W_OA))[tok * 512 + hd * 64 + lane] = f2bf(o * bf2f(((const u16*)(p.ws + W_ZA))[tok * 512 + hd * 64 + lane]));
  }
}

constexpr int P2_HP = BATCH * 4 * 32;
constexpr int P2_CMP = BATCH * 2 * 2;
constexpr int P2_SA = DEC_BATCH * 2 * 4;
constexpr int P2_HS = DEC_BATCH * 4;
constexpr int P2_TOTAL = P2_HP + P2_CMP + P2_SA + P2_HS;
DI void phase2_item(const Params& p, int it, char* lds) {
  if (it < P2_SA) { sample_attn_item(p, it, lds); return; }
  it -= P2_SA;
  if (it < P2_CMP) {
    const int kv = it & 1, g = (it >> 1) & 1, b = it >> 2;
    LoadCellBf16 al{(const u16*)(p.ws + W_KV) + (size_t)kv * NT * 128 + (size_t)b * 2048 * 128 + g * 64};
    comp_tile(p, al, b, g, kv, lds); return;
  }
  it -= P2_CMP;
  if (it < P2_HS) { hgrn_sample_item(p, it, lds); return; }
  it -= P2_HS;
  hgrn_h1_item(p, it, lds);
}

constexpr int AKS = 72, AVS = 68, ACS = 132;
DI bf16x8 pack8(const f32x16& x, int s2) {
  uint4 u; u.x = pk2(x[8 * s2], x[8 * s2 + 1]); u.y = pk2(x[8 * s2 + 2], x[8 * s2 + 3]);
  u.z = pk2(x[8 * s2 + 4], x[8 * s2 + 5]); u.w = pk2(x[8 * s2 + 6], x[8 * s2 + 7]);
  return __builtin_bit_cast(bf16x8, u);
}
DI void zero16(f32x16& x) {
#pragma unroll
  for (int i = 0; i < 16; ++i) x[i] = 0.f;
}

template <bool WIN, bool FAST>
DI void attn_tile(const u16* Kt, const u16* Vt, const float* brel_r, float cfar, const bf16x8 (&qf)[4], int qpos, int kpos0, bool lane_on,
                  float& m_run, float& l_run, f32x16 (&oacc)[2], int ql, int hh) {
  f32x16 sacc[2];
#pragma unroll
  for (int kt = 0; kt < 2; ++kt) {
    zero16(sacc[kt]);
#pragma unroll
    for (int ks = 0; ks < 4; ++ks) {
      const bf16x8 kf = *(const bf16x8*)(Kt + (32 * kt + ql) * AKS + 16 * ks + 8 * hh);
      sacc[kt] = MFMA32(kf, qf[ks], sacc[kt]);
    }
  }
  float mt = -1.0e30f;
  if (FAST) {
#pragma unroll
    for (int kt = 0; kt < 2; ++kt)
#pragma unroll
      for (int i = 0; i < 16; ++i) mt = fmaxf(mt, sacc[kt][i]);
    mt = lane_on ? mt + cfar : -1.0e30f;
  } else {
#pragma unroll
    for (int kt = 0; kt < 2; ++kt)
#pragma unroll
      for (int i = 0; i < 16; ++i) {
        const int rel = qpos - (kpos0 + 32 * kt + crow(i, hh));
        const bool ok = lane_on && rel >= 0 && (!WIN || rel < 512);
        const float sv = sacc[kt][i] + brel_r[rel < 0 ? 0 : (rel < 128 ? rel : 128)];
        sacc[kt][i] = ok ? sv : -1.0e30f;
        mt = fmaxf(mt, sacc[kt][i]);
      }
  }
  mt = fmaxf(mt, __shfl_xor(mt, 32));
  const float mn = fmaxf(m_run, mt);
  if (!__all(mn == m_run)) {
    const float alpha = __builtin_amdgcn_exp2f(m_run - mn);
    l_run *= alpha;
#pragma unroll
    for (int dt = 0; dt < 2; ++dt)
#pragma unroll
      for (int i = 0; i < 16; ++i) oacc[dt][i] *= alpha;
  }
  m_run = mn;
  float ls = 0.f;
  if (FAST) {
    const float dsh = lane_on ? cfar - mn : -1.0e30f;
#pragma unroll
    for (int kt = 0; kt < 2; ++kt)
#pragma unroll
      for (int i = 0; i < 16; ++i) { const float pv = __builtin_amdgcn_exp2f(sacc[kt][i] + dsh); sacc[kt][i] = pv; ls += pv; }
  } else {
#pragma unroll
    for (int kt = 0; kt < 2; ++kt)
#pragma unroll
      for (int i = 0; i < 16; ++i) {
        const float pv = (sacc[kt][i] > -1.0e29f) ? __builtin_amdgcn_exp2f(sacc[kt][i] - mn) : 0.f;
        sacc[kt][i] = pv; ls += pv;
      }
  }
  l_run += ls;
#pragma unroll
  for (int kt = 0; kt < 2; ++kt)
#pragma unroll
    for (int s2 = 0; s2 < 2; ++s2) {
      const bf16x8 pf = pack8(sacc[kt], s2);
#pragma unroll
      for (int dt = 0; dt < 2; ++dt) {
        const u16* vp = Vt + (32 * kt + 16 * s2 + 4 * hh + ((ql & 15) >> 2)) * AKS + 32 * dt + (ql & 16) + 4 * (ql & 3);
        const bf16x8 vf = cat8(tr_read(vp), tr_read(vp + 8 * AKS));
        oacc[dt] = MFMA32(vf, pf, oacc[dt]);
      }
    }
}

DI void attn_load_tile(u16* Kt, u16* Vt, const u16* ksrc  , const u16* vtsrc  ) {
  const int tid = otid512();
  {
    const int idx = tid, rw = idx >> 3, ch = idx & 7;
    *(uint4*)(Kt + rw * AKS + ch * 8) = *(const uint4*)(ksrc + (size_t)rw * 128 + ch * 8);
    const uint4 v = *(const uint4*)(vtsrc + (size_t)rw * 2048 + ch * 8);
    *(uint2*)(Vt + rw * AVS + ch * 8) = make_uint2(v.x, v.y);
    *(uint2*)(Vt + rw * AVS + ch * 8 + 4) = make_uint2(v.z, v.w);
  }
}

DI void prompt_attn_item(const Params& p, int it, char* lds) {
  const int qt = (it < 256) ? (31 - (it & 31)) : (it & 31), g = (it >> 5) & 1, b = (it >> 6) & 3 | ((it >> 8) << 2);
  const int t0 = qt * 64;
  const int tid = otid512(), lane = tid & 63, w = tid >> 6, ql = lane & 31, hh = lane >> 5, tl = ql >> 2, r = ql & 3;
  const int qpos = t0 + 8 * w + tl, head = g * 4 + r;
  const size_t tok = (size_t)b * 2048 + qpos;
  u16* Kt = (u16*)lds;
  u16* Vt = Kt + 128 * AKS;
  float* brel = (float*)(Vt + 128 * AKS);
  unsigned* wmask = (unsigned*)(brel + 4 * 129);
  const u16* Qb = (const u16*)(p.ws + W_Q);
  __syncthreads();
  for (int i = tid; i < 4 * 129; i += 512) { const int rr = i / 129, rel = i % 129; const int bk = rel < 128 ? T5B[rel] : 31; brel[i] = p.rel_bias[bk * 8 + g * 4 + rr] * LOG2E; }
  bf16x8 qf[4];
#pragma unroll
  for (int ks = 0; ks < 4; ++ks) qf[ks] = *(const bf16x8*)(Qb + tok * 512 + head * 64 + 16 * ks + 8 * hh);
  const float* gt = (const float*)(p.ws + W_GATE) + tok * 24;
  const float* brel_r = brel + r * 129;
  const float cfar = p.rel_bias[31 * 8 + head] * LOG2E;
  f32x16 of[2];
  unsigned selm;
  {
#pragma unroll
    for (int i = 0; i < 2; ++i) {
      const int idx = tid + 512 * i, n = idx >> 3, ch = idx & 7;
      *(uint4*)(Kt + n * AKS + ch * 8) = *(const uint4*)((const u16*)(p.ws + W_KCMP) + ((size_t)(b * 2 + g) * 128 + n) * 64 + ch * 8);
      *(uint4*)(Vt + n * AKS + ch * 8) = *(const uint4*)((const u16*)(p.ws + W_VCMP) + ((size_t)(b * 2 + g) * 128 + n) * 64 + ch * 8);
    }
    __syncthreads();
    f32x16 sacc[4];
#pragma unroll
    for (int kt = 0; kt < 4; ++kt) {
      zero16(sacc[kt]);
#pragma unroll
      for (int ks = 0; ks < 4; ++ks) {
        const bf16x8 kf = *(const bf16x8*)(Kt + (32 * kt + ql) * AKS + 16 * ks + 8 * hh);
        sacc[kt] = MFMA32(kf, qf[ks], sacc[kt]);
      }
    }
    float mt = -1.0e30f;
#pragma unroll
    for (int kt = 0; kt < 4; ++kt)
#pragma unroll
      for (int i = 0; i < 16; ++i) {
        const int n = 32 * kt + crow(i, hh);
        const int rel = qpos - (16 * n + 31);
        const bool ok = rel >= 0 && n < 127;
        const float sv = sacc[kt][i] + brel_r[rel < 0 ? 0 : (rel < 128 ? rel : 128)];
        sacc[kt][i] = ok ? sv : -1.0e30f;
        mt = fmaxf(mt, sacc[kt][i]);
      }
    mt = fmaxf(mt, __shfl_xor(mt, 32));
    float ls = 0.f;
#pragma unroll
    for (int kt = 0; kt < 4; ++kt)
#pragma unroll
      for (int i = 0; i < 16; ++i) { const float pv = (sacc[kt][i] > -1.0e29f) ? __builtin_amdgcn_exp2f(sacc[kt][i] - mt) : 0.f; sacc[kt][i] = pv; ls += pv; }
    ls += __shfl_xor(ls, 32);
    const float inv = ls > 0.f ? 1.f / ls : 0.f;
#pragma unroll
    for (int kt = 0; kt < 4; ++kt)
#pragma unroll
      for (int i = 0; i < 16; ++i) sacc[kt][i] *= inv;
    f32x16 oc[2]; zero16(oc[0]); zero16(oc[1]);
#pragma unroll
    for (int kt = 0; kt < 4; ++kt)
#pragma unroll
      for (int s2 = 0; s2 < 2; ++s2) {
        const bf16x8 pf = pack8(sacc[kt], s2);
#pragma unroll
        for (int dt = 0; dt < 2; ++dt) {
          const u16* vp = Vt + (32 * kt + 16 * s2 + 4 * hh + ((ql & 15) >> 2)) * AKS + 32 * dt + (ql & 16) + 4 * (ql & 3);
          const bf16x8 vf = cat8(tr_read(vp), tr_read(vp + 8 * AKS));
          oc[dt] = MFMA32(vf, pf, oc[dt]);
        }
      }
    const float g0 = gt[head];
#pragma unroll
    for (int dt = 0; dt < 2; ++dt)
#pragma unroll
      for (int i = 0; i < 16; ++i) of[dt][i] = g0 * oc[dt][i];
    float im[16], cm[16];
#pragma unroll
    for (int kt = 0; kt < 4; ++kt)
#pragma unroll
      for (int q4 = 0; q4 < 4; ++q4) {
        const float p0 = sacc[kt][4 * q4], p1 = sacc[kt][4 * q4 + 1], p2 = sacc[kt][4 * q4 + 2], p3 = sacc[kt][4 * q4 + 3];
        im[4 * kt + q4] = 2.f * (p0 + p1 + p2) + p3; cm[4 * kt + q4] = p3;
      }
#pragma unroll
    for (int m = 0; m < 16; ++m) cm[m] = __shfl_xor(cm[m], 32);
#pragma unroll
    for (int m = 15; m >= 0; --m) im[m] += hh ? cm[m] : (m > 0 ? cm[m - 1] : 0.f);
#pragma unroll
    for (int m = 0; m < 16; ++m) { im[m] += __shfl_xor(im[m], 1); im[m] += __shfl_xor(im[m], 2); }
    float ev[16], od[16];
#pragma unroll
    for (int m = 0; m < 16; ++m) { const float ot = __shfl_xor(im[m], 32); ev[m] = hh ? ot : im[m]; od[m] = hh ? im[m] : ot; }
    const int cur = qpos >> 6;
    if (cur < 8) selm = (2u << cur) - 1u;
    else {
      selm = 1u | (1u << cur) | (1u << (cur - 1));
      for (int c = 0; c < 5; ++c) {
        float best = -1.f;
#pragma unroll
        for (int J = 0; J < 32; ++J) { const float v = (J <= cur && !((selm >> J) & 1u)) ? ((J & 1) ? od[J >> 1] : ev[J >> 1]) : -1.f; best = fmaxf(best, v); }
        int bi = 32;
#pragma unroll
        for (int J = 31; J >= 0; --J) { const float v = (J <= cur && !((selm >> J) & 1u)) ? ((J & 1) ? od[J >> 1] : ev[J >> 1]) : -1.f; if (v == best) bi = J; }
        if (best >= 0.f) selm |= 1u << bi;
      }
    }
    unsigned um = selm;
    um |= __shfl_xor(um, 4); um |= __shfl_xor(um, 8); um |= __shfl_xor(um, 16);
    if (lane == 0) wmask[w] = um;
  }
  __syncthreads();
  const unsigned un = wmask[0] | wmask[1] | wmask[2] | wmask[3] | wmask[4] | wmask[5] | wmask[6] | wmask[7];
  {
    const u16* ks = (const u16*)(p.ws + W_KV) + (size_t)2 * NT * 128 + (size_t)b * 2048 * 128 + g * 64;
    const u16* vts = (const u16*)(p.ws + W_KV) + (size_t)3 * NT * 128 + (size_t)b * 2048 * 128 + g * 64;
    const u16* kw = (const u16*)(p.ws + W_KV) + (size_t)4 * NT * 128 + (size_t)b * 2048 * 128 + g * 64;
    const u16* vtw = (const u16*)(p.ws + W_KV) + (size_t)5 * NT * 128 + (size_t)b * 2048 * 128 + g * 64;
    const int rw = tid >> 3, ch = tid & 7;
    uint4 kreg, vreg;
#define ATT_PREFETCH(kb, vb, j_) do { kreg = *(const uint4*)((kb) + ((size_t)(j_) * 64 + rw) * 128 + ch * 8); vreg = *(const uint4*)((vb) + ((size_t)(j_) * 64 + rw) * 128 + ch * 8); } while (0)
#define ATT_COMMIT() do { *(uint4*)(Kt + rw * AKS + ch * 8) = kreg; *(uint4*)(Vt + rw * AKS + ch * 8) = vreg; } while (0)
    const int jlo = (t0 >= 511) ? ((t0 - 511) >> 6) : 0, jhi = (t0 + 63) >> 6;
    {
      float m_run = -1.0e30f, l_run = 0.f; f32x16 oacc[2]; zero16(oacc[0]); zero16(oacc[1]);
      unsigned rem = un;
      int j = __builtin_ctz(rem); rem &= rem - 1u;
      ATT_PREFETCH(ks, vts, j);
      for (;;) {
        __syncthreads();
        ATT_COMMIT();
        __syncthreads();
        const int jn = rem ? __builtin_ctz(rem) : -1;
        if (jn >= 0) { rem &= rem - 1u; ATT_PREFETCH(ks, vts, jn); } else { ATT_PREFETCH(kw, vtw, jlo); }
        const bool on = (selm >> j) & 1u;
        if (__ballot(on) != 0ull) {
          if (64 * j + 63 + 128 <= t0 + 8 * w) attn_tile<false, true>(Kt, Vt, brel_r, cfar, qf, qpos, j * 64, on, m_run, l_run, oacc, ql, hh);
          else attn_tile<false, false>(Kt, Vt, brel_r, cfar, qf, qpos, j * 64, on, m_run, l_run, oacc, ql, hh);
        }
        if (jn < 0) break;
        j = jn;
      }
      l_run += __shfl_xor(l_run, 32);
      const float sc = gt[8 + head] * (l_run > 0.f ? 1.f / l_run : 0.f);
#pragma unroll
      for (int dt = 0; dt < 2; ++dt)
#pragma unroll
        for (int i = 0; i < 16; ++i) of[dt][i] += sc * oacc[dt][i];
    }
    {
      float m_run = -1.0e30f, l_run = 0.f; f32x16 oacc[2]; zero16(oacc[0]); zero16(oacc[1]);
      for (int j = jlo; j <= jhi; ++j) {
        __syncthreads();
        ATT_COMMIT();
        __syncthreads();
        if (j < jhi) ATT_PREFETCH(kw, vtw, j + 1);
        if (64 * j + 63 + 128 <= t0 + 8 * w && 64 * j + 511 >= t0 + 8 * w + 7) attn_tile<true, true>(Kt, Vt, brel_r, cfar, qf, qpos, j * 64, true, m_run, l_run, oacc, ql, hh);
        else attn_tile<true, false>(Kt, Vt, brel_r, cfar, qf, qpos, j * 64, true, m_run, l_run, oacc, ql, hh);
      }
      l_run += __shfl_xor(l_run, 32);
      const float sc = gt[16 + head] * (l_run > 0.f ? 1.f / l_run : 0.f);
#pragma unroll
      for (int dt = 0; dt < 2; ++dt)
#pragma unroll
        for (int i = 0; i < 16; ++i) of[dt][i] += sc * oacc[dt][i];
    }
#undef ATT_PREFETCH
#undef ATT_COMMIT
  }
  {
    const u16* za = (const u16*)(p.ws + W_ZA) + tok * 512 + head * 64; u16* oa = (u16*)(p.ws + W_OA) + tok * 512 + head * 64;
#pragma unroll
    for (int dt = 0; dt < 2; ++dt)
#pragma unroll
      for (int q4 = 0; q4 < 4; ++q4) {
        const int dd = 32 * dt + 8 * q4 + 4 * hh;
        const uint2 z = *(const uint2*)(za + dd);
        uint2 o; o.x = pk2(of[dt][4 * q4] * bflo(z.x), of[dt][4 * q4 + 1] * bfhi(z.x)); o.y = pk2(of[dt][4 * q4 + 2] * bflo(z.y), of[dt][4 * q4 + 3] * bfhi(z.y));
        *(uint2*)(oa + dd) = o;
      }
  }
}
constexpr int P3_FIN = BATCH * 4 * 32;
constexpr int P3_ATT = BATCH * 2 * 32;
constexpr int P3_TOTAL = P3_FIN + P3_ATT;

constexpr int P4_TOTAL = 128 * 8 + 4 * 16;
template <int NI>
DI void merge_a_tile_t(const Params& p, int tm, int tn, char* lds) {
  f32x16 aa[2][NI], ab[2][NI]; zero_acc<NI>(aa); zero_acc<NI>(ab);
  gemm_glds<NI>(aa, (const u16*)(p.ws + W_OA) + (size_t)tm * 128 * 512, 512, (const u16*)(p.ws + W_WBAT) + (size_t)tn * 64 * NI * 512, 512, 8, lds);
  gemm_glds<NI>(ab, (const u16*)(p.ws + W_OB) + (size_t)tm * 128 * 512, 512, (const u16*)(p.ws + W_WBBT) + (size_t)tn * 64 * NI * 512, 512, 8, lds);
  const int tid = otid(), lane = tid & 63, wave = tid >> 6, wm = wave >> 1, wn = wave & 1, r = lane & 31, h = lane >> 5;
#pragma unroll
  for (int mi = 0; mi < 2; ++mi)
#pragma unroll
    for (int ni = 0; ni < NI; ++ni) {
      const int c = tn * 64 * NI + wn * 32 * NI + ni * 32 + r;
#pragma unroll
      for (int i = 0; i < 16; ++i) {
        const size_t off = (size_t)(tm * 128 + wm * 64 + mi * 32 + crow(i, h)) * 1024 + c;
        const float y = bf2f(((const u16*)(p.ws + W_SA))[off]) * aa[mi][ni][i] + bf2f(((const u16*)(p.ws + W_SB))[off]) * ab[mi][ni][i];
        ((u16*)(p.ws + W_Y))[off] = f2bf(y);
      }
    }
}
DI void merge_a_tile(const Params& p, int it, char* lds) {
  if (it < 1024) merge_a_tile_t<2>(p, it >> 3, it & 7, lds);
  else { it -= 1024; merge_a_tile_t<1>(p, 128 + (it >> 4), it & 15, lds); }
}
constexpr int P5_TOTAL = 128 * 8 + 4 * 16;
template <int NI>
DI void merge_b_tile_t(const Params& p, int tm, int tn, char* lds) {
  f32x16 acc[2][NI]; zero_acc<NI>(acc);
  gemm_glds<NI>(acc, (const u16*)(p.ws + W_Y) + (size_t)tm * 128 * 1024, 1024, (const u16*)(p.ws + W_WOUTT) + (size_t)tn * 64 * NI * 1024, 1024, 16, lds);
  const int tid = otid(), lane = tid & 63, wave = tid >> 6, wm = wave >> 1, wn = wave & 1, r = lane & 31, h = lane >> 5;
  const float* xin = (tm < 128) ? p.x_prompt : (p.x_sample - (size_t)NTP * 1024);
#pragma unroll
  for (int mi = 0; mi < 2; ++mi) {
#pragma unroll
    for (int i = 0; i < 16; ++i) {
      const size_t row = (size_t)(tm * 128 + wm * 64 + mi * 32 + crow(i, h));
#pragma unroll
      for (int ni = 0; ni < NI; ++ni) {
        const int c = tn * 64 * NI + wn * 32 * NI + ni * 32 + r;
        p.out[row * 1024 + c] = acc[mi][ni][i] + xin[row * 1024 + c];
      }
    }
  }
}
DI void merge_b_tile(const Params& p, int it, char* lds) {
  if (it < 1024) merge_b_tile_t<2>(p, it >> 3, it & 7, lds);
  else { it -= 1024; merge_b_tile_t<1>(p, 128 + (it >> 4), it & 15, lds); }
}
constexpr int P6_TOTAL = NT / 8;
DI void final_norm_item(const Params& p, int it) {
  const int tid_ = otid(), lane = tid_ & 63, wave = tid_ >> 6; const size_t row = (size_t)it * 8 + wave * 2;
  float* o = p.out + row * 1024;
  float4 v[2][4]; float ss[2] = {0.f, 0.f};
#pragma unroll
  for (int rr = 0; rr < 2; ++rr)
#pragma unroll
    for (int i = 0; i < 4; ++i) v[rr][i] = *(const float4*)(o + rr * 1024 + (i * 64 + lane) * 4);
#pragma unroll
  for (int rr = 0; rr < 2; ++rr) {
#pragma unroll
    for (int i = 0; i < 4; ++i) ss[rr] += v[rr][i].x * v[rr][i].x + v[rr][i].y * v[rr][i].y + v[rr][i].z * v[rr][i].z + v[rr][i].w * v[rr][i].w;
    ss[rr] = wave_sum(ss[rr]);
  }
#pragma unroll
  for (int rr = 0; rr < 2; ++rr) {
    const float rs = rsqrtf(ss[rr] * (1.f / 1024.f) + 1e-6f);
#pragma unroll
    for (int i = 0; i < 4; ++i) {
      const float4 gg = *(const float4*)(p.final_g + (i * 64 + lane) * 4);
      *(float4*)(o + rr * 1024 + (i * 64 + lane) * 4) = make_float4(v[rr][i].x * rs * gg.x, v[rr][i].y * rs * gg.y, v[rr][i].z * rs * gg.z, v[rr][i].w * rs * gg.w);
    }
  }
}

namespace pg8 {
#define PG8_LAS __attribute__((address_space(3)))
typedef unsigned short bf16_t;
typedef short bf16x8 __attribute__((ext_vector_type(8)));
typedef float f32x4 __attribute__((ext_vector_type(4)));
typedef unsigned u32x4 __attribute__((ext_vector_type(4)));
constexpr int BM = 256, BK = 64, HALF = 128, HTB = HALF * BK * 2  , STAGE_BYTES = 8 * HTB, NXCD = 8, WGM = 8;

__host__ __device__ __forceinline__ int lds_byte(int r, int c) { const int st = (r >> 4) * 2 + (c >> 5), rr = r & 15, cc = c & 31, ob = rr * 64 + cc * 2; return st * 1024 + (ob ^ (((ob >> 9) & 1) << 5)); }
__host__ __device__ __forceinline__ void stage_rc(int b, int& R, int& C) { const int st = b / 1024, sb = b % 1024, swz = sb ^ (((sb >> 9) & 1) << 5); R = (st >> 1) * 16 + swz / 64; C = (st & 1) * 32 + (swz % 64) / 2; }
__host__ __device__ __forceinline__ int perm32(int rho) { const int n = rho >> 4, i = rho & 15; return 8 * (i >> 2) + 4 * n + (i & 3); }

struct Unit { int pm, pn; };
struct Gemm { const bf16_t* A; const bf16_t* Bt; int M, N, K; };

struct StaticOrder {
    int nM, nN, nwg, G, c;
    __host__ __device__ void init(int M, int N, int G_, int c_) { nM = M / BM; nN = N / BM; nwg = nM * nN; G = G_; c = c_; }
    __host__ __device__ bool next(int i, Unit& u) const {
        const long L = (long)i * G + c; if (L >= nwg) return false;
        int wgid = (int)L; { const int q = nwg / NXCD, r = nwg % NXCD, xcd = wgid % NXCD, off = wgid / NXCD; wgid = (xcd < r ? xcd * (q + 1) : r * (q + 1) + (xcd - r) * q) + off; }
        const int nig = WGM * nN, gid = wgid / nig, fm = gid * WGM, gsz = (nM - fm) < WGM ? (nM - fm) : WGM;
        u.pm = fm + ((wgid % nig) % gsz); u.pn = (wgid % nig) / gsz; return true;
    }
    __device__ __forceinline__ void a_ready(const Unit&) const {}
    __device__ __forceinline__ void done(const Unit&) const {}
};

template <class Epi, class Sched, bool STAMP = false>
__device__ __forceinline__ void gemm_phase(PG8_LAS unsigned char* lds, const Gemm g, const Sched& S, const Epi& E, unsigned long long* stamps) {
    int tid_ = threadIdx.x; asm volatile("" : "+v"(tid_));
    const int tid = tid_, wid = __builtin_amdgcn_readfirstlane(tid >> 6), lane = tid & 63, wr = wid >> 2, wc = wid & 3, fr = lane & 15, fq = lane >> 4;
    const int K = g.K, nt = K / BK;
    int ts_lo = 0, ts_hi = 0, nts = 0; const unsigned long long rt_entry = STAMP ? (unsigned long long)wall_clock64() : 0ull;
#define PG8_STAMP() do { if (STAMP && wid == 0 && nts < 64) { const unsigned long long _c = (unsigned long long)clock64(); \
        ts_lo = (lane == nts) ? (int)(unsigned)_c : ts_lo; ts_hi = (lane == nts) ? (int)(unsigned)(_c >> 32) : ts_hi; ++nts; } } while (0)
    PG8_STAMP();
    unsigned voffA[2], voffB[2];
#pragma unroll
    for (int i = 0; i < 2; ++i) { int R, C; stage_rc(tid * 16 + i * 8192, R, C); const int Rb = Epi::PERM ? ((R & ~31) + perm32(R & 31)) : R;
        voffA[i] = (unsigned)(R * K + C) * 2u; voffB[i] = (unsigned)(Rb * K + C) * 2u; }
    const size_t kstep = (size_t)(BK * 2);
    const size_t hstep = (size_t)HALF * K * 2;
    const size_t tstep = 2 * hstep;
    const unsigned ldsw = (unsigned)wid * 1024u;
    const int aoff = lds_byte(wr * 64 + fr, fq * 8), boff = lds_byte(wc * 32 + fr, fq * 8);
#define PG8_SA(b, h) (((b) * 2 + (h)) * HTB)
#define PG8_SB(b, h) ((4 + (b) * 2 + (h)) * HTB)
#define PG8_STAGE(bufoff, gbase, voff) do { _Pragma("unroll") for (int _i = 0; _i < 2; ++_i) \
        __builtin_amdgcn_global_load_lds((const unsigned*)((const char*)(gbase) + (voff)[_i]), (PG8_LAS unsigned*)(lds + (bufoff) + ldsw + _i * 8192), 16, 0, 0); } while (0)
#define PG8_LDA(dst, b, h) do { _Pragma("unroll") for (int m = 0; m < 4; ++m) _Pragma("unroll") for (int k = 0; k < 2; ++k) dst[m][k] = *(const PG8_LAS bf16x8*)(lds + PG8_SA(b, h) + aoff + m * 2048 + k * 1024); } while (0)
#define PG8_LDB(dst, b, h) do { _Pragma("unroll") for (int n = 0; n < 2; ++n) _Pragma("unroll") for (int k = 0; k < 2; ++k) dst[n][k] = *(const PG8_LAS bf16x8*)(lds + PG8_SB(b, h) + boff + n * 2048 + k * 1024); } while (0)
#define PG8_MMA(ai, bj, At, Bt) do { __builtin_amdgcn_s_setprio(1); _Pragma("unroll") for (int m = 0; m < 4; ++m) _Pragma("unroll") for (int n = 0; n < 2; ++n) _Pragma("unroll") for (int k = 0; k < 2; ++k) \
        acc[ai][bj][m][n] = __builtin_amdgcn_mfma_f32_16x16x32_bf16(Bt[n][k], At[m][k], acc[ai][bj][m][n], 0, 0, 0); __builtin_amdgcn_s_setprio(0); } while (0)
#define PG8_WAIT_V(n) asm volatile("s_waitcnt vmcnt(" #n ")" ::: "memory")
#define PG8_WAIT_L(n) asm volatile("s_waitcnt lgkmcnt(" #n ")" ::: "memory")
#define PG8_BAR __builtin_amdgcn_s_barrier()
#define PG8_SCHED __builtin_amdgcn_sched_barrier(0)
    Unit cur, nxt; int ui = 0;
    if (!S.next(0, cur)) return;
    f32x4 acc[2][2][4][2];
#pragma unroll
    for (int a = 0; a < 2; ++a)
#pragma unroll
        for (int b = 0; b < 2; ++b)
#pragma unroll
            for (int m = 0; m < 4; ++m)
#pragma unroll
                for (int n = 0; n < 2; ++n) acc[a][b][m][n] = (f32x4){0.f, 0.f, 0.f, 0.f};
    bf16x8 At[4][2], B0[2][2], B1[2][2];
    const char* cA = (const char*)g.A + (size_t)cur.pm * tstep; const char* cB = (const char*)g.Bt + (size_t)cur.pn * tstep;
    S.a_ready(cur);
    PG8_STAGE(PG8_SB(0, 0), cB, voffB); PG8_STAGE(PG8_SA(0, 0), cA, voffA); PG8_STAGE(PG8_SB(0, 1), cB + hstep, voffB); PG8_STAGE(PG8_SA(0, 1), cA + hstep, voffA);
    if (wr == 1) PG8_BAR;
    PG8_WAIT_V(4); PG8_BAR;
    PG8_STAGE(PG8_SB(1, 0), cB + kstep, voffB); PG8_STAGE(PG8_SA(1, 0), cA + kstep, voffA); PG8_STAGE(PG8_SB(1, 1), cB + hstep + kstep, voffB);
    PG8_WAIT_V(6); PG8_BAR;
    PG8_STAMP();
    for (;;) {
        const bool has_next = S.next(ui + 1, nxt);
        const char* nA = has_next ? (const char*)g.A + (size_t)nxt.pm * tstep : cA; const char* nB = has_next ? (const char*)g.Bt + (size_t)nxt.pn * tstep : cB;
        for (int t = 0; t < nt; t += 2) {
            const bool last = (t == nt - 2);
            const char* a1 = cA + (size_t)(t + 1) * kstep;
            const char* a2 = last ? nA : cA + (size_t)(t + 2) * kstep; const char* b2 = last ? nB : cB + (size_t)(t + 2) * kstep;
            const char* a3 = a2 + kstep; const char* b3 = b2 + kstep;
            if (last && has_next) S.a_ready(nxt);
            PG8_LDB(B0, 0, 0); PG8_SCHED; PG8_LDA(At, 0, 0); PG8_STAGE(PG8_SA(1, 1), a1 + hstep, voffA);
            PG8_WAIT_L(8); PG8_BAR; PG8_WAIT_L(0); PG8_MMA(0, 0, At, B0); PG8_BAR; PG8_SCHED;
            PG8_LDB(B1, 0, 1); PG8_STAGE(PG8_SB(0, 0), b2, voffB);
            PG8_BAR; PG8_WAIT_L(0); PG8_MMA(0, 1, At, B1); PG8_BAR;
            PG8_LDA(At, 0, 1); PG8_STAGE(PG8_SA(0, 0), a2, voffA);
            PG8_BAR; PG8_WAIT_L(0); PG8_MMA(1, 0, At, B0); PG8_BAR; PG8_SCHED;
            PG8_STAGE(PG8_SB(0, 1), b2 + hstep, voffB);
            PG8_WAIT_V(6); PG8_BAR; PG8_MMA(1, 1, At, B1); PG8_BAR;
            PG8_LDB(B0, 1, 0); PG8_SCHED; PG8_LDA(At, 1, 0); PG8_STAGE(PG8_SA(0, 1), a2 + hstep, voffA);
            PG8_WAIT_L(8); PG8_BAR; PG8_WAIT_L(0); PG8_MMA(0, 0, At, B0); PG8_BAR; PG8_SCHED;
            PG8_LDB(B1, 1, 1); PG8_STAGE(PG8_SB(1, 0), b3, voffB);
            PG8_BAR; PG8_WAIT_L(0); PG8_MMA(0, 1, At, B1); PG8_BAR;
            PG8_LDA(At, 1, 1); PG8_STAGE(PG8_SA(1, 0), a3, voffA);
            PG8_BAR; PG8_WAIT_L(0); PG8_MMA(1, 0, At, B0); PG8_BAR; PG8_SCHED;
            PG8_STAGE(PG8_SB(1, 1), b3 + hstep, voffB);
            PG8_WAIT_V(6); PG8_BAR; PG8_MMA(1, 1, At, B1); PG8_BAR;
        }
        PG8_STAMP();
        if constexpr (!Epi::AFTER_DRAIN) { E(acc, cur, wr, wc, fr, fq); S.done(cur); }
        PG8_STAMP();
        if (!has_next) break;
#pragma unroll
        for (int a = 0; a < 2; ++a)
#pragma unroll
            for (int b = 0; b < 2; ++b)
#pragma unroll
                for (int m = 0; m < 4; ++m)
#pragma unroll
                    for (int n = 0; n < 2; ++n) acc[a][b][m][n] = (f32x4){0.f, 0.f, 0.f, 0.f};
        cur = nxt; cA = nA; cB = nB; ++ui;
    }
    PG8_WAIT_V(0);
    if (wr == 0) PG8_BAR;
    PG8_BAR;
    if constexpr (Epi::AFTER_DRAIN) { E.fused(acc, cur, wr, wc, fr, fq, lds, wid, lane); S.done(cur); }
    PG8_STAMP();
    if (STAMP && wid == 0) { stamps[lane] = lane < nts ? (((unsigned long long)(unsigned)ts_hi << 32) | (unsigned)ts_lo) : 0ull;
        if (lane == 62) stamps[62] = rt_entry; if (lane == 63) stamps[63] = (unsigned long long)wall_clock64(); }
#undef PG8_STAMP
#undef PG8_SA
#undef PG8_SB
#undef PG8_STAGE
#undef PG8_LDA
#undef PG8_LDB
#undef PG8_MMA
#undef PG8_WAIT_V
#undef PG8_WAIT_L
#undef PG8_BAR
#undef PG8_SCHED
}
}


DI uint4 pack8f(const float (&v)[8]) { uint4 u; u.x = pk2(v[0], v[1]); u.y = pk2(v[2], v[3]); u.z = pk2(v[4], v[5]); u.w = pk2(v[6], v[7]); return u; }
struct EpiProj {
  static constexpr bool PERM = true, AFTER_DRAIN = false;
  Params p;
  DI void operator()(const pg8::f32x4 (&acc)[2][2][4][2], const pg8::Unit& u, int wr, int wc, int fr, int fq) const {
    const bool samp = u.pm >= NTP / 256;
#pragma unroll
    for (int bj = 0; bj < 2; ++bj) {
      const int tn = 2 * u.pn + bj;
      const int c = wc * 32 + 8 * fq;
      if (tn >= 47 || (tn == 46 && c >= 24)) continue;
      float lb[8];
      if (tn >= 18 && tn < 22) {
#pragma unroll
        for (int j = 0; j < 8; ++j) { const int cc = (tn - 18) * 128 + c + j; lb[j] = 1.f / (1.f + __expf(p.hg_lower[512 + cc] - p.hg_lower[cc])); }
      }
#pragma unroll
      for (int ai = 0; ai < 2; ++ai)
#pragma unroll
        for (int m = 0; m < 4; ++m) {
          const size_t row = (size_t)(u.pm * 256 + ai * 128 + wr * 64 + m * 16 + fr);
          float v[8];
#pragma unroll
          for (int j = 0; j < 4; ++j) { v[j] = acc[ai][bj][m][0][j]; v[4 + j] = acc[ai][bj][m][1][j]; }
          if (tn < 4) {
#pragma unroll
            for (int j = 0; j < 8; ++j) v[j] *= 0.125f * LOG2E;
            *(uint4*)((u16*)(p.ws + W_Q) + row * 512 + tn * 128 + c) = pack8f(v);
          } else if (tn < 10) {
            const int kvg = tn - 4;
            *(uint4*)((u16*)(p.ws + W_KV) + (size_t)kvg * NT * 128 + row * 128 + c) = pack8f(v);
            float* dst = nullptr;
            if (!samp) {
              if (kvg < 4) dst = p.out + O_PCK + (size_t)kvg * NTP * 128 + row * 128 + c;
              else { const int t = (int)row & 2047, b = (int)row >> 11; if (t >= 1536) dst = p.out + O_PWK + (size_t)(kvg - 4) * BATCH * 512 * 128 + ((size_t)b * 512 + t - 1536) * 128 + c; }
            } else {
              const int srow = (int)row - NTP;
              if (kvg < 4) dst = p.out + O_SCK + (size_t)kvg * NTS * 128 + (size_t)srow * 128 + c;
              else dst = p.out + O_SWK + (size_t)(kvg - 4) * DEC_BATCH * 512 * 128 + ((size_t)(srow >> 2) * 512 + 508 + (srow & 3)) * 128 + c;
            }
            if (dst) { *(float4*)dst = make_float4(v[0], v[1], v[2], v[3]); *(float4*)(dst + 4) = make_float4(v[4], v[5], v[6], v[7]); }
          } else if (tn < 14 || (tn >= 26 && tn < 30)) {
            const bool isA = tn < 14;
#pragma unroll
            for (int j = 0; j < 8; ++j) v[j] = siluf_(v[j]);
            *(uint4*)((u16*)(p.ws + (isA ? W_ZA : W_ZB)) + row * 512 + (isA ? tn - 10 : tn - 26) * 128 + c) = pack8f(v);
          } else if (tn < 18 || (tn >= 22 && tn < 26)) {
            const bool isQ = tn < 18;
            *(uint4*)((u16*)(p.ws + (isQ ? W_QB : W_VB)) + row * 512 + (isQ ? tn - 14 : tn - 22) * 128 + c) = pack8f(v);
          } else if (tn < 22) {
            float gg[8], kk[8];
#pragma unroll
            for (int j = 0; j < 8; ++j) { const float sg = sigmoidf_(v[j]); gg[j] = __logf(lb[j] + (1.f - lb[j]) * sg); kk[j] = (1.f - lb[j]) * (1.f - sg); }
            float* dg = (float*)(p.ws + W_GB) + row * 512 + (tn - 18) * 128 + c;
            *(float4*)dg = make_float4(gg[0], gg[1], gg[2], gg[3]); *(float4*)(dg + 4) = make_float4(gg[4], gg[5], gg[6], gg[7]);
            *(uint4*)((u16*)(p.ws + W_KB) + row * 512 + (tn - 18) * 128 + c) = pack8f(kk);
          } else if (tn < 46) {
            const bool isA = tn < 38;
#pragma unroll
            for (int j = 0; j < 8; ++j) v[j] = sigmoidf_(v[j]);
            *(uint4*)((u16*)(p.ws + (isA ? W_SA : W_SB)) + row * 1024 + (isA ? tn - 30 : tn - 38) * 128 + c) = pack8f(v);
          } else {
            float* dgt = (float*)(p.ws + W_GATE) + row * 24 + c;
            *(float4*)dgt = make_float4(sigmoidf_(v[0]), sigmoidf_(v[1]), sigmoidf_(v[2]), sigmoidf_(v[3]));
            *(float4*)(dgt + 4) = make_float4(sigmoidf_(v[4]), sigmoidf_(v[5]), sigmoidf_(v[6]), sigmoidf_(v[7]));
          }
        }
    }
  }
};


struct EpiOut {
  static constexpr bool PERM = false, AFTER_DRAIN = false;
  const float* x; float* out;
  DI void operator()(const pg8::f32x4 (&acc)[2][2][4][2], const pg8::Unit& u, int wr, int wc, int fr, int fq) const {
#pragma unroll
    for (int ai = 0; ai < 2; ++ai)
#pragma unroll
      for (int m = 0; m < 4; ++m) {
        const size_t rowoff = (size_t)(u.pm * 256 + ai * 128 + wr * 64 + m * 16 + fr) * 1024 + u.pn * 256 + wc * 32 + 4 * fq;
#pragma unroll
        for (int bj = 0; bj < 2; ++bj)
#pragma unroll
          for (int n = 0; n < 2; ++n) {
            const size_t off = rowoff + bj * 128 + n * 16;
            const float4 xv = *(const float4*)(x + off);
            *(float4*)(out + off) = make_float4(acc[ai][bj][m][n][0] + xv.x, acc[ai][bj][m][n][1] + xv.y, acc[ai][bj][m][n][2] + xv.z, acc[ai][bj][m][n][3] + xv.w);
          }
      }
  }
};


template <bool SECOND>
struct EpiMerge {
  static constexpr bool PERM = true, AFTER_DRAIN = false;
  const u16* gate; u16* Y;
  DI void operator()(const pg8::f32x4 (&acc)[2][2][4][2], const pg8::Unit& u, int wr, int wc, int fr, int fq) const {
#pragma unroll
    for (int ai = 0; ai < 2; ++ai)
#pragma unroll
      for (int m = 0; m < 4; ++m) {
        const size_t rowoff = (size_t)(u.pm * 256 + ai * 128 + wr * 64 + m * 16 + fr) * 1024 + u.pn * 256 + wc * 32 + 8 * fq;
#pragma unroll
        for (int bj = 0; bj < 2; ++bj) {
          const size_t off = rowoff + bj * 128;
          const uint4 gv = *(const uint4*)(gate + off);
          float v[8];
          v[0] = bflo(gv.x) * acc[ai][bj][m][0][0]; v[1] = bfhi(gv.x) * acc[ai][bj][m][0][1]; v[2] = bflo(gv.y) * acc[ai][bj][m][0][2]; v[3] = bfhi(gv.y) * acc[ai][bj][m][0][3];
          v[4] = bflo(gv.z) * acc[ai][bj][m][1][0]; v[5] = bfhi(gv.z) * acc[ai][bj][m][1][1]; v[6] = bflo(gv.w) * acc[ai][bj][m][1][2]; v[7] = bfhi(gv.w) * acc[ai][bj][m][1][3];
          if (SECOND) {
            const uint4 yv = *(const uint4*)(Y + off);
            v[0] += bflo(yv.x); v[1] += bfhi(yv.x); v[2] += bflo(yv.y); v[3] += bfhi(yv.y); v[4] += bflo(yv.z); v[5] += bfhi(yv.z); v[6] += bflo(yv.w); v[7] += bfhi(yv.w);
          }
          *(uint4*)(Y + off) = pack8f(v);
        }
      }
  }
};

#define XB_TMO      128
#define XB_XCNT(j)  (256  + 64 * (j))
#define XB_XSUB(j)  (1280 + 64 * (j))
#define XB_XGEN(j)  (2304 + 64 * (j))
#define XB_TOP      3328
#define XB_TOPGEN   3392
#define XCD_BAR_WORDS 3456
#define XB_SPIN_CAP (1u << 18)
#define LAS __attribute__((address_space(3)))
DI unsigned xb_ld(unsigned* p)              { return __hip_atomic_load(p, __ATOMIC_RELAXED, __HIP_MEMORY_SCOPE_AGENT); }
DI unsigned xb_add(unsigned* p, unsigned v) { return __hip_atomic_fetch_add(p, v, __ATOMIC_RELAXED, __HIP_MEMORY_SCOPE_AGENT); }
DI unsigned xb_xcc_id() { return (unsigned)__builtin_amdgcn_s_getreg((3 << 11) | 20) & 0xFu; }
#define XB_SPIN(cond, bar) do { unsigned _sp = 0; while (cond) { __builtin_amdgcn_s_sleep(1); \
    if ((++_sp & 255u) == 0u) { if (xb_ld(&(bar)[XB_TMO])) break; if (_sp > XB_SPIN_CAP) { atomicAdd(&(bar)[XB_TMO], 1u); break; } } } } while (0)
struct XcdBarrier { unsigned* bar; unsigned x; volatile LAS unsigned* st; };
DI XcdBarrier xcd_barrier_post(unsigned* bar, volatile LAS unsigned* st) {
  XcdBarrier b; b.bar = bar; b.x = xb_xcc_id(); b.st = st;
  if (threadIdx.x == 0) (void)xb_add(&bar[XB_XCNT(b.x)], 1u);
  return b;
}
DI void xcd_barrier_complete(unsigned* bar, unsigned x, unsigned& nloc, unsigned& nx) {
  const unsigned G = gridDim.x * gridDim.y * gridDim.z;
  unsigned sum, cnt, mine, sp = 0u;
  for (;;) {
    sum = 0u; cnt = 0u; mine = 0u;
#pragma unroll
    for (unsigned j = 0; j < 16; ++j) { const unsigned c = xb_ld(&bar[XB_XCNT(j)]); sum += c; cnt += (c > 0u) ? 1u : 0u; mine = (j == x) ? c : mine; }
    if (sum == G) break;
    __builtin_amdgcn_s_sleep(1);
    if ((++sp & 255u) == 0u) { if (xb_ld(&bar[XB_TMO])) break; if (sp > XB_SPIN_CAP) { atomicAdd(&bar[XB_TMO], 1u); break; } }
  }
  nloc = mine > 0u ? mine : 1u; nx = cnt > 0u ? cnt : 1u;
}
DI void xcd_barrier(XcdBarrier& b) {
  asm volatile("s_waitcnt vmcnt(0)" ::: "memory");
  __syncthreads();
  if (threadIdx.x == 0) {
    unsigned* bar = b.bar;
    __builtin_amdgcn_s_waitcnt(0);
    unsigned nloc = b.st[0], nx = b.st[1];
    if (nloc == 0u) { xcd_barrier_complete(bar, b.x, nloc, nx); b.st[0] = nloc; b.st[1] = nx; }
    const unsigned old = xb_add(&bar[XB_XSUB(b.x)], 1u);
    const unsigned gen = old / nloc;
    if (old + 1u == (gen + 1u) * nloc) {
      __builtin_amdgcn_fence(__ATOMIC_RELEASE, "agent");
      asm volatile("s_waitcnt vmcnt(0)" ::: "memory");
      const unsigned og = xb_add(&bar[XB_TOP], 1u);
      const unsigned tg = og / nx;
      if (og + 1u == (tg + 1u) * nx) xb_add(&bar[XB_TOPGEN], 1u);
      else XB_SPIN(xb_ld(&bar[XB_TOPGEN]) == tg, bar);
      __builtin_amdgcn_fence(__ATOMIC_ACQUIRE, "agent");
      xb_add(&bar[XB_XGEN(b.x)], 1u);
      asm volatile("s_waitcnt vmcnt(0)" ::: "memory");
    } else {
      XB_SPIN(xb_ld(&bar[XB_XGEN(b.x)]) == gen, bar);
      __builtin_amdgcn_fence(__ATOMIC_ACQUIRE, "agent");
      asm volatile("s_waitcnt vmcnt(0)" ::: "memory");
    }
  }
  __syncthreads();
}


template <int PH>
DI void run_phase(const Params& p, char* lds_all) {
  const int half = __builtin_amdgcn_readfirstlane(threadIdx.x >> 8);
  const int vb = blockIdx.x * 2 + half, nvb = gridDim.x * 2;
  char* lds = lds_all + half * 65536;
  if (PH == 0) { for (int it = vb; it < P0_TOTAL; it += nvb) phase0_item(p, it, lds); }
  if (PH == 1) {
    for (int it = vb; it < P1_CMP; it += nvb) phase1_item(p, it, lds);
    __syncthreads();
    pg8::StaticOrder S; S.init(NT, NPAD, gridDim.x, blockIdx.x);
    const pg8::Gemm gm{(const pg8::bf16_t*)(p.ws + W_XN), (const pg8::bf16_t*)(p.ws + W_WINT), NT, NPAD, 1024};
    const EpiProj E{p};
    pg8::gemm_phase<EpiProj, pg8::StaticOrder, false>((PG8_LAS unsigned char*)lds_all, gm, S, E, nullptr);
  }
  if (PH == 2) {
    volatile LAS unsigned* wq = (volatile LAS unsigned*)(lds_all + 128 * 1024 + 8);
    unsigned* ctr = (unsigned*)(p.ws + W_BAR);
    for (;;) {
      __syncthreads();
      if (threadIdx.x == 0) wq[0] = __hip_atomic_fetch_add(ctr, 1u, __ATOMIC_RELAXED, __HIP_MEMORY_SCOPE_AGENT);
      __syncthreads();
      const unsigned pr = wq[0];
      if (pr >= (unsigned)(P2_TOTAL / 2)) break;
      phase2_item(p, (int)pr * 2 + half, lds);
    }
  }
  if (PH == 7) { for (int it = vb; it < H2_ITEMS; it += nvb) hgrn_h2_item(p, it); }
  if (PH == 3) {
    for (int it = vb; it < P3_FIN; it += nvb) hgrn_h3_item(p, it);
    for (int it = blockIdx.x; it < P3_ATT; it += gridDim.x) prompt_attn_item(p, it, lds_all);
  }
  if (PH == 4) {
    for (int it = vb; it < 64; it += nvb) merge_a_tile_t<1>(p, 128 + (it >> 4), it & 15, lds);
    __syncthreads();
    pg8::StaticOrder S; S.init(NTP, 1024, gridDim.x, blockIdx.x);
    { const pg8::Gemm gm{(const pg8::bf16_t*)(p.ws + W_OA), (const pg8::bf16_t*)(p.ws + W_WBAT), NTP, 1024, 512};
      const EpiMerge<false> E{(const u16*)(p.ws + W_SA), (u16*)(p.ws + W_Y)};
      pg8::gemm_phase<EpiMerge<false>, pg8::StaticOrder, false>((PG8_LAS unsigned char*)lds_all, gm, S, E, nullptr); }
    { const pg8::Gemm gm{(const pg8::bf16_t*)(p.ws + W_OB), (const pg8::bf16_t*)(p.ws + W_WBBT), NTP, 1024, 512};
      const EpiMerge<true> E{(const u16*)(p.ws + W_SB), (u16*)(p.ws + W_Y)};
      pg8::gemm_phase<EpiMerge<true>, pg8::StaticOrder, false>((PG8_LAS unsigned char*)lds_all, gm, S, E, nullptr); }
  }
  if (PH == 5) {
    for (int it = vb; it < 64; it += nvb) merge_b_tile_t<1>(p, 128 + (it >> 4), it & 15, lds);
    __syncthreads();
    pg8::StaticOrder S; S.init(NTP, 1024, gridDim.x, blockIdx.x);
    const pg8::Gemm gm{(const pg8::bf16_t*)(p.ws + W_Y), (const pg8::bf16_t*)(p.ws + W_WOUTT), NTP, 1024, 1024};
    const EpiOut E{p.x_prompt, p.out};
    pg8::gemm_phase<EpiOut, pg8::StaticOrder, false>((PG8_LAS unsigned char*)lds_all, gm, S, E, nullptr);
  }
  if (PH == 6) { for (int it = vb; it < P6_TOTAL; it += nvb) final_norm_item(p, it); }
}

constexpr int LDS_DYN = 128 * 1024 + 16;
__global__ void __launch_bounds__(512, 2) k_mega(Params p) {
  extern __shared__ __attribute__((aligned(16))) char lds[];
  volatile LAS unsigned* st = (volatile LAS unsigned*)(lds + 128 * 1024);
  if (threadIdx.x == 0) { st[0] = 0u; st[1] = 0u; }
  __syncthreads();
  XcdBarrier bar = xcd_barrier_post((unsigned*)(p.ws + W_BAR), st);
  run_phase<0>(p, lds); xcd_barrier(bar);
  run_phase<1>(p, lds); xcd_barrier(bar);
  run_phase<2>(p, lds); xcd_barrier(bar);
  run_phase<7>(p, lds); xcd_barrier(bar);
  run_phase<3>(p, lds); xcd_barrier(bar);
  run_phase<4>(p, lds); xcd_barrier(bar);
  run_phase<5>(p, lds); xcd_barrier(bar);
  run_phase<6>(p, lds);
}

extern "C" void kernel_launch(void* const* d_in, const int* in_sizes, int n_in, void* d_out, int out_size,
                              void* d_ws, size_t ws_size, hipStream_t stream) {
  Params p{};
  p.x_prompt = (const float*)d_in[0]; p.x_sample = (const float*)d_in[1];
  p.cck = (const float*)d_in[2]; p.ccv = (const float*)d_in[3]; p.csk = (const float*)d_in[4]; p.csv = (const float*)d_in[5];
  p.swk = (const float*)d_in[6]; p.swv = (const float*)d_in[7]; p.shg = (const float*)d_in[8]; p.pt = (const int*)d_in[9];
  p.norm_g = (const float*)d_in[10]; p.w_in = (const float*)d_in[11];
  p.pos_k = (const float*)d_in[12]; p.w1_k = (const float*)d_in[13]; p.w2_k = (const float*)d_in[14];
  p.pos_v = (const float*)d_in[15]; p.w1_v = (const float*)d_in[16]; p.w2_v = (const float*)d_in[17];
  p.rel_bias = (const float*)d_in[18]; p.hg_lower = (const float*)d_in[19]; p.hg_norm_g = (const float*)d_in[20];
  p.w_ba = (const float*)d_in[21]; p.w_bb = (const float*)d_in[22]; p.w_out = (const float*)d_in[23]; p.final_g = (const float*)d_in[24];
  p.out = (float*)d_out; p.ws = (char*)d_ws;
  if ((size_t)out_size != O_END || ws_size < W_END) { fprintf(stderr, "kernel_launch: unexpected sizes out=%d ws=%zu (need %zu / %zu)\n", out_size, ws_size, (size_t)O_END, (size_t)W_END); return; }
  static int grid_blocks = 0;
  if (!grid_blocks) {
    int dev = 0, cus = 0, per_cu = 0;
    hipGetDevice(&dev);
    hipDeviceGetAttribute(&cus, hipDeviceAttributeMultiprocessorCount, dev);
    hipFuncSetAttribute((const void*)k_mega, hipFuncAttributeMaxDynamicSharedMemorySize, LDS_DYN);
    hipOccupancyMaxActiveBlocksPerMultiprocessor(&per_cu, k_mega, 512, LDS_DYN);
    if (per_cu < 1) fprintf(stderr, "kernel_launch: occupancy query reports %d blocks per CU\n", per_cu);
    grid_blocks = cus;
  }
  hipMemsetAsync((char*)d_ws + W_BAR, 0, XCD_BAR_WORDS * 4, stream);
  void* args[] = {&p};
  hipError_t e = hipLaunchCooperativeKernel((void*)k_mega, dim3(grid_blocks), dim3(512), args, LDS_DYN, stream);
  if (e != hipSuccess) fprintf(stderr, "cooperative launch failed: %s (grid %d)\n", hipGetErrorString(e), grid_blocks);
}
```

```cpp
#include <hip/hip_runtime.h>
#include <hip/hip_cooperative_groups.h>
#include <cstdio>
namespace cg = cooperative_groups;

#define DI __device__ __forceinline__
typedef unsigned short u16;
typedef __attribute__((ext_vector_type(8))) short bf16x8;
typedef __attribute__((ext_vector_type(4))) short s16x4;
typedef __attribute__((ext_vector_type(16))) float f32x16;
typedef __attribute__((ext_vector_type(4))) float f32x4;
typedef __attribute__((ext_vector_type(2))) float f32x2;
typedef __attribute__((ext_vector_type(2))) __bf16 bf16x2v;
#define MFMA32(a, b, c) __builtin_amdgcn_mfma_f32_32x32x16_bf16((a), (b), (c), 0, 0, 0)
#define MFMA16(a, b, c) __builtin_amdgcn_mfma_f32_16x16x32_bf16((a), (b), (c), 0, 0, 0)

constexpr int D_MODEL = 1024, BATCH = 8, SEQ = 2048, DEC_BATCH = 128, DEC_SEQ = 4, PAST = 2048;
constexpr int NTP = BATCH * SEQ;
constexpr int NTS = DEC_BATCH * DEC_SEQ;
constexpr int NT = NTP + NTS;
constexpr int IN_COLS = 5912, NPAD = 6144;
constexpr int NSEQ = BATCH + DEC_BATCH;

constexpr size_t O_YP = 0;
constexpr size_t O_YS = O_YP + (size_t)NTP * 1024;
constexpr size_t O_PCK = O_YS + (size_t)NTS * 1024;
constexpr size_t O_PWK = O_PCK + 4 * (size_t)NTP * 128;
constexpr size_t O_PHG = O_PWK + 2 * (size_t)BATCH * 512 * 128;
constexpr size_t O_SCK = O_PHG + (size_t)BATCH * 4 * 128 * 128;
constexpr size_t O_SWK = O_SCK + 4 * (size_t)NTS * 128;
constexpr size_t O_SHG = O_SWK + 2 * (size_t)DEC_BATCH * 512 * 128;
constexpr size_t O_END = O_SHG + (size_t)DEC_BATCH * 4 * 128 * 128;

constexpr size_t al256(size_t x) { return (x + 255) & ~(size_t)255; }
constexpr size_t W_WINT = 0;
constexpr size_t W_WBAT = al256(W_WINT + (size_t)NPAD * 1024 * 2);
constexpr size_t W_WBBT = al256(W_WBAT + (size_t)1024 * 512 * 2);
constexpr size_t W_WOUTT = al256(W_WBBT + (size_t)1024 * 512 * 2);
constexpr size_t W_W1T = al256(W_WOUTT + (size_t)1024 * 1024 * 2);
constexpr size_t W_C1 = al256(W_W1T + (size_t)2 * 128 * 1024 * 2);
constexpr size_t W_XN = al256(W_C1 + 2 * 64 * 4);
constexpr size_t W_Q = al256(W_XN + (size_t)NT * 1024 * 2);
constexpr size_t W_KV = al256(W_Q + (size_t)NT * 512 * 2);
constexpr size_t W_VST = al256(W_KV + (size_t)6 * NT * 128 * 2);
constexpr size_t W_VWT = al256(W_VST + (size_t)8 * 2 * 64 * 2048 * 2);
constexpr size_t W_GATE = al256(W_VWT + (size_t)8 * 2 * 64 * 2048 * 2);
constexpr size_t W_ZA = al256(W_GATE + (size_t)NT * 24 * 4);
constexpr size_t W_QB = al256(W_ZA + (size_t)NT * 512 * 2);
constexpr size_t W_KB = al256(W_QB + (size_t)NT * 512 * 2);
constexpr size_t W_GB = al256(W_KB + (size_t)NT * 512 * 2);
constexpr size_t W_VB = al256(W_GB + (size_t)NT * 512 * 4);
constexpr size_t W_ZB = al256(W_VB + (size_t)NT * 512 * 2);
constexpr size_t W_SA = al256(W_ZB + (size_t)NT * 512 * 2);
constexpr size_t W_SB = al256(W_SA + (size_t)NT * 1024 * 2);
constexpr size_t W_KCMP = al256(W_SB + (size_t)NT * 1024 * 2);
constexpr size_t W_VCMP = al256(W_KCMP + (size_t)NSEQ * 2 * 128 * 64 * 2);
constexpr size_t W_VCMPT = al256(W_VCMP + (size_t)NSEQ * 2 * 128 * 64 * 2);
constexpr size_t W_OA = al256(W_VCMPT + (size_t)8 * 2 * 64 * 128 * 2);
constexpr size_t W_OB = al256(W_OA + (size_t)NT * 512 * 2);
constexpr size_t W_Y = al256(W_OB + (size_t)NT * 512 * 2);
constexpr size_t W_SS = al256(W_Y + (size_t)NT * 1024 * 2);
constexpr size_t W_ORAW = al256(W_SS + (size_t)NT * 32 * 4);
constexpr size_t W_OSS = al256(W_ORAW + (size_t)NTP * 512 * 4);
constexpr size_t W_QG = al256(W_OSS + (size_t)NTP * 8 * 4);
constexpr size_t W_DST = al256(W_QG + (size_t)NTP * 512 * 2);
constexpr size_t W_DEC = al256(W_DST + (size_t)1024 * 128 * 128 * 4);
constexpr size_t W_SPT = al256(W_DEC + (size_t)1024 * 128 * 4);
constexpr size_t W_BAR = al256(W_SPT + (size_t)1024 * 128 * 128 * 2);
constexpr size_t W_END = al256(W_BAR + 3456 * 4);

struct Params {
  const float* x_prompt; const float* x_sample;
  const float* cck; const float* ccv; const float* csk; const float* csv;
  const float* swk; const float* swv; const float* shg; const int* pt;
  const float* norm_g; const float* w_in;
  const float* pos_k; const float* w1_k; const float* w2_k;
  const float* pos_v; const float* w1_v; const float* w2_v;
  const float* rel_bias; const float* hg_lower; const float* hg_norm_g;
  const float* w_ba; const float* w_bb; const float* w_out; const float* final_g;
  float* out; char* ws;
};

DI unsigned pk2(float a, float b) { f32x2 v = {a, b}; bf16x2v r = __builtin_convertvector(v, bf16x2v); return __builtin_bit_cast(unsigned, r); }
DI u16 f2bf(float a) { return (u16)(pk2(a, 0.f) & 0xffffu); }
DI float bf2f(u16 v) { return __uint_as_float(((unsigned)v) << 16); }
DI float bflo(unsigned v) { return __uint_as_float(v << 16); }
DI float bfhi(unsigned v) { return __uint_as_float(v & 0xffff0000u); }
constexpr float LOG2E = 1.4426950408889634f;
DI float sigmoidf_(float x) { return 1.f / (1.f + __expf(-x)); }
DI float siluf_(float x) { return x / (1.f + __expf(-x)); }
DI int otid() { int t = threadIdx.x & 255; asm volatile("" : "+v"(t)); return t; }
DI int otid512() { int t = threadIdx.x; asm volatile("" : "+v"(t)); return t; }
DI int crow(int reg, int h) { return (reg & 3) + 8 * (reg >> 2) + 4 * h; }
DI float wave_sum(float v) {
#pragma unroll
  for (int o = 32; o >= 1; o >>= 1) v += __shfl_xor(v, o);
  return v;
}
DI float wave_max(float v) {
#pragma unroll
  for (int o = 32; o >= 1; o >>= 1) v = fmaxf(v, __shfl_xor(v, o));
  return v;
}

__device__ const unsigned char T5B[128] = {
  0,1,2,3,4,5,6,7,8,9,10,11,12,13,14,15,
  16,16,16,17,17,18,18,18,19,19,19,20,20,20,20,21,
  21,21,21,22,22,22,22,22,23,23,23,23,23,23,24,24,
  24,24,24,24,25,25,25,25,25,25,25,26,26,26,26,26,
  26,26,26,27,27,27,27,27,27,27,27,27,27,28,28,28,
  28,28,28,28,28,28,28,29,29,29,29,29,29,29,29,29,
  29,29,29,30,30,30,30,30,30,30,30,30,30,30,30,30,
  30,31,31,31,31,31,31,31,31,31,31,31,31,31,31,31};

DI void transpose_tile(const float* __restrict__ src, int ldsrc, int K, int N, int k0, int n0,
                       u16* __restrict__ dst, int lddst, int dst_row_off, int dst_k0, int winperm, float* tl) {
  const int tid = otid();
  __syncthreads();
  {
    const int n = tid & 63, kb = tid >> 6;
#pragma unroll
    for (int i = 0; i < 16; ++i) {
      const int kk = kb + 4 * i;
      const int nc = (n0 + n < N) ? n0 + n : N - 1, kc = (k0 + kk < K) ? k0 + kk : K - 1;
      tl[kk * 65 + n] = src[(size_t)kc * ldsrc + nc];
    }
  }
  __syncthreads();
  {
    const int k = (tid & 31) * 2, nb = tid >> 5;
#pragma unroll
    for (int i = 0; i < 8; ++i) {
      const int nn = nb + 8 * i;
      int n = n0 + nn;
      if (n < N) {
        if (winperm) n = (n < 1280) ? n : ((n < 1304) ? (5888 + n - 1280) : (n - 24));
        const unsigned v = pk2(tl[k * 65 + nn], tl[(k + 1) * 65 + nn]);
        *(unsigned*)(dst + (size_t)(dst_row_off + n) * lddst + dst_k0 + k) = v;
      }
    }
  }
}

constexpr int P0_WIN = 16 * 93;
constexpr int P0_WBA = 8 * 16, P0_WBB = 8 * 16, P0_WOUT = 16 * 16, P0_W1 = 32 * 2;
constexpr int P0_TR = P0_WIN + P0_WBA + P0_WBB + P0_WOUT + P0_W1;
constexpr int P0_C1 = 2;
constexpr int P0_NORM = NT / 8;
constexpr int P0_WCP = 2 * DEC_BATCH * 8;
constexpr int P0_PAD = NPAD - IN_COLS;
constexpr int P0_TOTAL = P0_TR + P0_C1 + P0_NORM + P0_WCP + P0_PAD;

DI void phase0_item(const Params& p, int it, char* lds) {
  const int tid = otid(), lane = tid & 63, wave = tid >> 6;
  float* tl = (float*)lds;
  if (it < P0_TR) {
    if (it < P0_WIN) {
      const int kt = it / 93, nt = it % 93;
      transpose_tile(p.w_in, IN_COLS, 1024, IN_COLS, kt * 64, nt * 64, (u16*)(p.ws + W_WINT), 1024, 0, kt * 64, 1, tl);
      return;
    }
    it -= P0_WIN;
    if (it < P0_WBA) { const int kt = it / 16, nt = it % 16;
      transpose_tile(p.w_ba, 1024, 512, 1024, kt * 64, nt * 64, (u16*)(p.ws + W_WBAT), 512, 0, kt * 64, 0, tl); return; }
    it -= P0_WBA;
    if (it < P0_WBB) { const int kt = it / 16, nt = it % 16;
      transpose_tile(p.w_bb, 1024, 512, 1024, kt * 64, nt * 64, (u16*)(p.ws + W_WBBT), 512, 0, kt * 64, 0, tl); return; }
    it -= P0_WBB;
    if (it < P0_WOUT) { const int kt = it / 16, nt = it % 16;
      transpose_tile(p.w_out, 1024, 1024, 1024, kt * 64, nt * 64, (u16*)(p.ws + W_WOUTT), 1024, 0, kt * 64, 0, tl); return; }
    it -= P0_WOUT;
    { const int kv = it >> 5, kt = it & 31;
      const float* w1 = kv ? p.w1_v : p.w1_k;
      transpose_tile(w1, 64, 2048, 64, kt * 64, 0, (u16*)(p.ws + W_W1T) + (size_t)kv * 128 * 1024, 1024,
                     (kt >= 16) ? 64 : 0, (kt & 15) * 64, 0, tl); return; }
  }
  it -= P0_TR;
  if (it < P0_C1) {
    const float* pos = it ? p.pos_v : p.pos_k; const float* w1 = it ? p.w1_v : p.w1_k;
    const int j = tid & 63, part = tid >> 6;
    float s = 0.f;
    for (int i = part * 512; i < part * 512 + 512; ++i) s += pos[i] * w1[(size_t)i * 64 + j];
    __syncthreads();
    tl[part * 64 + j] = s;
    __syncthreads();
    if (tid < 64) ((float*)(p.ws + W_C1))[it * 64 + tid] = tl[tid] + tl[64 + tid] + tl[128 + tid] + tl[192 + tid];
    return;
  }
  it -= P0_C1;
  if (it < P0_NORM) {
#pragma unroll
    for (int rr = 0; rr < 2; ++rr) {
      const int row = it * 8 + wave * 2 + rr;
      const float* x = (row < NTP) ? (p.x_prompt + (size_t)row * 1024) : (p.x_sample + (size_t)(row - NTP) * 1024);
      float4 v[4]; float ss = 0.f;
#pragma unroll
      for (int i = 0; i < 4; ++i) { v[i] = *(const float4*)(x + (i * 64 + lane) * 4); ss += v[i].x * v[i].x + v[i].y * v[i].y + v[i].z * v[i].z + v[i].w * v[i].w; }
      ss = wave_sum(ss);
      const float rs = rsqrtf(ss * (1.f / 1024.f) + 1e-6f);
      u16* xn = (u16*)(p.ws + W_XN) + (size_t)row * 1024;
#pragma unroll
      for (int i = 0; i < 4; ++i) {
        const float4 g = *(const float4*)(p.norm_g + (i * 64 + lane) * 4);
        uint2 o; o.x = pk2(v[i].x * rs * g.x, v[i].y * rs * g.y); o.y = pk2(v[i].z * rs * g.z, v[i].w * rs * g.w);
        *(uint2*)(xn + (i * 64 + lane) * 4) = o;
      }
    }
    return;
  }
  it -= P0_NORM;
  if (it < P0_WCP) {
    const int sl = it & 7, b = (it >> 3) % DEC_BATCH, kv = it / (8 * DEC_BATCH);
    const float4* src = (const float4*)((kv ? p.swv : p.swk) + ((size_t)b * 512 + 4) * 128) + sl * 64 * 32;
    float4* dst = (float4*)(p.out + O_SWK + (size_t)kv * DEC_BATCH * 512 * 128 + (size_t)b * 512 * 128) + sl * 64 * 32;
    const int n = (sl == 7 ? 60 : 64) * 32;
    const float4* __restrict__ sp = src; float4* __restrict__ dp = dst;
#pragma unroll
    for (int i = 0; i < 8; ++i) { const int idx = (tid + 256 * i < n) ? tid + 256 * i : n - 1; dp[idx] = sp[idx]; }
    return;
  }
  it -= P0_WCP;
  { u16* d = (u16*)(p.ws + W_WINT) + (size_t)(IN_COLS + it) * 1024; *(uint2*)(d + tid * 4) = make_uint2(0u, 0u); }
}

constexpr int GST = 72;
struct LoadBf16 {
  const u16* base; int ld;
  DI uint4 load(int row, int ch, int kt) const { return *(const uint4*)(base + (size_t)row * ld + kt * 64 + ch * 8); }
};
struct LoadCellBf16 {
  const u16* base;
  DI uint4 load(int row, int ch, int kt) const { return *(const uint4*)(base + (size_t)(row * 16 + kt) * 128 + ch * 8); }
};
struct LoadCellPage {
  const float* cache; const int* pt; int g;
  DI uint4 load(int row, int ch, int kt) const {
    const int pos = row * 16 + kt; const int page = pt[pos >> 7];
    const float* s = cache + (((size_t)page * 128 + (pos & 127)) * 2 + g) * 64 + ch * 8;
    const float4 a = *(const float4*)s, b = *(const float4*)(s + 4);
    uint4 r; r.x = pk2(a.x, a.y); r.y = pk2(a.z, a.w); r.z = pk2(b.x, b.y); r.w = pk2(b.z, b.w); return r;
  }
};

template <int NI, class AL, class BL>
DI void gemm_main(f32x16 (&acc)[2][NI], const AL& al, const BL& bl, int nkt, char* lds) {
  u16* sA = (u16*)lds; u16* sB = sA + 128 * GST;
  const int tid = otid(), lane = tid & 63, wave = tid >> 6, wm = wave >> 1, wn = wave & 1;
  const int lrow = tid >> 3, lch = tid & 7, r = lane & 31, h = lane >> 5;
  uint4 ra[4], rb[2 * NI];
#pragma unroll
  for (int i = 0; i < 4; ++i) ra[i] = al.load(lrow + 32 * i, lch, 0);
#pragma unroll
  for (int i = 0; i < 2 * NI; ++i) rb[i] = bl.load(lrow + 32 * i, lch, 0);
  for (int kt = 0; kt < nkt; ++kt) {
    __syncthreads();
#pragma unroll
    for (int i = 0; i < 4; ++i) *(uint4*)(sA + (lrow + 32 * i) * GST + lch * 8) = ra[i];
#pragma unroll
    for (int i = 0; i < 2 * NI; ++i) *(uint4*)(sB + (lrow + 32 * i) * GST + lch * 8) = rb[i];
    __syncthreads();
    if (kt + 1 < nkt) {
#pragma unroll
      for (int i = 0; i < 4; ++i) ra[i] = al.load(lrow + 32 * i, lch, kt + 1);
#pragma unroll
      for (int i = 0; i < 2 * NI; ++i) rb[i] = bl.load(lrow + 32 * i, lch, kt + 1);
    }
#pragma unroll
    for (int s = 0; s < 4; ++s) {
      bf16x8 a[2], bb[NI];
#pragma unroll
      for (int mi = 0; mi < 2; ++mi) a[mi] = *(const bf16x8*)(sA + (wm * 64 + mi * 32 + r) * GST + s * 16 + 8 * h);
#pragma unroll
      for (int ni = 0; ni < NI; ++ni) bb[ni] = *(const bf16x8*)(sB + (wn * 32 * NI + ni * 32 + r) * GST + s * 16 + 8 * h);
#pragma unroll
      for (int mi = 0; mi < 2; ++mi)
#pragma unroll
        for (int ni = 0; ni < NI; ++ni) acc[mi][ni] = MFMA32(a[mi], bb[ni], acc[mi][ni]);
    }
  }
}

typedef __attribute__((address_space(1))) const unsigned gptr_t;
typedef __attribute__((address_space(3))) unsigned lptr_t;
template <int NI>
DI void gemm_glds(f32x16 (&acc)[2][NI], const u16* A, int lda, const u16* B, int ldb, int nkt, char* lds) {
  const int tid = otid(), lane = tid & 63, wave = tid >> 6, wm = wave >> 1, wn = wave & 1;
  const int r = lane & 31, h = lane >> 5;
  const int lr = (wave << 3) + (lane >> 3);
  const int lc = (lane & 7) ^ ((lane >> 3) & 7) ^ (wave & 1);
  const u16* ga = A + (size_t)lr * lda + lc * 8;
  const u16* gb = B + (size_t)lr * ldb + lc * 8;
  const int sw = (lane & 7) ^ ((lane >> 3) & 1);
  constexpr int STAGE = 16384 + 8192 * NI;
#define GLDS_ISSUE(buf, kt_) do { \
    char* sa_ = lds + (buf) * STAGE + tid * 16; \
    _Pragma("unroll") for (int i_ = 0; i_ < 4; ++i_) \
      __builtin_amdgcn_global_load_lds((gptr_t*)(ga + (size_t)(32 * i_) * lda + (kt_) * 64), (lptr_t*)(sa_ + i_ * 4096), 16, 0, 0); \
    _Pragma("unroll") for (int i_ = 0; i_ < 2 * NI; ++i_) \
      __builtin_amdgcn_global_load_lds((gptr_t*)(gb + (size_t)(32 * i_) * ldb + (kt_) * 64), (lptr_t*)(sa_ + 16384 + i_ * 4096), 16, 0, 0); \
  } while (0)
  __syncthreads();
  GLDS_ISSUE(0, 0);
#pragma unroll 1
  for (int kt = 0; kt < nkt; ++kt) {
    asm volatile("s_waitcnt vmcnt(0)" ::: "memory");
    __syncthreads();
    if (kt + 1 < nkt) GLDS_ISSUE((kt + 1) & 1, kt + 1);
    const char* sA = lds + (kt & 1) * STAGE; const char* sB = sA + 16384;
#pragma unroll
    for (int s = 0; s < 4; ++s) {
      const int co = ((2 * s + h) ^ sw) << 4;
      bf16x8 a[2], bb[NI];
#pragma unroll
      for (int mi = 0; mi < 2; ++mi) a[mi] = *(const bf16x8*)(sA + (wm * 64 + mi * 32 + r) * 128 + co);
#pragma unroll
      for (int ni = 0; ni < NI; ++ni) bb[ni] = *(const bf16x8*)(sB + (wn * 32 * NI + ni * 32 + r) * 128 + co);
#pragma unroll
      for (int mi = 0; mi < 2; ++mi)
#pragma unroll
        for (int ni = 0; ni < NI; ++ni) acc[mi][ni] = MFMA32(a[mi], bb[ni], acc[mi][ni]);
    }
  }
#undef GLDS_ISSUE
  __syncthreads();
}
template <int NI>
DI void zero_acc(f32x16 (&acc)[2][NI]) {
#pragma unroll
  for (int a = 0; a < 2; ++a)
#pragma unroll
    for (int b = 0; b < NI; ++b)
#pragma unroll
      for (int i = 0; i < 16; ++i) acc[a][b][i] = 0.f;
}

constexpr int G1_MT = NT / 128, G1_NT = NPAD / 128;
constexpr int P1_GEMM = G1_MT * G1_NT;
constexpr int P1_CMP = DEC_BATCH * 2 * 2;
constexpr int P1_TOTAL = P1_CMP + P1_GEMM;

DI void proj_tile(const Params& p, int tm, int tn, char* lds, bool store_ok) {
  f32x16 acc[2][2]; zero_acc<2>(acc);
  gemm_glds<2>(acc, (const u16*)(p.ws + W_XN) + (size_t)tm * 128 * 1024, 1024, (const u16*)(p.ws + W_WINT) + (size_t)tn * 128 * 1024, 1024, 16, lds);
  const int tid = otid(), lane = tid & 63, wave = tid >> 6, wm = wave >> 1, wn = wave & 1, r = lane & 31, h = lane >> 5;
  const bool samp = tm >= 128;
  if (!store_ok) return;
#pragma unroll
  for (int mi = 0; mi < 2; ++mi)
#pragma unroll
    for (int ni = 0; ni < 2; ++ni) {
      const int c = wn * 64 + ni * 32 + r;
      const int row0 = tm * 128 + wm * 64 + mi * 32;
      if (tn < 4) {
        u16* d = (u16*)(p.ws + W_Q) + tn * 128 + c;
#pragma unroll
        for (int i = 0; i < 16; ++i) d[(size_t)(row0 + crow(i, h)) * 512] = f2bf(acc[mi][ni][i] * (0.125f * LOG2E));
      } else if (tn < 10) {
        const int kvg = tn - 4;
        u16* d = (u16*)(p.ws + W_KV) + (size_t)kvg * NT * 128 + c;
#pragma unroll
        for (int i = 0; i < 16; ++i) {
          const int row = row0 + crow(i, h); const float v = acc[mi][ni][i];
          d[(size_t)row * 128] = f2bf(v);
          if (!samp) {
            if (kvg < 4) p.out[O_PCK + (size_t)kvg * NTP * 128 + (size_t)row * 128 + c] = v;
            else { const int t = row & 2047, b = row >> 11;
              if (t >= 1536) p.out[O_PWK + (size_t)(kvg - 4) * BATCH * 512 * 128 + ((size_t)b * 512 + t - 1536) * 128 + c] = v; }
          } else {
            const int srow = row - NTP;
            if (kvg < 4) p.out[O_SCK + (size_t)kvg * NTS * 128 + (size_t)srow * 128 + c] = v;
            else p.out[O_SWK + (size_t)(kvg - 4) * DEC_BATCH * 512 * 128 + ((size_t)(srow >> 2) * 512 + 508 + (srow & 3)) * 128 + c] = v;
          }
        }
        if (!samp && (kvg == 3 || kvg == 5)) {
          u16* vt = (u16*)(p.ws + (kvg == 3 ? W_VST : W_VWT));
          const int b = row0 >> 11, t0 = row0 & 2047, g = c >> 6, dd = c & 63;
          u16* drow = vt + ((size_t)(b * 2 + g) * 64 + dd) * 2048 + t0;
#pragma unroll
          for (int q = 0; q < 4; ++q) {
            uint2 o; o.x = pk2(acc[mi][ni][4 * q], acc[mi][ni][4 * q + 1]); o.y = pk2(acc[mi][ni][4 * q + 2], acc[mi][ni][4 * q + 3]);
            *(uint2*)(drow + 8 * q + 4 * h) = o;
          }
        }
      } else if (tn < 14 || (tn >= 26 && tn < 30)) {
        const bool isA = tn < 14; const int cc = (isA ? tn - 10 : tn - 26) * 128 + c;
        u16* d = (u16*)(p.ws + (isA ? W_ZA : W_ZB)) + cc;
#pragma unroll
        for (int i = 0; i < 16; ++i) d[(size_t)(row0 + crow(i, h)) * 512] = f2bf(siluf_(acc[mi][ni][i]));
      } else if (tn < 18 || (tn >= 22 && tn < 26)) {
        const bool isQ = tn < 18; const int cc = (isQ ? tn - 14 : tn - 22) * 128 + c;
        u16* d = (u16*)(p.ws + (isQ ? W_QB : W_VB)) + cc;
#pragma unroll
        for (int i = 0; i < 16; ++i) d[(size_t)(row0 + crow(i, h)) * 512] = f2bf(acc[mi][ni][i]);
      } else if (tn < 22) {
        const int cc = (tn - 18) * 128 + c;
        const float a0 = p.hg_lower[cc], a1 = p.hg_lower[512 + cc];
        const float lb = 1.f / (1.f + __expf(a1 - a0));
        u16* dk = (u16*)(p.ws + W_KB) + cc; float* dg = (float*)(p.ws + W_GB) + cc;
#pragma unroll
        for (int i = 0; i < 16; ++i) {
          const size_t row = row0 + crow(i, h);
          const float sg = sigmoidf_(acc[mi][ni][i]);
          const float f = lb + (1.f - lb) * sg;
          dg[row * 512] = __logf(f);
          dk[row * 512] = f2bf((1.f - lb) * (1.f - sg));
        }
      } else if (tn < 46) {
        const bool isA = tn < 38; const int cc = (isA ? tn - 30 : tn - 38) * 128 + c;
        u16* d = (u16*)(p.ws + (isA ? W_SA : W_SB)) + cc;
#pragma unroll
        for (int i = 0; i < 16; ++i) d[(size_t)(row0 + crow(i, h)) * 1024] = f2bf(sigmoidf_(acc[mi][ni][i]));
      } else {
        if (c < 24) {
          float* d = (float*)(p.ws + W_GATE) + c;
#pragma unroll
          for (int i = 0; i < 16; ++i) d[(size_t)(row0 + crow(i, h)) * 24] = sigmoidf_(acc[mi][ni][i]);
        }
      }
    }
}

template <class AL>
DI void comp_tile(const Params& p, const AL& al, int seq, int g, int kv, char* lds) {
  f32x16 acc[2][2]; zero_acc<2>(acc);
  LoadBf16 bl{(const u16*)(p.ws + W_W1T) + (size_t)kv * 128 * 1024, 1024};
  gemm_main<2>(acc, al, bl, 16, lds);
  const int tid = otid(), lane = tid & 63, wave = tid >> 6, wm = wave >> 1, wn = wave & 1, r = lane & 31, h = lane >> 5;
  float* T = (float*)lds;
  float* w2s = T + 128 * 65;
  const float* c1 = (const float*)(p.ws + W_C1) + kv * 64;
  const float* w2 = kv ? p.w2_v : p.w2_k;
  __syncthreads();
  for (int i = tid; i < 4096; i += 256) w2s[i] = w2[i];
  if (wn == 1) {
#pragma unroll
    for (int mi = 0; mi < 2; ++mi)
#pragma unroll
      for (int ni = 0; ni < 2; ++ni)
#pragma unroll
        for (int i = 0; i < 16; ++i) T[(wm * 64 + mi * 32 + crow(i, h)) * 65 + ni * 32 + r] = acc[mi][ni][i];
  }
  __syncthreads();
  if (wn == 0) {
    const float c1v[2] = {c1[r], c1[32 + r]};
#pragma unroll
    for (int mi = 0; mi < 2; ++mi)
#pragma unroll
      for (int ni = 0; ni < 2; ++ni)
#pragma unroll
        for (int i = 0; i < 16; ++i) {
          const int n = wm * 64 + mi * 32 + crow(i, h), j = ni * 32 + r;
          const float hv = siluf_(acc[mi][ni][i] + T[((n < 127) ? n + 1 : 127) * 65 + j] + c1v[ni]);
          acc[mi][ni][i] = (n < 127) ? hv : 0.f;
        }
  }
  __syncthreads();
  if (wn == 0) {
#pragma unroll
    for (int mi = 0; mi < 2; ++mi)
#pragma unroll
      for (int ni = 0; ni < 2; ++ni)
#pragma unroll
        for (int i = 0; i < 16; ++i) T[(wm * 64 + mi * 32 + crow(i, h)) * 65 + ni * 32 + r] = acc[mi][ni][i];
  }
  __syncthreads();
  {
    const int n = tid >> 1, eh = tid & 1;
    float o[32];
#pragma unroll
    for (int e = 0; e < 32; ++e) o[e] = 0.f;
#pragma unroll 2
    for (int j = 0; j < 64; ++j) {
      const float hv = T[n * 65 + j];
#pragma unroll
      for (int e = 0; e < 32; ++e) o[e] += hv * w2s[j * 64 + eh * 32 + e];
    }
    u16* dst = (u16*)(p.ws + (kv ? W_VCMP : W_KCMP)) + ((size_t)(seq * 2 + g) * 128 + n) * 64 + eh * 32;
#pragma unroll
    for (int e = 0; e < 32; e += 2) *(unsigned*)(dst + e) = pk2(o[e], o[e + 1]);
  }
  __syncthreads();
}

DI void phase1_item(const Params& p, int it, char* lds) {
  if (it < P1_CMP) {
    const int kv = it & 1, g = (it >> 1) & 1, b = it >> 2;
    LoadCellPage al{kv ? p.ccv : p.cck, p.pt + b * 16, g};
    comp_tile(p, al, BATCH + b, g, kv, lds);
    return;
  }
  it -= P1_CMP;
  const int tm = it / G1_NT, tn = it % G1_NT;
  proj_tile(p, tm, tn, lds, true);
}


DI void hgrn_sample_item(const Params& p, int it, char* lds) {
  const int b = it >> 2, h = it & 3, tid = otid(), lane = tid & 63, wave = tid >> 6;
  float* sf = (float*)lds; float* sk = sf + 512; float* sq = sk + 512; float* sv = sq + 512; float* so = sv + 512;
  __syncthreads();
  for (int i = tid; i < 512; i += 256) {
    const int t = i >> 7, c = i & 127; const size_t off = (size_t)(NTP + b * 4 + t) * 512 + h * 128 + c;
    sf[i] = __expf(((const float*)(p.ws + W_GB))[off]);
    sk[i] = bf2f(((const u16*)(p.ws + W_KB))[off]);
    sq[i] = bf2f(((const u16*)(p.ws + W_QB))[off]);
    sv[i] = bf2f(((const u16*)(p.ws + W_VB))[off]);
  }
  __syncthreads();
  const int e = tid & 127, dh = tid >> 7;
  const float* S0 = p.shg + (size_t)(b * 4 + h) * 128 * 128;
  float* S1 = p.out + O_SHG + (size_t)(b * 4 + h) * 128 * 128;
  const float v0 = sv[e], v1 = sv[128 + e], v2 = sv[256 + e], v3 = sv[384 + e];
  float o0 = 0.f, o1 = 0.f, o2 = 0.f, o3 = 0.f;
#pragma unroll 16
  for (int d = dh * 64; d < dh * 64 + 64; ++d) {
    float st = S0[(size_t)d * 128 + e];
    st = sf[d] * st + sk[d] * v0;             o0 += sq[d] * st;
    st = sf[128 + d] * st + sk[128 + d] * v1; o1 += sq[128 + d] * st;
    st = sf[256 + d] * st + sk[256 + d] * v2; o2 += sq[256 + d] * st;
    st = sf[384 + d] * st + sk[384 + d] * v3; o3 += sq[384 + d] * st;
    S1[(size_t)d * 128 + e] = st;
  }
  so[(dh * 4 + 0) * 128 + e] = o0; so[(dh * 4 + 1) * 128 + e] = o1; so[(dh * 4 + 2) * 128 + e] = o2; so[(dh * 4 + 3) * 128 + e] = o3;
  __syncthreads();
  {
    const int t = wave; const size_t row = (size_t)(NTP + b * 4 + t);
    const float a0 = so[t * 128 + lane] + so[(4 + t) * 128 + lane];
    const float a1 = so[t * 128 + 64 + lane] + so[(4 + t) * 128 + 64 + lane];
    const float ss = wave_sum(a0 * a0 + a1 * a1);
    const float rs = rsqrtf(ss * (1.f / 128.f) + 1e-6f);
    const u16* zb = (const u16*)(p.ws + W_ZB) + row * 512 + h * 128; u16* ob = (u16*)(p.ws + W_OB) + row * 512 + h * 128;
    ob[lane] = f2bf(a0 * rs * p.hg_norm_g[h * 128 + lane] * bf2f(zb[lane]));
    ob[64 + lane] = f2bf(a1 * rs * p.hg_norm_g[h * 128 + 64 + lane] * bf2f(zb[64 + lane]));
  }
}

typedef __attribute__((address_space(3))) s16x4 lds_s16x4;
DI s16x4 tr_read(const u16* ptr) { return __builtin_amdgcn_ds_read_tr16_b64_v4i16((lds_s16x4*)ptr); }
DI bf16x8 cat8(s16x4 lo, s16x4 hi) { return __builtin_shufflevector(lo, hi, 0, 1, 2, 3, 4, 5, 6, 7); }
constexpr int HST = 136;

DI void hgrn_h1_item(const Params& p, int it, char* lds) {
  const int c = it & 31, h = (it >> 5) & 3, b = it >> 7;
  const int tid = otid(), lane = tid & 63, w = __builtin_amdgcn_readfirstlane(tid >> 6), half = tid >> 7;
  const int c16 = lane & 15, hq = lane >> 4, tq = c16 >> 2, tp = c16 & 3;
  const int d = tid & 127, col = h * 128 + d;
  u16* Qe = (u16*)lds; u16* Ke = Qe + 64 * HST; u16* Vv = Ke + 64 * HST; u16* Am = Vv + 64 * HST;
  float* Rr = (float*)(Am + 64 * 72); float* G63 = Rr + 128;
  const u16* qB = (const u16*)(p.ws + W_QB); const u16* kB = (const u16*)(p.ws + W_KB); const u16* vB = (const u16*)(p.ws + W_VB);
  const float* gB = (const float*)(p.ws + W_GB);
  const size_t tok0 = (size_t)b * 2048 + c * 64;
  __syncthreads();
  float G[32];
  {
    float run = 0.f;
#pragma unroll
    for (int i = 0; i < 32; ++i) { run += gB[(tok0 + half * 32 + i) * 512 + col]; G[i] = run; }
    if (half == 0) Rr[d] = run;
  }
#pragma unroll
  for (int i = 0; i < 4; ++i) {
    const int idx = tid + 256 * i, s_ = idx >> 4, cc = idx & 15;
    *(uint4*)(Vv + s_ * HST + cc * 8) = *(const uint4*)(vB + (tok0 + s_) * 512 + h * 128 + cc * 8);
  }
  __syncthreads();
  {
    const float R = Rr[d];
    const float base = half ? R : 0.f;
    u16* qg = (u16*)(p.ws + W_QG);
#pragma unroll
    for (int i = 0; i < 32; ++i) {
      const int t = half * 32 + i;
      const float gt = base + G[i];
      const float q = bf2f(qB[(tok0 + t) * 512 + col]), k = bf2f(kB[(tok0 + t) * 512 + col]);
      const float dq = fminf(fmaxf(gt - R, -80.f), 80.f);
      Qe[t * HST + d] = f2bf(q * __expf(dq));
      Ke[t * HST + d] = f2bf(k * __expf(-dq));
      qg[(tok0 + t) * 512 + col] = f2bf(q * __expf(gt));
    }
    if (half == 1) G63[d] = base + G[31];
  }
  __syncthreads();
  for (int j = 0; j <= w; ++j) {
    f32x4 x = f32x4{0.f, 0.f, 0.f, 0.f};
#pragma unroll
    for (int ks = 0; ks < 4; ++ks) {
      const bf16x8 a = *(const bf16x8*)(Qe + (16 * w + c16) * HST + ks * 32 + 8 * hq);
      const bf16x8 bb = *(const bf16x8*)(Ke + (16 * j + c16) * HST + ks * 32 + 8 * hq);
      x = MFMA16(a, bb, x);
    }
#pragma unroll
    for (int r = 0; r < 4; ++r) {
      const bool ok = (j < w) || (c16 <= 4 * hq + r);
      Am[(16 * w + 4 * hq + r) * 72 + 16 * j + c16] = f2bf(ok ? x[r] : 0.f);
    }
  }
  if ((w & 1) == 0) {
#pragma unroll
    for (int r = 0; r < 4; ++r) Am[(16 * w + 4 * hq + r) * 72 + 16 * (w + 1) + c16] = 0;
  }
  __syncthreads();
  bf16x8 vf[2][2];
#pragma unroll
  for (int ks = 0; ks < 2; ++ks)
#pragma unroll
    for (int et = 0; et < 2; ++et) {
      const u16* base = Vv + (32 * ks + 8 * hq + tq) * HST + 32 * w + 16 * et + 4 * tp;
      vf[ks][et] = cat8(tr_read(base), tr_read(base + 4 * HST));
    }
  {
    f32x4 o[4][2];
#pragma unroll
    for (int tt = 0; tt < 4; ++tt)
#pragma unroll
      for (int et = 0; et < 2; ++et) o[tt][et] = f32x4{0.f, 0.f, 0.f, 0.f};
#pragma unroll
    for (int tt = 0; tt < 4; ++tt)
#pragma unroll
      for (int ks = 0; ks <= (tt >> 1); ++ks) {
        const bf16x8 a = *(const bf16x8*)(Am + (16 * tt + c16) * 72 + 32 * ks + 8 * hq);
#pragma unroll
        for (int et = 0; et < 2; ++et) o[tt][et] = MFMA16(a, vf[ks][et], o[tt][et]);
      }
    float* oraw = (float*)(p.ws + W_ORAW);
#pragma unroll
    for (int tt = 0; tt < 4; ++tt)
#pragma unroll
      for (int et = 0; et < 2; ++et)
#pragma unroll
        for (int r = 0; r < 4; ++r) oraw[(tok0 + 16 * tt + 4 * hq + r) * 512 + h * 128 + 32 * w + 16 * et + c16] = o[tt][et][r];
  }
  float* dst = (float*)(p.ws + W_DST) + (size_t)it * 128 * 128;
#pragma unroll
  for (int dt = 0; dt < 8; ++dt) {
    bf16x8 kt[2];
#pragma unroll
    for (int ks = 0; ks < 2; ++ks) {
      const u16* base = Ke + (32 * ks + 8 * hq + tq) * HST + 16 * dt + 4 * tp;
      kt[ks] = cat8(tr_read(base), tr_read(base + 4 * HST));
    }
    f32x4 sc2;
#pragma unroll
    for (int r = 0; r < 4; ++r) sc2[r] = __expf(G63[16 * dt + 4 * hq + r] - Rr[16 * dt + 4 * hq + r]);
#pragma unroll
    for (int et = 0; et < 2; ++et) {
      f32x4 dd = f32x4{0.f, 0.f, 0.f, 0.f};
      dd = MFMA16(kt[0], vf[0][et], dd); dd = MFMA16(kt[1], vf[1][et], dd);
      *(float4*)(dst + (size_t)(32 * w + 16 * et + c16) * 128 + 16 * dt + 4 * hq) = make_float4(dd[0] * sc2[0], dd[1] * sc2[1], dd[2] * sc2[2], dd[3] * sc2[3]);
    }
  }
  if (tid < 128) ((float*)(p.ws + W_DEC))[(size_t)it * 128 + tid] = __expf(G63[tid]);
}

constexpr int H2_ITEMS = 8 * 4 * 128 * 32 / 256;
DI void hgrn_h2_item(const Params& p, int it) {
  const int gt = it * 256 + otid(), bh = gt >> 12, e = (gt >> 5) & 127, dq = gt & 31;
  const float* dst = (const float*)(p.ws + W_DST); const float* dec = (const float*)(p.ws + W_DEC); u16* spt = (u16*)(p.ws + W_SPT);
  float4 s = make_float4(0.f, 0.f, 0.f, 0.f);
#pragma unroll 16
  for (int c = 0; c < 32; ++c) {
    const size_t idx = ((size_t)(bh * 32 + c) * 128 + e) * 128 + dq * 4;
    const float4 d4 = *(const float4*)(dst + idx);
    const float4 k4 = *(const float4*)(dec + (size_t)(bh * 32 + c) * 128 + dq * 4);
    *(uint2*)(spt + idx) = make_uint2(pk2(s.x, s.y), pk2(s.z, s.w));
    s.x = k4.x * s.x + d4.x; s.y = k4.y * s.y + d4.y; s.z = k4.z * s.z + d4.z; s.w = k4.w * s.w + d4.w;
  }
  float* So = p.out + O_PHG + (size_t)bh * 128 * 128;
  So[(size_t)(dq * 4 + 0) * 128 + e] = s.x; So[(size_t)(dq * 4 + 1) * 128 + e] = s.y;
  So[(size_t)(dq * 4 + 2) * 128 + e] = s.z; So[(size_t)(dq * 4 + 3) * 128 + e] = s.w;
}

DI void hgrn_h3_item(const Params& p, int it) {
  const int c = it & 31, h = (it >> 5) & 3, b = it >> 7;
  const int tid = otid(), lane = tid & 63, w = tid >> 6, c16 = lane & 15, hq = lane >> 4;
  const size_t tok0 = (size_t)b * 2048 + c * 64 + 16 * w;
  const u16* qg = (const u16*)(p.ws + W_QG) + (tok0 + c16) * 512 + h * 128 + 8 * hq;
  bf16x8 af[4];
#pragma unroll
  for (int ks = 0; ks < 4; ++ks) af[ks] = *(const bf16x8*)(qg + 32 * ks);
  const float* oraw = (const float*)(p.ws + W_ORAW) + (tok0 + 4 * hq) * 512 + h * 128 + c16;
  const u16* spt = (const u16*)(p.ws + W_SPT) + ((size_t)it * 128 + c16) * 128 + 8 * hq;
  f32x4 acc[8];
#pragma unroll
  for (int et = 0; et < 8; ++et) {
#pragma unroll
    for (int r = 0; r < 4; ++r) acc[et][r] = oraw[(size_t)r * 512 + 16 * et];
#pragma unroll
    for (int ks = 0; ks < 4; ++ks) {
      const bf16x8 bfr = *(const bf16x8*)(spt + (size_t)(16 * et) * 128 + 32 * ks);
      acc[et] = MFMA16(af[ks], bfr, acc[et]);
    }
  }
  const u16* zb = (const u16*)(p.ws + W_ZB) + (tok0 + 4 * hq) * 512 + h * 128 + c16;
  u16* ob = (u16*)(p.ws + W_OB) + (tok0 + 4 * hq) * 512 + h * 128 + c16;
#pragma unroll
  for (int r = 0; r < 4; ++r) {
    float v = 0.f;
#pragma unroll
    for (int et = 0; et < 8; ++et) v += acc[et][r] * acc[et][r];
    v += __shfl_xor(v, 1); v += __shfl_xor(v, 2); v += __shfl_xor(v, 4); v += __shfl_xor(v, 8);
    const float rs = rsqrtf(v * (1.f / 128.f) + 1e-6f);
#pragma unroll
    for (int et = 0; et < 8; ++et)
      ob[(size_t)r * 512 + 16 * et] = f2bf(acc[et][r] * rs * p.hg_norm_g[h * 128 + 16 * et + c16] * bf2f(zb[(size_t)r * 512 + 16 * et]));
  }
}

typedef __attribute__((address_space(3))) const float lds_cf;
template <int NR>
DI void sa_scores(const float* qrows_, const float4 (&kk)[16], float (&sc)[NR]) {
  lds_cf* qrows = (lds_cf*)qrows_; asm volatile("" : "+v"(qrows));
#pragma unroll
  for (int r = 0; r < NR; ++r) {
    float a0 = 0.f, a1 = 0.f;
#pragma unroll
    for (int dq = 0; dq < 16; dq += 2) {
      const f32x4 q0 = *(const __attribute__((address_space(3))) f32x4*)(qrows + r * 64 + dq * 4), q1 = *(const __attribute__((address_space(3))) f32x4*)(qrows + r * 64 + dq * 4 + 4);
      a0 += q0[0] * kk[dq].x + q0[1] * kk[dq].y + q0[2] * kk[dq].z + q0[3] * kk[dq].w;
      a1 += q1[0] * kk[dq + 1].x + q1[1] * kk[dq + 1].y + q1[2] * kk[dq + 1].z + q1[3] * kk[dq + 1].w;
    }
    sc[r] = a0 + a1;
    asm volatile("" : "+v"(sc[r]) :: "memory");
  }
}
DI void sa_load_f32(const float* rowp, bool ok, float4 (&kk)[16]) {
#pragma unroll
  for (int i = 0; i < 16; ++i) kk[i] = ok ? ((const float4*)rowp)[i] : make_float4(0.f, 0.f, 0.f, 0.f);
}
template <int NR>
DI void sa_softmax(float* P, int nk, int row, int sub) {
  float m = -3.0e38f;
  for (int k = sub; k < nk; k += 16) m = fmaxf(m, P[k * NR + row]);
  m = fmaxf(m, __shfl_xor(m, 1)); m = fmaxf(m, __shfl_xor(m, 2)); m = fmaxf(m, __shfl_xor(m, 4)); m = fmaxf(m, __shfl_xor(m, 8));
  float l = 0.f;
  for (int k = sub; k < nk; k += 16) { const float sv = P[k * NR + row]; const float pv = (sv > -1.0e38f) ? __builtin_amdgcn_exp2f(sv - m) : 0.f; P[k * NR + row] = pv; l += pv; }
  l += __shfl_xor(l, 1); l += __shfl_xor(l, 2); l += __shfl_xor(l, 4); l += __shfl_xor(l, 8);
  const float inv = (l > 0.f) ? 1.f / l : 0.f;
  for (int k = sub; k < nk; k += 16) P[k * NR + row] *= inv;
}

DI void sa_load_bf16(const u16* rowp, bool ok, float4 (&kk)[16]) {
#pragma unroll
  for (int i = 0; i < 8; ++i) {
    const uint4 u = ok ? ((const uint4*)rowp)[i] : make_uint4(0u, 0u, 0u, 0u);
    kk[2 * i] = make_float4(bflo(u.x), bfhi(u.x), bflo(u.y), bfhi(u.y)); kk[2 * i + 1] = make_float4(bflo(u.z), bfhi(u.z), bflo(u.w), bfhi(u.w));
  }
}
template <class VRow>
DI void sa_pv(const float* P, int k0, int k1, const VRow& vrow, int lane, float (&o)[4]) {
#pragma unroll 1
  for (int kb = k0; kb < k1; kb += 32) {
    float vv[32];
#pragma unroll
    for (int i = 0; i < 32; ++i) vv[i] = vrow((kb + i < k1) ? kb + i : k1 - 1, lane);
#pragma unroll
    for (int i = 0; i < 32; ++i) {
      const int key = (kb + i < k1) ? kb + i : k1 - 1;
      const float4 p4 = *(const float4*)(P + key * 4); const float v = (kb + i < k1) ? vv[i] : 0.f;
      o[0] += p4.x * v; o[1] += p4.y * v; o[2] += p4.z * v; o[3] += p4.w * v;
    }
  }
}
template <int CTRL> DI float dppf(float v) { return __builtin_bit_cast(float, __builtin_amdgcn_update_dpp(0, __builtin_bit_cast(int, v), CTRL, 0xF, 0xF, false)); }
DI float red16(float v) { v += dppf<0xB1>(v); v += dppf<0x4E>(v); v += dppf<0x141>(v); v += dppf<0x140>(v); return v; }
template <class KRow, class Fin>
DI void sa_tile4(const float4 (&q4)[4], float* Pdst, const KRow& krow, const Fin& fin, int lane) {
  const int chunk = lane & 15, k4 = lane >> 4;
  float4 kv[16];
#pragma unroll
  for (int i = 0; i < 16; ++i) kv[i] = krow(4 * i + k4, chunk);
#pragma unroll
  for (int i = 0; i < 16; ++i) {
    float sr[4];
#pragma unroll
    for (int r = 0; r < 4; ++r) sr[r] = red16(q4[r].x * kv[i].x + q4[r].y * kv[i].y + q4[r].z * kv[i].z + q4[r].w * kv[i].w);
    const float mine = (chunk == 0) ? sr[0] : ((chunk == 1) ? sr[1] : ((chunk == 2) ? sr[2] : sr[3]));
    const float fv = fin(4 * i + k4, chunk & 3, mine);
    if (chunk < 4) Pdst[(4 * i + k4) * 4 + chunk] = fv;
  }
}
DI void sa_softmax_row(float* P, int nk, int row, int lane) {
  float m = -3.0e38f;
  for (int k = lane; k < nk; k += 64) m = fmaxf(m, P[k * 4 + row]);
  m = wave_max(m);
  float l = 0.f;
  for (int k = lane; k < nk; k += 64) { const float sv = P[k * 4 + row]; const float pv = (sv > -1.0e38f) ? __builtin_amdgcn_exp2f(sv - m) : 0.f; P[k * 4 + row] = pv; l += pv; }
  l = wave_sum(l);
  const float inv = (l > 0.f) ? 1.f / l : 0.f;
  for (int k = lane; k < nk; k += 64) P[k * 4 + row] *= inv;
}
DI void sample_attn_item(const Params& p, int it, char* lds) {
  const int t = it & 3, g = (it >> 2) & 1, b = it >> 3, tid = otid(), lane = tid & 63, w = __builtin_amdgcn_readfirstlane(tid >> 6);
  float* qs = (float*)lds;
  float* Pc = qs + 256;
  float* Pw = Pc + 512;
  float* Ps = Pw + 2304;
  float* obuf = Ps + 2048;
  float* imp = obuf + 3072;
  int* sel = (int*)(imp + 36);
  int* pts = sel + 8;
  float* btab = (float*)(pts + 16);
  const size_t tok = (size_t)(NTP + b * 4 + t);
  const int qpos = PAST + t, seq = BATCH + b;
  __syncthreads();
  qs[tid] = bf2f(((const u16*)(p.ws + W_Q))[tok * 512 + (g * 4 + (tid >> 6)) * 64 + lane]);
  for (int i = tid; i < 4 * 129; i += 256) { const int r = i / 129, rel = i % 129; const int bk = rel < 128 ? T5B[rel] : 31; btab[i] = p.rel_bias[bk * 8 + g * 4 + r] * LOG2E; }
  if (tid < 16) pts[tid] = p.pt[b * 16 + tid];
  __syncthreads();
  const float* fresh_wk = p.out + O_SWK + ((size_t)b * 512 + 508) * 128 + g * 64;
  const float* fresh_wv = p.out + O_SWK + (size_t)DEC_BATCH * 512 * 128 + ((size_t)b * 512 + 508) * 128 + g * 64;
  const float* fresh_sk = p.out + O_SCK + 2 * (size_t)NTS * 128 + (size_t)(b * 4) * 128 + g * 64;
  const float* fresh_sv = p.out + O_SCK + 3 * (size_t)NTS * 128 + (size_t)(b * 4) * 128 + g * 64;
  float4 q4[4];
#pragma unroll
  for (int r = 0; r < 4; ++r) q4[r] = *(const float4*)(qs + r * 64 + (lane & 15) * 4);
  for (int ti = w; ti < 11; ti += 4) {
    if (ti < 2) {
      const u16* kc = (const u16*)(p.ws + W_KCMP) + (size_t)(seq * 2 + g) * 128 * 64;
      sa_tile4(q4, Pc + ti * 256,
               [&](int k, int c) { const int n = 64 * ti + k; const uint2 u = *(const uint2*)(kc + (size_t)n * 64 + c * 4); return make_float4(bflo(u.x), bfhi(u.x), bflo(u.y), bfhi(u.y)); },
               [&](int k, int r, float sv) { const int n = 64 * ti + k; const int rel = qpos - (16 * n + 31); return (n < 127) ? sv + btab[r * 129 + (rel < 128 ? rel : 128)] : -3.0e38f; }, lane);
    } else {
      const int k0 = (ti - 2) * 64;
      sa_tile4(q4, Pw + k0 * 4,
               [&](int k, int c) { const int key = (k0 + k < 516) ? k0 + k : 515;
                 const float* rp = (key < 512) ? (p.swk + ((size_t)b * 512 + key) * 128 + g * 64) : (fresh_wk + (size_t)(key - 512) * 128);
                 return *(const float4*)(rp + c * 4); },
               [&](int k, int r, float sv) { const int key = k0 + k; const int rel = qpos - (PAST - 512 + key);
                 const bool ok = key < 516 && rel >= 0 && rel < 512; return ok ? sv + btab[r * 129 + (rel < 128 ? rel : 128)] : -3.0e38f; }, lane);
    }
  }
  __syncthreads();
  sa_softmax_row(Pc, 128, w, lane);
  sa_softmax_row(Pw, 576, w, lane);
  __syncthreads();
  if (w == 0) {
    float sm = 0.f;
    {
      const int j = lane < 33 ? lane : 32;
      for (int u = -1; u <= 3; ++u) { const int n = 4 * j + u; if (n >= 0 && n < 127) { const float4 p4 = *(const float4*)(Pc + n * 4); sm += (p4.x + p4.y + p4.z + p4.w) * ((u == -1 || u == 3) ? 1.f : 2.f); } }
    }
    float v = (lane >= 1 && lane <= 30) ? sm : -2.f;
    if (lane == 0) { sel[0] = 0; sel[1] = 31; sel[2] = 32; }
    for (int c = 0; c < 5; ++c) {
      const float best = wave_max(v);
      const unsigned long long mk = __ballot(v == best);
      const int bi = __ffsll((long long)mk) - 1;
      if (lane == 0) sel[3 + c] = bi;
      if (lane == bi) v = -3.f;
    }
  }
  __syncthreads();
  for (int jj = w; jj < 8; jj += 4) {
    const int blk = sel[jj];
    const float* kbase = (blk < 32) ? (p.csk + (((size_t)pts[blk >> 1] * 128 + (blk & 1) * 64) * 2 + g) * 64) : fresh_sk;
    sa_tile4(q4, Ps + jj * 256,
             [&](int k, int c) { const int kk = (blk < 32) ? k : (k & 3); return *(const float4*)(kbase + (size_t)kk * 128 + c * 4); },
             [&](int k, int r, float sv) { const int rel = qpos - (blk * 64 + k); const bool ok = (blk < 32 || k < 4) && rel >= 0;
               return ok ? sv + btab[r * 129 + (rel < 0 ? 0 : (rel < 128 ? rel : 128))] : -3.0e38f; }, lane);
  }
  {
    float oc[4] = {0.f, 0.f, 0.f, 0.f}, ow[4] = {0.f, 0.f, 0.f, 0.f};
    const u16* vc = (const u16*)(p.ws + W_VCMP) + (size_t)(seq * 2 + g) * 128 * 64;
    sa_pv(Pc, 32 * w, (32 * w + 32 < 127) ? 32 * w + 32 : 127, [&](int k, int l) { return bf2f(vc[(size_t)k * 64 + l]); }, lane, oc);
    const float* vst = p.swv + (size_t)b * 512 * 128 + g * 64;
    sa_pv(Pw, 129 * w, 129 * w + 129, [&](int k, int l) { const float* rp = (k < 512) ? (vst + (size_t)k * 128) : (fresh_wv + (size_t)(k - 512) * 128); return rp[l]; }, lane, ow);
#pragma unroll
    for (int r = 0; r < 4; ++r) { obuf[((0 * 4 + w) * 4 + r) * 64 + lane] = oc[r]; obuf[((1 * 4 + w) * 4 + r) * 64 + lane] = ow[r]; }
  }
  __syncthreads();
  sa_softmax_row(Ps, 512, w, lane);
  __syncthreads();
  {
    float os[4] = {0.f, 0.f, 0.f, 0.f};
    for (int jj = 2 * w; jj < 2 * w + 2; ++jj) {
      const int blk = sel[jj];
      const float* vbase; int ns;
      if (blk < 32) { vbase = p.csv + (((size_t)pts[blk >> 1] * 128 + (blk & 1) * 64) * 2 + g) * 64; ns = 64; } else { vbase = fresh_sv; ns = 4; }
      sa_pv(Ps + jj * 64 * 4, 0, ns, [&](int k, int l) { return vbase[(size_t)k * 128 + l]; }, lane, os);
    }
#pragma unroll
    for (int r = 0; r < 4; ++r) obuf[((2 * 4 + w) * 4 + r) * 64 + lane] = os[r];
  }
  __syncthreads();
  {
    const int r = tid >> 6, hd = g * 4 + r;
    const float* gt = (const float*)(p.ws + W_GATE) + tok * 24;
    float o = 0.f;
#pragma unroll
    for (int br = 0; br < 3; ++br) {
      float a = 0.f;
#pragma unroll
      for (int ww = 0; ww < 4; ++ww) a += obuf[((br * 4 + ww) * 4 + r) * 64 + lane];
      o += gt[(br == 0 ? 0 : (br == 1 ? 16 : 8)) + hd] * a;
    }
    ((u16*)(p.ws + W_OA))[tok * 512 + hd * 64 + lane] = f2bf(o * bf2f(((const u16*)(p.ws + W_ZA))[tok * 512 + hd * 64 + lane]));
  }
}

constexpr int P2_HP = BATCH * 4 * 32;
constexpr int P2_CMP = BATCH * 2 * 2;
constexpr int P2_SA = DEC_BATCH * 2 * 4;
constexpr int P2_HS = DEC_BATCH * 4;
constexpr int P2_TOTAL = P2_HP + P2_CMP + P2_SA + P2_HS;
DI void phase2_item(const Params& p, int it, char* lds) {
  if (it < P2_SA) { sample_attn_item(p, it, lds); return; }
  it -= P2_SA;
  if (it < P2_CMP) {
    const int kv = it & 1, g = (it >> 1) & 1, b = it >> 2;
    LoadCellBf16 al{(const u16*)(p.ws + W_KV) + (size_t)kv * NT * 128 + (size_t)b * 2048 * 128 + g * 64};
    comp_tile(p, al, b, g, kv, lds); return;
  }
  it -= P2_CMP;
  if (it < P2_HS) { hgrn_sample_item(p, it, lds); return; }
  it -= P2_HS;
  hgrn_h1_item(p, it, lds);
}

constexpr int AKS = 72, AVS = 68, ACS = 132;
DI bf16x8 pack8(const f32x16& x, int s2) {
  uint4 u; u.x = pk2(x[8 * s2], x[8 * s2 + 1]); u.y = pk2(x[8 * s2 + 2], x[8 * s2 + 3]);
  u.z = pk2(x[8 * s2 + 4], x[8 * s2 + 5]); u.w = pk2(x[8 * s2 + 6], x[8 * s2 + 7]);
  return __builtin_bit_cast(bf16x8, u);
}
DI void zero16(f32x16& x) {
#pragma unroll
  for (int i = 0; i < 16; ++i) x[i] = 0.f;
}

template <bool WIN, bool FAST>
DI void attn_tile(const u16* Kt, const u16* Vt, const float* brel_r, float cfar, const bf16x8 (&qf)[4], int qpos, int kpos0, bool lane_on,
                  float& m_run, float& l_run, f32x16 (&oacc)[2], int ql, int hh) {
  f32x16 sacc[2];
#pragma unroll
  for (int kt = 0; kt < 2; ++kt) {
    zero16(sacc[kt]);
#pragma unroll
    for (int ks = 0; ks < 4; ++ks) {
      const bf16x8 kf = *(const bf16x8*)(Kt + (32 * kt + ql) * AKS + 16 * ks + 8 * hh);
      sacc[kt] = MFMA32(kf, qf[ks], sacc[kt]);
    }
  }
  float mt = -1.0e30f;
  if (FAST) {
#pragma unroll
    for (int kt = 0; kt < 2; ++kt)
#pragma unroll
      for (int i = 0; i < 16; ++i) mt = fmaxf(mt, sacc[kt][i]);
    mt = lane_on ? mt + cfar : -1.0e30f;
  } else {
#pragma unroll
    for (int kt = 0; kt < 2; ++kt)
#pragma unroll
      for (int i = 0; i < 16; ++i) {
        const int rel = qpos - (kpos0 + 32 * kt + crow(i, hh));
        const bool ok = lane_on && rel >= 0 && (!WIN || rel < 512);
        const float sv = sacc[kt][i] + brel_r[rel < 0 ? 0 : (rel < 128 ? rel : 128)];
        sacc[kt][i] = ok ? sv : -1.0e30f;
        mt = fmaxf(mt, sacc[kt][i]);
      }
  }
  mt = fmaxf(mt, __shfl_xor(mt, 32));
  const float mn = fmaxf(m_run, mt);
  if (!__all(mn == m_run)) {
    const float alpha = __builtin_amdgcn_exp2f(m_run - mn);
    l_run *= alpha;
#pragma unroll
    for (int dt = 0; dt < 2; ++dt)
#pragma unroll
      for (int i = 0; i < 16; ++i) oacc[dt][i] *= alpha;
  }
  m_run = mn;
  float ls = 0.f;
  if (FAST) {
    const float dsh = lane_on ? cfar - mn : -1.0e30f;
#pragma unroll
    for (int kt = 0; kt < 2; ++kt)
#pragma unroll
      for (int i = 0; i < 16; ++i) { const float pv = __builtin_amdgcn_exp2f(sacc[kt][i] + dsh); sacc[kt][i] = pv; ls += pv; }
  } else {
#pragma unroll
    for (int kt = 0; kt < 2; ++kt)
#pragma unroll
      for (int i = 0; i < 16; ++i) {
        const float pv = (sacc[kt][i] > -1.0e29f) ? __builtin_amdgcn_exp2f(sacc[kt][i] - mn) : 0.f;
        sacc[kt][i] = pv; ls += pv;
      }
  }
  l_run += ls;
#pragma unroll
  for (int kt = 0; kt < 2; ++kt)
#pragma unroll
    for (int s2 = 0; s2 < 2; ++s2) {
      const bf16x8 pf = pack8(sacc[kt], s2);
#pragma unroll
      for (int dt = 0; dt < 2; ++dt) {
        const u16* vp = Vt + (32 * kt + 16 * s2 + 4 * hh + ((ql & 15) >> 2)) * AKS + 32 * dt + (ql & 16) + 4 * (ql & 3);
        const bf16x8 vf = cat8(tr_read(vp), tr_read(vp + 8 * AKS));
        oacc[dt] = MFMA32(vf, pf, oacc[dt]);
      }
    }
}

DI void attn_load_tile(u16* Kt, u16* Vt, const u16* ksrc  , const u16* vtsrc  ) {
  const int tid = otid512();
  {
    const int idx = tid, rw = idx >> 3, ch = idx & 7;
    *(uint4*)(Kt + rw * AKS + ch * 8) = *(const uint4*)(ksrc + (size_t)rw * 128 + ch * 8);
    const uint4 v = *(const uint4*)(vtsrc + (size_t)rw * 2048 + ch * 8);
    *(uint2*)(Vt + rw * AVS + ch * 8) = make_uint2(v.x, v.y);
    *(uint2*)(Vt + rw * AVS + ch * 8 + 4) = make_uint2(v.z, v.w);
  }
}

DI void prompt_attn_item(const Params& p, int it, char* lds) {
  const int qt = (it < 256) ? (31 - (it & 31)) : (it & 31), g = (it >> 5) & 1, b = (it >> 6) & 3 | ((it >> 8) << 2);
  const int t0 = qt * 64;
  const int tid = otid512(), lane = tid & 63, w = tid >> 6, ql = lane & 31, hh = lane >> 5, tl = ql >> 2, r = ql & 3;
  const int qpos = t0 + 8 * w + tl, head = g * 4 + r;
  const size_t tok = (size_t)b * 2048 + qpos;
  u16* Kt = (u16*)lds;
  u16* Vt = Kt + 128 * AKS;
  float* brel = (float*)(Vt + 128 * AKS);
  unsigned* wmask = (unsigned*)(brel + 4 * 129);
  const u16* Qb = (const u16*)(p.ws + W_Q);
  __syncthreads();
  for (int i = tid; i < 4 * 129; i += 512) { const int rr = i / 129, rel = i % 129; const int bk = rel < 128 ? T5B[rel] : 31; brel[i] = p.rel_bias[bk * 8 + g * 4 + rr] * LOG2E; }
  bf16x8 qf[4];
#pragma unroll
  for (int ks = 0; ks < 4; ++ks) qf[ks] = *(const bf16x8*)(Qb + tok * 512 + head * 64 + 16 * ks + 8 * hh);
  const float* gt = (const float*)(p.ws + W_GATE) + tok * 24;
  const float* brel_r = brel + r * 129;
  const float cfar = p.rel_bias[31 * 8 + head] * LOG2E;
  f32x16 of[2];
  unsigned selm;
  {
#pragma unroll
    for (int i = 0; i < 2; ++i) {
      const int idx = tid + 512 * i, n = idx >> 3, ch = idx & 7;
      *(uint4*)(Kt + n * AKS + ch * 8) = *(const uint4*)((const u16*)(p.ws + W_KCMP) + ((size_t)(b * 2 + g) * 128 + n) * 64 + ch * 8);
      *(uint4*)(Vt + n * AKS + ch * 8) = *(const uint4*)((const u16*)(p.ws + W_VCMP) + ((size_t)(b * 2 + g) * 128 + n) * 64 + ch * 8);
    }
    __syncthreads();
    f32x16 sacc[4];
#pragma unroll
    for (int kt = 0; kt < 4; ++kt) {
      zero16(sacc[kt]);
#pragma unroll
      for (int ks = 0; ks < 4; ++ks) {
        const bf16x8 kf = *(const bf16x8*)(Kt + (32 * kt + ql) * AKS + 16 * ks + 8 * hh);
        sacc[kt] = MFMA32(kf, qf[ks], sacc[kt]);
      }
    }
    float mt = -1.0e30f;
#pragma unroll
    for (int kt = 0; kt < 4; ++kt)
#pragma unroll
      for (int i = 0; i < 16; ++i) {
        const int n = 32 * kt + crow(i, hh);
        const int rel = qpos - (16 * n + 31);
        const bool ok = rel >= 0 && n < 127;
        const float sv = sacc[kt][i] + brel_r[rel < 0 ? 0 : (rel < 128 ? rel : 128)];
        sacc[kt][i] = ok ? sv : -1.0e30f;
        mt = fmaxf(mt, sacc[kt][i]);
      }
    mt = fmaxf(mt, __shfl_xor(mt, 32));
    float ls = 0.f;
#pragma unroll
    for (int kt = 0; kt < 4; ++kt)
#pragma unroll
      for (int i = 0; i < 16; ++i) { const float pv = (sacc[kt][i] > -1.0e29f) ? __builtin_amdgcn_exp2f(sacc[kt][i] - mt) : 0.f; sacc[kt][i] = pv; ls += pv; }
    ls += __shfl_xor(ls, 32);
    const float inv = ls > 0.f ? 1.f / ls : 0.f;
#pragma unroll
    for (int kt = 0; kt < 4; ++kt)
#pragma unroll
      for (int i = 0; i < 16; ++i) sacc[kt][i] *= inv;
    f32x16 oc[2]; zero16(oc[0]); zero16(oc[1]);
#pragma unroll
    for (int kt = 0; kt < 4; ++kt)
#pragma unroll
      for (int s2 = 0; s2 < 2; ++s2) {
        const bf16x8 pf = pack8(sacc[kt], s2);
#pragma unroll
        for (int dt = 0; dt < 2; ++dt) {
          const u16* vp = Vt + (32 * kt + 16 * s2 + 4 * hh + ((ql & 15) >> 2)) * AKS + 32 * dt + (ql & 16) + 4 * (ql & 3);
          const bf16x8 vf = cat8(tr_read(vp), tr_read(vp + 8 * AKS));
          oc[dt] = MFMA32(vf, pf, oc[dt]);
        }
      }
    const float g0 = gt[head];
#pragma unroll
    for (int dt = 0; dt < 2; ++dt)
#pragma unroll
      for (int i = 0; i < 16; ++i) of[dt][i] = g0 * oc[dt][i];
    float im[16], cm[16];
#pragma unroll
    for (int kt = 0; kt < 4; ++kt)
#pragma unroll
      for (int q4 = 0; q4 < 4; ++q4) {
        const float p0 = sacc[kt][4 * q4], p1 = sacc[kt][4 * q4 + 1], p2 = sacc[kt][4 * q4 + 2], p3 = sacc[kt][4 * q4 + 3];
        im[4 * kt + q4] = 2.f * (p0 + p1 + p2) + p3; cm[4 * kt + q4] = p3;
      }
#pragma unroll
    for (int m = 0; m < 16; ++m) cm[m] = __shfl_xor(cm[m], 32);
#pragma unroll
    for (int m = 15; m >= 0; --m) im[m] += hh ? cm[m] : (m > 0 ? cm[m - 1] : 0.f);
#pragma unroll
    for (int m = 0; m < 16; ++m) { im[m] += __shfl_xor(im[m], 1); im[m] += __shfl_xor(im[m], 2); }
    float ev[16], od[16];
#pragma unroll
    for (int m = 0; m < 16; ++m) { const float ot = __shfl_xor(im[m], 32); ev[m] = hh ? ot : im[m]; od[m] = hh ? im[m] : ot; }
    const int cur = qpos >> 6;
    if (cur < 8) selm = (2u << cur) - 1u;
    else {
      selm = 1u | (1u << cur) | (1u << (cur - 1));
      for (int c = 0; c < 5; ++c) {
        float best = -1.f;
#pragma unroll
        for (int J = 0; J < 32; ++J) { const float v = (J <= cur && !((selm >> J) & 1u)) ? ((J & 1) ? od[J >> 1] : ev[J >> 1]) : -1.f; best = fmaxf(best, v); }
        int bi = 32;
#pragma unroll
        for (int J = 31; J >= 0; --J) { const float v = (J <= cur && !((selm >> J) & 1u)) ? ((J & 1) ? od[J >> 1] : ev[J >> 1]) : -1.f; if (v == best) bi = J; }
        if (best >= 0.f) selm |= 1u << bi;
      }
    }
    unsigned um = selm;
    um |= __shfl_xor(um, 4); um |= __shfl_xor(um, 8); um |= __shfl_xor(um, 16);
    if (lane == 0) wmask[w] = um;
  }
  __syncthreads();
  const unsigned un = wmask[0] | wmask[1] | wmask[2] | wmask[3] | wmask[4] | wmask[5] | wmask[6] | wmask[7];
  {
    const u16* ks = (const u16*)(p.ws + W_KV) + (size_t)2 * NT * 128 + (size_t)b * 2048 * 128 + g * 64;
    const u16* vts = (const u16*)(p.ws + W_KV) + (size_t)3 * NT * 128 + (size_t)b * 2048 * 128 + g * 64;
    const u16* kw = (const u16*)(p.ws + W_KV) + (size_t)4 * NT * 128 + (size_t)b * 2048 * 128 + g * 64;
    const u16* vtw = (const u16*)(p.ws + W_KV) + (size_t)5 * NT * 128 + (size_t)b * 2048 * 128 + g * 64;
    const int rw = tid >> 3, ch = tid & 7;
    uint4 kreg, vreg;
#define ATT_PREFETCH(kb, vb, j_) do { kreg = *(const uint4*)((kb) + ((size_t)(j_) * 64 + rw) * 128 + ch * 8); vreg = *(const uint4*)((vb) + ((size_t)(j_) * 64 + rw) * 128 + ch * 8); } while (0)
#define ATT_COMMIT() do { *(uint4*)(Kt + rw * AKS + ch * 8) = kreg; *(uint4*)(Vt + rw * AKS + ch * 8) = vreg; } while (0)
    const int jlo = (t0 >= 511) ? ((t0 - 511) >> 6) : 0, jhi = (t0 + 63) >> 6;
    {
      float m_run = -1.0e30f, l_run = 0.f; f32x16 oacc[2]; zero16(oacc[0]); zero16(oacc[1]);
      unsigned rem = un;
      int j = __builtin_ctz(rem); rem &= rem - 1u;
      ATT_PREFETCH(ks, vts, j);
      for (;;) {
        __syncthreads();
        ATT_COMMIT();
        __syncthreads();
        const int jn = rem ? __builtin_ctz(rem) : -1;
        if (jn >= 0) { rem &= rem - 1u; ATT_PREFETCH(ks, vts, jn); } else { ATT_PREFETCH(kw, vtw, jlo); }
        const bool on = (selm >> j) & 1u;
        if (__ballot(on) != 0ull) {
          if (64 * j + 63 + 128 <= t0 + 8 * w) attn_tile<false, true>(Kt, Vt, brel_r, cfar, qf, qpos, j * 64, on, m_run, l_run, oacc, ql, hh);
          else attn_tile<false, false>(Kt, Vt, brel_r, cfar, qf, qpos, j * 64, on, m_run, l_run, oacc, ql, hh);
        }
        if (jn < 0) break;
        j = jn;
      }
      l_run += __shfl_xor(l_run, 32);
      const float sc = gt[8 + head] * (l_run > 0.f ? 1.f / l_run : 0.f);
#pragma unroll
      for (int dt = 0; dt < 2; ++dt)
#pragma unroll
        for (int i = 0; i < 16; ++i) of[dt][i] += sc * oacc[dt][i];
    }
    {
      float m_run = -1.0e30f, l_run = 0.f; f32x16 oacc[2]; zero16(oacc[0]); zero16(oacc[1]);
      for (int j = jlo; j <= jhi; ++j) {
        __syncthreads();
        ATT_COMMIT();
        __syncthreads();
        if (j < jhi) ATT_PREFETCH(kw, vtw, j + 1);
        if (64 * j + 63 + 128 <= t0 + 8 * w && 64 * j + 511 >= t0 + 8 * w + 7) attn_tile<true, true>(Kt, Vt, brel_r, cfar, qf, qpos, j * 64, true, m_run, l_run, oacc, ql, hh);
        else attn_tile<true, false>(Kt, Vt, brel_r, cfar, qf, qpos, j * 64, true, m_run, l_run, oacc, ql, hh);
      }
      l_run += __shfl_xor(l_run, 32);
      const float sc = gt[16 + head] * (l_run > 0.f ? 1.f / l_run : 0.f);
#pragma unroll
      for (int dt = 0; dt < 2; ++dt)
#pragma unroll
        for (int i = 0; i < 16; ++i) of[dt][i] += sc * oacc[dt][i];
    }
#undef ATT_PREFETCH
#undef ATT_COMMIT
  }
  {
    const u16* za = (const u16*)(p.ws + W_ZA) + tok * 512 + head * 64; u16* oa = (u16*)(p.ws + W_OA) + tok * 512 + head * 64;
#pragma unroll
    for (int dt = 0; dt < 2; ++dt)
#pragma unroll
      for (int q4 = 0; q4 < 4; ++q4) {
        const int dd = 32 * dt + 8 * q4 + 4 * hh;
        const uint2 z = *(const uint2*)(za + dd);
        uint2 o; o.x = pk2(of[dt][4 * q4] * bflo(z.x), of[dt][4 * q4 + 1] * bfhi(z.x)); o.y = pk2(of[dt][4 * q4 + 2] * bflo(z.y), of[dt][4 * q4 + 3] * bfhi(z.y));
        *(uint2*)(oa + dd) = o;
      }
  }
}
constexpr int P3_FIN = BATCH * 4 * 32;
constexpr int P3_ATT = BATCH * 2 * 32;
constexpr int P3_TOTAL = P3_FIN + P3_ATT;

constexpr int P4_TOTAL = 128 * 8 + 4 * 16;
template <int NI>
DI void merge_a_tile_t(const Params& p, int tm, int tn, char* lds) {
  f32x16 aa[2][NI], ab[2][NI]; zero_acc<NI>(aa); zero_acc<NI>(ab);
  gemm_glds<NI>(aa, (const u16*)(p.ws + W_OA) + (size_t)tm * 128 * 512, 512, (const u16*)(p.ws + W_WBAT) + (size_t)tn * 64 * NI * 512, 512, 8, lds);
  gemm_glds<NI>(ab, (const u16*)(p.ws + W_OB) + (size_t)tm * 128 * 512, 512, (const u16*)(p.ws + W_WBBT) + (size_t)tn * 64 * NI * 512, 512, 8, lds);
  const int tid = otid(), lane = tid & 63, wave = tid >> 6, wm = wave >> 1, wn = wave & 1, r = lane & 31, h = lane >> 5;
#pragma unroll
  for (int mi = 0; mi < 2; ++mi)
#pragma unroll
    for (int ni = 0; ni < NI; ++ni) {
      const int c = tn * 64 * NI + wn * 32 * NI + ni * 32 + r;
#pragma unroll
      for (int i = 0; i < 16; ++i) {
        const size_t off = (size_t)(tm * 128 + wm * 64 + mi * 32 + crow(i, h)) * 1024 + c;
        const float y = bf2f(((const u16*)(p.ws + W_SA))[off]) * aa[mi][ni][i] + bf2f(((const u16*)(p.ws + W_SB))[off]) * ab[mi][ni][i];
        ((u16*)(p.ws + W_Y))[off] = f2bf(y);
      }
    }
}
DI void merge_a_tile(const Params& p, int it, char* lds) {
  if (it < 1024) merge_a_tile_t<2>(p, it >> 3, it & 7, lds);
  else { it -= 1024; merge_a_tile_t<1>(p, 128 + (it >> 4), it & 15, lds); }
}
constexpr int P5_TOTAL = 128 * 8 + 4 * 16;
template <int NI>
DI void merge_b_tile_t(const Params& p, int tm, int tn, char* lds) {
  f32x16 acc[2][NI]; zero_acc<NI>(acc);
  gemm_glds<NI>(acc, (const u16*)(p.ws + W_Y) + (size_t)tm * 128 * 1024, 1024, (const u16*)(p.ws + W_WOUTT) + (size_t)tn * 64 * NI * 1024, 1024, 16, lds);
  const int tid = otid(), lane = tid & 63, wave = tid >> 6, wm = wave >> 1, wn = wave & 1, r = lane & 31, h = lane >> 5;
  const float* xin = (tm < 128) ? p.x_prompt : (p.x_sample - (size_t)NTP * 1024);
#pragma unroll
  for (int mi = 0; mi < 2; ++mi) {
#pragma unroll
    for (int i = 0; i < 16; ++i) {
      const size_t row = (size_t)(tm * 128 + wm * 64 + mi * 32 + crow(i, h));
#pragma unroll
      for (int ni = 0; ni < NI; ++ni) {
        const int c = tn * 64 * NI + wn * 32 * NI + ni * 32 + r;
        p.out[row * 1024 + c] = acc[mi][ni][i] + xin[row * 1024 + c];
      }
    }
  }
}
DI void merge_b_tile(const Params& p, int it, char* lds) {
  if (it < 1024) merge_b_tile_t<2>(p, it >> 3, it & 7, lds);
  else { it -= 1024; merge_b_tile_t<1>(p, 128 + (it >> 4), it & 15, lds); }
}
constexpr int P6_TOTAL = NT / 8;
DI void final_norm_item(const Params& p, int it) {
  const int tid_ = otid(), lane = tid_ & 63, wave = tid_ >> 6; const size_t row = (size_t)it * 8 + wave * 2;
  float* o = p.out + row * 1024;
  float4 v[2][4]; float ss[2] = {0.f, 0.f};
#pragma unroll
  for (int rr = 0; rr < 2; ++rr)
#pragma unroll
    for (int i = 0; i < 4; ++i) v[rr][i] = *(const float4*)(o + rr * 1024 + (i * 64 + lane) * 4);
#pragma unroll
  for (int rr = 0; rr < 2; ++rr) {
#pragma unroll
    for (int i = 0; i < 4; ++i) ss[rr] += v[rr][i].x * v[rr][i].x + v[rr][i].y * v[rr][i].y + v[rr][i].z * v[rr][i].z + v[rr][i].w * v[rr][i].w;
    ss[rr] = wave_sum(ss[rr]);
  }
#pragma unroll
  for (int rr = 0; rr < 2; ++rr) {
    const float rs = rsqrtf(ss[rr] * (1.f / 1024.f) + 1e-6f);
#pragma unroll
    for (int i = 0; i < 4; ++i) {
      const float4 gg = *(const float4*)(p.final_g + (i * 64 + lane) * 4);
      *(float4*)(o + rr * 1024 + (i * 64 + lane) * 4) = make_float4(v[rr][i].x * rs * gg.x, v[rr][i].y * rs * gg.y, v[rr][i].z * rs * gg.z, v[rr][i].w * rs * gg.w);
    }
  }
}

namespace pg8 {
#define PG8_LAS __attribute__((address_space(3)))
typedef unsigned short bf16_t;
typedef short bf16x8 __attribute__((ext_vector_type(8)));
typedef float f32x4 __attribute__((ext_vector_type(4)));
typedef unsigned u32x4 __attribute__((ext_vector_type(4)));
constexpr int BM = 256, BK = 64, HALF = 128, HTB = HALF * BK * 2  , STAGE_BYTES = 8 * HTB, NXCD = 8, WGM = 8;

__host__ __device__ __forceinline__ int lds_byte(int r, int c) { const int st = (r >> 4) * 2 + (c >> 5), rr = r & 15, cc = c & 31, ob = rr * 64 + cc * 2; return st * 1024 + (ob ^ (((ob >> 9) & 1) << 5)); }
__host__ __device__ __forceinline__ void stage_rc(int b, int& R, int& C) { const int st = b / 1024, sb = b % 1024, swz = sb ^ (((sb >> 9) & 1) << 5); R = (st >> 1) * 16 + swz / 64; C = (st & 1) * 32 + (swz % 64) / 2; }
__host__ __device__ __forceinline__ int perm32(int rho) { const int n = rho >> 4, i = rho & 15; return 8 * (i >> 2) + 4 * n + (i & 3); }

struct Unit { int pm, pn; };
struct Gemm { const bf16_t* A; const bf16_t* Bt; int M, N, K; };

struct StaticOrder {
    int nM, nN, nwg, G, c;
    __host__ __device__ void init(int M, int N, int G_, int c_) { nM = M / BM; nN = N / BM; nwg = nM * nN; G = G_; c = c_; }
    __host__ __device__ bool next(int i, Unit& u) const {
        const long L = (long)i * G + c; if (L >= nwg) return false;
        int wgid = (int)L; { const int q = nwg / NXCD, r = nwg % NXCD, xcd = wgid % NXCD, off = wgid / NXCD; wgid = (xcd < r ? xcd * (q + 1) : r * (q + 1) + (xcd - r) * q) + off; }
        const int nig = WGM * nN, gid = wgid / nig, fm = gid * WGM, gsz = (nM - fm) < WGM ? (nM - fm) : WGM;
        u.pm = fm + ((wgid % nig) % gsz); u.pn = (wgid % nig) / gsz; return true;
    }
    __device__ __forceinline__ void a_ready(const Unit&) const {}
    __device__ __forceinline__ void done(const Unit&) const {}
};

template <class Epi, class Sched, bool STAMP = false>
__device__ __forceinline__ void gemm_phase(PG8_LAS unsigned char* lds, const Gemm g, const Sched& S, const Epi& E, unsigned long long* stamps) {
    int tid_ = threadIdx.x; asm volatile("" : "+v"(tid_));
    const int tid = tid_, wid = __builtin_amdgcn_readfirstlane(tid >> 6), lane = tid & 63, wr = wid >> 2, wc = wid & 3, fr = lane & 15, fq = lane >> 4;
    const int K = g.K, nt = K / BK;
    int ts_lo = 0, ts_hi = 0, nts = 0; const unsigned long long rt_entry = STAMP ? (unsigned long long)wall_clock64() : 0ull;
#define PG8_STAMP() do { if (STAMP && wid == 0 && nts < 64) { const unsigned long long _c = (unsigned long long)clock64(); \
        ts_lo = (lane == nts) ? (int)(unsigned)_c : ts_lo; ts_hi = (lane == nts) ? (int)(unsigned)(_c >> 32) : ts_hi; ++nts; } } while (0)
    PG8_STAMP();
    unsigned voffA[2], voffB[2];
#pragma unroll
    for (int i = 0; i < 2; ++i) { int R, C; stage_rc(tid * 16 + i * 8192, R, C); const int Rb = Epi::PERM ? ((R & ~31) + perm32(R & 31)) : R;
        voffA[i] = (unsigned)(R * K + C) * 2u; voffB[i] = (unsigned)(Rb * K + C) * 2u; }
    const size_t kstep = (size_t)(BK * 2);
    const size_t hstep = (size_t)HALF * K * 2;
    const size_t tstep = 2 * hstep;
    const unsigned ldsw = (unsigned)wid * 1024u;
    const int aoff = lds_byte(wr * 64 + fr, fq * 8), boff = lds_byte(wc * 32 + fr, fq * 8);
#define PG8_SA(b, h) (((b) * 2 + (h)) * HTB)
#define PG8_SB(b, h) ((4 + (b) * 2 + (h)) * HTB)
#define PG8_STAGE(bufoff, gbase, voff) do { _Pragma("unroll") for (int _i = 0; _i < 2; ++_i) \
        __builtin_amdgcn_global_load_lds((const unsigned*)((const char*)(gbase) + (voff)[_i]), (PG8_LAS unsigned*)(lds + (bufoff) + ldsw + _i * 8192), 16, 0, 0); } while (0)
#define PG8_LDA(dst, b, h) do { _Pragma("unroll") for (int m = 0; m < 4; ++m) _Pragma("unroll") for (int k = 0; k < 2; ++k) dst[m][k] = *(const PG8_LAS bf16x8*)(lds + PG8_SA(b, h) + aoff + m * 2048 + k * 1024); } while (0)
#define PG8_LDB(dst, b, h) do { _Pragma("unroll") for (int n = 0; n < 2; ++n) _Pragma("unroll") for (int k = 0; k < 2; ++k) dst[n][k] = *(const PG8_LAS bf16x8*)(lds + PG8_SB(b, h) + boff + n * 2048 + k * 1024); } while (0)
#define PG8_MMA(ai, bj, At, Bt) do { __builtin_amdgcn_s_setprio(1); _Pragma("unroll") for (int m = 0; m < 4; ++m) _Pragma("unroll") for (int n = 0; n < 2; ++n) _Pragma("unroll") for (int k = 0; k < 2; ++k) \
        acc[ai][bj][m][n] = __builtin_amdgcn_mfma_f32_16x16x32_bf16(Bt[n][k], At[m][k], acc[ai][bj][m][n], 0, 0, 0); __builtin_amdgcn_s_setprio(0); } while (0)
#define PG8_WAIT_V(n) asm volatile("s_waitcnt vmcnt(" #n ")" ::: "memory")
#define PG8_WAIT_L(n) asm volatile("s_waitcnt lgkmcnt(" #n ")" ::: "memory")
#define PG8_BAR __builtin_amdgcn_s_barrier()
#define PG8_SCHED __builtin_amdgcn_sched_barrier(0)
    Unit cur, nxt; int ui = 0;
    if (!S.next(0, cur)) return;
    f32x4 acc[2][2][4][2];
#pragma unroll
    for (int a = 0; a < 2; ++a)
#pragma unroll
        for (int b = 0; b < 2; ++b)
#pragma unroll
            for (int m = 0; m < 4; ++m)
#pragma unroll
                for (int n = 0; n < 2; ++n) acc[a][b][m][n] = (f32x4){0.f, 0.f, 0.f, 0.f};
    bf16x8 At[4][2], B0[2][2], B1[2][2];
    const char* cA = (const char*)g.A + (size_t)cur.pm * tstep; const char* cB = (const char*)g.Bt + (size_t)cur.pn * tstep;
    S.a_ready(cur);
    PG8_STAGE(PG8_SB(0, 0), cB, voffB); PG8_STAGE(PG8_SA(0, 0), cA, voffA); PG8_STAGE(PG8_SB(0, 1), cB + hstep, voffB); PG8_STAGE(PG8_SA(0, 1), cA + hstep, voffA);
    if (wr == 1) PG8_BAR;
    PG8_WAIT_V(4); PG8_BAR;
    PG8_STAGE(PG8_SB(1, 0), cB + kstep, voffB); PG8_STAGE(PG8_SA(1, 0), cA + kstep, voffA); PG8_STAGE(PG8_SB(1, 1), cB + hstep + kstep, voffB);
    PG8_WAIT_V(6); PG8_BAR;
    PG8_STAMP();
    for (;;) {
        const bool has_next = S.next(ui + 1, nxt);
        const char* nA = has_next ? (const char*)g.A + (size_t)nxt.pm * tstep : cA; const char* nB = has_next ? (const char*)g.Bt + (size_t)nxt.pn * tstep : cB;
        for (int t = 0; t < nt; t += 2) {
            const bool last = (t == nt - 2);
            const char* a1 = cA + (size_t)(t + 1) * kstep;
            const char* a2 = last ? nA : cA + (size_t)(t + 2) * kstep; const char* b2 = last ? nB : cB + (size_t)(t + 2) * kstep;
            const char* a3 = a2 + kstep; const char* b3 = b2 + kstep;
            if (last && has_next) S.a_ready(nxt);
            PG8_LDB(B0, 0, 0); PG8_SCHED; PG8_LDA(At, 0, 0); PG8_STAGE(PG8_SA(1, 1), a1 + hstep, voffA);
            PG8_WAIT_L(8); PG8_BAR; PG8_WAIT_L(0); PG8_MMA(0, 0, At, B0); PG8_BAR; PG8_SCHED;
            PG8_LDB(B1, 0, 1); PG8_STAGE(PG8_SB(0, 0), b2, voffB);
            PG8_BAR; PG8_WAIT_L(0); PG8_MMA(0, 1, At, B1); PG8_BAR;
            PG8_LDA(At, 0, 1); PG8_STAGE(PG8_SA(0, 0), a2, voffA);
            PG8_BAR; PG8_WAIT_L(0); PG8_MMA(1, 0, At, B0); PG8_BAR; PG8_SCHED;
            PG8_STAGE(PG8_SB(0, 1), b2 + hstep, voffB);
            PG8_WAIT_V(6); PG8_BAR; PG8_MMA(1, 1, At, B1); PG8_BAR;
            PG8_LDB(B0, 1, 0); PG8_SCHED; PG8_LDA(At, 1, 0); PG8_STAGE(PG8_SA(0, 1), a2 + hstep, voffA);
            PG8_WAIT_L(8); PG8_BAR; PG8_WAIT_L(0); PG8_MMA(0, 0, At, B0); PG8_BAR; PG8_SCHED;
            PG8_LDB(B1, 1, 1); PG8_STAGE(PG8_SB(1, 0), b3, voffB);
            PG8_BAR; PG8_WAIT_L(0); PG8_MMA(0, 1, At, B1); PG8_BAR;
            PG8_LDA(At, 1, 1); PG8_STAGE(PG8_SA(1, 0), a3, voffA);
            PG8_BAR; PG8_WAIT_L(0); PG8_MMA(1, 0, At, B0); PG8_BAR; PG8_SCHED;
            PG8_STAGE(PG8_SB(1, 1), b3 + hstep, voffB);
            PG8_WAIT_V(6); PG8_BAR; PG8_MMA(1, 1, At, B1); PG8_BAR;
        }
        PG8_STAMP();
        if constexpr (!Epi::AFTER_DRAIN) { E(acc, cur, wr, wc, fr, fq); S.done(cur); }
        PG8_STAMP();
        if (!has_next) break;
#pragma unroll
        for (int a = 0; a < 2; ++a)
#pragma unroll
            for (int b = 0; b < 2; ++b)
#pragma unroll
                for (int m = 0; m < 4; ++m)
#pragma unroll
                    for (int n = 0; n < 2; ++n) acc[a][b][m][n] = (f32x4){0.f, 0.f, 0.f, 0.f};
        cur = nxt; cA = nA; cB = nB; ++ui;
    }
    PG8_WAIT_V(0);
    if (wr == 0) PG8_BAR;
    PG8_BAR;
    if constexpr (Epi::AFTER_DRAIN) { E.fused(acc, cur, wr, wc, fr, fq, lds, wid, lane); S.done(cur); }
    PG8_STAMP();
    if (STAMP && wid == 0) { stamps[lane] = lane < nts ? (((unsigned long long)(unsigned)ts_hi << 32) | (unsigned)ts_lo) : 0ull;
        if (lane == 62) stamps[62] = rt_entry; if (lane == 63) stamps[63] = (unsigned long long)wall_clock64(); }
#undef PG8_STAMP
#undef PG8_SA
#undef PG8_SB
#undef PG8_STAGE
#undef PG8_LDA
#undef PG8_LDB
#undef PG8_MMA
#undef PG8_WAIT_V
#undef PG8_WAIT_L
#undef PG8_BAR
#undef PG8_SCHED
}
}


DI uint4 pack8f(const float (&v)[8]) { uint4 u; u.x = pk2(v[0], v[1]); u.y = pk2(v[2], v[3]); u.z = pk2(v[4], v[5]); u.w = pk2(v[6], v[7]); return u; }
struct EpiProj {
  static constexpr bool PERM = true, AFTER_DRAIN = false;
  Params p;
  DI void operator()(const pg8::f32x4 (&acc)[2][2][4][2], const pg8::Unit& u, int wr, int wc, int fr, int fq) const {
    const bool samp = u.pm >= NTP / 256;
#pragma unroll
    for (int bj = 0; bj < 2; ++bj) {
      const int tn = 2 * u.pn + bj;
      const int c = wc * 32 + 8 * fq;
      if (tn >= 47 || (tn == 46 && c >= 24)) continue;
      float lb[8];
      if (tn >= 18 && tn < 22) {
#pragma unroll
        for (int j = 0; j < 8; ++j) { const int cc = (tn - 18) * 128 + c + j; lb[j] = 1.f / (1.f + __expf(p.hg_lower[512 + cc] - p.hg_lower[cc])); }
      }
#pragma unroll
      for (int ai = 0; ai < 2; ++ai)
#pragma unroll
        for (int m = 0; m < 4; ++m) {
          const size_t row = (size_t)(u.pm * 256 + ai * 128 + wr * 64 + m * 16 + fr);
          float v[8];
#pragma unroll
          for (int j = 0; j < 4; ++j) { v[j] = acc[ai][bj][m][0][j]; v[4 + j] = acc[ai][bj][m][1][j]; }
          if (tn < 4) {
#pragma unroll
            for (int j = 0; j < 8; ++j) v[j] *= 0.125f * LOG2E;
            *(uint4*)((u16*)(p.ws + W_Q) + row * 512 + tn * 128 + c) = pack8f(v);
          } else if (tn < 10) {
            const int kvg = tn - 4;
            *(uint4*)((u16*)(p.ws + W_KV) + (size_t)kvg * NT * 128 + row * 128 + c) = pack8f(v);
            float* dst = nullptr;
            if (!samp) {
              if (kvg < 4) dst = p.out + O_PCK + (size_t)kvg * NTP * 128 + row * 128 + c;
              else { const int t = (int)row & 2047, b = (int)row >> 11; if (t >= 1536) dst = p.out + O_PWK + (size_t)(kvg - 4) * BATCH * 512 * 128 + ((size_t)b * 512 + t - 1536) * 128 + c; }
            } else {
              const int srow = (int)row - NTP;
              if (kvg < 4) dst = p.out + O_SCK + (size_t)kvg * NTS * 128 + (size_t)srow * 128 + c;
              else dst = p.out + O_SWK + (size_t)(kvg - 4) * DEC_BATCH * 512 * 128 + ((size_t)(srow >> 2) * 512 + 508 + (srow & 3)) * 128 + c;
            }
            if (dst) { *(float4*)dst = make_float4(v[0], v[1], v[2], v[3]); *(float4*)(dst + 4) = make_float4(v[4], v[5], v[6], v[7]); }
          } else if (tn < 14 || (tn >= 26 && tn < 30)) {
            const bool isA = tn < 14;
#pragma unroll
            for (int j = 0; j < 8; ++j) v[j] = siluf_(v[j]);
            *(uint4*)((u16*)(p.ws + (isA ? W_ZA : W_ZB)) + row * 512 + (isA ? tn - 10 : tn - 26) * 128 + c) = pack8f(v);
          } else if (tn < 18 || (tn >= 22 && tn < 26)) {
            const bool isQ = tn < 18;
            *(uint4*)((u16*)(p.ws + (isQ ? W_QB : W_VB)) + row * 512 + (isQ ? tn - 14 : tn - 22) * 128 + c) = pack8f(v);
          } else if (tn < 22) {
            float gg[8], kk[8];
#pragma unroll
            for (int j = 0; j < 8; ++j) { const float sg = sigmoidf_(v[j]); gg[j] = __logf(lb[j] + (1.f - lb[j]) * sg); kk[j] = (1.f - lb[j]) * (1.f - sg); }
            float* dg = (float*)(p.ws + W_GB) + row * 512 + (tn - 18) * 128 + c;
            *(float4*)dg = make_float4(gg[0], gg[1], gg[2], gg[3]); *(float4*)(dg + 4) = make_float4(gg[4], gg[5], gg[6], gg[7]);
            *(uint4*)((u16*)(p.ws + W_KB) + row * 512 + (tn - 18) * 128 + c) = pack8f(kk);
          } else if (tn < 46) {
            const bool isA = tn < 38;
#pragma unroll
            for (int j = 0; j < 8; ++j) v[j] = sigmoidf_(v[j]);
            *(uint4*)((u16*)(p.ws + (isA ? W_SA : W_SB)) + row * 1024 + (isA ? tn - 30 : tn - 38) * 128 + c) = pack8f(v);
          } else {
            float* dgt = (float*)(p.ws + W_GATE) + row * 24 + c;
            *(float4*)dgt = make_float4(sigmoidf_(v[0]), sigmoidf_(v[1]), sigmoidf_(v[2]), sigmoidf_(v[3]));
            *(float4*)(dgt + 4) = make_float4(sigmoidf_(v[4]), sigmoidf_(v[5]), sigmoidf_(v[6]), sigmoidf_(v[7]));
          }
        }
    }
  }
};


struct EpiOut {
  static constexpr bool PERM = false, AFTER_DRAIN = false;
  const float* x; float* out;
  DI void operator()(const pg8::f32x4 (&acc)[2][2][4][2], const pg8::Unit& u, int wr, int wc, int fr, int fq) const {
#pragma unroll
    for (int ai = 0; ai < 2; ++ai)
#pragma unroll
      for (int m = 0; m < 4; ++m) {
        const size_t rowoff = (size_t)(u.pm * 256 + ai * 128 + wr * 64 + m * 16 + fr) * 1024 + u.pn * 256 + wc * 32 + 4 * fq;
#pragma unroll
        for (int bj = 0; bj < 2; ++bj)
#pragma unroll
          for (int n = 0; n < 2; ++n) {
            const size_t off = rowoff + bj * 128 + n * 16;
            const float4 xv = *(const float4*)(x + off);
            *(float4*)(out + off) = make_float4(acc[ai][bj][m][n][0] + xv.x, acc[ai][bj][m][n][1] + xv.y, acc[ai][bj][m][n][2] + xv.z, acc[ai][bj][m][n][3] + xv.w);
          }
      }
  }
};


template <bool SECOND>
struct EpiMerge {
  static constexpr bool PERM = true, AFTER_DRAIN = false;
  const u16* gate; u16* Y;
  DI void operator()(const pg8::f32x4 (&acc)[2][2][4][2], const pg8::Unit& u, int wr, int wc, int fr, int fq) const {
#pragma unroll
    for (int ai = 0; ai < 2; ++ai)
#pragma unroll
      for (int m = 0; m < 4; ++m) {
        const size_t rowoff = (size_t)(u.pm * 256 + ai * 128 + wr * 64 + m * 16 + fr) * 1024 + u.pn * 256 + wc * 32 + 8 * fq;
#pragma unroll
        for (int bj = 0; bj < 2; ++bj) {
          const size_t off = rowoff + bj * 128;
          const uint4 gv = *(const uint4*)(gate + off);
          float v[8];
          v[0] = bflo(gv.x) * acc[ai][bj][m][0][0]; v[1] = bfhi(gv.x) * acc[ai][bj][m][0][1]; v[2] = bflo(gv.y) * acc[ai][bj][m][0][2]; v[3] = bfhi(gv.y) * acc[ai][bj][m][0][3];
          v[4] = bflo(gv.z) * acc[ai][bj][m][1][0]; v[5] = bfhi(gv.z) * acc[ai][bj][m][1][1]; v[6] = bflo(gv.w) * acc[ai][bj][m][1][2]; v[7] = bfhi(gv.w) * acc[ai][bj][m][1][3];
          if (SECOND) {
            const uint4 yv = *(const uint4*)(Y + off);
            v[0] += bflo(yv.x); v[1] += bfhi(yv.x); v[2] += bflo(yv.y); v[3] += bfhi(yv.y); v[4] += bflo(yv.z); v[5] += bfhi(yv.z); v[6] += bflo(yv.w); v[7] += bfhi(yv.w);
          }
          *(uint4*)(Y + off) = pack8f(v);
        }
      }
  }
};

#define XB_TMO      128
#define XB_XCNT(j)  (256  + 64 * (j))
#define XB_XSUB(j)  (1280 + 64 * (j))
#define XB_XGEN(j)  (2304 + 64 * (j))
#define XB_TOP      3328
#define XB_TOPGEN   3392
#define XCD_BAR_WORDS 3456
#define XB_SPIN_CAP (1u << 18)
#define LAS __attribute__((address_space(3)))
DI unsigned xb_ld(unsigned* p)              { return __hip_atomic_load(p, __ATOMIC_RELAXED, __HIP_MEMORY_SCOPE_AGENT); }
DI unsigned xb_add(unsigned* p, unsigned v) { return __hip_atomic_fetch_add(p, v, __ATOMIC_RELAXED, __HIP_MEMORY_SCOPE_AGENT); }
DI unsigned xb_xcc_id() { return (unsigned)__builtin_amdgcn_s_getreg((3 << 11) | 20) & 0xFu; }
#define XB_SPIN(cond, bar) do { unsigned _sp = 0; while (cond) { __builtin_amdgcn_s_sleep(1); \
    if ((++_sp & 255u) == 0u) { if (xb_ld(&(bar)[XB_TMO])) break; if (_sp > XB_SPIN_CAP) { atomicAdd(&(bar)[XB_TMO], 1u); break; } } } } while (0)
struct XcdBarrier { unsigned* bar; unsigned x; volatile LAS unsigned* st; };
DI XcdBarrier xcd_barrier_post(unsigned* bar, volatile LAS unsigned* st) {
  XcdBarrier b; b.bar = bar; b.x = xb_xcc_id(); b.st = st;
  if (threadIdx.x == 0) (void)xb_add(&bar[XB_XCNT(b.x)], 1u);
  return b;
}
DI void xcd_barrier_complete(unsigned* bar, unsigned x, unsigned& nloc, unsigned& nx) {
  const unsigned G = gridDim.x * gridDim.y * gridDim.z;
  unsigned sum, cnt, mine, sp = 0u;
  for (;;) {
    sum = 0u; cnt = 0u; mine = 0u;
#pragma unroll
    for (unsigned j = 0; j < 16; ++j) { const unsigned c = xb_ld(&bar[XB_XCNT(j)]); sum += c; cnt += (c > 0u) ? 1u : 0u; mine = (j == x) ? c : mine; }
    if (sum == G) break;
    __builtin_amdgcn_s_sleep(1);
    if ((++sp & 255u) == 0u) { if (xb_ld(&bar[XB_TMO])) break; if (sp > XB_SPIN_CAP) { atomicAdd(&bar[XB_TMO], 1u); break; } }
  }
  nloc = mine > 0u ? mine : 1u; nx = cnt > 0u ? cnt : 1u;
}
DI void xcd_barrier(XcdBarrier& b) {
  asm volatile("s_waitcnt vmcnt(0)" ::: "memory");
  __syncthreads();
  if (threadIdx.x == 0) {
    unsigned* bar = b.bar;
    __builtin_amdgcn_s_waitcnt(0);
    unsigned nloc = b.st[0], nx = b.st[1];
    if (nloc == 0u) { xcd_barrier_complete(bar, b.x, nloc, nx); b.st[0] = nloc; b.st[1] = nx; }
    const unsigned old = xb_add(&bar[XB_XSUB(b.x)], 1u);
    const unsigned gen = old / nloc;
    if (old + 1u == (gen + 1u) * nloc) {
      __builtin_amdgcn_fence(__ATOMIC_RELEASE, "agent");
      asm volatile("s_waitcnt vmcnt(0)" ::: "memory");
      const unsigned og = xb_add(&bar[XB_TOP], 1u);
      const unsigned tg = og / nx;
      if (og + 1u == (tg + 1u) * nx) xb_add(&bar[XB_TOPGEN], 1u);
      else XB_SPIN(xb_ld(&bar[XB_TOPGEN]) == tg, bar);
      __builtin_amdgcn_fence(__ATOMIC_ACQUIRE, "agent");
      xb_add(&bar[XB_XGEN(b.x)], 1u);
      asm volatile("s_waitcnt vmcnt(0)" ::: "memory");
    } else {
      XB_SPIN(xb_ld(&bar[XB_XGEN(b.x)]) == gen, bar);
      __builtin_amdgcn_fence(__ATOMIC_ACQUIRE, "agent");
      asm volatile("s_waitcnt vmcnt(0)" ::: "memory");
    }
  }
  __syncthreads();
}


template <int PH>
DI void run_phase(const Params& p, char* lds_all) {
  const int half = __builtin_amdgcn_readfirstlane(threadIdx.x >> 8);
  const int vb = blockIdx.x * 2 + half, nvb = gridDim.x * 2;
  char* lds = lds_all + half * 65536;
  if (PH == 0) { for (int it = vb; it < P0_TOTAL; it += nvb) phase0_item(p, it, lds); }
  if (PH == 1) {
    for (int it = vb; it < P1_CMP; it += nvb) phase1_item(p, it, lds);
    __syncthreads();
    pg8::StaticOrder S; S.init(NT, NPAD, gridDim.x, blockIdx.x);
    const pg8::Gemm gm{(const pg8::bf16_t*)(p.ws + W_XN), (const pg8::bf16_t*)(p.ws + W_WINT), NT, NPAD, 1024};
    const EpiProj E{p};
    pg8::gemm_phase<EpiProj, pg8::StaticOrder, false>((PG8_LAS unsigned char*)lds_all, gm, S, E, nullptr);
  }
  if (PH == 2) {
    volatile LAS unsigned* wq = (volatile LAS unsigned*)(lds_all + 128 * 1024 + 8);
    unsigned* ctr = (unsigned*)(p.ws + W_BAR);
    for (;;) {
      __syncthreads();
      if (threadIdx.x == 0) wq[0] = __hip_atomic_fetch_add(ctr, 1u, __ATOMIC_RELAXED, __HIP_MEMORY_SCOPE_AGENT);
      __syncthreads();
      const unsigned pr = wq[0];
      if (pr >= (unsigned)(P2_TOTAL / 2)) break;
      phase2_item(p, (int)pr * 2 + half, lds);
    }
  }
  if (PH == 7) { for (int it = vb; it < H2_ITEMS; it += nvb) hgrn_h2_item(p, it); }
  if (PH == 3) {
    for (int it = vb; it < P3_FIN; it += nvb) hgrn_h3_item(p, it);
    for (int it = blockIdx.x; it < P3_ATT; it += gridDim.x) prompt_attn_item(p, it, lds_all);
  }
  if (PH == 4) {
    for (int it = vb; it < 64; it += nvb) merge_a_tile_t<1>(p, 128 + (it >> 4), it & 15, lds);
    __syncthreads();
    pg8::StaticOrder S; S.init(NTP, 1024, gridDim.x, blockIdx.x);
    { const pg8::Gemm gm{(const pg8::bf16_t*)(p.ws + W_OA), (const pg8::bf16_t*)(p.ws + W_WBAT), NTP, 1024, 512};
      const EpiMerge<false> E{(const u16*)(p.ws + W_SA), (u16*)(p.ws + W_Y)};
      pg8::gemm_phase<EpiMerge<false>, pg8::StaticOrder, false>((PG8_LAS unsigned char*)lds_all, gm, S, E, nullptr); }
    { const pg8::Gemm gm{(const pg8::bf16_t*)(p.ws + W_OB), (const pg8::bf16_t*)(p.ws + W_WBBT), NTP, 1024, 512};
      const EpiMerge<true> E{(const u16*)(p.ws + W_SB), (u16*)(p.ws + W_Y)};
      pg8::gemm_phase<EpiMerge<true>, pg8::StaticOrder, false>((PG8_LAS unsigned char*)lds_all, gm, S, E, nullptr); }
  }
  if (PH == 5) {
    for (int it = vb; it < 64; it += nvb) merge_b_tile_t<1>(p, 128 + (it >> 4), it & 15, lds);
    __syncthreads();
    pg8::StaticOrder S; S.init(NTP, 1024, gridDim.x, blockIdx.x);
    const pg8::Gemm gm{(const pg8::bf16_t*)(p.ws + W_Y), (const pg8::bf16_t*)(p.ws + W_WOUTT), NTP, 1024, 1024};
    const EpiOut E{p.x_prompt, p.out};
    pg8::gemm_phase<EpiOut, pg8::StaticOrder, false>((PG8_LAS unsigned char*)lds_all, gm, S, E, nullptr);
  }
  if (PH == 6) { for (int it = vb; it < P6_TOTAL; it += nvb) final_norm_item(p, it); }
}

constexpr int LDS_DYN = 128 * 1024 + 16;
__global__ void __launch_bounds__(512, 2) k_mega(Params p) {
  extern __shared__ __attribute__((aligned(16))) char lds[];
  volatile LAS unsigned* st = (volatile LAS unsigned*)(lds + 128 * 1024);
  if (threadIdx.x == 0) { st[0] = 0u; st[1] = 0u; }
  __syncthreads();
  XcdBarrier bar = xcd_barrier_post((unsigned*)(p.ws + W_BAR), st);
  run_phase<0>(p, lds); xcd_barrier(bar);
  run_phase<1>(p, lds); xcd_barrier(bar);
  run_phase<2>(p, lds); xcd_barrier(bar);
  run_phase<7>(p, lds); xcd_barrier(bar);
  run_phase<3>(p, lds); xcd_barrier(bar);
  run_phase<4>(p, lds); xcd_barrier(bar);
  run_phase<5>(p, lds); xcd_barrier(bar);
  run_phase<6>(p, lds);
}

extern "C" void kernel_launch(void* const* d_in, const int* in_sizes, int n_in, void* d_out, int out_size,
                              void* d_ws, size_t ws_size, hipStream_t stream) {
  Params p{};
  p.x_prompt = (const float*)d_in[0]; p.x_sample = (const float*)d_in[1];
  p.cck = (const float*)d_in[2]; p.ccv = (const float*)d_in[3]; p.csk = (const float*)d_in[4]; p.csv = (const float*)d_in[5];
  p.swk = (const float*)d_in[6]; p.swv = (const float*)d_in[7]; p.shg = (const float*)d_in[8]; p.pt = (const int*)d_in[9];
  p.norm_g = (const float*)d_in[10]; p.w_in = (const float*)d_in[11];
  p.pos_k = (const float*)d_in[12]; p.w1_k = (const float*)d_in[13]; p.w2_k = (const float*)d_in[14];
  p.pos_v = (const float*)d_in[15]; p.w1_v = (const float*)d_in[16]; p.w2_v = (const float*)d_in[17];
  p.rel_bias = (const float*)d_in[18]; p.hg_lower = (const float*)d_in[19]; p.hg_norm_g = (const float*)d_in[20];
  p.w_ba = (const float*)d_in[21]; p.w_bb = (const float*)d_in[22]; p.w_out = (const float*)d_in[23]; p.final_g = (const float*)d_in[24];
  p.out = (float*)d_out; p.ws = (char*)d_ws;
  if ((size_t)out_size != O_END || ws_size < W_END) { fprintf(stderr, "kernel_launch: unexpected sizes out=%d ws=%zu (need %zu / %zu)\n", out_size, ws_size, (size_t)O_END, (size_t)W_END); return; }
  static int grid_blocks = 0;
  if (!grid_blocks) {
    int dev = 0, cus = 0, per_cu = 0;
    hipGetDevice(&dev);
    hipDeviceGetAttribute(&cus, hipDeviceAttributeMultiprocessorCount, dev);
    hipFuncSetAttribute((const void*)k_mega, hipFuncAttributeMaxDynamicSharedMemorySize, LDS_DYN);
    hipOccupancyMaxActiveBlocksPerMultiprocessor(&per_cu, k_mega, 512, LDS_DYN);
    if (per_cu < 1) fprintf(stderr, "kernel_launch: occupancy query reports %d blocks per CU\n", per_cu);
    grid_blocks = cus;
  }
  hipMemsetAsync((char*)d_ws + W_BAR, 0, XCD_BAR_WORDS * 4, stream);
  void* args[] = {&p};
  hipError_t e = hipLaunchCooperativeKernel((void*)k_mega, dim3(grid_blocks), dim3(512), args, LDS_DYN, stream);
  if (e != hipSuccess) fprintf(stderr, "cooperative launch failed: %s (grid %d)\n", hipGetErrorString(e), grid_blocks);
}
```

```cpp
#include <hip/hip_runtime.h>
#include <hip/hip_cooperative_groups.h>
#include <cstdio>
namespace cg = cooperative_groups;

#define DI __device__ __forceinline__
typedef unsigned short u16;
typedef __attribute__((ext_vector_type(8))) short bf16x8;
typedef __attribute__((ext_vector_type(4))) short s16x4;
typedef __attribute__((ext_vector_type(16))) float f32x16;
typedef __attribute__((ext_vector_type(4))) float f32x4;
typedef __attribute__((ext_vector_type(2))) float f32x2;
typedef __attribute__((ext_vector_type(2))) __bf16 bf16x2v;
#define MFMA32(a, b, c) __builtin_amdgcn_mfma_f32_32x32x16_bf16((a), (b), (c), 0, 0, 0)
#define MFMA16(a, b, c) __builtin_amdgcn_mfma_f32_16x16x32_bf16((a), (b), (c), 0, 0, 0)

constexpr int D_MODEL = 1024, BATCH = 8, SEQ = 2048, DEC_BATCH = 128, DEC_SEQ = 4, PAST = 2048;
constexpr int NTP = BATCH * SEQ;
constexpr int NTS = DEC_BATCH * DEC_SEQ;
constexpr int NT = NTP + NTS;
constexpr int IN_COLS = 5912, NPAD = 6144;
constexpr int NSEQ = BATCH + DEC_BATCH;

constexpr size_t O_YP = 0;
constexpr size_t O_YS = O_YP + (size_t)NTP * 1024;
constexpr size_t O_PCK = O_YS + (size_t)NTS * 1024;
constexpr size_t O_PWK = O_PCK + 4 * (size_t)NTP * 128;
constexpr size_t O_PHG = O_PWK + 2 * (size_t)BATCH * 512 * 128;
constexpr size_t O_SCK = O_PHG + (size_t)BATCH * 4 * 128 * 128;
constexpr size_t O_SWK = O_SCK + 4 * (size_t)NTS * 128;
constexpr size_t O_SHG = O_SWK + 2 * (size_t)DEC_BATCH * 512 * 128;
constexpr size_t O_END = O_SHG + (size_t)DEC_BATCH * 4 * 128 * 128;

constexpr size_t al256(size_t x) { return (x + 255) & ~(size_t)255; }
constexpr size_t W_WINT = 0;
constexpr size_t W_WBAT = al256(W_WINT + (size_t)NPAD * 1024 * 2);
constexpr size_t W_WBBT = al256(W_WBAT + (size_t)1024 * 512 * 2);
constexpr size_t W_WOUTT = al256(W_WBBT + (size_t)1024 * 512 * 2);
constexpr size_t W_W1T = al256(W_WOUTT + (size_t)1024 * 1024 * 2);
constexpr size_t W_C1 = al256(W_W1T + (size_t)2 * 128 * 1024 * 2);
constexpr size_t W_XN = al256(W_C1 + 2 * 64 * 4);
constexpr size_t W_Q = al256(W_XN + (size_t)NT * 1024 * 2);
constexpr size_t W_KV = al256(W_Q + (size_t)NT * 512 * 2);
constexpr size_t W_VST = al256(W_KV + (size_t)6 * NT * 128 * 2);
constexpr size_t W_VWT = al256(W_VST + (size_t)8 * 2 * 64 * 2048 * 2);
constexpr size_t W_GATE = al256(W_VWT + (size_t)8 * 2 * 64 * 2048 * 2);
constexpr size_t W_ZA = al256(W_GATE + (size_t)NT * 24 * 4);
constexpr size_t W_QB = al256(W_ZA + (size_t)NT * 512 * 2);
constexpr size_t W_KB = al256(W_QB + (size_t)NT * 512 * 2);
constexpr size_t W_GB = al256(W_KB + (size_t)NT * 512 * 2);
constexpr size_t W_VB = al256(W_GB + (size_t)NT * 512 * 4);
constexpr size_t W_ZB = al256(W_VB + (size_t)NT * 512 * 2);
constexpr size_t W_SA = al256(W_ZB + (size_t)NT * 512 * 2);
constexpr size_t W_SB = al256(W_SA + (size_t)NT * 1024 * 2);
constexpr size_t W_KCMP = al256(W_SB + (size_t)NT * 1024 * 2);
constexpr size_t W_VCMP = al256(W_KCMP + (size_t)NSEQ * 2 * 128 * 64 * 2);
constexpr size_t W_VCMPT = al256(W_VCMP + (size_t)NSEQ * 2 * 128 * 64 * 2);
constexpr size_t W_OA = al256(W_VCMPT + (size_t)8 * 2 * 64 * 128 * 2);
constexpr size_t W_OB = al256(W_OA + (size_t)NT * 512 * 2);
constexpr size_t W_Y = al256(W_OB + (size_t)NT * 512 * 2);
constexpr size_t W_SS = al256(W_Y + (size_t)NT * 1024 * 2);
constexpr size_t W_ORAW = al256(W_SS + (size_t)NT * 32 * 4);
constexpr size_t W_OSS = al256(W_ORAW + (size_t)NTP * 512 * 4);
constexpr size_t W_QG = al256(W_OSS + (size_t)NTP * 8 * 4);
constexpr size_t W_DST = al256(W_QG + (size_t)NTP * 512 * 2);
constexpr size_t W_DEC = al256(W_DST + (size_t)1024 * 128 * 128 * 4);
constexpr size_t W_SPT = al256(W_DEC + (size_t)1024 * 128 * 4);
constexpr size_t W_BAR = al256(W_SPT + (size_t)1024 * 128 * 128 * 2);
constexpr size_t W_END = al256(W_BAR + 3456 * 4);

struct Params {
  const float* x_prompt; const float* x_sample;
  const float* cck; const float* ccv; const float* csk; const float* csv;
  const float* swk; const float* swv; const float* shg; const int* pt;
  const float* norm_g; const float* w_in;
  const float* pos_k; const float* w1_k; const float* w2_k;
  const float* pos_v; const float* w1_v; const float* w2_v;
  const float* rel_bias; const float* hg_lower; const float* hg_norm_g;
  const float* w_ba; const float* w_bb; const float* w_out; const float* final_g;
  float* out; char* ws;
};

DI unsigned pk2(float a, float b) { f32x2 v = {a, b}; bf16x2v r = __builtin_convertvector(v, bf16x2v); return __builtin_bit_cast(unsigned, r); }
DI u16 f2bf(float a) { return (u16)(pk2(a, 0.f) & 0xffffu); }
DI float bf2f(u16 v) { return __uint_as_float(((unsigned)v) << 16); }
DI float bflo(unsigned v) { return __uint_as_float(v << 16); }
DI float bfhi(unsigned v) { return __uint_as_float(v & 0xffff0000u); }
constexpr float LOG2E = 1.4426950408889634f;
DI float sigmoidf_(float x) { return __builtin_amdgcn_rcpf(1.f + __expf(-x)); }
DI float siluf_(float x) { return x * __builtin_amdgcn_rcpf(1.f + __expf(-x)); }
DI int otid() { int t = threadIdx.x & 255; asm volatile("" : "+v"(t)); return t; }
DI int otid512() { int t = threadIdx.x; asm volatile("" : "+v"(t)); return t; }
DI int crow(int reg, int h) { return (reg & 3) + 8 * (reg >> 2) + 4 * h; }
DI float wave_sum(float v) {
#pragma unroll
  for (int o = 32; o >= 1; o >>= 1) v += __shfl_xor(v, o);
  return v;
}
DI float wave_max(float v) {
#pragma unroll
  for (int o = 32; o >= 1; o >>= 1) v = fmaxf(v, __shfl_xor(v, o));
  return v;
}

__device__ const unsigned char T5B[128] = {
  0,1,2,3,4,5,6,7,8,9,10,11,12,13,14,15,
  16,16,16,17,17,18,18,18,19,19,19,20,20,20,20,21,
  21,21,21,22,22,22,22,22,23,23,23,23,23,23,24,24,
  24,24,24,24,25,25,25,25,25,25,25,26,26,26,26,26,
  26,26,26,27,27,27,27,27,27,27,27,27,27,28,28,28,
  28,28,28,28,28,28,28,29,29,29,29,29,29,29,29,29,
  29,29,29,30,30,30,30,30,30,30,30,30,30,30,30,30,
  30,31,31,31,31,31,31,31,31,31,31,31,31,31,31,31};

DI void transpose_tile(const float* __restrict__ src, int ldsrc, int K, int N, int k0, int n0,
                       u16* __restrict__ dst, int lddst, int dst_row_off, int dst_k0, int winperm, float* tl) {
  const int tid = otid();
  __syncthreads();
  {
    const int n = tid & 63, kb = tid >> 6;
#pragma unroll
    for (int i = 0; i < 16; ++i) {
      const int kk = kb + 4 * i;
      const int nc = (n0 + n < N) ? n0 + n : N - 1, kc = (k0 + kk < K) ? k0 + kk : K - 1;
      tl[kk * 65 + n] = src[(size_t)kc * ldsrc + nc];
    }
  }
  __syncthreads();
  {
    const int k = (tid & 31) * 2, nb = tid >> 5;
#pragma unroll
    for (int i = 0; i < 8; ++i) {
      const int nn = nb + 8 * i;
      int n = n0 + nn;
      if (n < N) {
        if (winperm) n = (n < 1280) ? n : ((n < 1304) ? (5888 + n - 1280) : (n - 24));
        const unsigned v = pk2(tl[k * 65 + nn], tl[(k + 1) * 65 + nn]);
        *(unsigned*)(dst + (size_t)(dst_row_off + n) * lddst + dst_k0 + k) = v;
      }
    }
  }
}

constexpr int P0_WIN = 16 * 93;
constexpr int P0_WBA = 8 * 16, P0_WBB = 8 * 16, P0_WOUT = 16 * 16, P0_W1 = 32 * 2;
constexpr int P0_TR = P0_WIN + P0_WBA + P0_WBB + P0_WOUT + P0_W1;
constexpr int P0_C1 = 2;
constexpr int P0_NORM = NT / 8;
constexpr int P0_WCP = 2 * DEC_BATCH * 8;
constexpr int P0_PAD = NPAD - IN_COLS;
constexpr int P0_TOTAL = P0_TR + P0_C1 + P0_NORM + P0_WCP + P0_PAD;

DI void phase0_item(const Params& p, int it, char* lds) {
  const int tid = otid(), lane = tid & 63, wave = tid >> 6;
  float* tl = (float*)lds;
  if (it < P0_TR) {
    if (it < P0_WIN) {
      const int kt = it / 93, nt = it % 93;
      transpose_tile(p.w_in, IN_COLS, 1024, IN_COLS, kt * 64, nt * 64, (u16*)(p.ws + W_WINT), 1024, 0, kt * 64, 1, tl);
      return;
    }
    it -= P0_WIN;
    if (it < P0_WBA) { const int kt = it / 16, nt = it % 16;
      transpose_tile(p.w_ba, 1024, 512, 1024, kt * 64, nt * 64, (u16*)(p.ws + W_WBAT), 512, 0, kt * 64, 0, tl); return; }
    it -= P0_WBA;
    if (it < P0_WBB) { const int kt = it / 16, nt = it % 16;
      transpose_tile(p.w_bb, 1024, 512, 1024, kt * 64, nt * 64, (u16*)(p.ws + W_WBBT), 512, 0, kt * 64, 0, tl); return; }
    it -= P0_WBB;
    if (it < P0_WOUT) { const int kt = it / 16, nt = it % 16;
      transpose_tile(p.w_out, 1024, 1024, 1024, kt * 64, nt * 64, (u16*)(p.ws + W_WOUTT), 1024, 0, kt * 64, 0, tl); return; }
    it -= P0_WOUT;
    { const int kv = it >> 5, kt = it & 31;
      const float* w1 = kv ? p.w1_v : p.w1_k;
      transpose_tile(w1, 64, 2048, 64, kt * 64, 0, (u16*)(p.ws + W_W1T) + (size_t)kv * 128 * 1024, 1024,
                     (kt >= 16) ? 64 : 0, (kt & 15) * 64, 0, tl); return; }
  }
  it -= P0_TR;
  if (it < P0_C1) {
    const float* pos = it ? p.pos_v : p.pos_k; const float* w1 = it ? p.w1_v : p.w1_k;
    const int j = tid & 63, part = tid >> 6;
    float s = 0.f;
    for (int i = part * 512; i < part * 512 + 512; ++i) s += pos[i] * w1[(size_t)i * 64 + j];
    __syncthreads();
    tl[part * 64 + j] = s;
    __syncthreads();
    if (tid < 64) ((float*)(p.ws + W_C1))[it * 64 + tid] = tl[tid] + tl[64 + tid] + tl[128 + tid] + tl[192 + tid];
    return;
  }
  it -= P0_C1;
  if (it < P0_NORM) {
#pragma unroll
    for (int rr = 0; rr < 2; ++rr) {
      const int row = it * 8 + wave * 2 + rr;
      const float* x = (row < NTP) ? (p.x_prompt + (size_t)row * 1024) : (p.x_sample + (size_t)(row - NTP) * 1024);
      float4 v[4]; float ss = 0.f;
#pragma unroll
      for (int i = 0; i < 4; ++i) { v[i] = *(const float4*)(x + (i * 64 + lane) * 4); ss += v[i].x * v[i].x + v[i].y * v[i].y + v[i].z * v[i].z + v[i].w * v[i].w; }
      ss = wave_sum(ss);
      const float rs = rsqrtf(ss * (1.f / 1024.f) + 1e-6f);
      u16* xn = (u16*)(p.ws + W_XN) + (size_t)row * 1024;
#pragma unroll
      for (int i = 0; i < 4; ++i) {
        const float4 g = *(const float4*)(p.norm_g + (i * 64 + lane) * 4);
        uint2 o; o.x = pk2(v[i].x * rs * g.x, v[i].y * rs * g.y); o.y = pk2(v[i].z * rs * g.z, v[i].w * rs * g.w);
        *(uint2*)(xn + (i * 64 + lane) * 4) = o;
      }
    }
    return;
  }
  it -= P0_NORM;
  if (it < P0_WCP) {
    const int sl = it & 7, b = (it >> 3) % DEC_BATCH, kv = it / (8 * DEC_BATCH);
    const float4* src = (const float4*)((kv ? p.swv : p.swk) + ((size_t)b * 512 + 4) * 128) + sl * 64 * 32;
    float4* dst = (float4*)(p.out + O_SWK + (size_t)kv * DEC_BATCH * 512 * 128 + (size_t)b * 512 * 128) + sl * 64 * 32;
    const int n = (sl == 7 ? 60 : 64) * 32;
    const float4* __restrict__ sp = src; float4* __restrict__ dp = dst;
#pragma unroll
    for (int i = 0; i < 8; ++i) { const int idx = (tid + 256 * i < n) ? tid + 256 * i : n - 1; dp[idx] = sp[idx]; }
    return;
  }
  it -= P0_WCP;
  { u16* d = (u16*)(p.ws + W_WINT) + (size_t)(IN_COLS + it) * 1024; *(uint2*)(d + tid * 4) = make_uint2(0u, 0u); }
}

constexpr int GST = 72;
struct LoadBf16 {
  const u16* base; int ld;
  DI uint4 load(int row, int ch, int kt) const { return *(const uint4*)(base + (size_t)row * ld + kt * 64 + ch * 8); }
};
struct LoadCellBf16 {
  const u16* base;
  DI uint4 load(int row, int ch, int kt) const { return *(const uint4*)(base + (size_t)(row * 16 + kt) * 128 + ch * 8); }
};
struct LoadCellPage {
  const float* cache; const int* pt; int g;
  DI uint4 load(int row, int ch, int kt) const {
    const int pos = row * 16 + kt; const int page = pt[pos >> 7];
    const float* s = cache + (((size_t)page * 128 + (pos & 127)) * 2 + g) * 64 + ch * 8;
    const float4 a = *(const float4*)s, b = *(const float4*)(s + 4);
    uint4 r; r.x = pk2(a.x, a.y); r.y = pk2(a.z, a.w); r.z = pk2(b.x, b.y); r.w = pk2(b.z, b.w); return r;
  }
};

template <int NI, class AL, class BL>
DI void gemm_main(f32x16 (&acc)[2][NI], const AL& al, const BL& bl, int nkt, char* lds) {
  u16* sA = (u16*)lds; u16* sB = sA + 128 * GST;
  const int tid = otid(), lane = tid & 63, wave = tid >> 6, wm = wave >> 1, wn = wave & 1;
  const int lrow = tid >> 3, lch = tid & 7, r = lane & 31, h = lane >> 5;
  uint4 ra0[4], rb0[2 * NI], ra1[4], rb1[2 * NI];
#pragma unroll
  for (int i = 0; i < 4; ++i) { ra0[i] = al.load(lrow + 32 * i, lch, 0); ra1[i] = al.load(lrow + 32 * i, lch, 1); }
#pragma unroll
  for (int i = 0; i < 2 * NI; ++i) { rb0[i] = bl.load(lrow + 32 * i, lch, 0); rb1[i] = bl.load(lrow + 32 * i, lch, 1); }
#define GM_STEP(RA, RB, kt_) do { \
    __syncthreads(); \
    _Pragma("unroll") for (int i = 0; i < 4; ++i) *(uint4*)(sA + (lrow + 32 * i) * GST + lch * 8) = RA[i]; \
    _Pragma("unroll") for (int i = 0; i < 2 * NI; ++i) *(uint4*)(sB + (lrow + 32 * i) * GST + lch * 8) = RB[i]; \
    __syncthreads(); \
    { const int kn_ = ((kt_) + 2 < nkt) ? (kt_) + 2 : (kt_);       \
      _Pragma("unroll") for (int i = 0; i < 4; ++i) RA[i] = al.load(lrow + 32 * i, lch, kn_); \
      _Pragma("unroll") for (int i = 0; i < 2 * NI; ++i) RB[i] = bl.load(lrow + 32 * i, lch, kn_); } \
    _Pragma("unroll") for (int s_ = 0; s_ < 4; ++s_) { \
      bf16x8 a[2], bb[NI]; \
      _Pragma("unroll") for (int mi = 0; mi < 2; ++mi) a[mi] = *(const bf16x8*)(sA + (wm * 64 + mi * 32 + r) * GST + s_ * 16 + 8 * h); \
      _Pragma("unroll") for (int ni = 0; ni < NI; ++ni) bb[ni] = *(const bf16x8*)(sB + (wn * 32 * NI + ni * 32 + r) * GST + s_ * 16 + 8 * h); \
      _Pragma("unroll") for (int mi = 0; mi < 2; ++mi) \
        _Pragma("unroll") for (int ni = 0; ni < NI; ++ni) acc[mi][ni] = MFMA32(a[mi], bb[ni], acc[mi][ni]); \
    } \
  } while (0)
#pragma unroll 1
  for (int kt = 0; kt < nkt; kt += 2) {
    GM_STEP(ra0, rb0, kt);
    GM_STEP(ra1, rb1, kt + 1);
  }
#undef GM_STEP
}
typedef __attribute__((address_space(1))) const unsigned gptr_t;
typedef __attribute__((address_space(3))) unsigned lptr_t;
template <int NI>
DI void gemm_glds(f32x16 (&acc)[2][NI], const u16* A, int lda, const u16* B, int ldb, int nkt, char* lds) {
  const int tid = otid(), lane = tid & 63, wave = tid >> 6, wm = wave >> 1, wn = wave & 1;
  const int r = lane & 31, h = lane >> 5;
  const int lr = (wave << 3) + (lane >> 3);
  const int lc = (lane & 7) ^ ((lane >> 3) & 7) ^ (wave & 1);
  const u16* ga = A + (size_t)lr * lda + lc * 8;
  const u16* gb = B + (size_t)lr * ldb + lc * 8;
  const int sw = (lane & 7) ^ ((lane >> 3) & 1);
  constexpr int STAGE = 16384 + 8192 * NI;
#define GLDS_ISSUE(buf, kt_) do { \
    char* sa_ = lds + (buf) * STAGE + tid * 16; \
    _Pragma("unroll") for (int i_ = 0; i_ < 4; ++i_) \
      __builtin_amdgcn_global_load_lds((gptr_t*)(ga + (size_t)(32 * i_) * lda + (kt_) * 64), (lptr_t*)(sa_ + i_ * 4096), 16, 0, 0); \
    _Pragma("unroll") for (int i_ = 0; i_ < 2 * NI; ++i_) \
      __builtin_amdgcn_global_load_lds((gptr_t*)(gb + (size_t)(32 * i_) * ldb + (kt_) * 64), (lptr_t*)(sa_ + 16384 + i_ * 4096), 16, 0, 0); \
  } while (0)
  __syncthreads();
  GLDS_ISSUE(0, 0);
#pragma unroll 1
  for (int kt = 0; kt < nkt; ++kt) {
    asm volatile("s_waitcnt vmcnt(0)" ::: "memory");
    __syncthreads();
    if (kt + 1 < nkt) GLDS_ISSUE((kt + 1) & 1, kt + 1);
    const char* sA = lds + (kt & 1) * STAGE; const char* sB = sA + 16384;
#pragma unroll
    for (int s = 0; s < 4; ++s) {
      const int co = ((2 * s + h) ^ sw) << 4;
      bf16x8 a[2], bb[NI];
#pragma unroll
      for (int mi = 0; mi < 2; ++mi) a[mi] = *(const bf16x8*)(sA + (wm * 64 + mi * 32 + r) * 128 + co);
#pragma unroll
      for (int ni = 0; ni < NI; ++ni) bb[ni] = *(const bf16x8*)(sB + (wn * 32 * NI + ni * 32 + r) * 128 + co);
#pragma unroll
      for (int mi = 0; mi < 2; ++mi)
#pragma unroll
        for (int ni = 0; ni < NI; ++ni) acc[mi][ni] = MFMA32(a[mi], bb[ni], acc[mi][ni]);
    }
  }
#undef GLDS_ISSUE
  __syncthreads();
}
template <int NI>
DI void zero_acc(f32x16 (&acc)[2][NI]) {
#pragma unroll
  for (int a = 0; a < 2; ++a)
#pragma unroll
    for (int b = 0; b < NI; ++b)
#pragma unroll
      for (int i = 0; i < 16; ++i) acc[a][b][i] = 0.f;
}

constexpr int G1_MT = NT / 128, G1_NT = NPAD / 128;
constexpr int P1_GEMM = G1_MT * G1_NT;
constexpr int P1_CMP = DEC_BATCH * 2 * 2;
constexpr int P1_TOTAL = P1_CMP + P1_GEMM;

DI void proj_tile(const Params& p, int tm, int tn, char* lds, bool store_ok) {
  f32x16 acc[2][2]; zero_acc<2>(acc);
  gemm_glds<2>(acc, (const u16*)(p.ws + W_XN) + (size_t)tm * 128 * 1024, 1024, (const u16*)(p.ws + W_WINT) + (size_t)tn * 128 * 1024, 1024, 16, lds);
  const int tid = otid(), lane = tid & 63, wave = tid >> 6, wm = wave >> 1, wn = wave & 1, r = lane & 31, h = lane >> 5;
  const bool samp = tm >= 128;
  if (!store_ok) return;
#pragma unroll
  for (int mi = 0; mi < 2; ++mi)
#pragma unroll
    for (int ni = 0; ni < 2; ++ni) {
      const int c = wn * 64 + ni * 32 + r;
      const int row0 = tm * 128 + wm * 64 + mi * 32;
      if (tn < 4) {
        u16* d = (u16*)(p.ws + W_Q) + tn * 128 + c;
#pragma unroll
        for (int i = 0; i < 16; ++i) d[(size_t)(row0 + crow(i, h)) * 512] = f2bf(acc[mi][ni][i] * (0.125f * LOG2E));
      } else if (tn < 10) {
        const int kvg = tn - 4;
        u16* d = (u16*)(p.ws + W_KV) + (size_t)kvg * NT * 128 + c;
#pragma unroll
        for (int i = 0; i < 16; ++i) {
          const int row = row0 + crow(i, h); const float v = acc[mi][ni][i];
          d[(size_t)row * 128] = f2bf(v);
          if (!samp) {
            if (kvg < 4) p.out[O_PCK + (size_t)kvg * NTP * 128 + (size_t)row * 128 + c] = v;
            else { const int t = row & 2047, b = row >> 11;
              if (t >= 1536) p.out[O_PWK + (size_t)(kvg - 4) * BATCH * 512 * 128 + ((size_t)b * 512 + t - 1536) * 128 + c] = v; }
          } else {
            const int srow = row - NTP;
            if (kvg < 4) p.out[O_SCK + (size_t)kvg * NTS * 128 + (size_t)srow * 128 + c] = v;
            else p.out[O_SWK + (size_t)(kvg - 4) * DEC_BATCH * 512 * 128 + ((size_t)(srow >> 2) * 512 + 508 + (srow & 3)) * 128 + c] = v;
          }
        }
        if (!samp && (kvg == 3 || kvg == 5)) {
          u16* vt = (u16*)(p.ws + (kvg == 3 ? W_VST : W_VWT));
          const int b = row0 >> 11, t0 = row0 & 2047, g = c >> 6, dd = c & 63;
          u16* drow = vt + ((size_t)(b * 2 + g) * 64 + dd) * 2048 + t0;
#pragma unroll
          for (int q = 0; q < 4; ++q) {
            uint2 o; o.x = pk2(acc[mi][ni][4 * q], acc[mi][ni][4 * q + 1]); o.y = pk2(acc[mi][ni][4 * q + 2], acc[mi][ni][4 * q + 3]);
            *(uint2*)(drow + 8 * q + 4 * h) = o;
          }
        }
      } else if (tn < 14 || (tn >= 26 && tn < 30)) {
        const bool isA = tn < 14; const int cc = (isA ? tn - 10 : tn - 26) * 128 + c;
        u16* d = (u16*)(p.ws + (isA ? W_ZA : W_ZB)) + cc;
#pragma unroll
        for (int i = 0; i < 16; ++i) d[(size_t)(row0 + crow(i, h)) * 512] = f2bf(siluf_(acc[mi][ni][i]));
      } else if (tn < 18 || (tn >= 22 && tn < 26)) {
        const bool isQ = tn < 18; const int cc = (isQ ? tn - 14 : tn - 22) * 128 + c;
        u16* d = (u16*)(p.ws + (isQ ? W_QB : W_VB)) + cc;
#pragma unroll
        for (int i = 0; i < 16; ++i) d[(size_t)(row0 + crow(i, h)) * 512] = f2bf(acc[mi][ni][i]);
      } else if (tn < 22) {
        const int cc = (tn - 18) * 128 + c;
        const float a0 = p.hg_lower[cc], a1 = p.hg_lower[512 + cc];
        const float lb = 1.f / (1.f + __expf(a1 - a0));
        u16* dk = (u16*)(p.ws + W_KB) + cc; float* dg = (float*)(p.ws + W_GB) + cc;
#pragma unroll
        for (int i = 0; i < 16; ++i) {
          const size_t row = row0 + crow(i, h);
          const float sg = sigmoidf_(acc[mi][ni][i]);
          const float f = lb + (1.f - lb) * sg;
          dg[row * 512] = __logf(f);
          dk[row * 512] = f2bf((1.f - lb) * (1.f - sg));
        }
      } else if (tn < 46) {
        const bool isA = tn < 38; const int cc = (isA ? tn - 30 : tn - 38) * 128 + c;
        u16* d = (u16*)(p.ws + (isA ? W_SA : W_SB)) + cc;
#pragma unroll
        for (int i = 0; i < 16; ++i) d[(size_t)(row0 + crow(i, h)) * 1024] = f2bf(sigmoidf_(acc[mi][ni][i]));
      } else {
        if (c < 24) {
          float* d = (float*)(p.ws + W_GATE) + c;
#pragma unroll
          for (int i = 0; i < 16; ++i) d[(size_t)(row0 + crow(i, h)) * 24] = sigmoidf_(acc[mi][ni][i]);
        }
      }
    }
}

template <class AL>
DI void comp_tile(const Params& p, const AL& al, int seq, int g, int kv, char* lds) {
  f32x16 acc[2][2]; zero_acc<2>(acc);
  LoadBf16 bl{(const u16*)(p.ws + W_W1T) + (size_t)kv * 128 * 1024, 1024};
  gemm_main<2>(acc, al, bl, 16, lds);
  const int tid = otid(), lane = tid & 63, wave = tid >> 6, wm = wave >> 1, wn = wave & 1, r = lane & 31, h = lane >> 5;
  float* T = (float*)lds;
  float* w2s = T + 128 * 65;
  const float* c1 = (const float*)(p.ws + W_C1) + kv * 64;
  const float* w2 = kv ? p.w2_v : p.w2_k;
  __syncthreads();
  for (int i = tid; i < 4096; i += 256) w2s[i] = w2[i];
  if (wn == 1) {
#pragma unroll
    for (int mi = 0; mi < 2; ++mi)
#pragma unroll
      for (int ni = 0; ni < 2; ++ni)
#pragma unroll
        for (int i = 0; i < 16; ++i) T[(wm * 64 + mi * 32 + crow(i, h)) * 65 + ni * 32 + r] = acc[mi][ni][i];
  }
  __syncthreads();
  if (wn == 0) {
    const float c1v[2] = {c1[r], c1[32 + r]};
#pragma unroll
    for (int mi = 0; mi < 2; ++mi)
#pragma unroll
      for (int ni = 0; ni < 2; ++ni)
#pragma unroll
        for (int i = 0; i < 16; ++i) {
          const int n = wm * 64 + mi * 32 + crow(i, h), j = ni * 32 + r;
          const float hv = siluf_(acc[mi][ni][i] + T[((n < 127) ? n + 1 : 127) * 65 + j] + c1v[ni]);
          acc[mi][ni][i] = (n < 127) ? hv : 0.f;
        }
  }
  __syncthreads();
  if (wn == 0) {
#pragma unroll
    for (int mi = 0; mi < 2; ++mi)
#pragma unroll
      for (int ni = 0; ni < 2; ++ni)
#pragma unroll
        for (int i = 0; i < 16; ++i) T[(wm * 64 + mi * 32 + crow(i, h)) * 65 + ni * 32 + r] = acc[mi][ni][i];
  }
  __syncthreads();
  {
    const int n = tid >> 1, eh = tid & 1;
    float o[32];
#pragma unroll
    for (int e = 0; e < 32; ++e) o[e] = 0.f;
#pragma unroll 2
    for (int j = 0; j < 64; ++j) {
      const float hv = T[n * 65 + j];
#pragma unroll
      for (int e = 0; e < 32; ++e) o[e] += hv * w2s[j * 64 + eh * 32 + e];
    }
    u16* dst = (u16*)(p.ws + (kv ? W_VCMP : W_KCMP)) + ((size_t)(seq * 2 + g) * 128 + n) * 64 + eh * 32;
#pragma unroll
    for (int e = 0; e < 32; e += 2) *(unsigned*)(dst + e) = pk2(o[e], o[e + 1]);
  }
  __syncthreads();
}

DI void phase1_item(const Params& p, int it, char* lds) {
  if (it < P1_CMP) {
    const int kv = it & 1, g = (it >> 1) & 1, b = it >> 2;
    LoadCellPage al{kv ? p.ccv : p.cck, p.pt + b * 16, g};
    comp_tile(p, al, BATCH + b, g, kv, lds);
    return;
  }
  it -= P1_CMP;
  const int tm = it / G1_NT, tn = it % G1_NT;
  proj_tile(p, tm, tn, lds, true);
}


DI void hgrn_sample_item(const Params& p, int it, char* lds) {
  const int b = it >> 2, h = it & 3, tid = otid(), lane = tid & 63, wave = tid >> 6;
  float* sf = (float*)lds; float* sk = sf + 512; float* sq = sk + 512; float* sv = sq + 512; float* so = sv + 512;
  __syncthreads();
  for (int i = tid; i < 512; i += 256) {
    const int t = i >> 7, c = i & 127; const size_t off = (size_t)(NTP + b * 4 + t) * 512 + h * 128 + c;
    sf[i] = __expf(((const float*)(p.ws + W_GB))[off]);
    sk[i] = bf2f(((const u16*)(p.ws + W_KB))[off]);
    sq[i] = bf2f(((const u16*)(p.ws + W_QB))[off]);
    sv[i] = bf2f(((const u16*)(p.ws + W_VB))[off]);
  }
  __syncthreads();
  const int e = tid & 127, dh = tid >> 7;
  const float* S0 = p.shg + (size_t)(b * 4 + h) * 128 * 128;
  float* S1 = p.out + O_SHG + (size_t)(b * 4 + h) * 128 * 128;
  const float v0 = sv[e], v1 = sv[128 + e], v2 = sv[256 + e], v3 = sv[384 + e];
  float o0 = 0.f, o1 = 0.f, o2 = 0.f, o3 = 0.f;
#pragma unroll 1
  for (int d0 = dh * 64; d0 < dh * 64 + 64; d0 += 16) {
    float sv[16];
#pragma unroll
    for (int i = 0; i < 16; ++i) sv[i] = S0[(size_t)(d0 + i) * 128 + e];
#pragma unroll
    for (int i = 0; i < 16; ++i) {
      const int d = d0 + i; float st = sv[i];
      st = sf[d] * st + sk[d] * v0;             o0 += sq[d] * st;
      st = sf[128 + d] * st + sk[128 + d] * v1; o1 += sq[128 + d] * st;
      st = sf[256 + d] * st + sk[256 + d] * v2; o2 += sq[256 + d] * st;
      st = sf[384 + d] * st + sk[384 + d] * v3; o3 += sq[384 + d] * st;
      sv[i] = st;
    }
#pragma unroll
    for (int i = 0; i < 16; ++i) S1[(size_t)(d0 + i) * 128 + e] = sv[i];
  }
  so[(dh * 4 + 0) * 128 + e] = o0; so[(dh * 4 + 1) * 128 + e] = o1; so[(dh * 4 + 2) * 128 + e] = o2; so[(dh * 4 + 3) * 128 + e] = o3;
  __syncthreads();
  {
    const int t = wave; const size_t row = (size_t)(NTP + b * 4 + t);
    const float a0 = so[t * 128 + lane] + so[(4 + t) * 128 + lane];
    const float a1 = so[t * 128 + 64 + lane] + so[(4 + t) * 128 + 64 + lane];
    const float ss = wave_sum(a0 * a0 + a1 * a1);
    const float rs = rsqrtf(ss * (1.f / 128.f) + 1e-6f);
    const u16* zb = (const u16*)(p.ws + W_ZB) + row * 512 + h * 128; u16* ob = (u16*)(p.ws + W_OB) + row * 512 + h * 128;
    ob[lane] = f2bf(a0 * rs * p.hg_norm_g[h * 128 + lane] * bf2f(zb[lane]));
    ob[64 + lane] = f2bf(a1 * rs * p.hg_norm_g[h * 128 + 64 + lane] * bf2f(zb[64 + lane]));
  }
}

typedef __attribute__((address_space(3))) s16x4 lds_s16x4;
DI s16x4 tr_read(const u16* ptr) { return __builtin_amdgcn_ds_read_tr16_b64_v4i16((lds_s16x4*)ptr); }
DI bf16x8 cat8(s16x4 lo, s16x4 hi) { return __builtin_shufflevector(lo, hi, 0, 1, 2, 3, 4, 5, 6, 7); }
constexpr int HST = 136;

DI void hgrn_h1_item(const Params& p, int it, char* lds) {
  const int c = it & 31, h = (it >> 5) & 3, b = it >> 7;
  const int tid = otid(), lane = tid & 63, w = __builtin_amdgcn_readfirstlane(tid >> 6), half = tid >> 7;
  const int c16 = lane & 15, hq = lane >> 4, tq = c16 >> 2, tp = c16 & 3;
  const int d = tid & 127, col = h * 128 + d;
  u16* Qe = (u16*)lds; u16* Ke = Qe + 64 * HST; u16* Vv = Ke + 64 * HST; u16* Am = Vv + 64 * HST;
  float* Rr = (float*)(Am + 64 * 72); float* G63 = Rr + 128;
  const u16* qB = (const u16*)(p.ws + W_QB); const u16* kB = (const u16*)(p.ws + W_KB); const u16* vB = (const u16*)(p.ws + W_VB);
  const float* gB = (const float*)(p.ws + W_GB);
  const size_t tok0 = (size_t)b * 2048 + c * 64;
  __syncthreads();
  float G[32];
  {
    float run = 0.f;
#pragma unroll
    for (int i = 0; i < 32; ++i) { run += gB[(tok0 + half * 32 + i) * 512 + col]; G[i] = run; }
    if (half == 0) Rr[d] = run;
  }
#pragma unroll
  for (int i = 0; i < 4; ++i) {
    const int idx = tid + 256 * i, s_ = idx >> 4, cc = idx & 15;
    *(uint4*)(Vv + s_ * HST + cc * 8) = *(const uint4*)(vB + (tok0 + s_) * 512 + h * 128 + cc * 8);
  }
  __syncthreads();
  {
    const float R = Rr[d];
    const float base = half ? R : 0.f;
    u16* qg = (u16*)(p.ws + W_QG);
    u16 qv[32], kv[32];
#pragma unroll
    for (int i = 0; i < 32; ++i) { qv[i] = qB[(tok0 + half * 32 + i) * 512 + col]; kv[i] = kB[(tok0 + half * 32 + i) * 512 + col]; }
#pragma unroll
    for (int i = 0; i < 32; ++i) {
      const int t = half * 32 + i;
      const float gt = base + G[i];
      const float q = bf2f(qv[i]), k = bf2f(kv[i]);
      const float dq = fminf(fmaxf(gt - R, -80.f), 80.f);
      const float eq = __expf(dq);
      Qe[t * HST + d] = f2bf(q * eq);
      Ke[t * HST + d] = f2bf(k * __builtin_amdgcn_rcpf(eq));
      qg[(tok0 + t) * 512 + col] = f2bf(q * __expf(gt));
    }
    if (half == 1) G63[d] = base + G[31];
  }
  __syncthreads();
  for (int j = 0; j <= w; ++j) {
    f32x4 x = f32x4{0.f, 0.f, 0.f, 0.f};
#pragma unroll
    for (int ks = 0; ks < 4; ++ks) {
      const bf16x8 a = *(const bf16x8*)(Qe + (16 * w + c16) * HST + ks * 32 + 8 * hq);
      const bf16x8 bb = *(const bf16x8*)(Ke + (16 * j + c16) * HST + ks * 32 + 8 * hq);
      x = MFMA16(a, bb, x);
    }
#pragma unroll
    for (int r = 0; r < 4; ++r) {
      const bool ok = (j < w) || (c16 <= 4 * hq + r);
      Am[(16 * w + 4 * hq + r) * 72 + 16 * j + c16] = f2bf(ok ? x[r] : 0.f);
    }
  }
  if ((w & 1) == 0) {
#pragma unroll
    for (int r = 0; r < 4; ++r) Am[(16 * w + 4 * hq + r) * 72 + 16 * (w + 1) + c16] = 0;
  }
  __syncthreads();
  bf16x8 vf[2][2];
#pragma unroll
  for (int ks = 0; ks < 2; ++ks)
#pragma unroll
    for (int et = 0; et < 2; ++et) {
      const u16* base = Vv + (32 * ks + 8 * hq + tq) * HST + 32 * w + 16 * et + 4 * tp;
      vf[ks][et] = cat8(tr_read(base), tr_read(base + 4 * HST));
    }
  {
    f32x4 o[4][2];
#pragma unroll
    for (int tt = 0; tt < 4; ++tt)
#pragma unroll
      for (int et = 0; et < 2; ++et) o[tt][et] = f32x4{0.f, 0.f, 0.f, 0.f};
#pragma unroll
    for (int tt = 0; tt < 4; ++tt)
#pragma unroll
      for (int ks = 0; ks <= (tt >> 1); ++ks) {
        const bf16x8 a = *(const bf16x8*)(Am + (16 * tt + c16) * 72 + 32 * ks + 8 * hq);
#pragma unroll
        for (int et = 0; et < 2; ++et) o[tt][et] = MFMA16(a, vf[ks][et], o[tt][et]);
      }
    float* oraw = (float*)(p.ws + W_ORAW);
#pragma unroll
    for (int tt = 0; tt < 4; ++tt)
#pragma unroll
      for (int et = 0; et < 2; ++et)
#pragma unroll
        for (int r = 0; r < 4; ++r) oraw[(tok0 + 16 * tt + 4 * hq + r) * 512 + h * 128 + 32 * w + 16 * et + c16] = o[tt][et][r];
  }
  float* dst = (float*)(p.ws + W_DST) + (size_t)it * 128 * 128;
#pragma unroll
  for (int dt = 0; dt < 8; ++dt) {
    bf16x8 kt[2];
#pragma unroll
    for (int ks = 0; ks < 2; ++ks) {
      const u16* base = Ke + (32 * ks + 8 * hq + tq) * HST + 16 * dt + 4 * tp;
      kt[ks] = cat8(tr_read(base), tr_read(base + 4 * HST));
    }
    f32x4 sc2;
#pragma unroll
    for (int r = 0; r < 4; ++r) sc2[r] = __expf(G63[16 * dt + 4 * hq + r] - Rr[16 * dt + 4 * hq + r]);
#pragma unroll
    for (int et = 0; et < 2; ++et) {
      f32x4 dd = f32x4{0.f, 0.f, 0.f, 0.f};
      dd = MFMA16(kt[0], vf[0][et], dd); dd = MFMA16(kt[1], vf[1][et], dd);
      *(float4*)(dst + (size_t)(32 * w + 16 * et + c16) * 128 + 16 * dt + 4 * hq) = make_float4(dd[0] * sc2[0], dd[1] * sc2[1], dd[2] * sc2[2], dd[3] * sc2[3]);
    }
  }
  if (tid < 128) ((float*)(p.ws + W_DEC))[(size_t)it * 128 + tid] = __expf(G63[tid]);
}

constexpr int H2_ITEMS = 8 * 4 * 128 * 32 / 256;
DI void hgrn_h2_item(const Params& p, int it) {
  const int gt = it * 256 + otid(), bh = gt >> 12, e = (gt >> 5) & 127, dq = gt & 31;
  const float* dst = (const float*)(p.ws + W_DST); const float* dec = (const float*)(p.ws + W_DEC); u16* spt = (u16*)(p.ws + W_SPT);
  float4 s = make_float4(0.f, 0.f, 0.f, 0.f);
#pragma unroll 1
  for (int c0 = 0; c0 < 32; c0 += 8) {
    float4 d4[8], k4[8];
#pragma unroll
    for (int i = 0; i < 8; ++i) {
      d4[i] = *(const float4*)(dst + ((size_t)(bh * 32 + c0 + i) * 128 + e) * 128 + dq * 4);
      k4[i] = *(const float4*)(dec + (size_t)(bh * 32 + c0 + i) * 128 + dq * 4);
    }
#pragma unroll
    for (int i = 0; i < 8; ++i) {
      *(uint2*)(spt + ((size_t)(bh * 32 + c0 + i) * 128 + e) * 128 + dq * 4) = make_uint2(pk2(s.x, s.y), pk2(s.z, s.w));
      s.x = k4[i].x * s.x + d4[i].x; s.y = k4[i].y * s.y + d4[i].y; s.z = k4[i].z * s.z + d4[i].z; s.w = k4[i].w * s.w + d4[i].w;
    }
  }
  float* So = p.out + O_PHG + (size_t)bh * 128 * 128;
  So[(size_t)(dq * 4 + 0) * 128 + e] = s.x; So[(size_t)(dq * 4 + 1) * 128 + e] = s.y;
  So[(size_t)(dq * 4 + 2) * 128 + e] = s.z; So[(size_t)(dq * 4 + 3) * 128 + e] = s.w;
}

DI void hgrn_h3_item(const Params& p, int it) {
  const int c = it & 31, h = (it >> 5) & 3, b = it >> 7;
  const int tid = otid(), lane = tid & 63, w = tid >> 6, c16 = lane & 15, hq = lane >> 4;
  const size_t tok0 = (size_t)b * 2048 + c * 64 + 16 * w;
  const u16* qg = (const u16*)(p.ws + W_QG) + (tok0 + c16) * 512 + h * 128 + 8 * hq;
  bf16x8 af[4];
#pragma unroll
  for (int ks = 0; ks < 4; ++ks) af[ks] = *(const bf16x8*)(qg + 32 * ks);
  const float* oraw = (const float*)(p.ws + W_ORAW) + (tok0 + 4 * hq) * 512 + h * 128 + c16;
  const u16* spt = (const u16*)(p.ws + W_SPT) + ((size_t)it * 128 + c16) * 128 + 8 * hq;
  f32x4 acc[8];
#pragma unroll
  for (int et = 0; et < 8; ++et) {
#pragma unroll
    for (int r = 0; r < 4; ++r) acc[et][r] = oraw[(size_t)r * 512 + 16 * et];
#pragma unroll
    for (int ks = 0; ks < 4; ++ks) {
      const bf16x8 bfr = *(const bf16x8*)(spt + (size_t)(16 * et) * 128 + 32 * ks);
      acc[et] = MFMA16(af[ks], bfr, acc[et]);
    }
  }
  const u16* zb = (const u16*)(p.ws + W_ZB) + (tok0 + 4 * hq) * 512 + h * 128 + c16;
  u16* ob = (u16*)(p.ws + W_OB) + (tok0 + 4 * hq) * 512 + h * 128 + c16;
  u16 zv[4][8]; float ng[8];
#pragma unroll
  for (int r = 0; r < 4; ++r)
#pragma unroll
    for (int et = 0; et < 8; ++et) zv[r][et] = zb[(size_t)r * 512 + 16 * et];
#pragma unroll
  for (int et = 0; et < 8; ++et) ng[et] = p.hg_norm_g[h * 128 + 16 * et + c16];
#pragma unroll
  for (int r = 0; r < 4; ++r) {
    float v = 0.f;
#pragma unroll
    for (int et = 0; et < 8; ++et) v += acc[et][r] * acc[et][r];
    v += __shfl_xor(v, 1); v += __shfl_xor(v, 2); v += __shfl_xor(v, 4); v += __shfl_xor(v, 8);
    const float rs = rsqrtf(v * (1.f / 128.f) + 1e-6f);
#pragma unroll
    for (int et = 0; et < 8; ++et) ob[(size_t)r * 512 + 16 * et] = f2bf(acc[et][r] * rs * ng[et] * bf2f(zv[r][et]));
  }
}

typedef __attribute__((address_space(3))) const float lds_cf;
template <int NR>
DI void sa_scores(const float* qrows_, const float4 (&kk)[16], float (&sc)[NR]) {
  lds_cf* qrows = (lds_cf*)qrows_; asm volatile("" : "+v"(qrows));
#pragma unroll
  for (int r = 0; r < NR; ++r) {
    float a0 = 0.f, a1 = 0.f;
#pragma unroll
    for (int dq = 0; dq < 16; dq += 2) {
      const f32x4 q0 = *(const __attribute__((address_space(3))) f32x4*)(qrows + r * 64 + dq * 4), q1 = *(const __attribute__((address_space(3))) f32x4*)(qrows + r * 64 + dq * 4 + 4);
      a0 += q0[0] * kk[dq].x + q0[1] * kk[dq].y + q0[2] * kk[dq].z + q0[3] * kk[dq].w;
      a1 += q1[0] * kk[dq + 1].x + q1[1] * kk[dq + 1].y + q1[2] * kk[dq + 1].z + q1[3] * kk[dq + 1].w;
    }
    sc[r] = a0 + a1;
    asm volatile("" : "+v"(sc[r]) :: "memory");
  }
}
DI void sa_load_f32(const float* rowp, bool ok, float4 (&kk)[16]) {
#pragma unroll
  for (int i = 0; i < 16; ++i) kk[i] = ok ? ((const float4*)rowp)[i] : make_float4(0.f, 0.f, 0.f, 0.f);
}
template <int NR>
DI void sa_softmax(float* P, int nk, int row, int sub) {
  float m = -3.0e38f;
  for (int k = sub; k < nk; k += 16) m = fmaxf(m, P[k * NR + row]);
  m = fmaxf(m, __shfl_xor(m, 1)); m = fmaxf(m, __shfl_xor(m, 2)); m = fmaxf(m, __shfl_xor(m, 4)); m = fmaxf(m, __shfl_xor(m, 8));
  float l = 0.f;
  for (int k = sub; k < nk; k += 16) { const float sv = P[k * NR + row]; const float pv = (sv > -1.0e38f) ? __builtin_amdgcn_exp2f(sv - m) : 0.f; P[k * NR + row] = pv; l += pv; }
  l += __shfl_xor(l, 1); l += __shfl_xor(l, 2); l += __shfl_xor(l, 4); l += __shfl_xor(l, 8);
  const float inv = (l > 0.f) ? 1.f / l : 0.f;
  for (int k = sub; k < nk; k += 16) P[k * NR + row] *= inv;
}

DI void sa_load_bf16(const u16* rowp, bool ok, float4 (&kk)[16]) {
#pragma unroll
  for (int i = 0; i < 8; ++i) {
    const uint4 u = ok ? ((const uint4*)rowp)[i] : make_uint4(0u, 0u, 0u, 0u);
    kk[2 * i] = make_float4(bflo(u.x), bfhi(u.x), bflo(u.y), bfhi(u.y)); kk[2 * i + 1] = make_float4(bflo(u.z), bfhi(u.z), bflo(u.w), bfhi(u.w));
  }
}
template <class VRow>
DI void sa_pv(const float* P, int k0, int k1, const VRow& vrow, int lane, float (&o)[4]) {
#pragma unroll 1
  for (int kb = k0; kb < k1; kb += 32) {
    float vv[32];
#pragma unroll
    for (int i = 0; i < 32; ++i) vv[i] = vrow((kb + i < k1) ? kb + i : k1 - 1, lane);
#pragma unroll
    for (int i = 0; i < 32; ++i) {
      const int key = (kb + i < k1) ? kb + i : k1 - 1;
      const float4 p4 = *(const float4*)(P + key * 4); const float v = (kb + i < k1) ? vv[i] : 0.f;
      o[0] += p4.x * v; o[1] += p4.y * v; o[2] += p4.z * v; o[3] += p4.w * v;
    }
  }
}
template <int CTRL> DI float dppf(float v) { return __builtin_bit_cast(float, __builtin_amdgcn_update_dpp(0, __builtin_bit_cast(int, v), CTRL, 0xF, 0xF, false)); }
DI float red16(float v) { v += dppf<0xB1>(v); v += dppf<0x4E>(v); v += dppf<0x141>(v); v += dppf<0x140>(v); return v; }
template <class KRow, class Fin>
DI void sa_tile4(const float4 (&q4)[4], float* Pdst, const KRow& krow, const Fin& fin, int lane) {
  const int chunk = lane & 15, k4 = lane >> 4;
  float4 kv[16];
#pragma unroll
  for (int i = 0; i < 16; ++i) kv[i] = krow(4 * i + k4, chunk);
#pragma unroll
  for (int i = 0; i < 16; ++i) {
    float sr[4];
#pragma unroll
    for (int r = 0; r < 4; ++r) sr[r] = red16(q4[r].x * kv[i].x + q4[r].y * kv[i].y + q4[r].z * kv[i].z + q4[r].w * kv[i].w);
    const float mine = (chunk == 0) ? sr[0] : ((chunk == 1) ? sr[1] : ((chunk == 2) ? sr[2] : sr[3]));
    const float fv = fin(4 * i + k4, chunk & 3, mine);
    if (chunk < 4) Pdst[(4 * i + k4) * 4 + chunk] = fv;
  }
}
DI void sa_softmax_row(float* P, int nk, int row, int lane) {
  float m = -3.0e38f;
  for (int k = lane; k < nk; k += 64) m = fmaxf(m, P[k * 4 + row]);
  m = wave_max(m);
  float l = 0.f;
  for (int k = lane; k < nk; k += 64) { const float sv = P[k * 4 + row]; const float pv = (sv > -1.0e38f) ? __builtin_amdgcn_exp2f(sv - m) : 0.f; P[k * 4 + row] = pv; l += pv; }
  l = wave_sum(l);
  const float inv = (l > 0.f) ? 1.f / l : 0.f;
  for (int k = lane; k < nk; k += 64) P[k * 4 + row] *= inv;
}
DI void sample_attn_item(const Params& p, int it, char* lds) {
  const int t = it & 3, g = (it >> 2) & 1, b = it >> 3, tid = otid(), lane = tid & 63, w = __builtin_amdgcn_readfirstlane(tid >> 6);
  float* qs = (float*)lds;
  float* Pc = qs + 256;
  float* Pw = Pc + 512;
  float* Ps = Pw + 2304;
  float* obuf = Ps + 2048;
  float* imp = obuf + 3072;
  int* sel = (int*)(imp + 36);
  int* pts = sel + 8;
  float* btab = (float*)(pts + 16);
  const size_t tok = (size_t)(NTP + b * 4 + t);
  const int qpos = PAST + t, seq = BATCH + b;
  __syncthreads();
  qs[tid] = bf2f(((const u16*)(p.ws + W_Q))[tok * 512 + (g * 4 + (tid >> 6)) * 64 + lane]);
  for (int i = tid; i < 4 * 129; i += 256) { const int r = i / 129, rel = i % 129; const int bk = rel < 128 ? T5B[rel] : 31; btab[i] = p.rel_bias[bk * 8 + g * 4 + r] * LOG2E; }
  if (tid < 16) pts[tid] = p.pt[b * 16 + tid];
  __syncthreads();
  const float* fresh_wk = p.out + O_SWK + ((size_t)b * 512 + 508) * 128 + g * 64;
  const float* fresh_wv = p.out + O_SWK + (size_t)DEC_BATCH * 512 * 128 + ((size_t)b * 512 + 508) * 128 + g * 64;
  const float* fresh_sk = p.out + O_SCK + 2 * (size_t)NTS * 128 + (size_t)(b * 4) * 128 + g * 64;
  const float* fresh_sv = p.out + O_SCK + 3 * (size_t)NTS * 128 + (size_t)(b * 4) * 128 + g * 64;
  float4 q4[4];
#pragma unroll
  for (int r = 0; r < 4; ++r) q4[r] = *(const float4*)(qs + r * 64 + (lane & 15) * 4);
  for (int ti = w; ti < 11; ti += 4) {
    if (ti < 2) {
      const u16* kc = (const u16*)(p.ws + W_KCMP) + (size_t)(seq * 2 + g) * 128 * 64;
      sa_tile4(q4, Pc + ti * 256,
               [&](int k, int c) { const int n = 64 * ti + k; const uint2 u = *(const uint2*)(kc + (size_t)n * 64 + c * 4); return make_float4(bflo(u.x), bfhi(u.x), bflo(u.y), bfhi(u.y)); },
               [&](int k, int r, float sv) { const int n = 64 * ti + k; const int rel = qpos - (16 * n + 31); return (n < 127) ? sv + btab[r * 129 + (rel < 128 ? rel : 128)] : -3.0e38f; }, lane);
    } else {
      const int k0 = (ti - 2) * 64;
      sa_tile4(q4, Pw + k0 * 4,
               [&](int k, int c) { const int key = (k0 + k < 516) ? k0 + k : 515;
                 const float* rp = (key < 512) ? (p.swk + ((size_t)b * 512 + key) * 128 + g * 64) : (fresh_wk + (size_t)(key - 512) * 128);
                 return *(const float4*)(rp + c * 4); },
               [&](int k, int r, float sv) { const int key = k0 + k; const int rel = qpos - (PAST - 512 + key);
                 const bool ok = key < 516 && rel >= 0 && rel < 512; return ok ? sv + btab[r * 129 + (rel < 128 ? rel : 128)] : -3.0e38f; }, lane);
    }
  }
  __syncthreads();
  sa_softmax_row(Pc, 128, w, lane);
  sa_softmax_row(Pw, 576, w, lane);
  __syncthreads();
  if (w == 0) {
    if (lane < 33) {
      const int j = lane; float sm = 0.f;
      for (int u = -1; u <= 3; ++u) { const int n = 4 * j + u; if (n >= 0 && n < 127) { const float4 p4 = *(const float4*)(Pc + n * 4); sm += (p4.x + p4.y + p4.z + p4.w) * ((u == -1 || u == 3) ? 1.f : 2.f); } }
      imp[j] = sm;
    }
    if (lane == 0) {
      sel[0] = 0; sel[1] = 31; sel[2] = 32;
      unsigned taken = 0u;
      for (int c = 0; c < 5; ++c) {
        float best = -1.f; int bi = 1;
        for (int j = 1; j <= 30; ++j) { const float v = imp[j]; if (!((taken >> j) & 1u) && v > best) { best = v; bi = j; } }
        taken |= 1u << bi; sel[3 + c] = bi;
      }
    }
  }
  __syncthreads();
  for (int jj = w; jj < 8; jj += 4) {
    const int blk = sel[jj];
    const float* kbase = (blk < 32) ? (p.csk + (((size_t)pts[blk >> 1] * 128 + (blk & 1) * 64) * 2 + g) * 64) : fresh_sk;
    sa_tile4(q4, Ps + jj * 256,
             [&](int k, int c) { const int kk = (blk < 32) ? k : (k & 3); return *(const float4*)(kbase + (size_t)kk * 128 + c * 4); },
             [&](int k, int r, float sv) { const int rel = qpos - (blk * 64 + k); const bool ok = (blk < 32 || k < 4) && rel >= 0;
               return ok ? sv + btab[r * 129 + (rel < 0 ? 0 : (rel < 128 ? rel : 128))] : -3.0e38f; }, lane);
  }
  {
    float oc[4] = {0.f, 0.f, 0.f, 0.f}, ow[4] = {0.f, 0.f, 0.f, 0.f};
    const u16* vc = (const u16*)(p.ws + W_VCMP) + (size_t)(seq * 2 + g) * 128 * 64;
    sa_pv(Pc, 32 * w, (32 * w + 32 < 127) ? 32 * w + 32 : 127, [&](int k, int l) { return bf2f(vc[(size_t)k * 64 + l]); }, lane, oc);
    const float* vst = p.swv + (size_t)b * 512 * 128 + g * 64;
    sa_pv(Pw, 129 * w, 129 * w + 129, [&](int k, int l) { const float* rp = (k < 512) ? (vst + (size_t)k * 128) : (fresh_wv + (size_t)(k - 512) * 128); return rp[l]; }, lane, ow);
#pragma unroll
    for (int r = 0; r < 4; ++r) { obuf[((0 * 4 + w) * 4 + r) * 64 + lane] = oc[r]; obuf[((1 * 4 + w) * 4 + r) * 64 + lane] = ow[r]; }
  }
  __syncthreads();
  sa_softmax_row(Ps, 512, w, lane);
  __syncthreads();
  {
    float os[4] = {0.f, 0.f, 0.f, 0.f};
    for (int jj = 2 * w; jj < 2 * w + 2; ++jj) {
      const int blk = sel[jj];
      const float* vbase; int ns;
      if (blk < 32) { vbase = p.csv + (((size_t)pts[blk >> 1] * 128 + (blk & 1) * 64) * 2 + g) * 64; ns = 64; } else { vbase = fresh_sv; ns = 4; }
      sa_pv(Ps + jj * 64 * 4, 0, ns, [&](int k, int l) { return vbase[(size_t)k * 128 + l]; }, lane, os);
    }
#pragma unroll
    for (int r = 0; r < 4; ++r) obuf[((2 * 4 + w) * 4 + r) * 64 + lane] = os[r];
  }
  __syncthreads();
  {
    const int r = tid >> 6, hd = g * 4 + r;
    const float* gt = (const float*)(p.ws + W_GATE) + tok * 24;
    float o = 0.f;
#pragma unroll
    for (int br = 0; br < 3; ++br) {
      float a = 0.f;
#pragma unroll
      for (int ww = 0; ww < 4; ++ww) a += obuf[((br * 4 + ww) * 4 + r) * 64 + lane];
      o += gt[(br == 0 ? 0 : (br == 1 ? 16 : 8)) + hd] * a;
    }
    ((u16*)(p.ws + W_OA))[tok * 512 + hd * 64 + lane] = f2bf(o * bf2f(((const u16*)(p.ws + W_ZA))[tok * 512 + hd * 64 + lane]));
  }
}

constexpr int P2_HP = BATCH * 4 * 32;
constexpr int P2_CMP = BATCH * 2 * 2;
constexpr int P2_SA = DEC_BATCH * 2 * 4;
constexpr int P2_HS = DEC_BATCH * 4;
constexpr int P2_TOTAL = P2_HP + P2_CMP + P2_SA + P2_HS;
DI void phase2_item(const Params& p, int it, char* lds) {
  if (it < P2_SA) { sample_attn_item(p, it, lds); return; }
  it -= P2_SA;
  if (it < P2_CMP) {
    const int kv = it & 1, g = (it >> 1) & 1, b = it >> 2;
    LoadCellBf16 al{(const u16*)(p.ws + W_KV) + (size_t)kv * NT * 128 + (size_t)b * 2048 * 128 + g * 64};
    comp_tile(p, al, b, g, kv, lds); return;
  }
  it -= P2_CMP;
  if (it < P2_HS) { hgrn_sample_item(p, it, lds); return; }
  it -= P2_HS;
  hgrn_h1_item(p, it, lds);
}

constexpr int AKS = 72, AVS = 68, ACS = 132;
DI bf16x8 pack8(const f32x16& x, int s2) {
  uint4 u; u.x = pk2(x[8 * s2], x[8 * s2 + 1]); u.y = pk2(x[8 * s2 + 2], x[8 * s2 + 3]);
  u.z = pk2(x[8 * s2 + 4], x[8 * s2 + 5]); u.w = pk2(x[8 * s2 + 6], x[8 * s2 + 7]);
  return __builtin_bit_cast(bf16x8, u);
}
DI void zero16(f32x16& x) {
#pragma unroll
  for (int i = 0; i < 16; ++i) x[i] = 0.f;
}

constexpr int T2N = 264;
template <int MODE>
DI void attn_tile(const u16* Kt, const u16* Vt, const float* t2r, float cfar, const bf16x8 (&qf)[4], int qpos, int kpos0, bool lane_on,
                  float& m_run, float& l_run, f32x16 (&oacc)[2], int ql, int hh) {
  f32x16 sacc[2];
#pragma unroll
  for (int kt = 0; kt < 2; ++kt) {
    zero16(sacc[kt]);
#pragma unroll
    for (int ks = 0; ks < 4; ++ks) {
      const bf16x8 kf = *(const bf16x8*)(Kt + (32 * kt + ql) * AKS + 16 * ks + 8 * hh);
      sacc[kt] = MFMA32(kf, qf[ks], sacc[kt]);
    }
  }
  float mt = -1.0e30f;
  if (MODE == 0) {
#pragma unroll
    for (int kt = 0; kt < 2; ++kt)
#pragma unroll
      for (int i = 0; i < 16; ++i) mt = fmaxf(mt, sacc[kt][i]);
    mt = lane_on ? mt + cfar : -1.0e30f;
  } else if (MODE == 1) {
    const float* tb = t2r + (lane_on ? (qpos - kpos0 + 63 - 4 * hh) : 59) - 59;
#pragma unroll
    for (int kt = 0; kt < 2; ++kt)
#pragma unroll
      for (int i = 0; i < 16; ++i) {
        sacc[kt][i] += tb[59 - (32 * kt + (i & 3) + 8 * (i >> 2))];
        mt = fmaxf(mt, sacc[kt][i]);
      }
  } else {
    const int thr = qpos - kpos0 - 4 * hh - 512;
#pragma unroll
    for (int kt = 0; kt < 2; ++kt)
#pragma unroll
      for (int i = 0; i < 16; ++i) {
        const bool ok = lane_on && (32 * kt + (i & 3) + 8 * (i >> 2)) > thr;
        sacc[kt][i] = ok ? sacc[kt][i] + cfar : -1.0e30f;
        mt = fmaxf(mt, sacc[kt][i]);
      }
  }
  mt = fmaxf(mt, __shfl_xor(mt, 32));
  const float mn = fmaxf(m_run, mt);
  if (!__all(mn == m_run)) {
    const float alpha = __builtin_amdgcn_exp2f(m_run - mn);
    l_run *= alpha;
#pragma unroll
    for (int dt = 0; dt < 2; ++dt)
#pragma unroll
      for (int i = 0; i < 16; ++i) oacc[dt][i] *= alpha;
  }
  m_run = mn;
  float ls = 0.f;
  if (MODE == 0) {
    const float dsh = lane_on ? cfar - mn : -1.0e30f;
#pragma unroll
    for (int kt = 0; kt < 2; ++kt)
#pragma unroll
      for (int i = 0; i < 16; ++i) { const float pv = __builtin_amdgcn_exp2f(sacc[kt][i] + dsh); sacc[kt][i] = pv; ls += pv; }
  } else {
#pragma unroll
    for (int kt = 0; kt < 2; ++kt)
#pragma unroll
      for (int i = 0; i < 16; ++i) {
        const float pv = (sacc[kt][i] > -1.0e29f) ? __builtin_amdgcn_exp2f(sacc[kt][i] - mn) : 0.f;
        sacc[kt][i] = pv; ls += pv;
      }
  }
  l_run += ls;
#pragma unroll
  for (int kt = 0; kt < 2; ++kt)
#pragma unroll
    for (int s2 = 0; s2 < 2; ++s2) {
      const bf16x8 pf = pack8(sacc[kt], s2);
#pragma unroll
      for (int dt = 0; dt < 2; ++dt) {
        const u16* vp = Vt + (32 * kt + 16 * s2 + 4 * hh + ((ql & 15) >> 2)) * AKS + 32 * dt + (ql & 16) + 4 * (ql & 3);
        const bf16x8 vf = cat8(tr_read(vp), tr_read(vp + 8 * AKS));
        oacc[dt] = MFMA32(vf, pf, oacc[dt]);
      }
    }
}

DI void attn_load_tile(u16* Kt, u16* Vt, const u16* ksrc  , const u16* vtsrc  ) {
  const int tid = otid512();
  {
    const int idx = tid, rw = idx >> 3, ch = idx & 7;
    *(uint4*)(Kt + rw * AKS + ch * 8) = *(const uint4*)(ksrc + (size_t)rw * 128 + ch * 8);
    const uint4 v = *(const uint4*)(vtsrc + (size_t)rw * 2048 + ch * 8);
    *(uint2*)(Vt + rw * AVS + ch * 8) = make_uint2(v.x, v.y);
    *(uint2*)(Vt + rw * AVS + ch * 8 + 4) = make_uint2(v.z, v.w);
  }
}

DI void prompt_attn_item(const Params& p, int it, char* lds) {
  const int qt = (it < 256) ? (31 - (it & 31)) : (it & 31), g = (it >> 5) & 1, b = (it >> 6) & 3 | ((it >> 8) << 2);
  const int t0 = qt * 64;
  const int tid = otid512(), lane = tid & 63, w = tid >> 6, ql = lane & 31, hh = lane >> 5, tl = ql >> 2, r = ql & 3;
  const int qpos = t0 + 8 * w + tl, head = g * 4 + r;
  const size_t tok = (size_t)b * 2048 + qpos;
  u16* Kt = (u16*)lds;
  u16* Vt = Kt + 128 * AKS;
  float* brel = (float*)(Vt + 128 * AKS);
  float* t2 = brel + 4 * 129;
  unsigned* wmask = (unsigned*)(t2 + 4 * T2N);
  const u16* Qb = (const u16*)(p.ws + W_Q);
  __syncthreads();
  for (int i = tid; i < 4 * 129; i += 512) { const int rr = i / 129, rel = i % 129; const int bk = rel < 128 ? T5B[rel] : 31; brel[i] = p.rel_bias[bk * 8 + g * 4 + rr] * LOG2E; }
  for (int i = tid; i < 4 * T2N; i += 512) { const int rr = i / T2N, rel = i % T2N - 63; const int bk = rel < 128 ? T5B[rel < 0 ? 0 : rel] : 31;
    t2[i] = (rel < 0) ? -1.0e30f : p.rel_bias[bk * 8 + g * 4 + rr] * LOG2E; }
  bf16x8 qf[4];
#pragma unroll
  for (int ks = 0; ks < 4; ++ks) qf[ks] = *(const bf16x8*)(Qb + tok * 512 + head * 64 + 16 * ks + 8 * hh);
  const float* gt = (const float*)(p.ws + W_GATE) + tok * 24;
  const float* brel_r = brel + r * 129;
  const float* t2r = t2 + r * T2N;
  const float cfar = p.rel_bias[31 * 8 + head] * LOG2E;
  f32x16 of[2];
  unsigned selm;
  {
#pragma unroll
    for (int i = 0; i < 2; ++i) {
      const int idx = tid + 512 * i, n = idx >> 3, ch = idx & 7;
      *(uint4*)(Kt + n * AKS + ch * 8) = *(const uint4*)((const u16*)(p.ws + W_KCMP) + ((size_t)(b * 2 + g) * 128 + n) * 64 + ch * 8);
      *(uint4*)(Vt + n * AKS + ch * 8) = *(const uint4*)((const u16*)(p.ws + W_VCMP) + ((size_t)(b * 2 + g) * 128 + n) * 64 + ch * 8);
    }
    __syncthreads();
    f32x16 sacc[4];
#pragma unroll
    for (int kt = 0; kt < 4; ++kt) {
      zero16(sacc[kt]);
#pragma unroll
      for (int ks = 0; ks < 4; ++ks) {
        const bf16x8 kf = *(const bf16x8*)(Kt + (32 * kt + ql) * AKS + 16 * ks + 8 * hh);
        sacc[kt] = MFMA32(kf, qf[ks], sacc[kt]);
      }
    }
    float mt = -1.0e30f;
#pragma unroll
    for (int kt = 0; kt < 4; ++kt)
#pragma unroll
      for (int i = 0; i < 16; ++i) {
        const int n = 32 * kt + crow(i, hh);
        const int rel = qpos - (16 * n + 31);
        const bool ok = rel >= 0 && n < 127;
        const float sv = sacc[kt][i] + brel_r[rel < 0 ? 0 : (rel < 128 ? rel : 128)];
        sacc[kt][i] = ok ? sv : -1.0e30f;
        mt = fmaxf(mt, sacc[kt][i]);
      }
    mt = fmaxf(mt, __shfl_xor(mt, 32));
    float ls = 0.f;
#pragma unroll
    for (int kt = 0; kt < 4; ++kt)
#pragma unroll
      for (int i = 0; i < 16; ++i) { const float pv = (sacc[kt][i] > -1.0e29f) ? __builtin_amdgcn_exp2f(sacc[kt][i] - mt) : 0.f; sacc[kt][i] = pv; ls += pv; }
    ls += __shfl_xor(ls, 32);
    const float inv = ls > 0.f ? 1.f / ls : 0.f;
#pragma unroll
    for (int kt = 0; kt < 4; ++kt)
#pragma unroll
      for (int i = 0; i < 16; ++i) sacc[kt][i] *= inv;
    f32x16 oc[2]; zero16(oc[0]); zero16(oc[1]);
#pragma unroll
    for (int kt = 0; kt < 4; ++kt)
#pragma unroll
      for (int s2 = 0; s2 < 2; ++s2) {
        const bf16x8 pf = pack8(sacc[kt], s2);
#pragma unroll
        for (int dt = 0; dt < 2; ++dt) {
          const u16* vp = Vt + (32 * kt + 16 * s2 + 4 * hh + ((ql & 15) >> 2)) * AKS + 32 * dt + (ql & 16) + 4 * (ql & 3);
          const bf16x8 vf = cat8(tr_read(vp), tr_read(vp + 8 * AKS));
          oc[dt] = MFMA32(vf, pf, oc[dt]);
        }
      }
    const float g0 = gt[head];
#pragma unroll
    for (int dt = 0; dt < 2; ++dt)
#pragma unroll
      for (int i = 0; i < 16; ++i) of[dt][i] = g0 * oc[dt][i];
    float im[16], cm[16];
#pragma unroll
    for (int kt = 0; kt < 4; ++kt)
#pragma unroll
      for (int q4 = 0; q4 < 4; ++q4) {
        const float p0 = sacc[kt][4 * q4], p1 = sacc[kt][4 * q4 + 1], p2 = sacc[kt][4 * q4 + 2], p3 = sacc[kt][4 * q4 + 3];
        im[4 * kt + q4] = 2.f * (p0 + p1 + p2) + p3; cm[4 * kt + q4] = p3;
      }
#pragma unroll
    for (int m = 0; m < 16; ++m) cm[m] = __shfl_xor(cm[m], 32);
#pragma unroll
    for (int m = 15; m >= 0; --m) im[m] += hh ? cm[m] : (m > 0 ? cm[m - 1] : 0.f);
#pragma unroll
    for (int m = 0; m < 16; ++m) { im[m] += __shfl_xor(im[m], 1); im[m] += __shfl_xor(im[m], 2); }
    float ev[16], od[16];
#pragma unroll
    for (int m = 0; m < 16; ++m) { const float ot = __shfl_xor(im[m], 32); ev[m] = hh ? ot : im[m]; od[m] = hh ? im[m] : ot; }
    const int cur = qpos >> 6;
    if (cur < 8) selm = (2u << cur) - 1u;
    else {
      selm = 1u | (1u << cur) | (1u << (cur - 1));
      for (int c = 0; c < 5; ++c) {
        float best = -1.f;
#pragma unroll
        for (int J = 0; J < 32; ++J) { const float v = (J <= cur && !((selm >> J) & 1u)) ? ((J & 1) ? od[J >> 1] : ev[J >> 1]) : -1.f; best = fmaxf(best, v); }
        int bi = 32;
#pragma unroll
        for (int J = 31; J >= 0; --J) { const float v = (J <= cur && !((selm >> J) & 1u)) ? ((J & 1) ? od[J >> 1] : ev[J >> 1]) : -1.f; if (v == best) bi = J; }
        if (best >= 0.f) selm |= 1u << bi;
      }
    }
    unsigned um = selm;
    um |= __shfl_xor(um, 4); um |= __shfl_xor(um, 8); um |= __shfl_xor(um, 16);
    if (lane == 0) wmask[w] = um;
  }
  __syncthreads();
  const unsigned un = wmask[0] | wmask[1] | wmask[2] | wmask[3] | wmask[4] | wmask[5] | wmask[6] | wmask[7];
  {
    const u16* ks = (const u16*)(p.ws + W_KV) + (size_t)2 * NT * 128 + (size_t)b * 2048 * 128 + g * 64;
    const u16* vts = (const u16*)(p.ws + W_KV) + (size_t)3 * NT * 128 + (size_t)b * 2048 * 128 + g * 64;
    const u16* kw = (const u16*)(p.ws + W_KV) + (size_t)4 * NT * 128 + (size_t)b * 2048 * 128 + g * 64;
    const u16* vtw = (const u16*)(p.ws + W_KV) + (size_t)5 * NT * 128 + (size_t)b * 2048 * 128 + g * 64;
    const int rw = tid >> 3, ch = tid & 7;
    uint4 kreg, vreg;
#define ATT_PREFETCH(kb, vb, j_) do { kreg = *(const uint4*)((kb) + ((size_t)(j_) * 64 + rw) * 128 + ch * 8); vreg = *(const uint4*)((vb) + ((size_t)(j_) * 64 + rw) * 128 + ch * 8); } while (0)
#define ATT_COMMIT() do { *(uint4*)(Kt + rw * AKS + ch * 8) = kreg; *(uint4*)(Vt + rw * AKS + ch * 8) = vreg; } while (0)
    const int jlo = (t0 >= 511) ? ((t0 - 511) >> 6) : 0, jhi = (t0 + 63) >> 6;
    {
      float m_run = -1.0e30f, l_run = 0.f; f32x16 oacc[2]; zero16(oacc[0]); zero16(oacc[1]);
      unsigned rem = un;
      int j = __builtin_ctz(rem); rem &= rem - 1u;
      ATT_PREFETCH(ks, vts, j);
      for (;;) {
        __syncthreads();
        ATT_COMMIT();
        __syncthreads();
        const int jn = rem ? __builtin_ctz(rem) : -1;
        if (jn >= 0) { rem &= rem - 1u; ATT_PREFETCH(ks, vts, jn); } else { ATT_PREFETCH(kw, vtw, jlo); }
        const bool on = (selm >> j) & 1u;
        if (__ballot(on) != 0ull) {
          if (64 * j + 63 + 128 <= t0 + 8 * w) attn_tile<0>(Kt, Vt, t2r, cfar, qf, qpos, j * 64, on, m_run, l_run, oacc, ql, hh);
          else attn_tile<1>(Kt, Vt, t2r, cfar, qf, qpos, j * 64, on, m_run, l_run, oacc, ql, hh);
        }
        if (jn < 0) break;
        j = jn;
      }
      l_run += __shfl_xor(l_run, 32);
      const float sc = gt[8 + head] * (l_run > 0.f ? 1.f / l_run : 0.f);
#pragma unroll
      for (int dt = 0; dt < 2; ++dt)
#pragma unroll
        for (int i = 0; i < 16; ++i) of[dt][i] += sc * oacc[dt][i];
    }
    {
      float m_run = -1.0e30f, l_run = 0.f; f32x16 oacc[2]; zero16(oacc[0]); zero16(oacc[1]);
      for (int j = jlo; j <= jhi; ++j) {
        __syncthreads();
        ATT_COMMIT();
        __syncthreads();
        if (j < jhi) ATT_PREFETCH(kw, vtw, j + 1);
        if (64 * j + 63 + 128 > t0 + 8 * w) attn_tile<1>(Kt, Vt, t2r, cfar, qf, qpos, j * 64, true, m_run, l_run, oacc, ql, hh);
        else if (64 * j + 511 >= t0 + 8 * w + 7) attn_tile<0>(Kt, Vt, t2r, cfar, qf, qpos, j * 64, true, m_run, l_run, oacc, ql, hh);
        else attn_tile<2>(Kt, Vt, t2r, cfar, qf, qpos, j * 64, true, m_run, l_run, oacc, ql, hh);
      }
      l_run += __shfl_xor(l_run, 32);
      const float sc = gt[16 + head] * (l_run > 0.f ? 1.f / l_run : 0.f);
#pragma unroll
      for (int dt = 0; dt < 2; ++dt)
#pragma unroll
        for (int i = 0; i < 16; ++i) of[dt][i] += sc * oacc[dt][i];
    }
#undef ATT_PREFETCH
#undef ATT_COMMIT
  }
  {
    const u16* za = (const u16*)(p.ws + W_ZA) + tok * 512 + head * 64; u16* oa = (u16*)(p.ws + W_OA) + tok * 512 + head * 64;
    uint2 zz[2][4];
#pragma unroll
    for (int dt = 0; dt < 2; ++dt)
#pragma unroll
      for (int q4 = 0; q4 < 4; ++q4) zz[dt][q4] = *(const uint2*)(za + 32 * dt + 8 * q4 + 4 * hh);
#pragma unroll
    for (int dt = 0; dt < 2; ++dt)
#pragma unroll
      for (int q4 = 0; q4 < 4; ++q4) {
        const int dd = 32 * dt + 8 * q4 + 4 * hh;
        const uint2 z = zz[dt][q4];
        uint2 o; o.x = pk2(of[dt][4 * q4] * bflo(z.x), of[dt][4 * q4 + 1] * bfhi(z.x)); o.y = pk2(of[dt][4 * q4 + 2] * bflo(z.y), of[dt][4 * q4 + 3] * bfhi(z.y));
        *(uint2*)(oa + dd) = o;
      }
  }
}
constexpr int P3_FIN = BATCH * 4 * 32;
constexpr int P3_ATT = BATCH * 2 * 32;
constexpr int P3_TOTAL = P3_FIN + P3_ATT;

constexpr int P4_TOTAL = 128 * 8 + 4 * 16;
template <int NI>
DI void merge_a_tile_t(const Params& p, int tm, int tn, char* lds) {
  f32x16 aa[2][NI], ab[2][NI]; zero_acc<NI>(aa); zero_acc<NI>(ab);
  gemm_glds<NI>(aa, (const u16*)(p.ws + W_OA) + (size_t)tm * 128 * 512, 512, (const u16*)(p.ws + W_WBAT) + (size_t)tn * 64 * NI * 512, 512, 8, lds);
  gemm_glds<NI>(ab, (const u16*)(p.ws + W_OB) + (size_t)tm * 128 * 512, 512, (const u16*)(p.ws + W_WBBT) + (size_t)tn * 64 * NI * 512, 512, 8, lds);
  const int tid = otid(), lane = tid & 63, wave = tid >> 6, wm = wave >> 1, wn = wave & 1, r = lane & 31, h = lane >> 5;
#pragma unroll
  for (int mi = 0; mi < 2; ++mi)
#pragma unroll
    for (int ni = 0; ni < NI; ++ni) {
      const int c = tn * 64 * NI + wn * 32 * NI + ni * 32 + r;
      u16 ga[16], gb[16];
#pragma unroll
      for (int i = 0; i < 16; ++i) { const size_t off = (size_t)(tm * 128 + wm * 64 + mi * 32 + crow(i, h)) * 1024 + c; ga[i] = ((const u16*)(p.ws + W_SA))[off]; gb[i] = ((const u16*)(p.ws + W_SB))[off]; }
#pragma unroll
      for (int i = 0; i < 16; ++i) {
        const size_t off = (size_t)(tm * 128 + wm * 64 + mi * 32 + crow(i, h)) * 1024 + c;
        ((u16*)(p.ws + W_Y))[off] = f2bf(bf2f(ga[i]) * aa[mi][ni][i] + bf2f(gb[i]) * ab[mi][ni][i]);
      }
    }
}
DI void merge_a_tile(const Params& p, int it, char* lds) {
  if (it < 1024) merge_a_tile_t<2>(p, it >> 3, it & 7, lds);
  else { it -= 1024; merge_a_tile_t<1>(p, 128 + (it >> 4), it & 15, lds); }
}
constexpr int P5_TOTAL = 128 * 8 + 4 * 16;
template <int NI>
DI void merge_b_tile_t(const Params& p, int tm, int tn, char* lds) {
  f32x16 acc[2][NI]; zero_acc<NI>(acc);
  gemm_glds<NI>(acc, (const u16*)(p.ws + W_Y) + (size_t)tm * 128 * 1024, 1024, (const u16*)(p.ws + W_WOUTT) + (size_t)tn * 64 * NI * 1024, 1024, 16, lds);
  const int tid = otid(), lane = tid & 63, wave = tid >> 6, wm = wave >> 1, wn = wave & 1, r = lane & 31, h = lane >> 5;
  const float* xin = (tm < 128) ? p.x_prompt : (p.x_sample - (size_t)NTP * 1024);
#pragma unroll
  for (int mi = 0; mi < 2; ++mi) {
    float xv[16][NI];
#pragma unroll
    for (int i = 0; i < 16; ++i)
#pragma unroll
      for (int ni = 0; ni < NI; ++ni) xv[i][ni] = xin[(size_t)(tm * 128 + wm * 64 + mi * 32 + crow(i, h)) * 1024 + tn * 64 * NI + wn * 32 * NI + ni * 32 + r];
#pragma unroll
    for (int i = 0; i < 16; ++i) {
      const size_t row = (size_t)(tm * 128 + wm * 64 + mi * 32 + crow(i, h));
#pragma unroll
      for (int ni = 0; ni < NI; ++ni) {
        const int c = tn * 64 * NI + wn * 32 * NI + ni * 32 + r;
        p.out[row * 1024 + c] = acc[mi][ni][i] + xv[i][ni];
      }
    }
  }
}
DI void merge_b_tile(const Params& p, int it, char* lds) {
  if (it < 1024) merge_b_tile_t<2>(p, it >> 3, it & 7, lds);
  else { it -= 1024; merge_b_tile_t<1>(p, 128 + (it >> 4), it & 15, lds); }
}
constexpr int P6_TOTAL = NT / 8;
DI void final_norm_item(const Params& p, int it) {
  const int tid_ = otid(), lane = tid_ & 63, wave = tid_ >> 6; const size_t row = (size_t)it * 8 + wave * 2;
  float* o = p.out + row * 1024;
  float4 v[2][4]; float ss[2] = {0.f, 0.f};
#pragma unroll
  for (int rr = 0; rr < 2; ++rr)
#pragma unroll
    for (int i = 0; i < 4; ++i) v[rr][i] = *(const float4*)(o + rr * 1024 + (i * 64 + lane) * 4);
#pragma unroll
  for (int rr = 0; rr < 2; ++rr) {
#pragma unroll
    for (int i = 0; i < 4; ++i) ss[rr] += v[rr][i].x * v[rr][i].x + v[rr][i].y * v[rr][i].y + v[rr][i].z * v[rr][i].z + v[rr][i].w * v[rr][i].w;
    ss[rr] = wave_sum(ss[rr]);
  }
#pragma unroll
  for (int rr = 0; rr < 2; ++rr) {
    const float rs = rsqrtf(ss[rr] * (1.f / 1024.f) + 1e-6f);
#pragma unroll
    for (int i = 0; i < 4; ++i) {
      const float4 gg = *(const float4*)(p.final_g + (i * 64 + lane) * 4);
      *(float4*)(o + rr * 1024 + (i * 64 + lane) * 4) = make_float4(v[rr][i].x * rs * gg.x, v[rr][i].y * rs * gg.y, v[rr][i].z * rs * gg.z, v[rr][i].w * rs * gg.w);
    }
  }
}

namespace pg8 {
#define PG8_LAS __attribute__((address_space(3)))
typedef unsigned short bf16_t;
typedef short bf16x8 __attribute__((ext_vector_type(8)));
typedef float f32x4 __attribute__((ext_vector_type(4)));
typedef unsigned u32x4 __attribute__((ext_vector_type(4)));
constexpr int BM = 256, BK = 64, HALF = 128, HTB = HALF * BK * 2  , STAGE_BYTES = 8 * HTB, NXCD = 8, WGM = 8;

__host__ __device__ __forceinline__ int lds_byte(int r, int c) { const int st = (r >> 4) * 2 + (c >> 5), rr = r & 15, cc = c & 31, ob = rr * 64 + cc * 2; return st * 1024 + (ob ^ (((ob >> 9) & 1) << 5)); }
__host__ __device__ __forceinline__ void stage_rc(int b, int& R, int& C) { const int st = b / 1024, sb = b % 1024, swz = sb ^ (((sb >> 9) & 1) << 5); R = (st >> 1) * 16 + swz / 64; C = (st & 1) * 32 + (swz % 64) / 2; }
__host__ __device__ __forceinline__ int perm32(int rho) { const int n = rho >> 4, i = rho & 15; return 8 * (i >> 2) + 4 * n + (i & 3); }

struct Unit { int pm, pn; };
struct Gemm { const bf16_t* A; const bf16_t* Bt; int M, N, K; };

struct StaticOrder {
    int nM, nN, nwg, G, c;
    __host__ __device__ void init(int M, int N, int G_, int c_) { nM = M / BM; nN = N / BM; nwg = nM * nN; G = G_; c = c_; }
    __host__ __device__ bool next(int i, Unit& u) const {
        const long L = (long)i * G + c; if (L >= nwg) return false;
        int wgid = (int)L; { const int q = nwg / NXCD, r = nwg % NXCD, xcd = wgid % NXCD, off = wgid / NXCD; wgid = (xcd < r ? xcd * (q + 1) : r * (q + 1) + (xcd - r) * q) + off; }
        const int nig = WGM * nN, gid = wgid / nig, fm = gid * WGM, gsz = (nM - fm) < WGM ? (nM - fm) : WGM;
        u.pm = fm + ((wgid % nig) % gsz); u.pn = (wgid % nig) / gsz; return true;
    }
    __device__ __forceinline__ void a_ready(const Unit&) const {}
    __device__ __forceinline__ void done(const Unit&) const {}
};

template <class Epi, class Sched, bool STAMP = false>
__device__ __forceinline__ void gemm_phase(PG8_LAS unsigned char* lds, const Gemm g, const Sched& S, const Epi& E, unsigned long long* stamps) {
    int tid_ = threadIdx.x; asm volatile("" : "+v"(tid_));
    const int tid = tid_, wid = __builtin_amdgcn_readfirstlane(tid >> 6), lane = tid & 63, wr = wid >> 2, wc = wid & 3, fr = lane & 15, fq = lane >> 4;
    const int K = g.K, nt = K / BK;
    int ts_lo = 0, ts_hi = 0, nts = 0; const unsigned long long rt_entry = STAMP ? (unsigned long long)wall_clock64() : 0ull;
#define PG8_STAMP() do { if (STAMP && wid == 0 && nts < 64) { const unsigned long long _c = (unsigned long long)clock64(); \
        ts_lo = (lane == nts) ? (int)(unsigned)_c : ts_lo; ts_hi = (lane == nts) ? (int)(unsigned)(_c >> 32) : ts_hi; ++nts; } } while (0)
    PG8_STAMP();
    unsigned voffA[2], voffB[2];
#pragma unroll
    for (int i = 0; i < 2; ++i) { int R, C; stage_rc(tid * 16 + i * 8192, R, C); const int Rb = Epi::PERM ? ((R & ~31) + perm32(R & 31)) : R;
        voffA[i] = (unsigned)(R * K + C) * 2u; voffB[i] = (unsigned)(Rb * K + C) * 2u; }
    const size_t kstep = (size_t)(BK * 2);
    const size_t hstep = (size_t)HALF * K * 2;
    const size_t tstep = 2 * hstep;
    const unsigned ldsw = (unsigned)wid * 1024u;
    const int aoff = lds_byte(wr * 64 + fr, fq * 8), boff = lds_byte(wc * 32 + fr, fq * 8);
#define PG8_SA(b, h) (((b) * 2 + (h)) * HTB)
#define PG8_SB(b, h) ((4 + (b) * 2 + (h)) * HTB)
#define PG8_STAGE(bufoff, gbase, voff) do { _Pragma("unroll") for (int _i = 0; _i < 2; ++_i) \
        __builtin_amdgcn_global_load_lds((const unsigned*)((const char*)(gbase) + (voff)[_i]), (PG8_LAS unsigned*)(lds + (bufoff) + ldsw + _i * 8192), 16, 0, 0); } while (0)
#define PG8_LDA(dst, b, h) do { _Pragma("unroll") for (int m = 0; m < 4; ++m) _Pragma("unroll") for (int k = 0; k < 2; ++k) dst[m][k] = *(const PG8_LAS bf16x8*)(lds + PG8_SA(b, h) + aoff + m * 2048 + k * 1024); } while (0)
#define PG8_LDB(dst, b, h) do { _Pragma("unroll") for (int n = 0; n < 2; ++n) _Pragma("unroll") for (int k = 0; k < 2; ++k) dst[n][k] = *(const PG8_LAS bf16x8*)(lds + PG8_SB(b, h) + boff + n * 2048 + k * 1024); } while (0)
#define PG8_MMA(ai, bj, At, Bt) do { __builtin_amdgcn_s_setprio(1); _Pragma("unroll") for (int m = 0; m < 4; ++m) _Pragma("unroll") for (int n = 0; n < 2; ++n) _Pragma("unroll") for (int k = 0; k < 2; ++k) \
        acc[ai][bj][m][n] = __builtin_amdgcn_mfma_f32_16x16x32_bf16(Bt[n][k], At[m][k], acc[ai][bj][m][n], 0, 0, 0); __builtin_amdgcn_s_setprio(0); } while (0)
#define PG8_WAIT_V(n) asm volatile("s_waitcnt vmcnt(" #n ")" ::: "memory")
#define PG8_WAIT_L(n) asm volatile("s_waitcnt lgkmcnt(" #n ")" ::: "memory")
#define PG8_BAR __builtin_amdgcn_s_barrier()
#define PG8_SCHED __builtin_amdgcn_sched_barrier(0)
    Unit cur, nxt; int ui = 0;
    if (!S.next(0, cur)) return;
    f32x4 acc[2][2][4][2];
#pragma unroll
    for (int a = 0; a < 2; ++a)
#pragma unroll
        for (int b = 0; b < 2; ++b)
#pragma unroll
            for (int m = 0; m < 4; ++m)
#pragma unroll
                for (int n = 0; n < 2; ++n) acc[a][b][m][n] = (f32x4){0.f, 0.f, 0.f, 0.f};
    bf16x8 At[4][2], B0[2][2], B1[2][2];
    const char* cA = (const char*)g.A + (size_t)cur.pm * tstep; const char* cB = (const char*)g.Bt + (size_t)cur.pn * tstep;
    S.a_ready(cur);
    PG8_STAGE(PG8_SB(0, 0), cB, voffB); PG8_STAGE(PG8_SA(0, 0), cA, voffA); PG8_STAGE(PG8_SB(0, 1), cB + hstep, voffB); PG8_STAGE(PG8_SA(0, 1), cA + hstep, voffA);
    if (wr == 1) PG8_BAR;
    PG8_WAIT_V(4); PG8_BAR;
    PG8_STAGE(PG8_SB(1, 0), cB + kstep, voffB); PG8_STAGE(PG8_SA(1, 0), cA + kstep, voffA); PG8_STAGE(PG8_SB(1, 1), cB + hstep + kstep, voffB);
    PG8_WAIT_V(6); PG8_BAR;
    PG8_STAMP();
    for (;;) {
        const bool has_next = S.next(ui + 1, nxt);
        const char* nA = has_next ? (const char*)g.A + (size_t)nxt.pm * tstep : cA; const char* nB = has_next ? (const char*)g.Bt + (size_t)nxt.pn * tstep : cB;
        for (int t = 0; t < nt; t += 2) {
            const bool last = (t == nt - 2);
            const char* a1 = cA + (size_t)(t + 1) * kstep;
            const char* a2 = last ? nA : cA + (size_t)(t + 2) * kstep; const char* b2 = last ? nB : cB + (size_t)(t + 2) * kstep;
            const char* a3 = a2 + kstep; const char* b3 = b2 + kstep;
            if (last && has_next) S.a_ready(nxt);
            PG8_LDB(B0, 0, 0); PG8_SCHED; PG8_LDA(At, 0, 0); PG8_STAGE(PG8_SA(1, 1), a1 + hstep, voffA);
            PG8_WAIT_L(8); PG8_BAR; PG8_WAIT_L(0); PG8_MMA(0, 0, At, B0); PG8_BAR; PG8_SCHED;
            PG8_LDB(B1, 0, 1); PG8_STAGE(PG8_SB(0, 0), b2, voffB);
            PG8_BAR; PG8_WAIT_L(0); PG8_MMA(0, 1, At, B1); PG8_BAR;
            PG8_LDA(At, 0, 1); PG8_STAGE(PG8_SA(0, 0), a2, voffA);
            PG8_BAR; PG8_WAIT_L(0); PG8_MMA(1, 0, At, B0); PG8_BAR; PG8_SCHED;
            PG8_STAGE(PG8_SB(0, 1), b2 + hstep, voffB);
            PG8_WAIT_V(6); PG8_BAR; PG8_MMA(1, 1, At, B1); PG8_BAR;
            PG8_LDB(B0, 1, 0); PG8_SCHED; PG8_LDA(At, 1, 0); PG8_STAGE(PG8_SA(0, 1), a2 + hstep, voffA);
            PG8_WAIT_L(8); PG8_BAR; PG8_WAIT_L(0); PG8_MMA(0, 0, At, B0); PG8_BAR; PG8_SCHED;
            PG8_LDB(B1, 1, 1); PG8_STAGE(PG8_SB(1, 0), b3, voffB);
            PG8_BAR; PG8_WAIT_L(0); PG8_MMA(0, 1, At, B1); PG8_BAR;
            PG8_LDA(At, 1, 1); PG8_STAGE(PG8_SA(1, 0), a3, voffA);
            PG8_BAR; PG8_WAIT_L(0); PG8_MMA(1, 0, At, B0); PG8_BAR; PG8_SCHED;
            PG8_STAGE(PG8_SB(1, 1), b3 + hstep, voffB);
            PG8_WAIT_V(6); PG8_BAR; PG8_MMA(1, 1, At, B1); PG8_BAR;
        }
        PG8_STAMP();
        if constexpr (!Epi::AFTER_DRAIN) { E(acc, cur, wr, wc, fr, fq); S.done(cur); }
        PG8_STAMP();
        if (!has_next) break;
#pragma unroll
        for (int a = 0; a < 2; ++a)
#pragma unroll
            for (int b = 0; b < 2; ++b)
#pragma unroll
                for (int m = 0; m < 4; ++m)
#pragma unroll
                    for (int n = 0; n < 2; ++n) acc[a][b][m][n] = (f32x4){0.f, 0.f, 0.f, 0.f};
        cur = nxt; cA = nA; cB = nB; ++ui;
    }
    PG8_WAIT_V(0);
    if (wr == 0) PG8_BAR;
    PG8_BAR;
    if constexpr (Epi::AFTER_DRAIN) { E.fused(acc, cur, wr, wc, fr, fq, lds, wid, lane); S.done(cur); }
    PG8_STAMP();
    if (STAMP && wid == 0) { stamps[lane] = lane < nts ? (((unsigned long long)(unsigned)ts_hi << 32) | (unsigned)ts_lo) : 0ull;
        if (lane == 62) stamps[62] = rt_entry; if (lane == 63) stamps[63] = (unsigned long long)wall_clock64(); }
#undef PG8_STAMP
#undef PG8_SA
#undef PG8_SB
#undef PG8_STAGE
#undef PG8_LDA
#undef PG8_LDB
#undef PG8_MMA
#undef PG8_WAIT_V
#undef PG8_WAIT_L
#undef PG8_BAR
#undef PG8_SCHED
}
}


DI uint4 pack8f(const float (&v)[8]) { uint4 u; u.x = pk2(v[0], v[1]); u.y = pk2(v[2], v[3]); u.z = pk2(v[4], v[5]); u.w = pk2(v[6], v[7]); return u; }
struct EpiProj {
  static constexpr bool PERM = true, AFTER_DRAIN = false;
  Params p;
#define EPI_ROWS(BODY) _Pragma("unroll") for (int ai = 0; ai < 2; ++ai) _Pragma("unroll") for (int m = 0; m < 4; ++m) { \
      const size_t row = (size_t)(u.pm * 256 + ai * 128 + wr * 64 + m * 16 + fr); float v[8]; \
      _Pragma("unroll") for (int j = 0; j < 4; ++j) { v[j] = acc[ai][bj][m][0][j]; v[4 + j] = acc[ai][bj][m][1][j]; } BODY }
  DI void operator()(const pg8::f32x4 (&acc)[2][2][4][2], const pg8::Unit& u, int wr, int wc, int fr, int fq) const {
    const bool samp = u.pm >= NTP / 256;
#pragma unroll
    for (int bj = 0; bj < 2; ++bj) {
      const int tn = 2 * u.pn + bj;
      const int c = wc * 32 + 8 * fq;
      if (tn < 4) {
        u16* d = (u16*)(p.ws + W_Q) + tn * 128 + c;
        EPI_ROWS({ _Pragma("unroll") for (int j = 0; j < 8; ++j) v[j] *= 0.125f * LOG2E; *(uint4*)(d + row * 512) = pack8f(v); })
      } else if (tn < 10) {
        const int kvg = tn - 4;
        u16* d = (u16*)(p.ws + W_KV) + (size_t)kvg * NT * 128 + c;
        if (!samp) {
          if (kvg < 4) {
            float* o = p.out + O_PCK + (size_t)kvg * NTP * 128 + c;
            EPI_ROWS({ *(uint4*)(d + row * 128) = pack8f(v); float* q_ = o + row * 128; *(float4*)q_ = make_float4(v[0], v[1], v[2], v[3]); *(float4*)(q_ + 4) = make_float4(v[4], v[5], v[6], v[7]); })
          } else if ((u.pm & 7) >= 6) {
            float* o = p.out + O_PWK + (size_t)(kvg - 4) * BATCH * 512 * 128 + c;
            EPI_ROWS({ *(uint4*)(d + row * 128) = pack8f(v); const size_t wr_ = (row >> 11) * 512 + (row & 2047) - 1536;
                       float* q_ = o + wr_ * 128; *(float4*)q_ = make_float4(v[0], v[1], v[2], v[3]); *(float4*)(q_ + 4) = make_float4(v[4], v[5], v[6], v[7]); })
          } else {
            EPI_ROWS({ *(uint4*)(d + row * 128) = pack8f(v); })
          }
        } else {
          float* o = (kvg < 4) ? (p.out + O_SCK + (size_t)kvg * NTS * 128 + c) : (p.out + O_SWK + (size_t)(kvg - 4) * DEC_BATCH * 512 * 128 + c);
          const bool win = kvg >= 4;
          EPI_ROWS({ *(uint4*)(d + row * 128) = pack8f(v); const size_t sr = row - NTP; const size_t orow = win ? ((sr >> 2) * 512 + 508 + (sr & 3)) : sr;
                     float* q_ = o + orow * 128; *(float4*)q_ = make_float4(v[0], v[1], v[2], v[3]); *(float4*)(q_ + 4) = make_float4(v[4], v[5], v[6], v[7]); })
        }
      } else if (tn < 14 || (tn >= 26 && tn < 30)) {
        u16* d = (u16*)(p.ws + (tn < 14 ? W_ZA : W_ZB)) + (tn < 14 ? tn - 10 : tn - 26) * 128 + c;
        EPI_ROWS({ _Pragma("unroll") for (int j = 0; j < 8; ++j) v[j] = siluf_(v[j]); *(uint4*)(d + row * 512) = pack8f(v); })
      } else if (tn < 18 || (tn >= 22 && tn < 26)) {
        u16* d = (u16*)(p.ws + (tn < 18 ? W_QB : W_VB)) + (tn < 18 ? tn - 14 : tn - 22) * 128 + c;
        EPI_ROWS({ *(uint4*)(d + row * 512) = pack8f(v); })
      } else if (tn < 22) {
        float lb[8], ol[8];
#pragma unroll
        for (int j = 0; j < 8; ++j) { const int cc = (tn - 18) * 128 + c + j; lb[j] = __builtin_amdgcn_rcpf(1.f + __expf(p.hg_lower[512 + cc] - p.hg_lower[cc])); ol[j] = 1.f - lb[j]; }
        float* dg = (float*)(p.ws + W_GB) + (tn - 18) * 128 + c; u16* dk = (u16*)(p.ws + W_KB) + (tn - 18) * 128 + c;
        EPI_ROWS({ float gg[8]; float kk[8];
                   _Pragma("unroll") for (int j = 0; j < 8; ++j) { const float sg = sigmoidf_(v[j]); gg[j] = __logf(lb[j] + ol[j] * sg); kk[j] = ol[j] * (1.f - sg); }
                   float* q_ = dg + row * 512; *(float4*)q_ = make_float4(gg[0], gg[1], gg[2], gg[3]); *(float4*)(q_ + 4) = make_float4(gg[4], gg[5], gg[6], gg[7]);
                   *(uint4*)(dk + row * 512) = pack8f(kk); })
      } else if (tn < 46) {
        u16* d = (u16*)(p.ws + (tn < 38 ? W_SA : W_SB)) + (tn < 38 ? tn - 30 : tn - 38) * 128 + c;
        EPI_ROWS({ _Pragma("unroll") for (int j = 0; j < 8; ++j) v[j] = sigmoidf_(v[j]); *(uint4*)(d + row * 1024) = pack8f(v); })
      } else if (tn == 46 && c < 24) {
        float* d = (float*)(p.ws + W_GATE) + c;
        EPI_ROWS({ float* q_ = d + row * 24; *(float4*)q_ = make_float4(sigmoidf_(v[0]), sigmoidf_(v[1]), sigmoidf_(v[2]), sigmoidf_(v[3]));
                   *(float4*)(q_ + 4) = make_float4(sigmoidf_(v[4]), sigmoidf_(v[5]), sigmoidf_(v[6]), sigmoidf_(v[7])); })
      }
    }
  }
#undef EPI_ROWS
};

struct EpiOut {
  static constexpr bool PERM = false, AFTER_DRAIN = false;
  const float* x; float* out;
  DI void operator()(const pg8::f32x4 (&acc)[2][2][4][2], const pg8::Unit& u, int wr, int wc, int fr, int fq) const {
#pragma unroll
    for (int ai = 0; ai < 2; ++ai)
#pragma unroll
      for (int mh = 0; mh < 2; ++mh) {
        float4 xv[2][2][2];
#pragma unroll
        for (int m2 = 0; m2 < 2; ++m2)
#pragma unroll
          for (int bj = 0; bj < 2; ++bj)
#pragma unroll
            for (int n = 0; n < 2; ++n) {
              const size_t off = (size_t)(u.pm * 256 + ai * 128 + wr * 64 + (2 * mh + m2) * 16 + fr) * 1024 + u.pn * 256 + wc * 32 + 4 * fq + bj * 128 + n * 16;
              xv[m2][bj][n] = *(const float4*)(x + off);
            }
#pragma unroll
        for (int m2 = 0; m2 < 2; ++m2)
#pragma unroll
          for (int bj = 0; bj < 2; ++bj)
#pragma unroll
            for (int n = 0; n < 2; ++n) {
              const int m = 2 * mh + m2;
              const size_t off = (size_t)(u.pm * 256 + ai * 128 + wr * 64 + m * 16 + fr) * 1024 + u.pn * 256 + wc * 32 + 4 * fq + bj * 128 + n * 16;
              const float4 xq = xv[m2][bj][n];
              *(float4*)(out + off) = make_float4(acc[ai][bj][m][n][0] + xq.x, acc[ai][bj][m][n][1] + xq.y, acc[ai][bj][m][n][2] + xq.z, acc[ai][bj][m][n][3] + xq.w);
            }
      }
  }
};

template <bool SECOND>
struct EpiMerge {
  static constexpr bool PERM = true, AFTER_DRAIN = false;
  const u16* gate; u16* Y;
  DI void operator()(const pg8::f32x4 (&acc)[2][2][4][2], const pg8::Unit& u, int wr, int wc, int fr, int fq) const {
#pragma unroll
    for (int ai = 0; ai < 2; ++ai) {
      uint4 gv[4][2], yv[4][2];
#pragma unroll
      for (int m = 0; m < 4; ++m)
#pragma unroll
        for (int bj = 0; bj < 2; ++bj) {
          const size_t off = (size_t)(u.pm * 256 + ai * 128 + wr * 64 + m * 16 + fr) * 1024 + u.pn * 256 + wc * 32 + 8 * fq + bj * 128;
          gv[m][bj] = *(const uint4*)(gate + off);
          if (SECOND) yv[m][bj] = *(const uint4*)(Y + off);
        }
#pragma unroll
      for (int m = 0; m < 4; ++m)
#pragma unroll
        for (int bj = 0; bj < 2; ++bj) {
          const size_t off = (size_t)(u.pm * 256 + ai * 128 + wr * 64 + m * 16 + fr) * 1024 + u.pn * 256 + wc * 32 + 8 * fq + bj * 128;
          const uint4 g4 = gv[m][bj];
          float v[8];
          v[0] = bflo(g4.x) * acc[ai][bj][m][0][0]; v[1] = bfhi(g4.x) * acc[ai][bj][m][0][1]; v[2] = bflo(g4.y) * acc[ai][bj][m][0][2]; v[3] = bfhi(g4.y) * acc[ai][bj][m][0][3];
          v[4] = bflo(g4.z) * acc[ai][bj][m][1][0]; v[5] = bfhi(g4.z) * acc[ai][bj][m][1][1]; v[6] = bflo(g4.w) * acc[ai][bj][m][1][2]; v[7] = bfhi(g4.w) * acc[ai][bj][m][1][3];
          if (SECOND) {
            const uint4 y4 = yv[m][bj];
            v[0] += bflo(y4.x); v[1] += bfhi(y4.x); v[2] += bflo(y4.y); v[3] += bfhi(y4.y); v[4] += bflo(y4.z); v[5] += bfhi(y4.z); v[6] += bflo(y4.w); v[7] += bfhi(y4.w);
          }
          *(uint4*)(Y + off) = pack8f(v);
        }
    }
  }
};

#define XB_TMO      128
#define XB_XCNT(j)  (256  + 64 * (j))
#define XB_XSUB(j)  (1280 + 64 * (j))
#define XB_XGEN(j)  (2304 + 64 * (j))
#define XB_TOP      3328
#define XB_TOPGEN   3392
#define XCD_BAR_WORDS 3456
#define XB_SPIN_CAP (1u << 18)
#define LAS __attribute__((address_space(3)))
DI unsigned xb_ld(unsigned* p)              { return __hip_atomic_load(p, __ATOMIC_RELAXED, __HIP_MEMORY_SCOPE_AGENT); }
DI unsigned xb_add(unsigned* p, unsigned v) { return __hip_atomic_fetch_add(p, v, __ATOMIC_RELAXED, __HIP_MEMORY_SCOPE_AGENT); }
DI unsigned xb_xcc_id() { return (unsigned)__builtin_amdgcn_s_getreg((3 << 11) | 20) & 0xFu; }
#define XB_SPIN(cond, bar) do { unsigned _sp = 0; while (cond) { __builtin_amdgcn_s_sleep(1); \
    if ((++_sp & 255u) == 0u) { if (xb_ld(&(bar)[XB_TMO])) break; if (_sp > XB_SPIN_CAP) { atomicAdd(&(bar)[XB_TMO], 1u); break; } } } } while (0)
struct XcdBarrier { unsigned* bar; unsigned x; volatile LAS unsigned* st; };
DI XcdBarrier xcd_barrier_post(unsigned* bar, volatile LAS unsigned* st) {
  XcdBarrier b; b.bar = bar; b.x = xb_xcc_id(); b.st = st;
  if (threadIdx.x == 0) (void)xb_add(&bar[XB_XCNT(b.x)], 1u);
  return b;
}
DI void xcd_barrier_complete(unsigned* bar, unsigned x, unsigned& nloc, unsigned& nx) {
  const unsigned G = gridDim.x * gridDim.y * gridDim.z;
  unsigned sum, cnt, mine, sp = 0u;
  for (;;) {
    sum = 0u; cnt = 0u; mine = 0u;
#pragma unroll
    for (unsigned j = 0; j < 16; ++j) { const unsigned c = xb_ld(&bar[XB_XCNT(j)]); sum += c; cnt += (c > 0u) ? 1u : 0u; mine = (j == x) ? c : mine; }
    if (sum == G) break;
    __builtin_amdgcn_s_sleep(1);
    if ((++sp & 255u) == 0u) { if (xb_ld(&bar[XB_TMO])) break; if (sp > XB_SPIN_CAP) { atomicAdd(&bar[XB_TMO], 1u); break; } }
  }
  nloc = mine > 0u ? mine : 1u; nx = cnt > 0u ? cnt : 1u;
}
DI void xcd_barrier(XcdBarrier& b) {
  asm volatile("s_waitcnt vmcnt(0)" ::: "memory");
  __syncthreads();
  if (threadIdx.x == 0) {
    unsigned* bar = b.bar;
    __builtin_amdgcn_s_waitcnt(0);
    unsigned nloc = b.st[0], nx = b.st[1];
    if (nloc == 0u) { xcd_barrier_complete(bar, b.x, nloc, nx); b.st[0] = nloc; b.st[1] = nx; }
    const unsigned old = xb_add(&bar[XB_XSUB(b.x)], 1u);
    const unsigned gen = old / nloc;
    if (old + 1u == (gen + 1u) * nloc) {
      __builtin_amdgcn_fence(__ATOMIC_RELEASE, "agent");
      asm volatile("s_waitcnt vmcnt(0)" ::: "memory");
      const unsigned og = xb_add(&bar[XB_TOP], 1u);
      const unsigned tg = og / nx;
      if (og + 1u == (tg + 1u) * nx) xb_add(&bar[XB_TOPGEN], 1u);
      else XB_SPIN(xb_ld(&bar[XB_TOPGEN]) == tg, bar);
      __builtin_amdgcn_fence(__ATOMIC_ACQUIRE, "agent");
      xb_add(&bar[XB_XGEN(b.x)], 1u);
      asm volatile("s_waitcnt vmcnt(0)" ::: "memory");
    } else {
      XB_SPIN(xb_ld(&bar[XB_XGEN(b.x)]) == gen, bar);
      __builtin_amdgcn_fence(__ATOMIC_ACQUIRE, "agent");
      asm volatile("s_waitcnt vmcnt(0)" ::: "memory");
    }
  }
  __syncthreads();
}


template <int PH>
DI void run_phase(const Params& p, char* lds_all) {
  const int half = __builtin_amdgcn_readfirstlane(threadIdx.x >> 8);
  const int vb = blockIdx.x * 2 + half, nvb = gridDim.x * 2;
  char* lds = lds_all + half * 65536;
  if (PH == 0) { for (int it = vb; it < P0_TOTAL; it += nvb) phase0_item(p, it, lds); }
  if (PH == 1) {
    for (int it = vb; it < P1_CMP; it += nvb) phase1_item(p, it, lds);
    __syncthreads();
    pg8::StaticOrder S; S.init(NT, NPAD, gridDim.x, blockIdx.x);
    const pg8::Gemm gm{(const pg8::bf16_t*)(p.ws + W_XN), (const pg8::bf16_t*)(p.ws + W_WINT), NT, NPAD, 1024};
    const EpiProj E{p};
    pg8::gemm_phase<EpiProj, pg8::StaticOrder, false>((PG8_LAS unsigned char*)lds_all, gm, S, E, nullptr);
  }
  if (PH == 2) {
    volatile LAS unsigned* wq = (volatile LAS unsigned*)(lds_all + 128 * 1024 + 8);
    unsigned* ctr = (unsigned*)(p.ws + W_BAR);
    for (;;) {
      __syncthreads();
      if (threadIdx.x == 0) wq[0] = __hip_atomic_fetch_add(ctr, 1u, __ATOMIC_RELAXED, __HIP_MEMORY_SCOPE_AGENT);
      __syncthreads();
      const unsigned pr = wq[0];
      if (pr >= (unsigned)(P2_TOTAL / 2)) break;
      phase2_item(p, (int)pr * 2 + half, lds);
    }
  }
  if (PH == 7) { for (int it = vb; it < H2_ITEMS; it += nvb) hgrn_h2_item(p, it); }
  if (PH == 3) {
    for (int it = vb; it < P3_FIN; it += nvb) hgrn_h3_item(p, it);
    for (int it = blockIdx.x; it < P3_ATT; it += gridDim.x) prompt_attn_item(p, it, lds_all);
  }
  if (PH == 4) {
    for (int it = vb; it < 64; it += nvb) merge_a_tile_t<1>(p, 128 + (it >> 4), it & 15, lds);
    __syncthreads();
    pg8::StaticOrder S; S.init(NTP, 1024, gridDim.x, blockIdx.x);
    { const pg8::Gemm gm{(const pg8::bf16_t*)(p.ws + W_OA), (const pg8::bf16_t*)(p.ws + W_WBAT), NTP, 1024, 512};
      const EpiMerge<false> E{(const u16*)(p.ws + W_SA), (u16*)(p.ws + W_Y)};
      pg8::gemm_phase<EpiMerge<false>, pg8::StaticOrder, false>((PG8_LAS unsigned char*)lds_all, gm, S, E, nullptr); }
    { const pg8::Gemm gm{(const pg8::bf16_t*)(p.ws + W_OB), (const pg8::bf16_t*)(p.ws + W_WBBT), NTP, 1024, 512};
      const EpiMerge<true> E{(const u16*)(p.ws + W_SB), (u16*)(p.ws + W_Y)};
      pg8::gemm_phase<EpiMerge<true>, pg8::StaticOrder, false>((PG8_LAS unsigned char*)lds_all, gm, S, E, nullptr); }
  }
  if (PH == 5) {
    for (int it = vb; it < 64; it += nvb) merge_b_tile_t<1>(p, 128 + (it >> 4), it & 15, lds);
    __syncthreads();
    pg8::StaticOrder S; S.init(NTP, 1024, gridDim.x, blockIdx.x);
    const pg8::Gemm gm{(const pg8::bf16_t*)(p.ws + W_Y), (const pg8::bf16_t*)(p.ws + W_WOUTT), NTP, 1024, 1024};
    const EpiOut E{p.x_prompt, p.out};
    pg8::gemm_phase<EpiOut, pg8::StaticOrder, false>((PG8_LAS unsigned char*)lds_all, gm, S, E, nullptr);
  }
  if (PH == 6) { for (int it = vb; it < P6_TOTAL; it += nvb) final_norm_item(p, it); }
}

constexpr int LDS_DYN = 128 * 1024 + 16;
__global__ void __launch_bounds__(512, 2) k_mega(Params p) {
  extern __shared__ __attribute__((aligned(16))) char lds[];
  volatile LAS unsigned* st = (volatile LAS unsigned*)(lds + 128 * 1024);
  if (threadIdx.x == 0) { st[0] = 0u; st[1] = 0u; }
  __syncthreads();
  XcdBarrier bar = xcd_barrier_post((unsigned*)(p.ws + W_BAR), st);
  run_phase<0>(p, lds); xcd_barrier(bar);
  run_phase<1>(p, lds); xcd_barrier(bar);
  run_phase<2>(p, lds); xcd_barrier(bar);
  run_phase<7>(p, lds); xcd_barrier(bar);
  run_phase<3>(p, lds); xcd_barrier(bar);
  run_phase<4>(p, lds); xcd_barrier(bar);
  run_phase<5>(p, lds); xcd_barrier(bar);
  run_phase<6>(p, lds);
}

extern "C" void kernel_launch(void* const* d_in, const int* in_sizes, int n_in, void* d_out, int out_size,
                              void* d_ws, size_t ws_size, hipStream_t stream) {
  Params p{};
  p.x_prompt = (const float*)d_in[0]; p.x_sample = (const float*)d_in[1];
  p.cck = (const float*)d_in[2]; p.ccv = (const float*)d_in[3]; p.csk = (const float*)d_in[4]; p.csv = (const float*)d_in[5];
  p.swk = (const float*)d_in[6]; p.swv = (const float*)d_in[7]; p.shg = (const float*)d_in[8]; p.pt = (const int*)d_in[9];
  p.norm_g = (const float*)d_in[10]; p.w_in = (const float*)d_in[11];
  p.pos_k = (const float*)d_in[12]; p.w1_k = (const float*)d_in[13]; p.w2_k = (const float*)d_in[14];
  p.pos_v = (const float*)d_in[15]; p.w1_v = (const float*)d_in[16]; p.w2_v = (const float*)d_in[17];
  p.rel_bias = (const float*)d_in[18]; p.hg_lower = (const float*)d_in[19]; p.hg_norm_g = (const float*)d_in[20];
  p.w_ba = (const float*)d_in[21]; p.w_bb = (const float*)d_in[22]; p.w_out = (const float*)d_in[23]; p.final_g = (const float*)d_in[24];
  p.out = (float*)d_out; p.ws = (char*)d_ws;
  if ((size_t)out_size != O_END || ws_size < W_END) { fprintf(stderr, "kernel_launch: unexpected sizes out=%d ws=%zu (need %zu / %zu)\n", out_size, ws_size, (size_t)O_END, (size_t)W_END); return; }
  static int grid_blocks = 0;
  if (!grid_blocks) {
    int dev = 0, cus = 0, per_cu = 0;
    hipGetDevice(&dev);
    hipDeviceGetAttribute(&cus, hipDeviceAttributeMultiprocessorCount, dev);
    hipFuncSetAttribute((const void*)k_mega, hipFuncAttributeMaxDynamicSharedMemorySize, LDS_DYN);
    hipOccupancyMaxActiveBlocksPerMultiprocessor(&per_cu, k_mega, 512, LDS_DYN);
    if (per_cu < 1) fprintf(stderr, "kernel_launch: occupancy query reports %d blocks per CU\n", per_cu);
    grid_blocks = cus;
  }
  hipMemsetAsync((char*)d_ws + W_BAR, 0, XCD_BAR_WORDS * 4, stream);
  void* args[] = {&p};
  hipError_t e = hipLaunchCooperativeKernel((void*)k_mega, dim3(grid_blocks), dim3(512), args, LDS_DYN, stream);
  if (e != hipSuccess) fprintf(stderr, "cooperative launch failed: %s (grid %d)\n", hipGetErrorString(e), grid_blocks);
}
```

```cpp
#include <hip/hip_runtime.h>
#include <hip/hip_cooperative_groups.h>
#include <cstdio>
namespace cg = cooperative_groups;

#define DI __device__ __forceinline__
typedef unsigned short u16;
typedef __attribute__((ext_vector_type(8))) short bf16x8;
typedef __attribute__((ext_vector_type(4))) short s16x4;
typedef __attribute__((ext_vector_type(16))) float f32x16;
typedef __attribute__((ext_vector_type(4))) float f32x4;
typedef __attribute__((ext_vector_type(2))) float f32x2;
typedef __attribute__((ext_vector_type(2))) __bf16 bf16x2v;
#define MFMA32(a, b, c) __builtin_amdgcn_mfma_f32_32x32x16_bf16((a), (b), (c), 0, 0, 0)
#define MFMA16(a, b, c) __builtin_amdgcn_mfma_f32_16x16x32_bf16((a), (b), (c), 0, 0, 0)

constexpr int D_MODEL = 1024, BATCH = 8, SEQ = 2048, DEC_BATCH = 128, DEC_SEQ = 4, PAST = 2048;
constexpr int NTP = BATCH * SEQ;
constexpr int NTS = DEC_BATCH * DEC_SEQ;
constexpr int NT = NTP + NTS;
constexpr int IN_COLS = 5912, NPAD = 6144;
constexpr int NSEQ = BATCH + DEC_BATCH;

constexpr size_t O_YP = 0;
constexpr size_t O_YS = O_YP + (size_t)NTP * 1024;
constexpr size_t O_PCK = O_YS + (size_t)NTS * 1024;
constexpr size_t O_PWK = O_PCK + 4 * (size_t)NTP * 128;
constexpr size_t O_PHG = O_PWK + 2 * (size_t)BATCH * 512 * 128;
constexpr size_t O_SCK = O_PHG + (size_t)BATCH * 4 * 128 * 128;
constexpr size_t O_SWK = O_SCK + 4 * (size_t)NTS * 128;
constexpr size_t O_SHG = O_SWK + 2 * (size_t)DEC_BATCH * 512 * 128;
constexpr size_t O_END = O_SHG + (size_t)DEC_BATCH * 4 * 128 * 128;

constexpr size_t al256(size_t x) { return (x + 255) & ~(size_t)255; }
constexpr size_t W_WINT = 0;
constexpr size_t W_WBAT = al256(W_WINT + (size_t)NPAD * 1024 * 2);
constexpr size_t W_WBBT = al256(W_WBAT + (size_t)1024 * 512 * 2);
constexpr size_t W_WOUTT = al256(W_WBBT + (size_t)1024 * 512 * 2);
constexpr size_t W_W1T = al256(W_WOUTT + (size_t)1024 * 1024 * 2);
constexpr size_t W_C1 = al256(W_W1T + (size_t)2 * 128 * 1024 * 2);
constexpr size_t W_XN = al256(W_C1 + 2 * 64 * 4);
constexpr size_t W_Q = al256(W_XN + (size_t)NT * 1024 * 2);
constexpr size_t W_KV = al256(W_Q + (size_t)NT * 512 * 2);
constexpr size_t W_VST = al256(W_KV + (size_t)6 * NT * 128 * 2);
constexpr size_t W_VWT = al256(W_VST + (size_t)8 * 2 * 64 * 2048 * 2);
constexpr size_t W_GATE = al256(W_VWT + (size_t)8 * 2 * 64 * 2048 * 2);
constexpr size_t W_ZA = al256(W_GATE + (size_t)NT * 24 * 4);
constexpr size_t W_QB = al256(W_ZA + (size_t)NT * 512 * 2);
constexpr size_t W_KB = al256(W_QB + (size_t)NT * 512 * 2);
constexpr size_t W_GB = al256(W_KB + (size_t)NT * 512 * 2);
constexpr size_t W_VB = al256(W_GB + (size_t)NT * 512 * 4);
constexpr size_t W_ZB = al256(W_VB + (size_t)NT * 512 * 2);
constexpr size_t W_SA = al256(W_ZB + (size_t)NT * 512 * 2);
constexpr size_t W_SB = al256(W_SA + (size_t)NT * 1024 * 2);
constexpr size_t W_KCMP = al256(W_SB + (size_t)NT * 1024 * 2);
constexpr size_t W_VCMP = al256(W_KCMP + (size_t)NSEQ * 2 * 128 * 64 * 2);
constexpr size_t W_VCMPT = al256(W_VCMP + (size_t)NSEQ * 2 * 128 * 64 * 2);
constexpr size_t W_OA = al256(W_VCMPT + (size_t)8 * 2 * 64 * 128 * 2);
constexpr size_t W_OB = al256(W_OA + (size_t)NT * 512 * 2);
constexpr size_t W_Y = al256(W_OB + (size_t)NT * 512 * 2);
constexpr size_t W_SS = al256(W_Y + (size_t)NT * 1024 * 2);
constexpr size_t W_ORAW = al256(W_SS + (size_t)NT * 32 * 4);
constexpr size_t W_OSS = al256(W_ORAW + (size_t)NTP * 512 * 4);
constexpr size_t W_QG = al256(W_OSS + (size_t)NTP * 8 * 4);
constexpr size_t W_DST = al256(W_QG + (size_t)NTP * 512 * 2);
constexpr size_t W_DEC = al256(W_DST + (size_t)1024 * 128 * 128 * 4);
constexpr size_t W_SPT = al256(W_DEC + (size_t)1024 * 128 * 4);
constexpr size_t W_VCF = al256(W_SPT + (size_t)1024 * 128 * 128 * 2);
constexpr size_t W_BAR = al256(W_VCF + (size_t)DEC_BATCH * 2 * 128 * 64 * 4);
constexpr size_t W_END = al256(W_BAR + 3456 * 4);

struct Params {
  const float* x_prompt; const float* x_sample;
  const float* cck; const float* ccv; const float* csk; const float* csv;
  const float* swk; const float* swv; const float* shg; const int* pt;
  const float* norm_g; const float* w_in;
  const float* pos_k; const float* w1_k; const float* w2_k;
  const float* pos_v; const float* w1_v; const float* w2_v;
  const float* rel_bias; const float* hg_lower; const float* hg_norm_g;
  const float* w_ba; const float* w_bb; const float* w_out; const float* final_g;
  float* out; char* ws;
};

DI unsigned pk2(float a, float b) { f32x2 v = {a, b}; bf16x2v r = __builtin_convertvector(v, bf16x2v); return __builtin_bit_cast(unsigned, r); }
DI u16 f2bf(float a) { return (u16)(pk2(a, 0.f) & 0xffffu); }
DI float bf2f(u16 v) { return __uint_as_float(((unsigned)v) << 16); }
DI float bflo(unsigned v) { return __uint_as_float(v << 16); }
DI float bfhi(unsigned v) { return __uint_as_float(v & 0xffff0000u); }
constexpr float LOG2E = 1.4426950408889634f;
DI float sigmoidf_(float x) { return __builtin_amdgcn_rcpf(1.f + __expf(-x)); }
DI float siluf_(float x) { return x * __builtin_amdgcn_rcpf(1.f + __expf(-x)); }
DI int otid() { int t = threadIdx.x & 255; asm volatile("" : "+v"(t)); return t; }
DI int otid512() { int t = threadIdx.x; asm volatile("" : "+v"(t)); return t; }
DI int crow(int reg, int h) { return (reg & 3) + 8 * (reg >> 2) + 4 * h; }
DI float wave_sum(float v) {
#pragma unroll
  for (int o = 32; o >= 1; o >>= 1) v += __shfl_xor(v, o);
  return v;
}
DI float wave_max(float v) {
#pragma unroll
  for (int o = 32; o >= 1; o >>= 1) v = fmaxf(v, __shfl_xor(v, o));
  return v;
}

__device__ const unsigned char T5B[128] = {
  0,1,2,3,4,5,6,7,8,9,10,11,12,13,14,15,
  16,16,16,17,17,18,18,18,19,19,19,20,20,20,20,21,
  21,21,21,22,22,22,22,22,23,23,23,23,23,23,24,24,
  24,24,24,24,25,25,25,25,25,25,25,26,26,26,26,26,
  26,26,26,27,27,27,27,27,27,27,27,27,27,28,28,28,
  28,28,28,28,28,28,28,29,29,29,29,29,29,29,29,29,
  29,29,29,30,30,30,30,30,30,30,30,30,30,30,30,30,
  30,31,31,31,31,31,31,31,31,31,31,31,31,31,31,31};

DI void transpose_tile(const float* __restrict__ src, int ldsrc, int K, int N, int k0, int n0,
                       u16* __restrict__ dst, int lddst, int dst_row_off, int dst_k0, int winperm, float* tl) {
  const int tid = otid();
  __syncthreads();
  {
    const int n = tid & 63, kb = tid >> 6;
#pragma unroll
    for (int i = 0; i < 16; ++i) {
      const int kk = kb + 4 * i;
      const int nc = (n0 + n < N) ? n0 + n : N - 1, kc = (k0 + kk < K) ? k0 + kk : K - 1;
      tl[kk * 65 + n] = src[(size_t)kc * ldsrc + nc];
    }
  }
  __syncthreads();
  {
    const int k = (tid & 31) * 2, nb = tid >> 5;
#pragma unroll
    for (int i = 0; i < 8; ++i) {
      const int nn = nb + 8 * i;
      int n = n0 + nn;
      if (n < N) {
        if (winperm) n = (n < 1280) ? n : ((n < 1304) ? (5888 + n - 1280) : (n - 24));
        const unsigned v = pk2(tl[k * 65 + nn], tl[(k + 1) * 65 + nn]);
        *(unsigned*)(dst + (size_t)(dst_row_off + n) * lddst + dst_k0 + k) = v;
      }
    }
  }
}

constexpr int P0_WIN = 16 * 93;
constexpr int P0_WBA = 8 * 16, P0_WBB = 8 * 16, P0_WOUT = 16 * 16, P0_W1 = 32 * 2;
constexpr int P0_TR = P0_WIN + P0_WBA + P0_WBB + P0_WOUT + P0_W1;
constexpr int P0_C1 = 2;
constexpr int P0_NORM = NT / 8;
constexpr int P0_WCP = 2 * DEC_BATCH * 8;
constexpr int P0_PAD = NPAD - IN_COLS;
constexpr int P0_TOTAL = P0_TR + P0_C1 + P0_NORM + P0_WCP + P0_PAD;

DI void phase0_item(const Params& p, int it, char* lds) {
  const int tid = otid(), lane = tid & 63, wave = tid >> 6;
  float* tl = (float*)lds;
  if (it < P0_TR) {
    if (it < P0_WIN) {
      const int kt = it / 93, nt = it % 93;
      transpose_tile(p.w_in, IN_COLS, 1024, IN_COLS, kt * 64, nt * 64, (u16*)(p.ws + W_WINT), 1024, 0, kt * 64, 1, tl);
      return;
    }
    it -= P0_WIN;
    if (it < P0_WBA) { const int kt = it / 16, nt = it % 16;
      transpose_tile(p.w_ba, 1024, 512, 1024, kt * 64, nt * 64, (u16*)(p.ws + W_WBAT), 512, 0, kt * 64, 0, tl); return; }
    it -= P0_WBA;
    if (it < P0_WBB) { const int kt = it / 16, nt = it % 16;
      transpose_tile(p.w_bb, 1024, 512, 1024, kt * 64, nt * 64, (u16*)(p.ws + W_WBBT), 512, 0, kt * 64, 0, tl); return; }
    it -= P0_WBB;
    if (it < P0_WOUT) { const int kt = it / 16, nt = it % 16;
      transpose_tile(p.w_out, 1024, 1024, 1024, kt * 64, nt * 64, (u16*)(p.ws + W_WOUTT), 1024, 0, kt * 64, 0, tl); return; }
    it -= P0_WOUT;
    { const int kv = it >> 5, kt = it & 31;
      const float* w1 = kv ? p.w1_v : p.w1_k;
      transpose_tile(w1, 64, 2048, 64, kt * 64, 0, (u16*)(p.ws + W_W1T) + (size_t)kv * 128 * 1024, 1024,
                     (kt >= 16) ? 64 : 0, (kt & 15) * 64, 0, tl); return; }
  }
  it -= P0_TR;
  if (it < P0_C1) {
    const float* pos = it ? p.pos_v : p.pos_k; const float* w1 = it ? p.w1_v : p.w1_k;
    const int j = tid & 63, part = tid >> 6;
    float s = 0.f;
    for (int i = part * 512; i < part * 512 + 512; ++i) s += pos[i] * w1[(size_t)i * 64 + j];
    __syncthreads();
    tl[part * 64 + j] = s;
    __syncthreads();
    if (tid < 64) ((float*)(p.ws + W_C1))[it * 64 + tid] = tl[tid] + tl[64 + tid] + tl[128 + tid] + tl[192 + tid];
    return;
  }
  it -= P0_C1;
  if (it < P0_NORM) {
#pragma unroll
    for (int rr = 0; rr < 2; ++rr) {
      const int row = it * 8 + wave * 2 + rr;
      const float* x = (row < NTP) ? (p.x_prompt + (size_t)row * 1024) : (p.x_sample + (size_t)(row - NTP) * 1024);
      float4 v[4]; float ss = 0.f;
#pragma unroll
      for (int i = 0; i < 4; ++i) { v[i] = *(const float4*)(x + (i * 64 + lane) * 4); ss += v[i].x * v[i].x + v[i].y * v[i].y + v[i].z * v[i].z + v[i].w * v[i].w; }
      ss = wave_sum(ss);
      const float rs = rsqrtf(ss * (1.f / 1024.f) + 1e-6f);
      u16* xn = (u16*)(p.ws + W_XN) + (size_t)row * 1024;
#pragma unroll
      for (int i = 0; i < 4; ++i) {
        const float4 g = *(const float4*)(p.norm_g + (i * 64 + lane) * 4);
        uint2 o; o.x = pk2(v[i].x * rs * g.x, v[i].y * rs * g.y); o.y = pk2(v[i].z * rs * g.z, v[i].w * rs * g.w);
        *(uint2*)(xn + (i * 64 + lane) * 4) = o;
      }
    }
    return;
  }
  it -= P0_NORM;
  if (it < P0_WCP) {
    const int sl = it & 7, b = (it >> 3) % DEC_BATCH, kv = it / (8 * DEC_BATCH);
    const float4* src = (const float4*)((kv ? p.swv : p.swk) + ((size_t)b * 512 + 4) * 128) + sl * 64 * 32;
    float4* dst = (float4*)(p.out + O_SWK + (size_t)kv * DEC_BATCH * 512 * 128 + (size_t)b * 512 * 128) + sl * 64 * 32;
    const int n = (sl == 7 ? 60 : 64) * 32;
    const float4* __restrict__ sp = src; float4* __restrict__ dp = dst;
#pragma unroll
    for (int i = 0; i < 8; ++i) { const int idx = (tid + 256 * i < n) ? tid + 256 * i : n - 1; dp[idx] = sp[idx]; }
    return;
  }
  it -= P0_WCP;
  { u16* d = (u16*)(p.ws + W_WINT) + (size_t)(IN_COLS + it) * 1024; *(uint2*)(d + tid * 4) = make_uint2(0u, 0u); }
}

constexpr int GST = 72;
struct LoadBf16 {
  const u16* base; int ld;
  DI uint4 load(int row, int ch, int kt) const { return *(const uint4*)(base + (size_t)row * ld + kt * 64 + ch * 8); }
};
struct LoadCellBf16 {
  const u16* base;
  DI uint4 load(int row, int ch, int kt) const { return *(const uint4*)(base + (size_t)(row * 16 + kt) * 128 + ch * 8); }
};
struct LoadCellPage {
  const float* cache; const int* pt; int g;
  DI uint4 load(int row, int ch, int kt) const {
    const int pos = row * 16 + kt; const int page = pt[pos >> 7];
    const float* s = cache + (((size_t)page * 128 + (pos & 127)) * 2 + g) * 64 + ch * 8;
    const float4 a = *(const float4*)s, b = *(const float4*)(s + 4);
    uint4 r; r.x = pk2(a.x, a.y); r.y = pk2(a.z, a.w); r.z = pk2(b.x, b.y); r.w = pk2(b.z, b.w); return r;
  }
};

template <int NI, class AL, class BL>
DI void gemm_main(f32x16 (&acc)[2][NI], const AL& al, const BL& bl, int nkt, char* lds) {
  u16* sA = (u16*)lds; u16* sB = sA + 128 * GST;
  const int tid = otid(), lane = tid & 63, wave = tid >> 6, wm = wave >> 1, wn = wave & 1;
  const int lrow = tid >> 3, lch = tid & 7, r = lane & 31, h = lane >> 5;
  uint4 ra0[4], rb0[2 * NI], ra1[4], rb1[2 * NI];
#pragma unroll
  for (int i = 0; i < 4; ++i) { ra0[i] = al.load(lrow + 32 * i, lch, 0); ra1[i] = al.load(lrow + 32 * i, lch, 1); }
#pragma unroll
  for (int i = 0; i < 2 * NI; ++i) { rb0[i] = bl.load(lrow + 32 * i, lch, 0); rb1[i] = bl.load(lrow + 32 * i, lch, 1); }
#define GM_STEP(RA, RB, kt_) do { \
    __syncthreads(); \
    _Pragma("unroll") for (int i = 0; i < 4; ++i) *(uint4*)(sA + (lrow + 32 * i) * GST + lch * 8) = RA[i]; \
    _Pragma("unroll") for (int i = 0; i < 2 * NI; ++i) *(uint4*)(sB + (lrow + 32 * i) * GST + lch * 8) = RB[i]; \
    __syncthreads(); \
    { const int kn_ = ((kt_) + 2 < nkt) ? (kt_) + 2 : (kt_);       \
      _Pragma("unroll") for (int i = 0; i < 4; ++i) RA[i] = al.load(lrow + 32 * i, lch, kn_); \
      _Pragma("unroll") for (int i = 0; i < 2 * NI; ++i) RB[i] = bl.load(lrow + 32 * i, lch, kn_); } \
    _Pragma("unroll") for (int s_ = 0; s_ < 4; ++s_) { \
      bf16x8 a[2], bb[NI]; \
      _Pragma("unroll") for (int mi = 0; mi < 2; ++mi) a[mi] = *(const bf16x8*)(sA + (wm * 64 + mi * 32 + r) * GST + s_ * 16 + 8 * h); \
      _Pragma("unroll") for (int ni = 0; ni < NI; ++ni) bb[ni] = *(const bf16x8*)(sB + (wn * 32 * NI + ni * 32 + r) * GST + s_ * 16 + 8 * h); \
      _Pragma("unroll") for (int mi = 0; mi < 2; ++mi) \
        _Pragma("unroll") for (int ni = 0; ni < NI; ++ni) acc[mi][ni] = MFMA32(a[mi], bb[ni], acc[mi][ni]); \
    } \
  } while (0)
#pragma unroll 1
  for (int kt = 0; kt < nkt; kt += 2) {
    GM_STEP(ra0, rb0, kt);
    GM_STEP(ra1, rb1, kt + 1);
  }
#undef GM_STEP
}
typedef __attribute__((address_space(1))) const unsigned gptr_t;
typedef __attribute__((address_space(3))) unsigned lptr_t;
template <int NI>
DI void gemm_glds(f32x16 (&acc)[2][NI], const u16* A, int lda, const u16* B, int ldb, int nkt, char* lds) {
  const int tid = otid(), lane = tid & 63, wave = tid >> 6, wm = wave >> 1, wn = wave & 1;
  const int r = lane & 31, h = lane >> 5;
  const int lr = (wave << 3) + (lane >> 3);
  const int lc = (lane & 7) ^ ((lane >> 3) & 7) ^ (wave & 1);
  const u16* ga = A + (size_t)lr * lda + lc * 8;
  const u16* gb = B + (size_t)lr * ldb + lc * 8;
  const int sw = (lane & 7) ^ ((lane >> 3) & 1);
  constexpr int STAGE = 16384 + 8192 * NI;
#define GLDS_ISSUE(buf, kt_) do { \
    char* sa_ = lds + (buf) * STAGE + tid * 16; \
    _Pragma("unroll") for (int i_ = 0; i_ < 4; ++i_) \
      __builtin_amdgcn_global_load_lds((gptr_t*)(ga + (size_t)(32 * i_) * lda + (kt_) * 64), (lptr_t*)(sa_ + i_ * 4096), 16, 0, 0); \
    _Pragma("unroll") for (int i_ = 0; i_ < 2 * NI; ++i_) \
      __builtin_amdgcn_global_load_lds((gptr_t*)(gb + (size_t)(32 * i_) * ldb + (kt_) * 64), (lptr_t*)(sa_ + 16384 + i_ * 4096), 16, 0, 0); \
  } while (0)
  __syncthreads();
  GLDS_ISSUE(0, 0);
#pragma unroll 1
  for (int kt = 0; kt < nkt; ++kt) {
    asm volatile("s_waitcnt vmcnt(0)" ::: "memory");
    __syncthreads();
    if (kt + 1 < nkt) GLDS_ISSUE((kt + 1) & 1, kt + 1);
    const char* sA = lds + (kt & 1) * STAGE; const char* sB = sA + 16384;
#pragma unroll
    for (int s = 0; s < 4; ++s) {
      const int co = ((2 * s + h) ^ sw) << 4;
      bf16x8 a[2], bb[NI];
#pragma unroll
      for (int mi = 0; mi < 2; ++mi) a[mi] = *(const bf16x8*)(sA + (wm * 64 + mi * 32 + r) * 128 + co);
#pragma unroll
      for (int ni = 0; ni < NI; ++ni) bb[ni] = *(const bf16x8*)(sB + (wn * 32 * NI + ni * 32 + r) * 128 + co);
#pragma unroll
      for (int mi = 0; mi < 2; ++mi)
#pragma unroll
        for (int ni = 0; ni < NI; ++ni) acc[mi][ni] = MFMA32(a[mi], bb[ni], acc[mi][ni]);
    }
  }
#undef GLDS_ISSUE
  __syncthreads();
}
template <int NI>
DI void zero_acc(f32x16 (&acc)[2][NI]) {
#pragma unroll
  for (int a = 0; a < 2; ++a)
#pragma unroll
    for (int b = 0; b < NI; ++b)
#pragma unroll
      for (int i = 0; i < 16; ++i) acc[a][b][i] = 0.f;
}

constexpr int G1_MT = NT / 128, G1_NT = NPAD / 128;
constexpr int P1_GEMM = G1_MT * G1_NT;
constexpr int P1_CMP = DEC_BATCH * 2 * 2;
constexpr int P1_TOTAL = P1_CMP + P1_GEMM;

DI void proj_tile(const Params& p, int tm, int tn, char* lds, bool store_ok) {
  f32x16 acc[2][2]; zero_acc<2>(acc);
  gemm_glds<2>(acc, (const u16*)(p.ws + W_XN) + (size_t)tm * 128 * 1024, 1024, (const u16*)(p.ws + W_WINT) + (size_t)tn * 128 * 1024, 1024, 16, lds);
  const int tid = otid(), lane = tid & 63, wave = tid >> 6, wm = wave >> 1, wn = wave & 1, r = lane & 31, h = lane >> 5;
  const bool samp = tm >= 128;
  if (!store_ok) return;
#pragma unroll
  for (int mi = 0; mi < 2; ++mi)
#pragma unroll
    for (int ni = 0; ni < 2; ++ni) {
      const int c = wn * 64 + ni * 32 + r;
      const int row0 = tm * 128 + wm * 64 + mi * 32;
      if (tn < 4) {
        u16* d = (u16*)(p.ws + W_Q) + tn * 128 + c;
#pragma unroll
        for (int i = 0; i < 16; ++i) d[(size_t)(row0 + crow(i, h)) * 512] = f2bf(acc[mi][ni][i] * (0.125f * LOG2E));
      } else if (tn < 10) {
        const int kvg = tn - 4;
        u16* d = (u16*)(p.ws + W_KV) + (size_t)kvg * NT * 128 + c;
#pragma unroll
        for (int i = 0; i < 16; ++i) {
          const int row = row0 + crow(i, h); const float v = acc[mi][ni][i];
          d[(size_t)row * 128] = f2bf(v);
          if (!samp) {
            if (kvg < 4) p.out[O_PCK + (size_t)kvg * NTP * 128 + (size_t)row * 128 + c] = v;
            else { const int t = row & 2047, b = row >> 11;
              if (t >= 1536) p.out[O_PWK + (size_t)(kvg - 4) * BATCH * 512 * 128 + ((size_t)b * 512 + t - 1536) * 128 + c] = v; }
          } else {
            const int srow = row - NTP;
            if (kvg < 4) p.out[O_SCK + (size_t)kvg * NTS * 128 + (size_t)srow * 128 + c] = v;
            else p.out[O_SWK + (size_t)(kvg - 4) * DEC_BATCH * 512 * 128 + ((size_t)(srow >> 2) * 512 + 508 + (srow & 3)) * 128 + c] = v;
          }
        }
        if (!samp && (kvg == 3 || kvg == 5)) {
          u16* vt = (u16*)(p.ws + (kvg == 3 ? W_VST : W_VWT));
          const int b = row0 >> 11, t0 = row0 & 2047, g = c >> 6, dd = c & 63;
          u16* drow = vt + ((size_t)(b * 2 + g) * 64 + dd) * 2048 + t0;
#pragma unroll
          for (int q = 0; q < 4; ++q) {
            uint2 o; o.x = pk2(acc[mi][ni][4 * q], acc[mi][ni][4 * q + 1]); o.y = pk2(acc[mi][ni][4 * q + 2], acc[mi][ni][4 * q + 3]);
            *(uint2*)(drow + 8 * q + 4 * h) = o;
          }
        }
      } else if (tn < 14 || (tn >= 26 && tn < 30)) {
        const bool isA = tn < 14; const int cc = (isA ? tn - 10 : tn - 26) * 128 + c;
        u16* d = (u16*)(p.ws + (isA ? W_ZA : W_ZB)) + cc;
#pragma unroll
        for (int i = 0; i < 16; ++i) d[(size_t)(row0 + crow(i, h)) * 512] = f2bf(siluf_(acc[mi][ni][i]));
      } else if (tn < 18 || (tn >= 22 && tn < 26)) {
        const bool isQ = tn < 18; const int cc = (isQ ? tn - 14 : tn - 22) * 128 + c;
        u16* d = (u16*)(p.ws + (isQ ? W_QB : W_VB)) + cc;
#pragma unroll
        for (int i = 0; i < 16; ++i) d[(size_t)(row0 + crow(i, h)) * 512] = f2bf(acc[mi][ni][i]);
      } else if (tn < 22) {
        const int cc = (tn - 18) * 128 + c;
        const float a0 = p.hg_lower[cc], a1 = p.hg_lower[512 + cc];
        const float lb = 1.f / (1.f + __expf(a1 - a0));
        u16* dk = (u16*)(p.ws + W_KB) + cc; float* dg = (float*)(p.ws + W_GB) + cc;
#pragma unroll
        for (int i = 0; i < 16; ++i) {
          const size_t row = row0 + crow(i, h);
          const float sg = sigmoidf_(acc[mi][ni][i]);
          const float f = lb + (1.f - lb) * sg;
          dg[row * 512] = __logf(f);
          dk[row * 512] = f2bf((1.f - lb) * (1.f - sg));
        }
      } else if (tn < 46) {
        const bool isA = tn < 38; const int cc = (isA ? tn - 30 : tn - 38) * 128 + c;
        u16* d = (u16*)(p.ws + (isA ? W_SA : W_SB)) + cc;
#pragma unroll
        for (int i = 0; i < 16; ++i) d[(size_t)(row0 + crow(i, h)) * 1024] = f2bf(sigmoidf_(acc[mi][ni][i]));
      } else {
        if (c < 24) {
          float* d = (float*)(p.ws + W_GATE) + c;
#pragma unroll
          for (int i = 0; i < 16; ++i) d[(size_t)(row0 + crow(i, h)) * 24] = sigmoidf_(acc[mi][ni][i]);
        }
      }
    }
}

template <class AL>
DI void comp_tile(const Params& p, const AL& al, int seq, int g, int kv, char* lds) {
  f32x16 acc[2][2]; zero_acc<2>(acc);
  LoadBf16 bl{(const u16*)(p.ws + W_W1T) + (size_t)kv * 128 * 1024, 1024};
  gemm_main<2>(acc, al, bl, 16, lds);
  const int tid = otid(), lane = tid & 63, wave = tid >> 6, wm = wave >> 1, wn = wave & 1, r = lane & 31, h = lane >> 5;
  float* T = (float*)lds;
  float* w2s = T + 128 * 65;
  const float* c1 = (const float*)(p.ws + W_C1) + kv * 64;
  const float* w2 = kv ? p.w2_v : p.w2_k;
  __syncthreads();
  for (int i = tid; i < 4096; i += 256) w2s[i] = w2[i];
  if (wn == 1) {
#pragma unroll
    for (int mi = 0; mi < 2; ++mi)
#pragma unroll
      for (int ni = 0; ni < 2; ++ni)
#pragma unroll
        for (int i = 0; i < 16; ++i) T[(wm * 64 + mi * 32 + crow(i, h)) * 65 + ni * 32 + r] = acc[mi][ni][i];
  }
  __syncthreads();
  if (wn == 0) {
    const float c1v[2] = {c1[r], c1[32 + r]};
#pragma unroll
    for (int mi = 0; mi < 2; ++mi)
#pragma unroll
      for (int ni = 0; ni < 2; ++ni)
#pragma unroll
        for (int i = 0; i < 16; ++i) {
          const int n = wm * 64 + mi * 32 + crow(i, h), j = ni * 32 + r;
          const float hv = siluf_(acc[mi][ni][i] + T[((n < 127) ? n + 1 : 127) * 65 + j] + c1v[ni]);
          acc[mi][ni][i] = (n < 127) ? hv : 0.f;
        }
  }
  __syncthreads();
  if (wn == 0) {
#pragma unroll
    for (int mi = 0; mi < 2; ++mi)
#pragma unroll
      for (int ni = 0; ni < 2; ++ni)
#pragma unroll
        for (int i = 0; i < 16; ++i) T[(wm * 64 + mi * 32 + crow(i, h)) * 65 + ni * 32 + r] = acc[mi][ni][i];
  }
  __syncthreads();
  {
    const int n = tid >> 1, eh = tid & 1;
    float o[32];
#pragma unroll
    for (int e = 0; e < 32; ++e) o[e] = 0.f;
#pragma unroll 2
    for (int j = 0; j < 64; ++j) {
      const float hv = T[n * 65 + j];
#pragma unroll
      for (int e = 0; e < 32; ++e) o[e] += hv * w2s[j * 64 + eh * 32 + e];
    }
    u16* dst = (u16*)(p.ws + (kv ? W_VCMP : W_KCMP)) + ((size_t)(seq * 2 + g) * 128 + n) * 64 + eh * 32;
#pragma unroll
    for (int e = 0; e < 32; e += 2) *(unsigned*)(dst + e) = pk2(o[e], o[e + 1]);
    if (kv == 1 && seq >= BATCH) {
      float* df = (float*)(p.ws + W_VCF) + ((size_t)((seq - BATCH) * 2 + g) * 128 + n) * 64 + eh * 32;
#pragma unroll
      for (int e = 0; e < 32; e += 4) *(float4*)(df + e) = make_float4(o[e], o[e + 1], o[e + 2], o[e + 3]);
    }
  }
  __syncthreads();
}

DI void phase1_item(const Params& p, int it, char* lds) {
  if (it < P1_CMP) {
    const int kv = it & 1, g = (it >> 1) & 1, b = it >> 2;
    LoadCellPage al{kv ? p.ccv : p.cck, p.pt + b * 16, g};
    comp_tile(p, al, BATCH + b, g, kv, lds);
    return;
  }
  it -= P1_CMP;
  const int tm = it / G1_NT, tn = it % G1_NT;
  proj_tile(p, tm, tn, lds, true);
}


DI void hgrn_sample_item(const Params& p, int it, char* lds) {
  const int b = it >> 2, h = it & 3, tid = otid(), lane = tid & 63, wave = tid >> 6;
  float* sf = (float*)lds; float* sk = sf + 512; float* sq = sk + 512; float* sv = sq + 512; float* so = sv + 512;
  __syncthreads();
  for (int i = tid; i < 512; i += 256) {
    const int t = i >> 7, c = i & 127; const size_t off = (size_t)(NTP + b * 4 + t) * 512 + h * 128 + c;
    sf[i] = __expf(((const float*)(p.ws + W_GB))[off]);
    sk[i] = bf2f(((const u16*)(p.ws + W_KB))[off]);
    sq[i] = bf2f(((const u16*)(p.ws + W_QB))[off]);
    sv[i] = bf2f(((const u16*)(p.ws + W_VB))[off]);
  }
  __syncthreads();
  const int e = tid & 127, dh = tid >> 7;
  const float* S0 = p.shg + (size_t)(b * 4 + h) * 128 * 128;
  float* S1 = p.out + O_SHG + (size_t)(b * 4 + h) * 128 * 128;
  const float v0 = sv[e], v1 = sv[128 + e], v2 = sv[256 + e], v3 = sv[384 + e];
  float o0 = 0.f, o1 = 0.f, o2 = 0.f, o3 = 0.f;
#pragma unroll 1
  for (int d0 = dh * 64; d0 < dh * 64 + 64; d0 += 16) {
    float sv[16];
#pragma unroll
    for (int i = 0; i < 16; ++i) sv[i] = S0[(size_t)(d0 + i) * 128 + e];
#pragma unroll
    for (int i = 0; i < 16; ++i) {
      const int d = d0 + i; float st = sv[i];
      st = sf[d] * st + sk[d] * v0;             o0 += sq[d] * st;
      st = sf[128 + d] * st + sk[128 + d] * v1; o1 += sq[128 + d] * st;
      st = sf[256 + d] * st + sk[256 + d] * v2; o2 += sq[256 + d] * st;
      st = sf[384 + d] * st + sk[384 + d] * v3; o3 += sq[384 + d] * st;
      sv[i] = st;
    }
#pragma unroll
    for (int i = 0; i < 16; ++i) S1[(size_t)(d0 + i) * 128 + e] = sv[i];
  }
  so[(dh * 4 + 0) * 128 + e] = o0; so[(dh * 4 + 1) * 128 + e] = o1; so[(dh * 4 + 2) * 128 + e] = o2; so[(dh * 4 + 3) * 128 + e] = o3;
  __syncthreads();
  {
    const int t = wave; const size_t row = (size_t)(NTP + b * 4 + t);
    const float a0 = so[t * 128 + lane] + so[(4 + t) * 128 + lane];
    const float a1 = so[t * 128 + 64 + lane] + so[(4 + t) * 128 + 64 + lane];
    const float ss = wave_sum(a0 * a0 + a1 * a1);
    const float rs = rsqrtf(ss * (1.f / 128.f) + 1e-6f);
    const u16* zb = (const u16*)(p.ws + W_ZB) + row * 512 + h * 128; u16* ob = (u16*)(p.ws + W_OB) + row * 512 + h * 128;
    ob[lane] = f2bf(a0 * rs * p.hg_norm_g[h * 128 + lane] * bf2f(zb[lane]));
    ob[64 + lane] = f2bf(a1 * rs * p.hg_norm_g[h * 128 + 64 + lane] * bf2f(zb[64 + lane]));
  }
}

typedef __attribute__((address_space(3))) s16x4 lds_s16x4;
DI s16x4 tr_read(const u16* ptr) { return __builtin_amdgcn_ds_read_tr16_b64_v4i16((lds_s16x4*)ptr); }
DI bf16x8 cat8(s16x4 lo, s16x4 hi) { return __builtin_shufflevector(lo, hi, 0, 1, 2, 3, 4, 5, 6, 7); }
constexpr int HST = 136;

DI void hgrn_h1_item(const Params& p, int it, char* lds) {
  const int c = it & 31, h = (it >> 5) & 3, b = it >> 7;
  const int tid = otid(), lane = tid & 63, w = __builtin_amdgcn_readfirstlane(tid >> 6), half = tid >> 7;
  const int c16 = lane & 15, hq = lane >> 4, tq = c16 >> 2, tp = c16 & 3;
  const int d = tid & 127, col = h * 128 + d;
  u16* Qe = (u16*)lds; u16* Ke = Qe + 64 * HST; u16* Vv = Ke + 64 * HST; u16* Am = Vv + 64 * HST;
  float* Rr = (float*)(Am + 64 * 72); float* G63 = Rr + 128;
  const u16* qB = (const u16*)(p.ws + W_QB); const u16* kB = (const u16*)(p.ws + W_KB); const u16* vB = (const u16*)(p.ws + W_VB);
  const float* gB = (const float*)(p.ws + W_GB);
  const size_t tok0 = (size_t)b * 2048 + c * 64;
  __syncthreads();
  float G[32];
  {
    float run = 0.f;
#pragma unroll
    for (int i = 0; i < 32; ++i) { run += gB[(tok0 + half * 32 + i) * 512 + col]; G[i] = run; }
    if (half == 0) Rr[d] = run;
  }
#pragma unroll
  for (int i = 0; i < 4; ++i) {
    const int idx = tid + 256 * i, s_ = idx >> 4, cc = idx & 15;
    *(uint4*)(Vv + s_ * HST + cc * 8) = *(const uint4*)(vB + (tok0 + s_) * 512 + h * 128 + cc * 8);
  }
  __syncthreads();
  {
    const float R = Rr[d];
    const float base = half ? R : 0.f;
    u16* qg = (u16*)(p.ws + W_QG);
    u16 qv[32], kv[32];
#pragma unroll
    for (int i = 0; i < 32; ++i) { qv[i] = qB[(tok0 + half * 32 + i) * 512 + col]; kv[i] = kB[(tok0 + half * 32 + i) * 512 + col]; }
#pragma unroll
    for (int i = 0; i < 32; ++i) {
      const int t = half * 32 + i;
      const float gt = base + G[i];
      const float q = bf2f(qv[i]), k = bf2f(kv[i]);
      const float dq = fminf(fmaxf(gt - R, -80.f), 80.f);
      const float eq = __expf(dq);
      Qe[t * HST + d] = f2bf(q * eq);
      Ke[t * HST + d] = f2bf(k * __builtin_amdgcn_rcpf(eq));
      qg[(tok0 + t) * 512 + col] = f2bf(q * __expf(gt));
    }
    if (half == 1) G63[d] = base + G[31];
  }
  __syncthreads();
  for (int j = 0; j <= w; ++j) {
    f32x4 x = f32x4{0.f, 0.f, 0.f, 0.f};
#pragma unroll
    for (int ks = 0; ks < 4; ++ks) {
      const bf16x8 a = *(const bf16x8*)(Qe + (16 * w + c16) * HST + ks * 32 + 8 * hq);
      const bf16x8 bb = *(const bf16x8*)(Ke + (16 * j + c16) * HST + ks * 32 + 8 * hq);
      x = MFMA16(a, bb, x);
    }
#pragma unroll
    for (int r = 0; r < 4; ++r) {
      const bool ok = (j < w) || (c16 <= 4 * hq + r);
      Am[(16 * w + 4 * hq + r) * 72 + 16 * j + c16] = f2bf(ok ? x[r] : 0.f);
    }
  }
  if ((w & 1) == 0) {
#pragma unroll
    for (int r = 0; r < 4; ++r) Am[(16 * w + 4 * hq + r) * 72 + 16 * (w + 1) + c16] = 0;
  }
  __syncthreads();
  bf16x8 vf[2][2];
#pragma unroll
  for (int ks = 0; ks < 2; ++ks)
#pragma unroll
    for (int et = 0; et < 2; ++et) {
      const u16* base = Vv + (32 * ks + 8 * hq + tq) * HST + 32 * w + 16 * et + 4 * tp;
      vf[ks][et] = cat8(tr_read(base), tr_read(base + 4 * HST));
    }
  {
    f32x4 o[4][2];
#pragma unroll
    for (int tt = 0; tt < 4; ++tt)
#pragma unroll
      for (int et = 0; et < 2; ++et) o[tt][et] = f32x4{0.f, 0.f, 0.f, 0.f};
#pragma unroll
    for (int tt = 0; tt < 4; ++tt)
#pragma unroll
      for (int ks = 0; ks <= (tt >> 1); ++ks) {
        const bf16x8 a = *(const bf16x8*)(Am + (16 * tt + c16) * 72 + 32 * ks + 8 * hq);
#pragma unroll
        for (int et = 0; et < 2; ++et) o[tt][et] = MFMA16(a, vf[ks][et], o[tt][et]);
      }
    float* oraw = (float*)(p.ws + W_ORAW);
#pragma unroll
    for (int tt = 0; tt < 4; ++tt)
#pragma unroll
      for (int et = 0; et < 2; ++et)
#pragma unroll
        for (int r = 0; r < 4; ++r) oraw[(tok0 + 16 * tt + 4 * hq + r) * 512 + h * 128 + 32 * w + 16 * et + c16] = o[tt][et][r];
  }
  float* dst = (float*)(p.ws + W_DST) + (size_t)it * 128 * 128;
#pragma unroll
  for (int dt = 0; dt < 8; ++dt) {
    bf16x8 kt[2];
#pragma unroll
    for (int ks = 0; ks < 2; ++ks) {
      const u16* base = Ke + (32 * ks + 8 * hq + tq) * HST + 16 * dt + 4 * tp;
      kt[ks] = cat8(tr_read(base), tr_read(base + 4 * HST));
    }
    f32x4 sc2;
#pragma unroll
    for (int r = 0; r < 4; ++r) sc2[r] = __expf(G63[16 * dt + 4 * hq + r] - Rr[16 * dt + 4 * hq + r]);
#pragma unroll
    for (int et = 0; et < 2; ++et) {
      f32x4 dd = f32x4{0.f, 0.f, 0.f, 0.f};
      dd = MFMA16(kt[0], vf[0][et], dd); dd = MFMA16(kt[1], vf[1][et], dd);
      *(float4*)(dst + (size_t)(32 * w + 16 * et + c16) * 128 + 16 * dt + 4 * hq) = make_float4(dd[0] * sc2[0], dd[1] * sc2[1], dd[2] * sc2[2], dd[3] * sc2[3]);
    }
  }
  if (tid < 128) ((float*)(p.ws + W_DEC))[(size_t)it * 128 + tid] = __expf(G63[tid]);
}

constexpr int H2_ITEMS = 8 * 4 * 128 * 32 / 256;
DI void hgrn_h2_item(const Params& p, int it) {
  const int gt = it * 256 + otid(), bh = gt >> 12, e = (gt >> 5) & 127, dq = gt & 31;
  const float* dst = (const float*)(p.ws + W_DST); const float* dec = (const float*)(p.ws + W_DEC); u16* spt = (u16*)(p.ws + W_SPT);
  float4 s = make_float4(0.f, 0.f, 0.f, 0.f);
#pragma unroll 1
  for (int c0 = 0; c0 < 32; c0 += 8) {
    float4 d4[8], k4[8];
#pragma unroll
    for (int i = 0; i < 8; ++i) {
      d4[i] = *(const float4*)(dst + ((size_t)(bh * 32 + c0 + i) * 128 + e) * 128 + dq * 4);
      k4[i] = *(const float4*)(dec + (size_t)(bh * 32 + c0 + i) * 128 + dq * 4);
    }
#pragma unroll
    for (int i = 0; i < 8; ++i) {
      *(uint2*)(spt + ((size_t)(bh * 32 + c0 + i) * 128 + e) * 128 + dq * 4) = make_uint2(pk2(s.x, s.y), pk2(s.z, s.w));
      s.x = k4[i].x * s.x + d4[i].x; s.y = k4[i].y * s.y + d4[i].y; s.z = k4[i].z * s.z + d4[i].z; s.w = k4[i].w * s.w + d4[i].w;
    }
  }
  float* So = p.out + O_PHG + (size_t)bh * 128 * 128;
  So[(size_t)(dq * 4 + 0) * 128 + e] = s.x; So[(size_t)(dq * 4 + 1) * 128 + e] = s.y;
  So[(size_t)(dq * 4 + 2) * 128 + e] = s.z; So[(size_t)(dq * 4 + 3) * 128 + e] = s.w;
}

DI void hgrn_h3_item(const Params& p, int it) {
  const int c = it & 31, h = (it >> 5) & 3, b = it >> 7;
  const int tid = otid(), lane = tid & 63, w = tid >> 6, c16 = lane & 15, hq = lane >> 4;
  const size_t tok0 = (size_t)b * 2048 + c * 64 + 16 * w;
  const u16* qg = (const u16*)(p.ws + W_QG) + (tok0 + c16) * 512 + h * 128 + 8 * hq;
  bf16x8 af[4];
#pragma unroll
  for (int ks = 0; ks < 4; ++ks) af[ks] = *(const bf16x8*)(qg + 32 * ks);
  const float* oraw = (const float*)(p.ws + W_ORAW) + (tok0 + 4 * hq) * 512 + h * 128 + c16;
  const u16* spt = (const u16*)(p.ws + W_SPT) + ((size_t)it * 128 + c16) * 128 + 8 * hq;
  f32x4 acc[8];
#pragma unroll
  for (int et = 0; et < 8; ++et) {
#pragma unroll
    for (int r = 0; r < 4; ++r) acc[et][r] = oraw[(size_t)r * 512 + 16 * et];
#pragma unroll
    for (int ks = 0; ks < 4; ++ks) {
      const bf16x8 bfr = *(const bf16x8*)(spt + (size_t)(16 * et) * 128 + 32 * ks);
      acc[et] = MFMA16(af[ks], bfr, acc[et]);
    }
  }
  const u16* zb = (const u16*)(p.ws + W_ZB) + (tok0 + 4 * hq) * 512 + h * 128 + c16;
  u16* ob = (u16*)(p.ws + W_OB) + (tok0 + 4 * hq) * 512 + h * 128 + c16;
  u16 zv[4][8]; float ng[8];
#pragma unroll
  for (int r = 0; r < 4; ++r)
#pragma unroll
    for (int et = 0; et < 8; ++et) zv[r][et] = zb[(size_t)r * 512 + 16 * et];
#pragma unroll
  for (int et = 0; et < 8; ++et) ng[et] = p.hg_norm_g[h * 128 + 16 * et + c16];
#pragma unroll
  for (int r = 0; r < 4; ++r) {
    float v = 0.f;
#pragma unroll
    for (int et = 0; et < 8; ++et) v += acc[et][r] * acc[et][r];
    v += __shfl_xor(v, 1); v += __shfl_xor(v, 2); v += __shfl_xor(v, 4); v += __shfl_xor(v, 8);
    const float rs = rsqrtf(v * (1.f / 128.f) + 1e-6f);
#pragma unroll
    for (int et = 0; et < 8; ++et) ob[(size_t)r * 512 + 16 * et] = f2bf(acc[et][r] * rs * ng[et] * bf2f(zv[r][et]));
  }
}

typedef __attribute__((address_space(3))) const float lds_cf;
template <int NR>
DI void sa_scores(const float* qrows_, const float4 (&kk)[16], float (&sc)[NR]) {
  lds_cf* qrows = (lds_cf*)qrows_; asm volatile("" : "+v"(qrows));
#pragma unroll
  for (int r = 0; r < NR; ++r) {
    float a0 = 0.f, a1 = 0.f;
#pragma unroll
    for (int dq = 0; dq < 16; dq += 2) {
      const f32x4 q0 = *(const __attribute__((address_space(3))) f32x4*)(qrows + r * 64 + dq * 4), q1 = *(const __attribute__((address_space(3))) f32x4*)(qrows + r * 64 + dq * 4 + 4);
      a0 += q0[0] * kk[dq].x + q0[1] * kk[dq].y + q0[2] * kk[dq].z + q0[3] * kk[dq].w;
      a1 += q1[0] * kk[dq + 1].x + q1[1] * kk[dq + 1].y + q1[2] * kk[dq + 1].z + q1[3] * kk[dq + 1].w;
    }
    sc[r] = a0 + a1;
    asm volatile("" : "+v"(sc[r]) :: "memory");
  }
}
DI void sa_load_f32(const float* rowp, bool ok, float4 (&kk)[16]) {
#pragma unroll
  for (int i = 0; i < 16; ++i) kk[i] = ok ? ((const float4*)rowp)[i] : make_float4(0.f, 0.f, 0.f, 0.f);
}
template <int NR>
DI void sa_softmax(float* P, int nk, int row, int sub) {
  float m = -3.0e38f;
  for (int k = sub; k < nk; k += 16) m = fmaxf(m, P[k * NR + row]);
  m = fmaxf(m, __shfl_xor(m, 1)); m = fmaxf(m, __shfl_xor(m, 2)); m = fmaxf(m, __shfl_xor(m, 4)); m = fmaxf(m, __shfl_xor(m, 8));
  float l = 0.f;
  for (int k = sub; k < nk; k += 16) { const float sv = P[k * NR + row]; const float pv = (sv > -1.0e38f) ? __builtin_amdgcn_exp2f(sv - m) : 0.f; P[k * NR + row] = pv; l += pv; }
  l += __shfl_xor(l, 1); l += __shfl_xor(l, 2); l += __shfl_xor(l, 4); l += __shfl_xor(l, 8);
  const float inv = (l > 0.f) ? 1.f / l : 0.f;
  for (int k = sub; k < nk; k += 16) P[k * NR + row] *= inv;
}

DI void sa_load_bf16(const u16* rowp, bool ok, float4 (&kk)[16]) {
#pragma unroll
  for (int i = 0; i < 8; ++i) {
    const uint4 u = ok ? ((const uint4*)rowp)[i] : make_uint4(0u, 0u, 0u, 0u);
    kk[2 * i] = make_float4(bflo(u.x), bfhi(u.x), bflo(u.y), bfhi(u.y)); kk[2 * i + 1] = make_float4(bflo(u.z), bfhi(u.z), bflo(u.w), bfhi(u.w));
  }
}
template <class VRow>
DI void sa_pv(const float* P, int k0, int k1, const VRow& vrow, int lane, float (&o)[4]) {
#pragma unroll 1
  for (int kb = k0; kb < k1; kb += 32) {
    float vv[32];
#pragma unroll
    for (int i = 0; i < 32; ++i) vv[i] = vrow((kb + i < k1) ? kb + i : k1 - 1, lane);
#pragma unroll
    for (int i = 0; i < 32; ++i) {
      const int key = (kb + i < k1) ? kb + i : k1 - 1;
      const float4 p4 = *(const float4*)(P + key * 4); const float v = (kb + i < k1) ? vv[i] : 0.f;
      o[0] += p4.x * v; o[1] += p4.y * v; o[2] += p4.z * v; o[3] += p4.w * v;
    }
  }
}
template <int CTRL> DI float dppf(float v) { return __builtin_bit_cast(float, __builtin_amdgcn_update_dpp(0, __builtin_bit_cast(int, v), CTRL, 0xF, 0xF, false)); }
DI float red16(float v) { v += dppf<0xB1>(v); v += dppf<0x4E>(v); v += dppf<0x141>(v); v += dppf<0x140>(v); return v; }
template <class KRow, class Fin>
DI void sa_tile4(const float4 (&q4)[4], float* Pdst, const KRow& krow, const Fin& fin, int lane) {
  const int chunk = lane & 15, k4 = lane >> 4;
  float4 kv[16];
#pragma unroll
  for (int i = 0; i < 16; ++i) kv[i] = krow(4 * i + k4, chunk);
#pragma unroll
  for (int i = 0; i < 16; ++i) {
    float sr[4];
#pragma unroll
    for (int r = 0; r < 4; ++r) sr[r] = red16(q4[r].x * kv[i].x + q4[r].y * kv[i].y + q4[r].z * kv[i].z + q4[r].w * kv[i].w);
    const float mine = (chunk == 0) ? sr[0] : ((chunk == 1) ? sr[1] : ((chunk == 2) ? sr[2] : sr[3]));
    const float fv = fin(4 * i + k4, chunk & 3, mine);
    if (chunk < 4) Pdst[(4 * i + k4) * 4 + chunk] = fv;
  }
}
DI void sa_softmax_row(float* P, int nk, int row, int lane) {
  float m = -3.0e38f;
  for (int k = lane; k < nk; k += 64) m = fmaxf(m, P[k * 4 + row]);
  m = wave_max(m);
  float l = 0.f;
  for (int k = lane; k < nk; k += 64) { const float sv = P[k * 4 + row]; const float pv = (sv > -1.0e38f) ? __builtin_amdgcn_exp2f(sv - m) : 0.f; P[k * 4 + row] = pv; l += pv; }
  l = wave_sum(l);
  const float inv = (l > 0.f) ? 1.f / l : 0.f;
  for (int k = lane; k < nk; k += 64) P[k * 4 + row] *= inv;
}
DI void sample_attn_item(const Params& p, int it, char* lds) {
  const int t = it & 3, g = (it >> 2) & 1, b = it >> 3, tid = otid(), lane = tid & 63, w = __builtin_amdgcn_readfirstlane(tid >> 6);
  float* qs = (float*)lds;
  float* Pc = qs + 256;
  float* Pw = Pc + 512;
  float* Ps = Pw + 2304;
  float* obuf = Ps + 2048;
  float* imp = obuf + 3072;
  int* sel = (int*)(imp + 36);
  int* pts = sel + 8;
  float* btab = (float*)(pts + 16);
  const size_t tok = (size_t)(NTP + b * 4 + t);
  const int qpos = PAST + t, seq = BATCH + b;
  __syncthreads();
  qs[tid] = bf2f(((const u16*)(p.ws + W_Q))[tok * 512 + (g * 4 + (tid >> 6)) * 64 + lane]);
  for (int i = tid; i < 4 * 129; i += 256) { const int r = i / 129, rel = i % 129; const int bk = rel < 128 ? T5B[rel] : 31; btab[i] = p.rel_bias[bk * 8 + g * 4 + r] * LOG2E; }
  if (tid < 16) pts[tid] = p.pt[b * 16 + tid];
  __syncthreads();
  const float* fresh_wk = p.out + O_SWK + ((size_t)b * 512 + 508) * 128 + g * 64;
  const float* fresh_wv = p.out + O_SWK + (size_t)DEC_BATCH * 512 * 128 + ((size_t)b * 512 + 508) * 128 + g * 64;
  const float* fresh_sk = p.out + O_SCK + 2 * (size_t)NTS * 128 + (size_t)(b * 4) * 128 + g * 64;
  const float* fresh_sv = p.out + O_SCK + 3 * (size_t)NTS * 128 + (size_t)(b * 4) * 128 + g * 64;
  float4 q4[4];
#pragma unroll
  for (int r = 0; r < 4; ++r) q4[r] = *(const float4*)(qs + r * 64 + (lane & 15) * 4);
  for (int ti = w; ti < 11; ti += 4) {
    if (ti < 2) {
      const u16* kc = (const u16*)(p.ws + W_KCMP) + (size_t)(seq * 2 + g) * 128 * 64;
      sa_tile4(q4, Pc + ti * 256,
               [&](int k, int c) { const int n = 64 * ti + k; const uint2 u = *(const uint2*)(kc + (size_t)n * 64 + c * 4); return make_float4(bflo(u.x), bfhi(u.x), bflo(u.y), bfhi(u.y)); },
               [&](int k, int r, float sv) { const int n = 64 * ti + k; const int rel = qpos - (16 * n + 31); return (n < 127) ? sv + btab[r * 129 + (rel < 128 ? rel : 128)] : -3.0e38f; }, lane);
    } else {
      const int k0 = (ti - 2) * 64;
      sa_tile4(q4, Pw + k0 * 4,
               [&](int k, int c) { const int key = (k0 + k < 516) ? k0 + k : 515;
                 const float* rp = (key < 512) ? (p.swk + ((size_t)b * 512 + key) * 128 + g * 64) : (fresh_wk + (size_t)(key - 512) * 128);
                 return *(const float4*)(rp + c * 4); },
               [&](int k, int r, float sv) { const int key = k0 + k; const int rel = qpos - (PAST - 512 + key);
                 const bool ok = key < 516 && rel >= 0 && rel < 512; return ok ? sv + btab[r * 129 + (rel < 128 ? rel : 128)] : -3.0e38f; }, lane);
    }
  }
  __syncthreads();
  sa_softmax_row(Pc, 128, w, lane);
  sa_softmax_row(Pw, 576, w, lane);
  __syncthreads();
  if (w == 0) {
    if (lane < 33) {
      const int j = lane; float sm = 0.f;
      for (int u = -1; u <= 3; ++u) { const int n = 4 * j + u; if (n >= 0 && n < 127) { const float4 p4 = *(const float4*)(Pc + n * 4); sm += (p4.x + p4.y + p4.z + p4.w) * ((u == -1 || u == 3) ? 1.f : 2.f); } }
      imp[j] = sm;
    }
    if (lane == 0) {
      sel[0] = 0; sel[1] = 31; sel[2] = 32;
      unsigned taken = 0u;
      for (int c = 0; c < 5; ++c) {
        float best = -1.f; int bi = 1;
        for (int j = 1; j <= 30; ++j) { const float v = imp[j]; if (!((taken >> j) & 1u) && v > best) { best = v; bi = j; } }
        taken |= 1u << bi; sel[3 + c] = bi;
      }
    }
  }
  __syncthreads();
  for (int jj = w; jj < 8; jj += 4) {
    const int blk = sel[jj];
    const float* kbase = (blk < 32) ? (p.csk + (((size_t)pts[blk >> 1] * 128 + (blk & 1) * 64) * 2 + g) * 64) : fresh_sk;
    sa_tile4(q4, Ps + jj * 256,
             [&](int k, int c) { const int kk = (blk < 32) ? k : (k & 3); return *(const float4*)(kbase + (size_t)kk * 128 + c * 4); },
             [&](int k, int r, float sv) { const int rel = qpos - (blk * 64 + k); const bool ok = (blk < 32 || k < 4) && rel >= 0;
               return ok ? sv + btab[r * 129 + (rel < 0 ? 0 : (rel < 128 ? rel : 128))] : -3.0e38f; }, lane);
  }
  {
    float oc[4] = {0.f, 0.f, 0.f, 0.f}, ow[4] = {0.f, 0.f, 0.f, 0.f};
    const float* vc = (const float*)(p.ws + W_VCF) + (size_t)(b * 2 + g) * 128 * 64;
    sa_pv(Pc, 32 * w, (32 * w + 32 < 127) ? 32 * w + 32 : 127, [&](int k, int l) { return vc[(size_t)k * 64 + l]; }, lane, oc);
    const float* vst = p.swv + (size_t)b * 512 * 128 + g * 64;
    sa_pv(Pw, 129 * w, 129 * w + 129, [&](int k, int l) { const float* rp = (k < 512) ? (vst + (size_t)k * 128) : (fresh_wv + (size_t)(k - 512) * 128); return rp[l]; }, lane, ow);
#pragma unroll
    for (int r = 0; r < 4; ++r) { obuf[((0 * 4 + w) * 4 + r) * 64 + lane] = oc[r]; obuf[((1 * 4 + w) * 4 + r) * 64 + lane] = ow[r]; }
  }
  __syncthreads();
  sa_softmax_row(Ps, 512, w, lane);
  __syncthreads();
  {
    float os[4] = {0.f, 0.f, 0.f, 0.f};
    for (int jj = 2 * w; jj < 2 * w + 2; ++jj) {
      const int blk = sel[jj];
      const float* vbase; int ns;
      if (blk < 32) { vbase = p.csv + (((size_t)pts[blk >> 1] * 128 + (blk & 1) * 64) * 2 + g) * 64; ns = 64; } else { vbase = fresh_sv; ns = 4; }
      sa_pv(Ps + jj * 64 * 4, 0, ns, [&](int k, int l) { return vbase[(size_t)k * 128 + l]; }, lane, os);
    }
#pragma unroll
    for (int r = 0; r < 4; ++r) obuf[((2 * 4 + w) * 4 + r) * 64 + lane] = os[r];
  }
  __syncthreads();
  {
    const int r = tid >> 6, hd = g * 4 + r;
    const float* gt = (const float*)(p.ws + W_GATE) + tok * 24;
    float o = 0.f;
#pragma unroll
    for (int br = 0; br < 3; ++br) {
      float a = 0.f;
#pragma unroll
      for (int ww = 0; ww < 4; ++ww) a += obuf[((br * 4 + ww) * 4 + r) * 64 + lane];
      o += gt[(br == 0 ? 0 : (br == 1 ? 16 : 8)) + hd] * a;
    }
    ((u16*)(p.ws + W_OA))[tok * 512 + hd * 64 + lane] = f2bf(o * bf2f(((const u16*)(p.ws + W_ZA))[tok * 512 + hd * 64 + lane]));
  }
}

constexpr int P2_HP = BATCH * 4 * 32;
constexpr int P2_CMP = BATCH * 2 * 2;
constexpr int P2_SA = DEC_BATCH * 2 * 4;
constexpr int P2_HS = DEC_BATCH * 4;
constexpr int P2_TOTAL = P2_HP + P2_CMP + P2_SA + P2_HS;
DI void phase2_item(const Params& p, int it, char* lds) {
  if (it < P2_SA) { sample_attn_item(p, it, lds); return; }
  it -= P2_SA;
  if (it < P2_CMP) {
    const int kv = it & 1, g = (it >> 1) & 1, b = it >> 2;
    LoadCellBf16 al{(const u16*)(p.ws + W_KV) + (size_t)kv * NT * 128 + (size_t)b * 2048 * 128 + g * 64};
    comp_tile(p, al, b, g, kv, lds); return;
  }
  it -= P2_CMP;
  if (it < P2_HS) { hgrn_sample_item(p, it, lds); return; }
  it -= P2_HS;
  hgrn_h1_item(p, it, lds);
}

constexpr int AKS = 72, AVS = 68, ACS = 132;
DI bf16x8 pack8(const f32x16& x, int s2) {
  uint4 u; u.x = pk2(x[8 * s2], x[8 * s2 + 1]); u.y = pk2(x[8 * s2 + 2], x[8 * s2 + 3]);
  u.z = pk2(x[8 * s2 + 4], x[8 * s2 + 5]); u.w = pk2(x[8 * s2 + 6], x[8 * s2 + 7]);
  return __builtin_bit_cast(bf16x8, u);
}
DI void zero16(f32x16& x) {
#pragma unroll
  for (int i = 0; i < 16; ++i) x[i] = 0.f;
}

constexpr int T2N = 264;
template <int MODE>
DI void attn_tile(const u16* Kt, const u16* Vt, const float* t2r, float cfar, const bf16x8 (&qf)[4], int qpos, int kpos0, bool lane_on,
                  float& m_run, float& l_run, f32x16 (&oacc)[2], int ql, int hh) {
  f32x16 sacc[2];
#pragma unroll
  for (int kt = 0; kt < 2; ++kt) {
    zero16(sacc[kt]);
#pragma unroll
    for (int ks = 0; ks < 4; ++ks) {
      const bf16x8 kf = *(const bf16x8*)(Kt + (32 * kt + ql) * AKS + 16 * ks + 8 * hh);
      sacc[kt] = MFMA32(kf, qf[ks], sacc[kt]);
    }
  }
  float mt = -1.0e30f;
  if (MODE == 0) {
#pragma unroll
    for (int kt = 0; kt < 2; ++kt)
#pragma unroll
      for (int i = 0; i < 16; ++i) mt = fmaxf(mt, sacc[kt][i]);
    mt = lane_on ? mt + cfar : -1.0e30f;
  } else if (MODE == 1) {
    const float* tb = t2r + (lane_on ? (qpos - kpos0 + 63 - 4 * hh) : 59) - 59;
#pragma unroll
    for (int kt = 0; kt < 2; ++kt)
#pragma unroll
      for (int i = 0; i < 16; ++i) {
        sacc[kt][i] += tb[59 - (32 * kt + (i & 3) + 8 * (i >> 2))];
        mt = fmaxf(mt, sacc[kt][i]);
      }
  } else {
    const int thr = qpos - kpos0 - 4 * hh - 512;
#pragma unroll
    for (int kt = 0; kt < 2; ++kt)
#pragma unroll
      for (int i = 0; i < 16; ++i) {
        const bool ok = lane_on && (32 * kt + (i & 3) + 8 * (i >> 2)) > thr;
        sacc[kt][i] = ok ? sacc[kt][i] + cfar : -1.0e30f;
        mt = fmaxf(mt, sacc[kt][i]);
      }
  }
  mt = fmaxf(mt, __shfl_xor(mt, 32));
  const float mn = fmaxf(m_run, mt);
  if (!__all(mn == m_run)) {
    const float alpha = __builtin_amdgcn_exp2f(m_run - mn);
    l_run *= alpha;
#pragma unroll
    for (int dt = 0; dt < 2; ++dt)
#pragma unroll
      for (int i = 0; i < 16; ++i) oacc[dt][i] *= alpha;
  }
  m_run = mn;
  float ls = 0.f;
  if (MODE == 0) {
    const float dsh = lane_on ? cfar - mn : -1.0e30f;
#pragma unroll
    for (int kt = 0; kt < 2; ++kt)
#pragma unroll
      for (int i = 0; i < 16; ++i) { const float pv = __builtin_amdgcn_exp2f(sacc[kt][i] + dsh); sacc[kt][i] = pv; ls += pv; }
  } else {
#pragma unroll
    for (int kt = 0; kt < 2; ++kt)
#pragma unroll
      for (int i = 0; i < 16; ++i) {
        const float pv = (sacc[kt][i] > -1.0e29f) ? __builtin_amdgcn_exp2f(sacc[kt][i] - mn) : 0.f;
        sacc[kt][i] = pv; ls += pv;
      }
  }
  l_run += ls;
#pragma unroll
  for (int kt = 0; kt < 2; ++kt)
#pragma unroll
    for (int s2 = 0; s2 < 2; ++s2) {
      const bf16x8 pf = pack8(sacc[kt], s2);
#pragma unroll
      for (int dt = 0; dt < 2; ++dt) {
        const u16* vp = Vt + (32 * kt + 16 * s2 + 4 * hh + ((ql & 15) >> 2)) * AKS + 32 * dt + (ql & 16) + 4 * (ql & 3);
        const bf16x8 vf = cat8(tr_read(vp), tr_read(vp + 8 * AKS));
        oacc[dt] = MFMA32(vf, pf, oacc[dt]);
      }
    }
}

DI void attn_load_tile(u16* Kt, u16* Vt, const u16* ksrc  , const u16* vtsrc  ) {
  const int tid = otid512();
  {
    const int idx = tid, rw = idx >> 3, ch = idx & 7;
    *(uint4*)(Kt + rw * AKS + ch * 8) = *(const uint4*)(ksrc + (size_t)rw * 128 + ch * 8);
    const uint4 v = *(const uint4*)(vtsrc + (size_t)rw * 2048 + ch * 8);
    *(uint2*)(Vt + rw * AVS + ch * 8) = make_uint2(v.x, v.y);
    *(uint2*)(Vt + rw * AVS + ch * 8 + 4) = make_uint2(v.z, v.w);
  }
}

DI void prompt_attn_item(const Params& p, int it, char* lds) {
  const int qt = (it < 256) ? (31 - (it & 31)) : (it & 31), g = (it >> 5) & 1, b = (it >> 6) & 3 | ((it >> 8) << 2);
  const int t0 = qt * 64;
  const int tid = otid512(), lane = tid & 63, w = tid >> 6, ql = lane & 31, hh = lane >> 5, tl = ql >> 2, r = ql & 3;
  const int qpos = t0 + 8 * w + tl, head = g * 4 + r;
  const size_t tok = (size_t)b * 2048 + qpos;
  u16* Kt = (u16*)lds;
  u16* Vt = Kt + 128 * AKS;
  float* brel = (float*)(Vt + 128 * AKS);
  float* t2 = brel + 4 * 129;
  unsigned* wmask = (unsigned*)(t2 + 4 * T2N);
  const u16* Qb = (const u16*)(p.ws + W_Q);
  __syncthreads();
  for (int i = tid; i < 4 * 129; i += 512) { const int rr = i / 129, rel = i % 129; const int bk = rel < 128 ? T5B[rel] : 31; brel[i] = p.rel_bias[bk * 8 + g * 4 + rr] * LOG2E; }
  for (int i = tid; i < 4 * T2N; i += 512) { const int rr = i / T2N, rel = i % T2N - 63; const int bk = rel < 128 ? T5B[rel < 0 ? 0 : rel] : 31;
    t2[i] = (rel < 0) ? -1.0e30f : p.rel_bias[bk * 8 + g * 4 + rr] * LOG2E; }
  bf16x8 qf[4];
#pragma unroll
  for (int ks = 0; ks < 4; ++ks) qf[ks] = *(const bf16x8*)(Qb + tok * 512 + head * 64 + 16 * ks + 8 * hh);
  const float* gt = (const float*)(p.ws + W_GATE) + tok * 24;
  const float* brel_r = brel + r * 129;
  const float* t2r = t2 + r * T2N;
  const float cfar = p.rel_bias[31 * 8 + head] * LOG2E;
  f32x16 of[2];
  unsigned selm;
  {
#pragma unroll
    for (int i = 0; i < 2; ++i) {
      const int idx = tid + 512 * i, n = idx >> 3, ch = idx & 7;
      *(uint4*)(Kt + n * AKS + ch * 8) = *(const uint4*)((const u16*)(p.ws + W_KCMP) + ((size_t)(b * 2 + g) * 128 + n) * 64 + ch * 8);
      *(uint4*)(Vt + n * AKS + ch * 8) = *(const uint4*)((const u16*)(p.ws + W_VCMP) + ((size_t)(b * 2 + g) * 128 + n) * 64 + ch * 8);
    }
    __syncthreads();
    f32x16 sacc[4];
#pragma unroll
    for (int kt = 0; kt < 4; ++kt) {
      zero16(sacc[kt]);
#pragma unroll
      for (int ks = 0; ks < 4; ++ks) {
        const bf16x8 kf = *(const bf16x8*)(Kt + (32 * kt + ql) * AKS + 16 * ks + 8 * hh);
        sacc[kt] = MFMA32(kf, qf[ks], sacc[kt]);
      }
    }
    float mt = -1.0e30f;
#pragma unroll
    for (int kt = 0; kt < 4; ++kt)
#pragma unroll
      for (int i = 0; i < 16; ++i) {
        const int n = 32 * kt + crow(i, hh);
        const int rel = qpos - (16 * n + 31);
        const bool ok = rel >= 0 && n < 127;
        const float sv = sacc[kt][i] + brel_r[rel < 0 ? 0 : (rel < 128 ? rel : 128)];
        sacc[kt][i] = ok ? sv : -1.0e30f;
        mt = fmaxf(mt, sacc[kt][i]);
      }
    mt = fmaxf(mt, __shfl_xor(mt, 32));
    float ls = 0.f;
#pragma unroll
    for (int kt = 0; kt < 4; ++kt)
#pragma unroll
      for (int i = 0; i < 16; ++i) { const float pv = (sacc[kt][i] > -1.0e29f) ? __builtin_amdgcn_exp2f(sacc[kt][i] - mt) : 0.f; sacc[kt][i] = pv; ls += pv; }
    ls += __shfl_xor(ls, 32);
    const float inv = ls > 0.f ? 1.f / ls : 0.f;
#pragma unroll
    for (int kt = 0; kt < 4; ++kt)
#pragma unroll
      for (int i = 0; i < 16; ++i) sacc[kt][i] *= inv;
    f32x16 oc[2]; zero16(oc[0]); zero16(oc[1]);
#pragma unroll
    for (int kt = 0; kt < 4; ++kt)
#pragma unroll
      for (int s2 = 0; s2 < 2; ++s2) {
        const bf16x8 pf = pack8(sacc[kt], s2);
#pragma unroll
        for (int dt = 0; dt < 2; ++dt) {
          const u16* vp = Vt + (32 * kt + 16 * s2 + 4 * hh + ((ql & 15) >> 2)) * AKS + 32 * dt + (ql & 16) + 4 * (ql & 3);
          const bf16x8 vf = cat8(tr_read(vp), tr_read(vp + 8 * AKS));
          oc[dt] = MFMA32(vf, pf, oc[dt]);
        }
      }
    const float g0 = gt[head];
#pragma unroll
    for (int dt = 0; dt < 2; ++dt)
#pragma unroll
      for (int i = 0; i < 16; ++i) of[dt][i] = g0 * oc[dt][i];
    float im[16], cm[16];
#pragma unroll
    for (int kt = 0; kt < 4; ++kt)
#pragma unroll
      for (int q4 = 0; q4 < 4; ++q4) {
        const float p0 = sacc[kt][4 * q4], p1 = sacc[kt][4 * q4 + 1], p2 = sacc[kt][4 * q4 + 2], p3 = sacc[kt][4 * q4 + 3];
        im[4 * kt + q4] = 2.f * (p0 + p1 + p2) + p3; cm[4 * kt + q4] = p3;
      }
#pragma unroll
    for (int m = 0; m < 16; ++m) cm[m] = __shfl_xor(cm[m], 32);
#pragma unroll
    for (int m = 15; m >= 0; --m) im[m] += hh ? cm[m] : (m > 0 ? cm[m - 1] : 0.f);
#pragma unroll
    for (int m = 0; m < 16; ++m) { im[m] += __shfl_xor(im[m], 1); im[m] += __shfl_xor(im[m], 2); }
    float ev[16], od[16];
#pragma unroll
    for (int m = 0; m < 16; ++m) { const float ot = __shfl_xor(im[m], 32); ev[m] = hh ? ot : im[m]; od[m] = hh ? im[m] : ot; }
    const int cur = qpos >> 6;
    if (cur < 8) selm = (2u << cur) - 1u;
    else {
      selm = 1u | (1u << cur) | (1u << (cur - 1));
      for (int c = 0; c < 5; ++c) {
        float best = -1.f;
#pragma unroll
        for (int J = 0; J < 32; ++J) { const float v = (J <= cur && !((selm >> J) & 1u)) ? ((J & 1) ? od[J >> 1] : ev[J >> 1]) : -1.f; best = fmaxf(best, v); }
        int bi = 32;
#pragma unroll
        for (int J = 31; J >= 0; --J) { const float v = (J <= cur && !((selm >> J) & 1u)) ? ((J & 1) ? od[J >> 1] : ev[J >> 1]) : -1.f; if (v == best) bi = J; }
        if (best >= 0.f) selm |= 1u << bi;
      }
    }
    unsigned um = selm;
    um |= __shfl_xor(um, 4); um |= __shfl_xor(um, 8); um |= __shfl_xor(um, 16);
    if (lane == 0) wmask[w] = um;
  }
  __syncthreads();
  const unsigned un = wmask[0] | wmask[1] | wmask[2] | wmask[3] | wmask[4] | wmask[5] | wmask[6] | wmask[7];
  {
    const u16* ks = (const u16*)(p.ws + W_KV) + (size_t)2 * NT * 128 + (size_t)b * 2048 * 128 + g * 64;
    const u16* vts = (const u16*)(p.ws + W_KV) + (size_t)3 * NT * 128 + (size_t)b * 2048 * 128 + g * 64;
    const u16* kw = (const u16*)(p.ws + W_KV) + (size_t)4 * NT * 128 + (size_t)b * 2048 * 128 + g * 64;
    const u16* vtw = (const u16*)(p.ws + W_KV) + (size_t)5 * NT * 128 + (size_t)b * 2048 * 128 + g * 64;
    const int rw = tid >> 3, ch = tid & 7;
    uint4 kreg, vreg;
#define ATT_PREFETCH(kb, vb, j_) do { kreg = *(const uint4*)((kb) + ((size_t)(j_) * 64 + rw) * 128 + ch * 8); vreg = *(const uint4*)((vb) + ((size_t)(j_) * 64 + rw) * 128 + ch * 8); } while (0)
#define ATT_COMMIT(par_) do { *(uint4*)(Kt + ((par_) * 64 + rw) * AKS + ch * 8) = kreg; *(uint4*)(Vt + ((par_) * 64 + rw) * AKS + ch * 8) = vreg; } while (0)
    const int jlo = (t0 >= 511) ? ((t0 - 511) >> 6) : 0, jhi = (t0 + 63) >> 6;
    int par = 0;
    {
      float m_run = -1.0e30f, l_run = 0.f; f32x16 oacc[2]; zero16(oacc[0]); zero16(oacc[1]);
      unsigned rem = un;
      int j = __builtin_ctz(rem); rem &= rem - 1u;
      ATT_PREFETCH(ks, vts, j);
      for (;;) {
        ATT_COMMIT(par);
        const int jn = rem ? __builtin_ctz(rem) : -1;
        if (jn >= 0) { rem &= rem - 1u; ATT_PREFETCH(ks, vts, jn); } else { ATT_PREFETCH(kw, vtw, jlo); }
        __syncthreads();
        const bool on = (selm >> j) & 1u;
        if (__ballot(on) != 0ull) {
          if (64 * j + 63 + 128 <= t0 + 8 * w) attn_tile<0>(Kt + par * 64 * AKS, Vt + par * 64 * AKS, t2r, cfar, qf, qpos, j * 64, on, m_run, l_run, oacc, ql, hh);
          else attn_tile<1>(Kt + par * 64 * AKS, Vt + par * 64 * AKS, t2r, cfar, qf, qpos, j * 64, on, m_run, l_run, oacc, ql, hh);
        }
        par ^= 1;
        if (jn < 0) break;
        j = jn;
      }
      l_run += __shfl_xor(l_run, 32);
      const float sc = gt[8 + head] * (l_run > 0.f ? 1.f / l_run : 0.f);
#pragma unroll
      for (int dt = 0; dt < 2; ++dt)
#pragma unroll
        for (int i = 0; i < 16; ++i) of[dt][i] += sc * oacc[dt][i];
    }
    {
      float m_run = -1.0e30f, l_run = 0.f; f32x16 oacc[2]; zero16(oacc[0]); zero16(oacc[1]);
      for (int j = jlo; j <= jhi; ++j) {
        ATT_COMMIT(par);
        if (j < jhi) ATT_PREFETCH(kw, vtw, j + 1);
        __syncthreads();
        const u16* Kp = Kt + par * 64 * AKS; const u16* Vp = Vt + par * 64 * AKS;
        if (64 * j + 63 + 128 > t0 + 8 * w) attn_tile<1>(Kp, Vp, t2r, cfar, qf, qpos, j * 64, true, m_run, l_run, oacc, ql, hh);
        else if (64 * j + 511 >= t0 + 8 * w + 7) attn_tile<0>(Kp, Vp, t2r, cfar, qf, qpos, j * 64, true, m_run, l_run, oacc, ql, hh);
        else attn_tile<2>(Kp, Vp, t2r, cfar, qf, qpos, j * 64, true, m_run, l_run, oacc, ql, hh);
        par ^= 1;
      }
      l_run += __shfl_xor(l_run, 32);
      const float sc = gt[16 + head] * (l_run > 0.f ? 1.f / l_run : 0.f);
#pragma unroll
      for (int dt = 0; dt < 2; ++dt)
#pragma unroll
        for (int i = 0; i < 16; ++i) of[dt][i] += sc * oacc[dt][i];
    }
#undef ATT_PREFETCH
#undef ATT_COMMIT
  }
  {
    const u16* za = (const u16*)(p.ws + W_ZA) + tok * 512 + head * 64; u16* oa = (u16*)(p.ws + W_OA) + tok * 512 + head * 64;
    uint2 zz[2][4];
#pragma unroll
    for (int dt = 0; dt < 2; ++dt)
#pragma unroll
      for (int q4 = 0; q4 < 4; ++q4) zz[dt][q4] = *(const uint2*)(za + 32 * dt + 8 * q4 + 4 * hh);
#pragma unroll
    for (int dt = 0; dt < 2; ++dt)
#pragma unroll
      for (int q4 = 0; q4 < 4; ++q4) {
        const int dd = 32 * dt + 8 * q4 + 4 * hh;
        const uint2 z = zz[dt][q4];
        uint2 o; o.x = pk2(of[dt][4 * q4] * bflo(z.x), of[dt][4 * q4 + 1] * bfhi(z.x)); o.y = pk2(of[dt][4 * q4 + 2] * bflo(z.y), of[dt][4 * q4 + 3] * bfhi(z.y));
        *(uint2*)(oa + dd) = o;
      }
  }
}
constexpr int P3_FIN = BATCH * 4 * 32;
constexpr int P3_ATT = BATCH * 2 * 32;
constexpr int P3_TOTAL = P3_FIN + P3_ATT;

constexpr int P4_TOTAL = 128 * 8 + 4 * 16;
template <int NI>
DI void merge_a_tile_t(const Params& p, int tm, int tn, char* lds) {
  f32x16 aa[2][NI], ab[2][NI]; zero_acc<NI>(aa); zero_acc<NI>(ab);
  gemm_glds<NI>(aa, (const u16*)(p.ws + W_OA) + (size_t)tm * 128 * 512, 512, (const u16*)(p.ws + W_WBAT) + (size_t)tn * 64 * NI * 512, 512, 8, lds);
  gemm_glds<NI>(ab, (const u16*)(p.ws + W_OB) + (size_t)tm * 128 * 512, 512, (const u16*)(p.ws + W_WBBT) + (size_t)tn * 64 * NI * 512, 512, 8, lds);
  const int tid = otid(), lane = tid & 63, wave = tid >> 6, wm = wave >> 1, wn = wave & 1, r = lane & 31, h = lane >> 5;
#pragma unroll
  for (int mi = 0; mi < 2; ++mi)
#pragma unroll
    for (int ni = 0; ni < NI; ++ni) {
      const int c = tn * 64 * NI + wn * 32 * NI + ni * 32 + r;
      u16 ga[16], gb[16];
#pragma unroll
      for (int i = 0; i < 16; ++i) { const size_t off = (size_t)(tm * 128 + wm * 64 + mi * 32 + crow(i, h)) * 1024 + c; ga[i] = ((const u16*)(p.ws + W_SA))[off]; gb[i] = ((const u16*)(p.ws + W_SB))[off]; }
#pragma unroll
      for (int i = 0; i < 16; ++i) {
        const size_t off = (size_t)(tm * 128 + wm * 64 + mi * 32 + crow(i, h)) * 1024 + c;
        ((u16*)(p.ws + W_Y))[off] = f2bf(bf2f(ga[i]) * aa[mi][ni][i] + bf2f(gb[i]) * ab[mi][ni][i]);
      }
    }
}
DI void merge_a_tile(const Params& p, int it, char* lds) {
  if (it < 1024) merge_a_tile_t<2>(p, it >> 3, it & 7, lds);
  else { it -= 1024; merge_a_tile_t<1>(p, 128 + (it >> 4), it & 15, lds); }
}
constexpr int P5_TOTAL = 128 * 8 + 4 * 16;
template <int NI>
DI void merge_b_tile_t(const Params& p, int tm, int tn, char* lds) {
  f32x16 acc[2][NI]; zero_acc<NI>(acc);
  gemm_glds<NI>(acc, (const u16*)(p.ws + W_Y) + (size_t)tm * 128 * 1024, 1024, (const u16*)(p.ws + W_WOUTT) + (size_t)tn * 64 * NI * 1024, 1024, 16, lds);
  const int tid = otid(), lane = tid & 63, wave = tid >> 6, wm = wave >> 1, wn = wave & 1, r = lane & 31, h = lane >> 5;
  const float* xin = (tm < 128) ? p.x_prompt : (p.x_sample - (size_t)NTP * 1024);
#pragma unroll
  for (int mi = 0; mi < 2; ++mi) {
    float xv[16][NI];
#pragma unroll
    for (int i = 0; i < 16; ++i)
#pragma unroll
      for (int ni = 0; ni < NI; ++ni) xv[i][ni] = xin[(size_t)(tm * 128 + wm * 64 + mi * 32 + crow(i, h)) * 1024 + tn * 64 * NI + wn * 32 * NI + ni * 32 + r];
#pragma unroll
    for (int i = 0; i < 16; ++i) {
      const size_t row = (size_t)(tm * 128 + wm * 64 + mi * 32 + crow(i, h));
#pragma unroll
      for (int ni = 0; ni < NI; ++ni) {
        const int c = tn * 64 * NI + wn * 32 * NI + ni * 32 + r;
        p.out[row * 1024 + c] = acc[mi][ni][i] + xv[i][ni];
      }
    }
  }
}
DI void merge_b_tile(const Params& p, int it, char* lds) {
  if (it < 1024) merge_b_tile_t<2>(p, it >> 3, it & 7, lds);
  else { it -= 1024; merge_b_tile_t<1>(p, 128 + (it >> 4), it & 15, lds); }
}
constexpr int P6_TOTAL = NT / 8;
DI void final_norm_item(const Params& p, int it) {
  const int tid_ = otid(), lane = tid_ & 63, wave = tid_ >> 6; const size_t row = (size_t)it * 8 + wave * 2;
  float* o = p.out + row * 1024;
  float4 v[2][4]; float ss[2] = {0.f, 0.f};
#pragma unroll
  for (int rr = 0; rr < 2; ++rr)
#pragma unroll
    for (int i = 0; i < 4; ++i) v[rr][i] = *(const float4*)(o + rr * 1024 + (i * 64 + lane) * 4);
#pragma unroll
  for (int rr = 0; rr < 2; ++rr) {
#pragma unroll
    for (int i = 0; i < 4; ++i) ss[rr] += v[rr][i].x * v[rr][i].x + v[rr][i].y * v[rr][i].y + v[rr][i].z * v[rr][i].z + v[rr][i].w * v[rr][i].w;
    ss[rr] = wave_sum(ss[rr]);
  }
#pragma unroll
  for (int rr = 0; rr < 2; ++rr) {
    const float rs = rsqrtf(ss[rr] * (1.f / 1024.f) + 1e-6f);
#pragma unroll
    for (int i = 0; i < 4; ++i) {
      const float4 gg = *(const float4*)(p.final_g + (i * 64 + lane) * 4);
      *(float4*)(o + rr * 1024 + (i * 64 + lane) * 4) = make_float4(v[rr][i].x * rs * gg.x, v[rr][i].y * rs * gg.y, v[rr][i].z * rs * gg.z, v[rr][i].w * rs * gg.w);
    }
  }
}

namespace pg8 {
#define PG8_LAS __attribute__((address_space(3)))
typedef unsigned short bf16_t;
typedef short bf16x8 __attribute__((ext_vector_type(8)));
typedef float f32x4 __attribute__((ext_vector_type(4)));
typedef unsigned u32x4 __attribute__((ext_vector_type(4)));
constexpr int BM = 256, BK = 64, HALF = 128, HTB = HALF * BK * 2  , STAGE_BYTES = 8 * HTB, NXCD = 8, WGM = 8;

__host__ __device__ __forceinline__ int lds_byte(int r, int c) { const int st = (r >> 4) * 2 + (c >> 5), rr = r & 15, cc = c & 31, ob = rr * 64 + cc * 2; return st * 1024 + (ob ^ (((ob >> 9) & 1) << 5)); }
__host__ __device__ __forceinline__ void stage_rc(int b, int& R, int& C) { const int st = b / 1024, sb = b % 1024, swz = sb ^ (((sb >> 9) & 1) << 5); R = (st >> 1) * 16 + swz / 64; C = (st & 1) * 32 + (swz % 64) / 2; }
__host__ __device__ __forceinline__ int perm32(int rho) { const int n = rho >> 4, i = rho & 15; return 8 * (i >> 2) + 4 * n + (i & 3); }

struct Unit { int pm, pn; };
struct Gemm { const bf16_t* A; const bf16_t* Bt; int M, N, K; };

struct StaticOrder {
    int nM, nN, nwg, G, c;
    __host__ __device__ void init(int M, int N, int G_, int c_) { nM = M / BM; nN = N / BM; nwg = nM * nN; G = G_; c = c_; }
    __host__ __device__ bool next(int i, Unit& u) const {
        const long L = (long)i * G + c; if (L >= nwg) return false;
        int wgid = (int)L; { const int q = nwg / NXCD, r = nwg % NXCD, xcd = wgid % NXCD, off = wgid / NXCD; wgid = (xcd < r ? xcd * (q + 1) : r * (q + 1) + (xcd - r) * q) + off; }
        const int nig = WGM * nN, gid = wgid / nig, fm = gid * WGM, gsz = (nM - fm) < WGM ? (nM - fm) : WGM;
        u.pm = fm + ((wgid % nig) % gsz); u.pn = (wgid % nig) / gsz; return true;
    }
    __device__ __forceinline__ void a_ready(const Unit&) const {}
    __device__ __forceinline__ void done(const Unit&) const {}
};

template <class Epi, class Sched, bool STAMP = false>
__device__ __forceinline__ void gemm_phase(PG8_LAS unsigned char* lds, const Gemm g, const Sched& S, const Epi& E, unsigned long long* stamps) {
    int tid_ = threadIdx.x; asm volatile("" : "+v"(tid_));
    const int tid = tid_, wid = __builtin_amdgcn_readfirstlane(tid >> 6), lane = tid & 63, wr = wid >> 2, wc = wid & 3, fr = lane & 15, fq = lane >> 4;
    const int K = g.K, nt = K / BK;
    int ts_lo = 0, ts_hi = 0, nts = 0; const unsigned long long rt_entry = STAMP ? (unsigned long long)wall_clock64() : 0ull;
#define PG8_STAMP() do { if (STAMP && wid == 0 && nts < 64) { const unsigned long long _c = (unsigned long long)clock64(); \
        ts_lo = (lane == nts) ? (int)(unsigned)_c : ts_lo; ts_hi = (lane == nts) ? (int)(unsigned)(_c >> 32) : ts_hi; ++nts; } } while (0)
    PG8_STAMP();
    unsigned voffA[2], voffB[2];
#pragma unroll
    for (int i = 0; i < 2; ++i) { int R, C; stage_rc(tid * 16 + i * 8192, R, C); const int Rb = Epi::PERM ? ((R & ~31) + perm32(R & 31)) : R;
        voffA[i] = (unsigned)(R * K + C) * 2u; voffB[i] = (unsigned)(Rb * K + C) * 2u; }
    const size_t kstep = (size_t)(BK * 2);
    const size_t hstep = (size_t)HALF * K * 2;
    const size_t tstep = 2 * hstep;
    const unsigned ldsw = (unsigned)wid * 1024u;
    const int aoff = lds_byte(wr * 64 + fr, fq * 8), boff = lds_byte(wc * 32 + fr, fq * 8);
#define PG8_SA(b, h) (((b) * 2 + (h)) * HTB)
#define PG8_SB(b, h) ((4 + (b) * 2 + (h)) * HTB)
#define PG8_STAGE(bufoff, gbase, voff) do { _Pragma("unroll") for (int _i = 0; _i < 2; ++_i) \
        __builtin_amdgcn_global_load_lds((const unsigned*)((const char*)(gbase) + (voff)[_i]), (PG8_LAS unsigned*)(lds + (bufoff) + ldsw + _i * 8192), 16, 0, 0); } while (0)
#define PG8_LDA(dst, b, h) do { _Pragma("unroll") for (int m = 0; m < 4; ++m) _Pragma("unroll") for (int k = 0; k < 2; ++k) dst[m][k] = *(const PG8_LAS bf16x8*)(lds + PG8_SA(b, h) + aoff + m * 2048 + k * 1024); } while (0)
#define PG8_LDB(dst, b, h) do { _Pragma("unroll") for (int n = 0; n < 2; ++n) _Pragma("unroll") for (int k = 0; k < 2; ++k) dst[n][k] = *(const PG8_LAS bf16x8*)(lds + PG8_SB(b, h) + boff + n * 2048 + k * 1024); } while (0)
#define PG8_MMA(ai, bj, At, Bt) do { __builtin_amdgcn_s_setprio(1); _Pragma("unroll") for (int m = 0; m < 4; ++m) _Pragma("unroll") for (int n = 0; n < 2; ++n) _Pragma("unroll") for (int k = 0; k < 2; ++k) \
        acc[ai][bj][m][n] = __builtin_amdgcn_mfma_f32_16x16x32_bf16(Bt[n][k], At[m][k], acc[ai][bj][m][n], 0, 0, 0); __builtin_amdgcn_s_setprio(0); } while (0)
#define PG8_WAIT_V(n) asm volatile("s_waitcnt vmcnt(" #n ")" ::: "memory")
#define PG8_WAIT_L(n) asm volatile("s_waitcnt lgkmcnt(" #n ")" ::: "memory")
#define PG8_BAR __builtin_amdgcn_s_barrier()
#define PG8_SCHED __builtin_amdgcn_sched_barrier(0)
    Unit cur, nxt; int ui = 0;
    if (!S.next(0, cur)) return;
    f32x4 acc[2][2][4][2];
#pragma unroll
    for (int a = 0; a < 2; ++a)
#pragma unroll
        for (int b = 0; b < 2; ++b)
#pragma unroll
            for (int m = 0; m < 4; ++m)
#pragma unroll
                for (int n = 0; n < 2; ++n) acc[a][b][m][n] = (f32x4){0.f, 0.f, 0.f, 0.f};
    bf16x8 At[4][2], B0[2][2], B1[2][2];
    const char* cA = (const char*)g.A + (size_t)cur.pm * tstep; const char* cB = (const char*)g.Bt + (size_t)cur.pn * tstep;
    S.a_ready(cur);
    PG8_STAGE(PG8_SB(0, 0), cB, voffB); PG8_STAGE(PG8_SA(0, 0), cA, voffA); PG8_STAGE(PG8_SB(0, 1), cB + hstep, voffB); PG8_STAGE(PG8_SA(0, 1), cA + hstep, voffA);
    if (wr == 1) PG8_BAR;
    PG8_WAIT_V(4); PG8_BAR;
    PG8_STAGE(PG8_SB(1, 0), cB + kstep, voffB); PG8_STAGE(PG8_SA(1, 0), cA + kstep, voffA); PG8_STAGE(PG8_SB(1, 1), cB + hstep + kstep, voffB);
    PG8_WAIT_V(6); PG8_BAR;
    PG8_STAMP();
    for (;;) {
        const bool has_next = S.next(ui + 1, nxt);
        const char* nA = has_next ? (const char*)g.A + (size_t)nxt.pm * tstep : cA; const char* nB = has_next ? (const char*)g.Bt + (size_t)nxt.pn * tstep : cB;
        for (int t = 0; t < nt; t += 2) {
            const bool last = (t == nt - 2);
            const char* a1 = cA + (size_t)(t + 1) * kstep;
            const char* a2 = last ? nA : cA + (size_t)(t + 2) * kstep; const char* b2 = last ? nB : cB + (size_t)(t + 2) * kstep;
            const char* a3 = a2 + kstep; const char* b3 = b2 + kstep;
            if (last && has_next) S.a_ready(nxt);
            PG8_LDB(B0, 0, 0); PG8_SCHED; PG8_LDA(At, 0, 0); PG8_STAGE(PG8_SA(1, 1), a1 + hstep, voffA);
            PG8_WAIT_L(8); PG8_BAR; PG8_WAIT_L(0); PG8_MMA(0, 0, At, B0); PG8_BAR; PG8_SCHED;
            PG8_LDB(B1, 0, 1); PG8_STAGE(PG8_SB(0, 0), b2, voffB);
            PG8_BAR; PG8_WAIT_L(0); PG8_MMA(0, 1, At, B1); PG8_BAR;
            PG8_LDA(At, 0, 1); PG8_STAGE(PG8_SA(0, 0), a2, voffA);
            PG8_BAR; PG8_WAIT_L(0); PG8_MMA(1, 0, At, B0); PG8_BAR; PG8_SCHED;
            PG8_STAGE(PG8_SB(0, 1), b2 + hstep, voffB);
            PG8_WAIT_V(6); PG8_BAR; PG8_MMA(1, 1, At, B1); PG8_BAR;
            PG8_LDB(B0, 1, 0); PG8_SCHED; PG8_LDA(At, 1, 0); PG8_STAGE(PG8_SA(0, 1), a2 + hstep, voffA);
            PG8_WAIT_L(8); PG8_BAR; PG8_WAIT_L(0); PG8_MMA(0, 0, At, B0); PG8_BAR; PG8_SCHED;
            PG8_LDB(B1, 1, 1); PG8_STAGE(PG8_SB(1, 0), b3, voffB);
            PG8_BAR; PG8_WAIT_L(0); PG8_MMA(0, 1, At, B1); PG8_BAR;
            PG8_LDA(At, 1, 1); PG8_STAGE(PG8_SA(1, 0), a3, voffA);
            PG8_BAR; PG8_WAIT_L(0); PG8_MMA(1, 0, At, B0); PG8_BAR; PG8_SCHED;
            PG8_STAGE(PG8_SB(1, 1), b3 + hstep, voffB);
            PG8_WAIT_V(6); PG8_BAR; PG8_MMA(1, 1, At, B1); PG8_BAR;
        }
        PG8_STAMP();
        if constexpr (!Epi::AFTER_DRAIN) { E(acc, cur, wr, wc, fr, fq); S.done(cur); }
        PG8_STAMP();
        if (!has_next) break;
#pragma unroll
        for (int a = 0; a < 2; ++a)
#pragma unroll
            for (int b = 0; b < 2; ++b)
#pragma unroll
                for (int m = 0; m < 4; ++m)
#pragma unroll
                    for (int n = 0; n < 2; ++n) acc[a][b][m][n] = (f32x4){0.f, 0.f, 0.f, 0.f};
        cur = nxt; cA = nA; cB = nB; ++ui;
    }
    PG8_WAIT_V(0);
    if (wr == 0) PG8_BAR;
    PG8_BAR;
    if constexpr (Epi::AFTER_DRAIN) { E.fused(acc, cur, wr, wc, fr, fq, lds, wid, lane); S.done(cur); }
    PG8_STAMP();
    if (STAMP && wid == 0) { stamps[lane] = lane < nts ? (((unsigned long long)(unsigned)ts_hi << 32) | (unsigned)ts_lo) : 0ull;
        if (lane == 62) stamps[62] = rt_entry; if (lane == 63) stamps[63] = (unsigned long long)wall_clock64(); }
#undef PG8_STAMP
#undef PG8_SA
#undef PG8_SB
#undef PG8_STAGE
#undef PG8_LDA
#undef PG8_LDB
#undef PG8_MMA
#undef PG8_WAIT_V
#undef PG8_WAIT_L
#undef PG8_BAR
#undef PG8_SCHED
}
}


DI uint4 pack8f(const float (&v)[8]) { uint4 u; u.x = pk2(v[0], v[1]); u.y = pk2(v[2], v[3]); u.z = pk2(v[4], v[5]); u.w = pk2(v[6], v[7]); return u; }
struct EpiProj {
  static constexpr bool PERM = true, AFTER_DRAIN = false;
  Params p;
#define EPI_ROWS(BODY) _Pragma("unroll") for (int ai = 0; ai < 2; ++ai) _Pragma("unroll") for (int m = 0; m < 4; ++m) { \
      const size_t row = (size_t)(u.pm * 256 + ai * 128 + wr * 64 + m * 16 + fr); float v[8]; \
      _Pragma("unroll") for (int j = 0; j < 4; ++j) { v[j] = acc[ai][bj][m][0][j]; v[4 + j] = acc[ai][bj][m][1][j]; } BODY }
  DI void operator()(const pg8::f32x4 (&acc)[2][2][4][2], const pg8::Unit& u, int wr, int wc, int fr, int fq) const {
    const bool samp = u.pm >= NTP / 256;
#pragma unroll
    for (int bj = 0; bj < 2; ++bj) {
      const int tn = 2 * u.pn + bj;
      const int c = wc * 32 + 8 * fq;
      if (tn < 4) {
        u16* d = (u16*)(p.ws + W_Q) + tn * 128 + c;
        EPI_ROWS({ _Pragma("unroll") for (int j = 0; j < 8; ++j) v[j] *= 0.125f * LOG2E; *(uint4*)(d + row * 512) = pack8f(v); })
      } else if (tn < 10) {
        const int kvg = tn - 4;
        u16* d = (u16*)(p.ws + W_KV) + (size_t)kvg * NT * 128 + c;
        if (!samp) {
          if (kvg < 4) {
            float* o = p.out + O_PCK + (size_t)kvg * NTP * 128 + c;
            EPI_ROWS({ *(uint4*)(d + row * 128) = pack8f(v); float* q_ = o + row * 128; *(float4*)q_ = make_float4(v[0], v[1], v[2], v[3]); *(float4*)(q_ + 4) = make_float4(v[4], v[5], v[6], v[7]); })
          } else if ((u.pm & 7) >= 6) {
            float* o = p.out + O_PWK + (size_t)(kvg - 4) * BATCH * 512 * 128 + c;
            EPI_ROWS({ *(uint4*)(d + row * 128) = pack8f(v); const size_t wr_ = (row >> 11) * 512 + (row & 2047) - 1536;
                       float* q_ = o + wr_ * 128; *(float4*)q_ = make_float4(v[0], v[1], v[2], v[3]); *(float4*)(q_ + 4) = make_float4(v[4], v[5], v[6], v[7]); })
          } else {
            EPI_ROWS({ *(uint4*)(d + row * 128) = pack8f(v); })
          }
        } else {
          float* o = (kvg < 4) ? (p.out + O_SCK + (size_t)kvg * NTS * 128 + c) : (p.out + O_SWK + (size_t)(kvg - 4) * DEC_BATCH * 512 * 128 + c);
          const bool win = kvg >= 4;
          EPI_ROWS({ *(uint4*)(d + row * 128) = pack8f(v); const size_t sr = row - NTP; const size_t orow = win ? ((sr >> 2) * 512 + 508 + (sr & 3)) : sr;
                     float* q_ = o + orow * 128; *(float4*)q_ = make_float4(v[0], v[1], v[2], v[3]); *(float4*)(q_ + 4) = make_float4(v[4], v[5], v[6], v[7]); })
        }
      } else if (tn < 14 || (tn >= 26 && tn < 30)) {
        u16* d = (u16*)(p.ws + (tn < 14 ? W_ZA : W_ZB)) + (tn < 14 ? tn - 10 : tn - 26) * 128 + c;
        EPI_ROWS({ _Pragma("unroll") for (int j = 0; j < 8; ++j) v[j] = siluf_(v[j]); *(uint4*)(d + row * 512) = pack8f(v); })
      } else if (tn < 18 || (tn >= 22 && tn < 26)) {
        u16* d = (u16*)(p.ws + (tn < 18 ? W_QB : W_VB)) + (tn < 18 ? tn - 14 : tn - 22) * 128 + c;
        EPI_ROWS({ *(uint4*)(d + row * 512) = pack8f(v); })
      } else if (tn < 22) {
        float lb[8], ol[8];
#pragma unroll
        for (int j = 0; j < 8; ++j) { const int cc = (tn - 18) * 128 + c + j; lb[j] = __builtin_amdgcn_rcpf(1.f + __expf(p.hg_lower[512 + cc] - p.hg_lower[cc])); ol[j] = 1.f - lb[j]; }
        float* dg = (float*)(p.ws + W_GB) + (tn - 18) * 128 + c; u16* dk = (u16*)(p.ws + W_KB) + (tn - 18) * 128 + c;
        EPI_ROWS({ float gg[8]; float kk[8];
                   _Pragma("unroll") for (int j = 0; j < 8; ++j) { const float sg = sigmoidf_(v[j]); gg[j] = __logf(lb[j] + ol[j] * sg); kk[j] = ol[j] * (1.f - sg); }
                   float* q_ = dg + row * 512; *(float4*)q_ = make_float4(gg[0], gg[1], gg[2], gg[3]); *(float4*)(q_ + 4) = make_float4(gg[4], gg[5], gg[6], gg[7]);
                   *(uint4*)(dk + row * 512) = pack8f(kk); })
      } else if (tn < 46) {
        u16* d = (u16*)(p.ws + (tn < 38 ? W_SA : W_SB)) + (tn < 38 ? tn - 30 : tn - 38) * 128 + c;
        EPI_ROWS({ _Pragma("unroll") for (int j = 0; j < 8; ++j) v[j] = sigmoidf_(v[j]); *(uint4*)(d + row * 1024) = pack8f(v); })
      } else if (tn == 46 && c < 24) {
        float* d = (float*)(p.ws + W_GATE) + c;
        EPI_ROWS({ float* q_ = d + row * 24; *(float4*)q_ = make_float4(sigmoidf_(v[0]), sigmoidf_(v[1]), sigmoidf_(v[2]), sigmoidf_(v[3]));
                   *(float4*)(q_ + 4) = make_float4(sigmoidf_(v[4]), sigmoidf_(v[5]), sigmoidf_(v[6]), sigmoidf_(v[7])); })
      }
    }
  }
#undef EPI_ROWS
};

struct EpiOut {
  static constexpr bool PERM = false, AFTER_DRAIN = false;
  const float* x; float* out;
  DI void operator()(const pg8::f32x4 (&acc)[2][2][4][2], const pg8::Unit& u, int wr, int wc, int fr, int fq) const {
#pragma unroll
    for (int ai = 0; ai < 2; ++ai)
#pragma unroll
      for (int mh = 0; mh < 2; ++mh) {
        float4 xv[2][2][2];
#pragma unroll
        for (int m2 = 0; m2 < 2; ++m2)
#pragma unroll
          for (int bj = 0; bj < 2; ++bj)
#pragma unroll
            for (int n = 0; n < 2; ++n) {
              const size_t off = (size_t)(u.pm * 256 + ai * 128 + wr * 64 + (2 * mh + m2) * 16 + fr) * 1024 + u.pn * 256 + wc * 32 + 4 * fq + bj * 128 + n * 16;
              xv[m2][bj][n] = *(const float4*)(x + off);
            }
#pragma unroll
        for (int m2 = 0; m2 < 2; ++m2)
#pragma unroll
          for (int bj = 0; bj < 2; ++bj)
#pragma unroll
            for (int n = 0; n < 2; ++n) {
              const int m = 2 * mh + m2;
              const size_t off = (size_t)(u.pm * 256 + ai * 128 + wr * 64 + m * 16 + fr) * 1024 + u.pn * 256 + wc * 32 + 4 * fq + bj * 128 + n * 16;
              const float4 xq = xv[m2][bj][n];
              *(float4*)(out + off) = make_float4(acc[ai][bj][m][n][0] + xq.x, acc[ai][bj][m][n][1] + xq.y, acc[ai][bj][m][n][2] + xq.z, acc[ai][bj][m][n][3] + xq.w);
            }
      }
  }
};

template <bool SECOND>
struct EpiMerge {
  static constexpr bool PERM = true, AFTER_DRAIN = false;
  const u16* gate; u16* Y;
  DI void operator()(const pg8::f32x4 (&acc)[2][2][4][2], const pg8::Unit& u, int wr, int wc, int fr, int fq) const {
#pragma unroll
    for (int ai = 0; ai < 2; ++ai) {
      uint4 gv[4][2], yv[4][2];
#pragma unroll
      for (int m = 0; m < 4; ++m)
#pragma unroll
        for (int bj = 0; bj < 2; ++bj) {
          const size_t off = (size_t)(u.pm * 256 + ai * 128 + wr * 64 + m * 16 + fr) * 1024 + u.pn * 256 + wc * 32 + 8 * fq + bj * 128;
          gv[m][bj] = *(const uint4*)(gate + off);
          if (SECOND) yv[m][bj] = *(const uint4*)(Y + off);
        }
#pragma unroll
      for (int m = 0; m < 4; ++m)
#pragma unroll
        for (int bj = 0; bj < 2; ++bj) {
          const size_t off = (size_t)(u.pm * 256 + ai * 128 + wr * 64 + m * 16 + fr) * 1024 + u.pn * 256 + wc * 32 + 8 * fq + bj * 128;
          const uint4 g4 = gv[m][bj];
          float v[8];
          v[0] = bflo(g4.x) * acc[ai][bj][m][0][0]; v[1] = bfhi(g4.x) * acc[ai][bj][m][0][1]; v[2] = bflo(g4.y) * acc[ai][bj][m][0][2]; v[3] = bfhi(g4.y) * acc[ai][bj][m][0][3];
          v[4] = bflo(g4.z) * acc[ai][bj][m][1][0]; v[5] = bfhi(g4.z) * acc[ai][bj][m][1][1]; v[6] = bflo(g4.w) * acc[ai][bj][m][1][2]; v[7] = bfhi(g4.w) * acc[ai][bj][m][1][3];
          if (SECOND) {
            const uint4 y4 = yv[m][bj];
            v[0] += bflo(y4.x); v[1] += bfhi(y4.x); v[2] += bflo(y4.y); v[3] += bfhi(y4.y); v[4] += bflo(y4.z); v[5] += bfhi(y4.z); v[6] += bflo(y4.w); v[7] += bfhi(y4.w);
          }
          *(uint4*)(Y + off) = pack8f(v);
        }
    }
  }
};

#define XB_TMO      128
#define XB_XCNT(j)  (256  + 64 * (j))
#define XB_XSUB(j)  (1280 + 64 * (j))
#define XB_XGEN(j)  (2304 + 64 * (j))
#define XB_TOP      3328
#define XB_TOPGEN   3392
#define XCD_BAR_WORDS 3456
#define XB_SPIN_CAP (1u << 18)
#define LAS __attribute__((address_space(3)))
DI unsigned xb_ld(unsigned* p)              { return __hip_atomic_load(p, __ATOMIC_RELAXED, __HIP_MEMORY_SCOPE_AGENT); }
DI unsigned xb_add(unsigned* p, unsigned v) { return __hip_atomic_fetch_add(p, v, __ATOMIC_RELAXED, __HIP_MEMORY_SCOPE_AGENT); }
DI unsigned xb_xcc_id() { return (unsigned)__builtin_amdgcn_s_getreg((3 << 11) | 20) & 0xFu; }
#define XB_SPIN(cond, bar) do { unsigned _sp = 0; while (cond) { __builtin_amdgcn_s_sleep(1); \
    if ((++_sp & 255u) == 0u) { if (xb_ld(&(bar)[XB_TMO])) break; if (_sp > XB_SPIN_CAP) { atomicAdd(&(bar)[XB_TMO], 1u); break; } } } } while (0)
struct XcdBarrier { unsigned* bar; unsigned x; volatile LAS unsigned* st; };
DI XcdBarrier xcd_barrier_post(unsigned* bar, volatile LAS unsigned* st) {
  XcdBarrier b; b.bar = bar; b.x = xb_xcc_id(); b.st = st;
  if (threadIdx.x == 0) (void)xb_add(&bar[XB_XCNT(b.x)], 1u);
  return b;
}
DI void xcd_barrier_complete(unsigned* bar, unsigned x, unsigned& nloc, unsigned& nx) {
  const unsigned G = gridDim.x * gridDim.y * gridDim.z;
  unsigned sum, cnt, mine, sp = 0u;
  for (;;) {
    sum = 0u; cnt = 0u; mine = 0u;
#pragma unroll
    for (unsigned j = 0; j < 16; ++j) { const unsigned c = xb_ld(&bar[XB_XCNT(j)]); sum += c; cnt += (c > 0u) ? 1u : 0u; mine = (j == x) ? c : mine; }
    if (sum == G) break;
    __builtin_amdgcn_s_sleep(1);
    if ((++sp & 255u) == 0u) { if (xb_ld(&bar[XB_TMO])) break; if (sp > XB_SPIN_CAP) { atomicAdd(&bar[XB_TMO], 1u); break; } }
  }
  nloc = mine > 0u ? mine : 1u; nx = cnt > 0u ? cnt : 1u;
}
DI void xcd_barrier(XcdBarrier& b) {
  asm volatile("s_waitcnt vmcnt(0)" ::: "memory");
  __syncthreads();
  if (threadIdx.x == 0) {
    unsigned* bar = b.bar;
    __builtin_amdgcn_s_waitcnt(0);
    unsigned nloc = b.st[0], nx = b.st[1];
    if (nloc == 0u) { xcd_barrier_complete(bar, b.x, nloc, nx); b.st[0] = nloc; b.st[1] = nx; }
    const unsigned old = xb_add(&bar[XB_XSUB(b.x)], 1u);
    const unsigned gen = old / nloc;
    if (old + 1u == (gen + 1u) * nloc) {
      __builtin_amdgcn_fence(__ATOMIC_RELEASE, "agent");
      asm volatile("s_waitcnt vmcnt(0)" ::: "memory");
      const unsigned og = xb_add(&bar[XB_TOP], 1u);
      const unsigned tg = og / nx;
      if (og + 1u == (tg + 1u) * nx) xb_add(&bar[XB_TOPGEN], 1u);
      else XB_SPIN(xb_ld(&bar[XB_TOPGEN]) == tg, bar);
      __builtin_amdgcn_fence(__ATOMIC_ACQUIRE, "agent");
      xb_add(&bar[XB_XGEN(b.x)], 1u);
      asm volatile("s_waitcnt vmcnt(0)" ::: "memory");
    } else {
      XB_SPIN(xb_ld(&bar[XB_XGEN(b.x)]) == gen, bar);
      __builtin_amdgcn_fence(__ATOMIC_ACQUIRE, "agent");
      asm volatile("s_waitcnt vmcnt(0)" ::: "memory");
    }
  }
  __syncthreads();
}


template <int PH>
DI void run_phase(const Params& p, char* lds_all) {
  const int half = __builtin_amdgcn_readfirstlane(threadIdx.x >> 8);
  const int vb = blockIdx.x * 2 + half, nvb = gridDim.x * 2;
  char* lds = lds_all + half * 65536;
  if (PH == 0) { for (int it = vb; it < P0_TOTAL; it += nvb) phase0_item(p, it, lds); }
  if (PH == 1) {
    for (int it = vb; it < P1_CMP; it += nvb) phase1_item(p, it, lds);
    __syncthreads();
    pg8::StaticOrder S; S.init(NT, NPAD, gridDim.x, blockIdx.x);
    const pg8::Gemm gm{(const pg8::bf16_t*)(p.ws + W_XN), (const pg8::bf16_t*)(p.ws + W_WINT), NT, NPAD, 1024};
    const EpiProj E{p};
    pg8::gemm_phase<EpiProj, pg8::StaticOrder, false>((PG8_LAS unsigned char*)lds_all, gm, S, E, nullptr);
  }
  if (PH == 2) {
    volatile LAS unsigned* wq = (volatile LAS unsigned*)(lds_all + 128 * 1024 + 8);
    unsigned* ctr = (unsigned*)(p.ws + W_BAR);
    for (;;) {
      __syncthreads();
      if (threadIdx.x == 0) wq[0] = __hip_atomic_fetch_add(ctr, 1u, __ATOMIC_RELAXED, __HIP_MEMORY_SCOPE_AGENT);
      __syncthreads();
      const unsigned pr = wq[0];
      if (pr >= (unsigned)(P2_TOTAL / 2)) break;
      phase2_item(p, (int)pr * 2 + half, lds);
    }
  }
  if (PH == 7) { for (int it = vb; it < H2_ITEMS; it += nvb) hgrn_h2_item(p, it); }
  if (PH == 3) {
    for (int it = vb; it < P3_FIN; it += nvb) hgrn_h3_item(p, it);
    for (int it = blockIdx.x; it < P3_ATT; it += gridDim.x) prompt_attn_item(p, it, lds_all);
  }
  if (PH == 4) {
    for (int it = vb; it < 64; it += nvb) merge_a_tile_t<1>(p, 128 + (it >> 4), it & 15, lds);
    __syncthreads();
    pg8::StaticOrder S; S.init(NTP, 1024, gridDim.x, blockIdx.x);
    { const pg8::Gemm gm{(const pg8::bf16_t*)(p.ws + W_OA), (const pg8::bf16_t*)(p.ws + W_WBAT), NTP, 1024, 512};
      const EpiMerge<false> E{(const u16*)(p.ws + W_SA), (u16*)(p.ws + W_Y)};
      pg8::gemm_phase<EpiMerge<false>, pg8::StaticOrder, false>((PG8_LAS unsigned char*)lds_all, gm, S, E, nullptr); }
    { const pg8::Gemm gm{(const pg8::bf16_t*)(p.ws + W_OB), (const pg8::bf16_t*)(p.ws + W_WBBT), NTP, 1024, 512};
      const EpiMerge<true> E{(const u16*)(p.ws + W_SB), (u16*)(p.ws + W_Y)};
      pg8::gemm_phase<EpiMerge<true>, pg8::StaticOrder, false>((PG8_LAS unsigned char*)lds_all, gm, S, E, nullptr); }
  }
  if (PH == 5) {
    for (int it = vb; it < 64; it += nvb) merge_b_tile_t<1>(p, 128 + (it >> 4), it & 15, lds);
    __syncthreads();
    pg8::StaticOrder S; S.init(NTP, 1024, gridDim.x, blockIdx.x);
    const pg8::Gemm gm{(const pg8::bf16_t*)(p.ws + W_Y), (const pg8::bf16_t*)(p.ws + W_WOUTT), NTP, 1024, 1024};
    const EpiOut E{p.x_prompt, p.out};
    pg8::gemm_phase<EpiOut, pg8::StaticOrder, false>((PG8_LAS unsigned char*)lds_all, gm, S, E, nullptr);
  }
  if (PH == 6) { for (int it = vb; it < P6_TOTAL; it += nvb) final_norm_item(p, it); }
}

constexpr int LDS_DYN = 128 * 1024 + 16;
__global__ void __launch_bounds__(512, 2) k_mega(Params p) {
  extern __shared__ __attribute__((aligned(16))) char lds[];
  volatile LAS unsigned* st = (volatile LAS unsigned*)(lds + 128 * 1024);
  if (threadIdx.x == 0) { st[0] = 0u; st[1] = 0u; }
  __syncthreads();
  XcdBarrier bar = xcd_barrier_post((unsigned*)(p.ws + W_BAR), st);
  run_phase<0>(p, lds); xcd_barrier(bar);
  run_phase<1>(p, lds); xcd_barrier(bar);
  run_phase<2>(p, lds); xcd_barrier(bar);
  run_phase<7>(p, lds); xcd_barrier(bar);
  run_phase<3>(p, lds); xcd_barrier(bar);
  run_phase<4>(p, lds); xcd_barrier(bar);
  run_phase<5>(p, lds); xcd_barrier(bar);
  run_phase<6>(p, lds);
}

extern "C" void kernel_launch(void* const* d_in, const int* in_sizes, int n_in, void* d_out, int out_size,
                              void* d_ws, size_t ws_size, hipStream_t stream) {
  Params p{};
  p.x_prompt = (const float*)d_in[0]; p.x_sample = (const float*)d_in[1];
  p.cck = (const float*)d_in[2]; p.ccv = (const float*)d_in[3]; p.csk = (const float*)d_in[4]; p.csv = (const float*)d_in[5];
  p.swk = (const float*)d_in[6]; p.swv = (const float*)d_in[7]; p.shg = (const float*)d_in[8]; p.pt = (const int*)d_in[9];
  p.norm_g = (const float*)d_in[10]; p.w_in = (const float*)d_in[11];
  p.pos_k = (const float*)d_in[12]; p.w1_k = (const float*)d_in[13]; p.w2_k = (const float*)d_in[14];
  p.pos_v = (const float*)d_in[15]; p.w1_v = (const float*)d_in[16]; p.w2_v = (const float*)d_in[17];
  p.rel_bias = (const float*)d_in[18]; p.hg_lower = (const float*)d_in[19]; p.hg_norm_g = (const float*)d_in[20];
  p.w_ba = (const float*)d_in[21]; p.w_bb = (const float*)d_in[22]; p.w_out = (const float*)d_in[23]; p.final_g = (const float*)d_in[24];
  p.out = (float*)d_out; p.ws = (char*)d_ws;
  if ((size_t)out_size != O_END || ws_size < W_END) { fprintf(stderr, "kernel_launch: unexpected sizes out=%d ws=%zu (need %zu / %zu)\n", out_size, ws_size, (size_t)O_END, (size_t)W_END); return; }
  static int grid_blocks = 0;
  if (!grid_blocks) {
    int dev = 0, cus = 0, per_cu = 0;
    hipGetDevice(&dev);
    hipDeviceGetAttribute(&cus, hipDeviceAttributeMultiprocessorCount, dev);
    hipFuncSetAttribute((const void*)k_mega, hipFuncAttributeMaxDynamicSharedMemorySize, LDS_DYN);
    hipOccupancyMaxActiveBlocksPerMultiprocessor(&per_cu, k_mega, 512, LDS_DYN);
    if (per_cu < 1) fprintf(stderr, "kernel_launch: occupancy query reports %d blocks per CU\n", per_cu);
    grid_blocks = cus;
  }
  hipMemsetAsync((char*)d_ws + W_BAR, 0, XCD_BAR_WORDS * 4, stream);
  void* args[] = {&p};
  hipError_t e = hipLaunchCooperativeKernel((void*)k_mega, dim3(grid_blocks), dim3(512), args, LDS_DYN, stream);
  if (e != hipSuccess) fprintf(stderr, "cooperative launch failed: %s (grid %d)\n", hipGetErrorString(e), grid_blocks);
}
```

```cpp
#include <hip/hip_runtime.h>
#include <hip/hip_cooperative_groups.h>
#include <cstdio>
namespace cg = cooperative_groups;

#define DI __device__ __forceinline__
typedef unsigned short u16;
typedef __attribute__((ext_vector_type(8))) short bf16x8;
typedef __attribute__((ext_vector_type(4))) short s16x4;
typedef __attribute__((ext_vector_type(16))) float f32x16;
typedef __attribute__((ext_vector_type(4))) float f32x4;
typedef __attribute__((ext_vector_type(2))) float f32x2;
typedef __attribute__((ext_vector_type(2))) __bf16 bf16x2v;
#define MFMA32(a, b, c) __builtin_amdgcn_mfma_f32_32x32x16_bf16((a), (b), (c), 0, 0, 0)
#define MFMA16(a, b, c) __builtin_amdgcn_mfma_f32_16x16x32_bf16((a), (b), (c), 0, 0, 0)

constexpr int D_MODEL = 1024, BATCH = 8, SEQ = 2048, DEC_BATCH = 128, DEC_SEQ = 4, PAST = 2048;
constexpr int NTP = BATCH * SEQ;
constexpr int NTS = DEC_BATCH * DEC_SEQ;
constexpr int NT = NTP + NTS;
constexpr int IN_COLS = 5912, NPAD = 6144;
constexpr int NSEQ = BATCH + DEC_BATCH;

constexpr size_t O_YP = 0;
constexpr size_t O_YS = O_YP + (size_t)NTP * 1024;
constexpr size_t O_PCK = O_YS + (size_t)NTS * 1024;
constexpr size_t O_PWK = O_PCK + 4 * (size_t)NTP * 128;
constexpr size_t O_PHG = O_PWK + 2 * (size_t)BATCH * 512 * 128;
constexpr size_t O_SCK = O_PHG + (size_t)BATCH * 4 * 128 * 128;
constexpr size_t O_SWK = O_SCK + 4 * (size_t)NTS * 128;
constexpr size_t O_SHG = O_SWK + 2 * (size_t)DEC_BATCH * 512 * 128;
constexpr size_t O_END = O_SHG + (size_t)DEC_BATCH * 4 * 128 * 128;

constexpr size_t al256(size_t x) { return (x + 255) & ~(size_t)255; }
constexpr size_t W_WINT = 0;
constexpr size_t W_WBAT = al256(W_WINT + (size_t)NPAD * 1024 * 2);
constexpr size_t W_WBBT = al256(W_WBAT + (size_t)1024 * 512 * 2);
constexpr size_t W_WOUTT = al256(W_WBBT + (size_t)1024 * 512 * 2);
constexpr size_t W_W1T = al256(W_WOUTT + (size_t)1024 * 1024 * 2);
constexpr size_t W_C1 = al256(W_W1T + (size_t)2 * 128 * 1024 * 2);
constexpr size_t W_XN = al256(W_C1 + 2 * 16 * 64 * 4);
constexpr size_t W_Q = al256(W_XN + (size_t)NT * 1024 * 2);
constexpr size_t W_KV = al256(W_Q + (size_t)NT * 512 * 2);
constexpr size_t W_VST = al256(W_KV + (size_t)6 * NT * 128 * 2);
constexpr size_t W_VWT = al256(W_VST + (size_t)8 * 2 * 64 * 2048 * 2);
constexpr size_t W_GATE = al256(W_VWT + (size_t)8 * 2 * 64 * 2048 * 2);
constexpr size_t W_ZA = al256(W_GATE + (size_t)NT * 24 * 4);
constexpr size_t W_QB = al256(W_ZA + (size_t)NT * 512 * 2);
constexpr size_t W_KB = al256(W_QB + (size_t)NT * 512 * 2);
constexpr size_t W_GB = al256(W_KB + (size_t)NT * 512 * 2);
constexpr size_t W_VB = al256(W_GB + (size_t)NT * 512 * 4);
constexpr size_t W_ZB = al256(W_VB + (size_t)NT * 512 * 2);
constexpr size_t W_SA = al256(W_ZB + (size_t)NT * 512 * 2);
constexpr size_t W_SB = al256(W_SA + (size_t)NT * 1024 * 2);
constexpr size_t W_KCMP = al256(W_SB + (size_t)NT * 1024 * 2);
constexpr size_t W_VCMP = al256(W_KCMP + (size_t)NSEQ * 2 * 128 * 64 * 2);
constexpr size_t W_VCMPT = al256(W_VCMP + (size_t)NSEQ * 2 * 128 * 64 * 2);
constexpr size_t W_OA = al256(W_VCMPT + (size_t)8 * 2 * 64 * 128 * 2);
constexpr size_t W_OB = al256(W_OA + (size_t)NT * 512 * 2);
constexpr size_t W_Y = al256(W_OB + (size_t)NT * 512 * 2);
constexpr size_t W_SS = al256(W_Y + (size_t)NT * 1024 * 2);
constexpr size_t W_ORAW = al256(W_SS + (size_t)NT * 32 * 4);
constexpr size_t W_OSS = al256(W_ORAW + (size_t)NTP * 512 * 4);
constexpr size_t W_QG = al256(W_OSS + (size_t)NTP * 8 * 4);
constexpr size_t W_DST = al256(W_QG + (size_t)NTP * 512 * 2);
constexpr size_t W_DEC = al256(W_DST + (size_t)1024 * 128 * 128 * 4);
constexpr size_t W_SPT = al256(W_DEC + (size_t)1024 * 128 * 4);
constexpr size_t W_VCF = al256(W_SPT + (size_t)1024 * 128 * 128 * 2);
constexpr size_t W_BAR = al256(W_VCF + (size_t)DEC_BATCH * 2 * 128 * 64 * 4);
constexpr size_t W_END = al256(W_BAR + 3456 * 4);

struct Params {
  const float* x_prompt; const float* x_sample;
  const float* cck; const float* ccv; const float* csk; const float* csv;
  const float* swk; const float* swv; const float* shg; const int* pt;
  const float* norm_g; const float* w_in;
  const float* pos_k; const float* w1_k; const float* w2_k;
  const float* pos_v; const float* w1_v; const float* w2_v;
  const float* rel_bias; const float* hg_lower; const float* hg_norm_g;
  const float* w_ba; const float* w_bb; const float* w_out; const float* final_g;
  float* out; char* ws;
};

DI unsigned pk2(float a, float b) { f32x2 v = {a, b}; bf16x2v r = __builtin_convertvector(v, bf16x2v); return __builtin_bit_cast(unsigned, r); }
DI u16 f2bf(float a) { return (u16)(pk2(a, 0.f) & 0xffffu); }
DI float bf2f(u16 v) { return __uint_as_float(((unsigned)v) << 16); }
DI float bflo(unsigned v) { return __uint_as_float(v << 16); }
DI float bfhi(unsigned v) { return __uint_as_float(v & 0xffff0000u); }
constexpr float LOG2E = 1.4426950408889634f;
DI float sigmoidf_(float x) { return __builtin_amdgcn_rcpf(1.f + __expf(-x)); }
DI float siluf_(float x) { return x * __builtin_amdgcn_rcpf(1.f + __expf(-x)); }
DI int otid() { int t = threadIdx.x & 255; asm volatile("" : "+v"(t)); return t; }
DI int otid512() { int t = threadIdx.x; asm volatile("" : "+v"(t)); return t; }
DI int crow(int reg, int h) { return (reg & 3) + 8 * (reg >> 2) + 4 * h; }
DI float wave_sum(float v) {
#pragma unroll
  for (int o = 32; o >= 1; o >>= 1) v += __shfl_xor(v, o);
  return v;
}
DI float wave_max(float v) {
#pragma unroll
  for (int o = 32; o >= 1; o >>= 1) v = fmaxf(v, __shfl_xor(v, o));
  return v;
}

__device__ const unsigned char T5B[128] = {
  0,1,2,3,4,5,6,7,8,9,10,11,12,13,14,15,
  16,16,16,17,17,18,18,18,19,19,19,20,20,20,20,21,
  21,21,21,22,22,22,22,22,23,23,23,23,23,23,24,24,
  24,24,24,24,25,25,25,25,25,25,25,26,26,26,26,26,
  26,26,26,27,27,27,27,27,27,27,27,27,27,28,28,28,
  28,28,28,28,28,28,28,29,29,29,29,29,29,29,29,29,
  29,29,29,30,30,30,30,30,30,30,30,30,30,30,30,30,
  30,31,31,31,31,31,31,31,31,31,31,31,31,31,31,31};

DI void transpose_tile(const float* __restrict__ src, int ldsrc, int K, int N, int k0, int n0,
                       u16* __restrict__ dst, int lddst, int dst_row_off, int dst_k0, int winperm, float* tl) {
  const int tid = otid();
  __syncthreads();
  {
    const int n = tid & 63, kb = tid >> 6;
#pragma unroll
    for (int i = 0; i < 16; ++i) {
      const int kk = kb + 4 * i;
      const int nc = (n0 + n < N) ? n0 + n : N - 1, kc = (k0 + kk < K) ? k0 + kk : K - 1;
      tl[kk * 65 + n] = src[(size_t)kc * ldsrc + nc];
    }
  }
  __syncthreads();
  {
    const int k = (tid & 31) * 2, nb = tid >> 5;
#pragma unroll
    for (int i = 0; i < 8; ++i) {
      const int nn = nb + 8 * i;
      int n = n0 + nn;
      if (n < N) {
        if (winperm) n = (n < 1280) ? n : ((n < 1304) ? (5888 + n - 1280) : (n - 24));
        const unsigned v = pk2(tl[k * 65 + nn], tl[(k + 1) * 65 + nn]);
        *(unsigned*)(dst + (size_t)(dst_row_off + n) * lddst + dst_k0 + k) = v;
      }
    }
  }
}

constexpr int P0_WIN = 16 * 93;
constexpr int P0_WBA = 8 * 16, P0_WBB = 8 * 16, P0_WOUT = 16 * 16, P0_W1 = 32 * 2;
constexpr int P0_TR = P0_WIN + P0_WBA + P0_WBB + P0_WOUT + P0_W1;
constexpr int P0_C1 = 32;
constexpr int P0_NORM = NT / 8;
constexpr int P0_WCP = 2 * DEC_BATCH * 8;
constexpr int P0_PAD = NPAD - IN_COLS;
constexpr int P0_TOTAL = P0_TR + P0_C1 + P0_NORM + P0_WCP + P0_PAD;

DI void phase0_item(const Params& p, int it, char* lds) {
  const int tid = otid(), lane = tid & 63, wave = tid >> 6;
  float* tl = (float*)lds;
  if (it < P0_TR) {
    if (it < P0_WIN) {
      const int kt = it / 93, nt = it % 93;
      transpose_tile(p.w_in, IN_COLS, 1024, IN_COLS, kt * 64, nt * 64, (u16*)(p.ws + W_WINT), 1024, 0, kt * 64, 1, tl);
      return;
    }
    it -= P0_WIN;
    if (it < P0_WBA) { const int kt = it / 16, nt = it % 16;
      transpose_tile(p.w_ba, 1024, 512, 1024, kt * 64, nt * 64, (u16*)(p.ws + W_WBAT), 512, 0, kt * 64, 0, tl); return; }
    it -= P0_WBA;
    if (it < P0_WBB) { const int kt = it / 16, nt = it % 16;
      transpose_tile(p.w_bb, 1024, 512, 1024, kt * 64, nt * 64, (u16*)(p.ws + W_WBBT), 512, 0, kt * 64, 0, tl); return; }
    it -= P0_WBB;
    if (it < P0_WOUT) { const int kt = it / 16, nt = it % 16;
      transpose_tile(p.w_out, 1024, 1024, 1024, kt * 64, nt * 64, (u16*)(p.ws + W_WOUTT), 1024, 0, kt * 64, 0, tl); return; }
    it -= P0_WOUT;
    { const int kv = it >> 5, kt = it & 31;
      const float* w1 = kv ? p.w1_v : p.w1_k;
      transpose_tile(w1, 64, 2048, 64, kt * 64, 0, (u16*)(p.ws + W_W1T) + (size_t)kv * 128 * 1024, 1024,
                     (kt >= 16) ? 64 : 0, (kt & 15) * 64, 0, tl); return; }
  }
  it -= P0_TR;
  if (it < P0_C1) {
    const int kv = it >> 4, sl = it & 15;
    const float* pos = kv ? p.pos_v : p.pos_k; const float* w1 = kv ? p.w1_v : p.w1_k;
    const int j = tid & 63, part = tid >> 6;
    float pv[32], wv[32];
#pragma unroll
    for (int i = 0; i < 32; ++i) { const int r_ = sl * 128 + part * 32 + i; pv[i] = pos[r_]; wv[i] = w1[(size_t)r_ * 64 + j]; }
    float sm = 0.f;
#pragma unroll
    for (int i = 0; i < 32; ++i) sm += pv[i] * wv[i];
    __syncthreads();
    tl[part * 64 + j] = sm;
    __syncthreads();
    if (tid < 64) ((float*)(p.ws + W_C1))[it * 64 + tid] = tl[tid] + tl[64 + tid] + tl[128 + tid] + tl[192 + tid];
    return;
  }
  it -= P0_C1;
  if (it < P0_NORM) {
#pragma unroll
    for (int rr = 0; rr < 2; ++rr) {
      const int row = it * 8 + wave * 2 + rr;
      const float* x = (row < NTP) ? (p.x_prompt + (size_t)row * 1024) : (p.x_sample + (size_t)(row - NTP) * 1024);
      float4 v[4]; float ss = 0.f;
#pragma unroll
      for (int i = 0; i < 4; ++i) { v[i] = *(const float4*)(x + (i * 64 + lane) * 4); ss += v[i].x * v[i].x + v[i].y * v[i].y + v[i].z * v[i].z + v[i].w * v[i].w; }
      ss = wave_sum(ss);
      const float rs = rsqrtf(ss * (1.f / 1024.f) + 1e-6f);
      u16* xn = (u16*)(p.ws + W_XN) + (size_t)row * 1024;
#pragma unroll
      for (int i = 0; i < 4; ++i) {
        const float4 g = *(const float4*)(p.norm_g + (i * 64 + lane) * 4);
        uint2 o; o.x = pk2(v[i].x * rs * g.x, v[i].y * rs * g.y); o.y = pk2(v[i].z * rs * g.z, v[i].w * rs * g.w);
        *(uint2*)(xn + (i * 64 + lane) * 4) = o;
      }
    }
    return;
  }
  it -= P0_NORM;
  if (it < P0_WCP) {
    const int sl = it & 7, b = (it >> 3) % DEC_BATCH, kv = it / (8 * DEC_BATCH);
    const float4* src = (const float4*)((kv ? p.swv : p.swk) + ((size_t)b * 512 + 4) * 128) + sl * 64 * 32;
    float4* dst = (float4*)(p.out + O_SWK + (size_t)kv * DEC_BATCH * 512 * 128 + (size_t)b * 512 * 128) + sl * 64 * 32;
    const int n = (sl == 7 ? 60 : 64) * 32;
    const float4* __restrict__ sp = src; float4* __restrict__ dp = dst;
#pragma unroll
    for (int i = 0; i < 8; ++i) { const int idx = (tid + 256 * i < n) ? tid + 256 * i : n - 1; dp[idx] = sp[idx]; }
    return;
  }
  it -= P0_WCP;
  { u16* d = (u16*)(p.ws + W_WINT) + (size_t)(IN_COLS + it) * 1024; *(uint2*)(d + tid * 4) = make_uint2(0u, 0u); }
}

constexpr int GST = 72;
struct LoadBf16 {
  const u16* base; int ld;
  DI uint4 load(int row, int ch, int kt) const { return *(const uint4*)(base + (size_t)row * ld + kt * 64 + ch * 8); }
};
struct LoadCellBf16 {
  const u16* base;
  DI uint4 load(int row, int ch, int kt) const { return *(const uint4*)(base + (size_t)(row * 16 + kt) * 128 + ch * 8); }
};
struct LoadCellPage {
  const float* cache; const int* pt; int g;
  DI uint4 load(int row, int ch, int kt) const {
    const int pos = row * 16 + kt; const int page = pt[pos >> 7];
    const float* s = cache + (((size_t)page * 128 + (pos & 127)) * 2 + g) * 64 + ch * 8;
    const float4 a = *(const float4*)s, b = *(const float4*)(s + 4);
    uint4 r; r.x = pk2(a.x, a.y); r.y = pk2(a.z, a.w); r.z = pk2(b.x, b.y); r.w = pk2(b.z, b.w); return r;
  }
};

template <int NI, class AL, class BL>
DI void gemm_main(f32x16 (&acc)[2][NI], const AL& al, const BL& bl, int nkt, char* lds) {
  u16* sA = (u16*)lds; u16* sB = sA + 128 * GST;
  const int tid = otid(), lane = tid & 63, wave = tid >> 6, wm = wave >> 1, wn = wave & 1;
  const int lrow = tid >> 3, lch = tid & 7, r = lane & 31, h = lane >> 5;
  uint4 ra0[4], rb0[2 * NI], ra1[4], rb1[2 * NI];
#pragma unroll
  for (int i = 0; i < 4; ++i) { ra0[i] = al.load(lrow + 32 * i, lch, 0); ra1[i] = al.load(lrow + 32 * i, lch, 1); }
#pragma unroll
  for (int i = 0; i < 2 * NI; ++i) { rb0[i] = bl.load(lrow + 32 * i, lch, 0); rb1[i] = bl.load(lrow + 32 * i, lch, 1); }
#define GM_STEP(RA, RB, kt_) do { \
    __syncthreads(); \
    _Pragma("unroll") for (int i = 0; i < 4; ++i) *(uint4*)(sA + (lrow + 32 * i) * GST + lch * 8) = RA[i]; \
    _Pragma("unroll") for (int i = 0; i < 2 * NI; ++i) *(uint4*)(sB + (lrow + 32 * i) * GST + lch * 8) = RB[i]; \
    __syncthreads(); \
    { const int kn_ = ((kt_) + 2 < nkt) ? (kt_) + 2 : (kt_);       \
      _Pragma("unroll") for (int i = 0; i < 4; ++i) RA[i] = al.load(lrow + 32 * i, lch, kn_); \
      _Pragma("unroll") for (int i = 0; i < 2 * NI; ++i) RB[i] = bl.load(lrow + 32 * i, lch, kn_); } \
    _Pragma("unroll") for (int s_ = 0; s_ < 4; ++s_) { \
      bf16x8 a[2], bb[NI]; \
      _Pragma("unroll") for (int mi = 0; mi < 2; ++mi) a[mi] = *(const bf16x8*)(sA + (wm * 64 + mi * 32 + r) * GST + s_ * 16 + 8 * h); \
      _Pragma("unroll") for (int ni = 0; ni < NI; ++ni) bb[ni] = *(const bf16x8*)(sB + (wn * 32 * NI + ni * 32 + r) * GST + s_ * 16 + 8 * h); \
      _Pragma("unroll") for (int mi = 0; mi < 2; ++mi) \
        _Pragma("unroll") for (int ni = 0; ni < NI; ++ni) acc[mi][ni] = MFMA32(a[mi], bb[ni], acc[mi][ni]); \
    } \
  } while (0)
#pragma unroll 1
  for (int kt = 0; kt < nkt; kt += 2) {
    GM_STEP(ra0, rb0, kt);
    GM_STEP(ra1, rb1, kt + 1);
  }
#undef GM_STEP
}
typedef __attribute__((address_space(1))) const unsigned gptr_t;
typedef __attribute__((address_space(3))) unsigned lptr_t;
template <int NI>
DI void gemm_glds(f32x16 (&acc)[2][NI], const u16* A, int lda, const u16* B, int ldb, int nkt, char* lds) {
  const int tid = otid(), lane = tid & 63, wave = tid >> 6, wm = wave >> 1, wn = wave & 1;
  const int r = lane & 31, h = lane >> 5;
  const int lr = (wave << 3) + (lane >> 3);
  const int lc = (lane & 7) ^ ((lane >> 3) & 7) ^ (wave & 1);
  const u16* ga = A + (size_t)lr * lda + lc * 8;
  const u16* gb = B + (size_t)lr * ldb + lc * 8;
  const int sw = (lane & 7) ^ ((lane >> 3) & 1);
  constexpr int STAGE = 16384 + 8192 * NI;
#define GLDS_ISSUE(buf, kt_) do { \
    char* sa_ = lds + (buf) * STAGE + tid * 16; \
    _Pragma("unroll") for (int i_ = 0; i_ < 4; ++i_) \
      __builtin_amdgcn_global_load_lds((gptr_t*)(ga + (size_t)(32 * i_) * lda + (kt_) * 64), (lptr_t*)(sa_ + i_ * 4096), 16, 0, 0); \
    _Pragma("unroll") for (int i_ = 0; i_ < 2 * NI; ++i_) \
      __builtin_amdgcn_global_load_lds((gptr_t*)(gb + (size_t)(32 * i_) * ldb + (kt_) * 64), (lptr_t*)(sa_ + 16384 + i_ * 4096), 16, 0, 0); \
  } while (0)
  __syncthreads();
  GLDS_ISSUE(0, 0);
#pragma unroll 1
  for (int kt = 0; kt < nkt; ++kt) {
    asm volatile("s_waitcnt vmcnt(0)" ::: "memory");
    __syncthreads();
    if (kt + 1 < nkt) GLDS_ISSUE((kt + 1) & 1, kt + 1);
    const char* sA = lds + (kt & 1) * STAGE; const char* sB = sA + 16384;
#pragma unroll
    for (int s = 0; s < 4; ++s) {
      const int co = ((2 * s + h) ^ sw) << 4;
      bf16x8 a[2], bb[NI];
#pragma unroll
      for (int mi = 0; mi < 2; ++mi) a[mi] = *(const bf16x8*)(sA + (wm * 64 + mi * 32 + r) * 128 + co);
#pragma unroll
      for (int ni = 0; ni < NI; ++ni) bb[ni] = *(const bf16x8*)(sB + (wn * 32 * NI + ni * 32 + r) * 128 + co);
#pragma unroll
      for (int mi = 0; mi < 2; ++mi)
#pragma unroll
        for (int ni = 0; ni < NI; ++ni) acc[mi][ni] = MFMA32(a[mi], bb[ni], acc[mi][ni]);
    }
  }
#undef GLDS_ISSUE
  __syncthreads();
}
template <int NI>
DI void zero_acc(f32x16 (&acc)[2][NI]) {
#pragma unroll
  for (int a = 0; a < 2; ++a)
#pragma unroll
    for (int b = 0; b < NI; ++b)
#pragma unroll
      for (int i = 0; i < 16; ++i) acc[a][b][i] = 0.f;
}

constexpr int G1_MT = NT / 128, G1_NT = NPAD / 128;
constexpr int P1_GEMM = G1_MT * G1_NT;
constexpr int P1_CMP = DEC_BATCH * 2 * 2;
constexpr int P1_TOTAL = P1_CMP + P1_GEMM;

DI void proj_tile(const Params& p, int tm, int tn, char* lds, bool store_ok) {
  f32x16 acc[2][2]; zero_acc<2>(acc);
  gemm_glds<2>(acc, (const u16*)(p.ws + W_XN) + (size_t)tm * 128 * 1024, 1024, (const u16*)(p.ws + W_WINT) + (size_t)tn * 128 * 1024, 1024, 16, lds);
  const int tid = otid(), lane = tid & 63, wave = tid >> 6, wm = wave >> 1, wn = wave & 1, r = lane & 31, h = lane >> 5;
  const bool samp = tm >= 128;
  if (!store_ok) return;
#pragma unroll
  for (int mi = 0; mi < 2; ++mi)
#pragma unroll
    for (int ni = 0; ni < 2; ++ni) {
      const int c = wn * 64 + ni * 32 + r;
      const int row0 = tm * 128 + wm * 64 + mi * 32;
      if (tn < 4) {
        u16* d = (u16*)(p.ws + W_Q) + tn * 128 + c;
#pragma unroll
        for (int i = 0; i < 16; ++i) d[(size_t)(row0 + crow(i, h)) * 512] = f2bf(acc[mi][ni][i] * (0.125f * LOG2E));
      } else if (tn < 10) {
        const int kvg = tn - 4;
        u16* d = (u16*)(p.ws + W_KV) + (size_t)kvg * NT * 128 + c;
#pragma unroll
        for (int i = 0; i < 16; ++i) {
          const int row = row0 + crow(i, h); const float v = acc[mi][ni][i];
          d[(size_t)row * 128] = f2bf(v);
          if (!samp) {
            if (kvg < 4) p.out[O_PCK + (size_t)kvg * NTP * 128 + (size_t)row * 128 + c] = v;
            else { const int t = row & 2047, b = row >> 11;
              if (t >= 1536) p.out[O_PWK + (size_t)(kvg - 4) * BATCH * 512 * 128 + ((size_t)b * 512 + t - 1536) * 128 + c] = v; }
          } else {
            const int srow = row - NTP;
            if (kvg < 4) p.out[O_SCK + (size_t)kvg * NTS * 128 + (size_t)srow * 128 + c] = v;
            else p.out[O_SWK + (size_t)(kvg - 4) * DEC_BATCH * 512 * 128 + ((size_t)(srow >> 2) * 512 + 508 + (srow & 3)) * 128 + c] = v;
          }
        }
        if (!samp && (kvg == 3 || kvg == 5)) {
          u16* vt = (u16*)(p.ws + (kvg == 3 ? W_VST : W_VWT));
          const int b = row0 >> 11, t0 = row0 & 2047, g = c >> 6, dd = c & 63;
          u16* drow = vt + ((size_t)(b * 2 + g) * 64 + dd) * 2048 + t0;
#pragma unroll
          for (int q = 0; q < 4; ++q) {
            uint2 o; o.x = pk2(acc[mi][ni][4 * q], acc[mi][ni][4 * q + 1]); o.y = pk2(acc[mi][ni][4 * q + 2], acc[mi][ni][4 * q + 3]);
            *(uint2*)(drow + 8 * q + 4 * h) = o;
          }
        }
      } else if (tn < 14 || (tn >= 26 && tn < 30)) {
        const bool isA = tn < 14; const int cc = (isA ? tn - 10 : tn - 26) * 128 + c;
        u16* d = (u16*)(p.ws + (isA ? W_ZA : W_ZB)) + cc;
#pragma unroll
        for (int i = 0; i < 16; ++i) d[(size_t)(row0 + crow(i, h)) * 512] = f2bf(siluf_(acc[mi][ni][i]));
      } else if (tn < 18 || (tn >= 22 && tn < 26)) {
        const bool isQ = tn < 18; const int cc = (isQ ? tn - 14 : tn - 22) * 128 + c;
        u16* d = (u16*)(p.ws + (isQ ? W_QB : W_VB)) + cc;
#pragma unroll
        for (int i = 0; i < 16; ++i) d[(size_t)(row0 + crow(i, h)) * 512] = f2bf(acc[mi][ni][i]);
      } else if (tn < 22) {
        const int cc = (tn - 18) * 128 + c;
        const float a0 = p.hg_lower[cc], a1 = p.hg_lower[512 + cc];
        const float lb = 1.f / (1.f + __expf(a1 - a0));
        u16* dk = (u16*)(p.ws + W_KB) + cc; float* dg = (float*)(p.ws + W_GB) + cc;
#pragma unroll
        for (int i = 0; i < 16; ++i) {
          const size_t row = row0 + crow(i, h);
          const float sg = sigmoidf_(acc[mi][ni][i]);
          const float f = lb + (1.f - lb) * sg;
          dg[row * 512] = __logf(f);
          dk[row * 512] = f2bf((1.f - lb) * (1.f - sg));
        }
      } else if (tn < 46) {
        const bool isA = tn < 38; const int cc = (isA ? tn - 30 : tn - 38) * 128 + c;
        u16* d = (u16*)(p.ws + (isA ? W_SA : W_SB)) + cc;
#pragma unroll
        for (int i = 0; i < 16; ++i) d[(size_t)(row0 + crow(i, h)) * 1024] = f2bf(sigmoidf_(acc[mi][ni][i]));
      } else {
        if (c < 24) {
          float* d = (float*)(p.ws + W_GATE) + c;
#pragma unroll
          for (int i = 0; i < 16; ++i) d[(size_t)(row0 + crow(i, h)) * 24] = sigmoidf_(acc[mi][ni][i]);
        }
      }
    }
}

template <class AL>
DI void comp_tile(const Params& p, const AL& al, int seq, int g, int kv, char* lds) {
  f32x16 acc[2][2]; zero_acc<2>(acc);
  LoadBf16 bl{(const u16*)(p.ws + W_W1T) + (size_t)kv * 128 * 1024, 1024};
  gemm_main<2>(acc, al, bl, 16, lds);
  const int tid = otid(), lane = tid & 63, wave = tid >> 6, wm = wave >> 1, wn = wave & 1, r = lane & 31, h = lane >> 5;
  float* T = (float*)lds;
  float* w2s = T + 128 * 65;
  const float* c1 = (const float*)(p.ws + W_C1) + kv * 16 * 64;
  const float* w2 = kv ? p.w2_v : p.w2_k;
  __syncthreads();
  for (int i = tid; i < 4096; i += 256) w2s[i] = w2[i];
  if (wn == 1) {
#pragma unroll
    for (int mi = 0; mi < 2; ++mi)
#pragma unroll
      for (int ni = 0; ni < 2; ++ni)
#pragma unroll
        for (int i = 0; i < 16; ++i) T[(wm * 64 + mi * 32 + crow(i, h)) * 65 + ni * 32 + r] = acc[mi][ni][i];
  }
  __syncthreads();
  if (wn == 0) {
    float c1v[2] = {0.f, 0.f};
#pragma unroll
    for (int sl = 0; sl < 16; ++sl) { c1v[0] += c1[sl * 64 + r]; c1v[1] += c1[sl * 64 + 32 + r]; }
#pragma unroll
    for (int mi = 0; mi < 2; ++mi)
#pragma unroll
      for (int ni = 0; ni < 2; ++ni)
#pragma unroll
        for (int i = 0; i < 16; ++i) {
          const int n = wm * 64 + mi * 32 + crow(i, h), j = ni * 32 + r;
          const float hv = siluf_(acc[mi][ni][i] + T[((n < 127) ? n + 1 : 127) * 65 + j] + c1v[ni]);
          acc[mi][ni][i] = (n < 127) ? hv : 0.f;
        }
  }
  __syncthreads();
  if (wn == 0) {
#pragma unroll
    for (int mi = 0; mi < 2; ++mi)
#pragma unroll
      for (int ni = 0; ni < 2; ++ni)
#pragma unroll
        for (int i = 0; i < 16; ++i) T[(wm * 64 + mi * 32 + crow(i, h)) * 65 + ni * 32 + r] = acc[mi][ni][i];
  }
  __syncthreads();
  {
    const int n = tid >> 1, eh = tid & 1;
    float o[32];
#pragma unroll
    for (int e = 0; e < 32; ++e) o[e] = 0.f;
#pragma unroll 2
    for (int j = 0; j < 64; ++j) {
      const float hv = T[n * 65 + j];
#pragma unroll
      for (int e = 0; e < 32; ++e) o[e] += hv * w2s[j * 64 + eh * 32 + e];
    }
    u16* dst = (u16*)(p.ws + (kv ? W_VCMP : W_KCMP)) + ((size_t)(seq * 2 + g) * 128 + n) * 64 + eh * 32;
#pragma unroll
    for (int e = 0; e < 32; e += 2) *(unsigned*)(dst + e) = pk2(o[e], o[e + 1]);
    if (kv == 1 && seq >= BATCH) {
      float* df = (float*)(p.ws + W_VCF) + ((size_t)((seq - BATCH) * 2 + g) * 128 + n) * 64 + eh * 32;
#pragma unroll
      for (int e = 0; e < 32; e += 4) *(float4*)(df + e) = make_float4(o[e], o[e + 1], o[e + 2], o[e + 3]);
    }
  }
  __syncthreads();
}

DI void phase1_item(const Params& p, int it, char* lds) {
  if (it < P1_CMP) {
    const int kv = it & 1, g = (it >> 1) & 1, b = it >> 2;
    LoadCellPage al{kv ? p.ccv : p.cck, p.pt + b * 16, g};
    comp_tile(p, al, BATCH + b, g, kv, lds);
    return;
  }
  it -= P1_CMP;
  const int tm = it / G1_NT, tn = it % G1_NT;
  proj_tile(p, tm, tn, lds, true);
}


DI void hgrn_sample_item(const Params& p, int it, char* lds) {
  const int b = it >> 2, h = it & 3, tid = otid(), lane = tid & 63, wave = tid >> 6;
  float* sf = (float*)lds; float* sk = sf + 512; float* sq = sk + 512; float* sv = sq + 512; float* so = sv + 512;
  __syncthreads();
  for (int i = tid; i < 512; i += 256) {
    const int t = i >> 7, c = i & 127; const size_t off = (size_t)(NTP + b * 4 + t) * 512 + h * 128 + c;
    { const int cc = h * 128 + c; const float lb = __builtin_amdgcn_rcpf(1.f + __expf(p.hg_lower[512 + cc] - p.hg_lower[cc]));
      const float sg = sigmoidf_(((const float*)(p.ws + W_GB))[off]);
      sf[i] = lb + (1.f - lb) * sg; sk[i] = (1.f - lb) * (1.f - sg); }
    sq[i] = bf2f(((const u16*)(p.ws + W_QB))[off]);
    sv[i] = bf2f(((const u16*)(p.ws + W_VB))[off]);
  }
  __syncthreads();
  const int e = tid & 127, dh = tid >> 7;
  const float* S0 = p.shg + (size_t)(b * 4 + h) * 128 * 128;
  float* S1 = p.out + O_SHG + (size_t)(b * 4 + h) * 128 * 128;
  const float v0 = sv[e], v1 = sv[128 + e], v2 = sv[256 + e], v3 = sv[384 + e];
  float o0 = 0.f, o1 = 0.f, o2 = 0.f, o3 = 0.f;
#pragma unroll 1
  for (int d0 = dh * 64; d0 < dh * 64 + 64; d0 += 16) {
    float sv[16];
#pragma unroll
    for (int i = 0; i < 16; ++i) sv[i] = S0[(size_t)(d0 + i) * 128 + e];
#pragma unroll
    for (int i = 0; i < 16; ++i) {
      const int d = d0 + i; float st = sv[i];
      st = sf[d] * st + sk[d] * v0;             o0 += sq[d] * st;
      st = sf[128 + d] * st + sk[128 + d] * v1; o1 += sq[128 + d] * st;
      st = sf[256 + d] * st + sk[256 + d] * v2; o2 += sq[256 + d] * st;
      st = sf[384 + d] * st + sk[384 + d] * v3; o3 += sq[384 + d] * st;
      sv[i] = st;
    }
#pragma unroll
    for (int i = 0; i < 16; ++i) S1[(size_t)(d0 + i) * 128 + e] = sv[i];
  }
  so[(dh * 4 + 0) * 128 + e] = o0; so[(dh * 4 + 1) * 128 + e] = o1; so[(dh * 4 + 2) * 128 + e] = o2; so[(dh * 4 + 3) * 128 + e] = o3;
  __syncthreads();
  {
    const int t = wave; const size_t row = (size_t)(NTP + b * 4 + t);
    const float a0 = so[t * 128 + lane] + so[(4 + t) * 128 + lane];
    const float a1 = so[t * 128 + 64 + lane] + so[(4 + t) * 128 + 64 + lane];
    const float ss = wave_sum(a0 * a0 + a1 * a1);
    const float rs = rsqrtf(ss * (1.f / 128.f) + 1e-6f);
    const u16* zb = (const u16*)(p.ws + W_ZB) + row * 512 + h * 128; u16* ob = (u16*)(p.ws + W_OB) + row * 512 + h * 128;
    const float z0 = siluf_(bf2f(zb[lane])), z1 = siluf_(bf2f(zb[64 + lane]));
    ob[lane] = f2bf(a0 * rs * p.hg_norm_g[h * 128 + lane] * z0);
    ob[64 + lane] = f2bf(a1 * rs * p.hg_norm_g[h * 128 + 64 + lane] * z1);
  }
}

typedef __attribute__((address_space(3))) s16x4 lds_s16x4;
DI s16x4 tr_read(const u16* ptr) { return __builtin_amdgcn_ds_read_tr16_b64_v4i16((lds_s16x4*)ptr); }
DI bf16x8 cat8(s16x4 lo, s16x4 hi) { return __builtin_shufflevector(lo, hi, 0, 1, 2, 3, 4, 5, 6, 7); }
constexpr int HST = 136;

DI void hgrn_h1_item(const Params& p, int it, char* lds) {
  const int c = it & 31, h = (it >> 5) & 3, b = it >> 7;
  const int tid = otid(), lane = tid & 63, w = __builtin_amdgcn_readfirstlane(tid >> 6), half = tid >> 7;
  const int c16 = lane & 15, hq = lane >> 4, tq = c16 >> 2, tp = c16 & 3;
  const int d = tid & 127, col = h * 128 + d;
  u16* Qe = (u16*)lds; u16* Ke = Qe + 64 * HST; u16* Vv = Ke + 64 * HST; u16* Am = Vv + 64 * HST;
  float* Rr = (float*)(Am + 64 * 72); float* G63 = Rr + 128;
  const u16* qB = (const u16*)(p.ws + W_QB); const u16* kB = (const u16*)(p.ws + W_KB); const u16* vB = (const u16*)(p.ws + W_VB);
  const float* gB = (const float*)(p.ws + W_GB);
  const size_t tok0 = (size_t)b * 2048 + c * 64;
  __syncthreads();
  float G[32], KQ[32];
  {
    float xr[32];
#pragma unroll
    for (int i = 0; i < 32; ++i) xr[i] = gB[(tok0 + half * 32 + i) * 512 + col];
    const float lb = __builtin_amdgcn_rcpf(1.f + __expf(p.hg_lower[512 + col] - p.hg_lower[col])), ol = 1.f - lb;
    float run = 0.f;
#pragma unroll
    for (int i = 0; i < 32; ++i) { const float sg = sigmoidf_(xr[i]); run += __logf(lb + ol * sg); G[i] = run; KQ[i] = ol * (1.f - sg); }
    if (half == 0) Rr[d] = run;
  }
#pragma unroll
  for (int i = 0; i < 4; ++i) {
    const int idx = tid + 256 * i, s_ = idx >> 4, cc = idx & 15;
    *(uint4*)(Vv + s_ * HST + cc * 8) = *(const uint4*)(vB + (tok0 + s_) * 512 + h * 128 + cc * 8);
  }
  __syncthreads();
  {
    const float R = Rr[d];
    const float base = half ? R : 0.f;
    u16* qg = (u16*)(p.ws + W_QG);
    u16 qv[32];
#pragma unroll
    for (int i = 0; i < 32; ++i) qv[i] = qB[(tok0 + half * 32 + i) * 512 + col];
#pragma unroll
    for (int i = 0; i < 32; ++i) {
      const int t = half * 32 + i;
      const float gt = base + G[i];
      const float q = bf2f(qv[i]), k = KQ[i];
      const float dq = fminf(fmaxf(gt - R, -80.f), 80.f);
      const float eq = __expf(dq);
      Qe[t * HST + d] = f2bf(q * eq);
      Ke[t * HST + d] = f2bf(k * __builtin_amdgcn_rcpf(eq));
      qg[(tok0 + t) * 512 + col] = f2bf(q * __expf(gt));
    }
    if (half == 1) G63[d] = base + G[31];
  }
  __syncthreads();
  for (int j = 0; j <= w; ++j) {
    f32x4 x = f32x4{0.f, 0.f, 0.f, 0.f};
#pragma unroll
    for (int ks = 0; ks < 4; ++ks) {
      const bf16x8 a = *(const bf16x8*)(Qe + (16 * w + c16) * HST + ks * 32 + 8 * hq);
      const bf16x8 bb = *(const bf16x8*)(Ke + (16 * j + c16) * HST + ks * 32 + 8 * hq);
      x = MFMA16(a, bb, x);
    }
#pragma unroll
    for (int r = 0; r < 4; ++r) {
      const bool ok = (j < w) || (c16 <= 4 * hq + r);
      Am[(16 * w + 4 * hq + r) * 72 + 16 * j + c16] = f2bf(ok ? x[r] : 0.f);
    }
  }
  if ((w & 1) == 0) {
#pragma unroll
    for (int r = 0; r < 4; ++r) Am[(16 * w + 4 * hq + r) * 72 + 16 * (w + 1) + c16] = 0;
  }
  __syncthreads();
  bf16x8 vf[2][2];
#pragma unroll
  for (int ks = 0; ks < 2; ++ks)
#pragma unroll
    for (int et = 0; et < 2; ++et) {
      const u16* base = Vv + (32 * ks + 8 * hq + tq) * HST + 32 * w + 16 * et + 4 * tp;
      vf[ks][et] = cat8(tr_read(base), tr_read(base + 4 * HST));
    }
  {
    f32x4 o[4][2];
#pragma unroll
    for (int tt = 0; tt < 4; ++tt)
#pragma unroll
      for (int et = 0; et < 2; ++et) o[tt][et] = f32x4{0.f, 0.f, 0.f, 0.f};
#pragma unroll
    for (int tt = 0; tt < 4; ++tt)
#pragma unroll
      for (int ks = 0; ks <= (tt >> 1); ++ks) {
        const bf16x8 a = *(const bf16x8*)(Am + (16 * tt + c16) * 72 + 32 * ks + 8 * hq);
#pragma unroll
        for (int et = 0; et < 2; ++et) o[tt][et] = MFMA16(a, vf[ks][et], o[tt][et]);
      }
    float* oraw = (float*)(p.ws + W_ORAW);
#pragma unroll
    for (int tt = 0; tt < 4; ++tt)
#pragma unroll
      for (int et = 0; et < 2; ++et)
#pragma unroll
        for (int r = 0; r < 4; ++r) oraw[(tok0 + 16 * tt + 4 * hq + r) * 512 + h * 128 + 32 * w + 16 * et + c16] = o[tt][et][r];
  }
  float* dst = (float*)(p.ws + W_DST) + (size_t)it * 128 * 128;
#pragma unroll
  for (int dt = 0; dt < 8; ++dt) {
    bf16x8 kt[2];
#pragma unroll
    for (int ks = 0; ks < 2; ++ks) {
      const u16* base = Ke + (32 * ks + 8 * hq + tq) * HST + 16 * dt + 4 * tp;
      kt[ks] = cat8(tr_read(base), tr_read(base + 4 * HST));
    }
    f32x4 sc2;
#pragma unroll
    for (int r = 0; r < 4; ++r) sc2[r] = __expf(G63[16 * dt + 4 * hq + r] - Rr[16 * dt + 4 * hq + r]);
#pragma unroll
    for (int et = 0; et < 2; ++et) {
      f32x4 dd = f32x4{0.f, 0.f, 0.f, 0.f};
      dd = MFMA16(kt[0], vf[0][et], dd); dd = MFMA16(kt[1], vf[1][et], dd);
      *(float4*)(dst + (size_t)(32 * w + 16 * et + c16) * 128 + 16 * dt + 4 * hq) = make_float4(dd[0] * sc2[0], dd[1] * sc2[1], dd[2] * sc2[2], dd[3] * sc2[3]);
    }
  }
  if (tid < 128) ((float*)(p.ws + W_DEC))[(size_t)it * 128 + tid] = __expf(G63[tid]);
}

constexpr int H2_ITEMS = 8 * 4 * 128 * 32 / 256;
DI void hgrn_h2_item(const Params& p, int it) {
  const int gt = it * 256 + otid(), bh = gt >> 12, e = (gt >> 5) & 127, dq = gt & 31;
  const float* dst = (const float*)(p.ws + W_DST); const float* dec = (const float*)(p.ws + W_DEC); u16* spt = (u16*)(p.ws + W_SPT);
  float4 s = make_float4(0.f, 0.f, 0.f, 0.f);
#pragma unroll 1
  for (int c0 = 0; c0 < 32; c0 += 8) {
    float4 d4[8], k4[8];
#pragma unroll
    for (int i = 0; i < 8; ++i) {
      d4[i] = *(const float4*)(dst + ((size_t)(bh * 32 + c0 + i) * 128 + e) * 128 + dq * 4);
      k4[i] = *(const float4*)(dec + (size_t)(bh * 32 + c0 + i) * 128 + dq * 4);
    }
#pragma unroll
    for (int i = 0; i < 8; ++i) {
      *(uint2*)(spt + ((size_t)(bh * 32 + c0 + i) * 128 + e) * 128 + dq * 4) = make_uint2(pk2(s.x, s.y), pk2(s.z, s.w));
      s.x = k4[i].x * s.x + d4[i].x; s.y = k4[i].y * s.y + d4[i].y; s.z = k4[i].z * s.z + d4[i].z; s.w = k4[i].w * s.w + d4[i].w;
    }
  }
  float* So = p.out + O_PHG + (size_t)bh * 128 * 128;
  So[(size_t)(dq * 4 + 0) * 128 + e] = s.x; So[(size_t)(dq * 4 + 1) * 128 + e] = s.y;
  So[(size_t)(dq * 4 + 2) * 128 + e] = s.z; So[(size_t)(dq * 4 + 3) * 128 + e] = s.w;
}

DI void hgrn_h3_item(const Params& p, int it) {
  const int c = it & 31, h = (it >> 5) & 3, b = it >> 7;
  const int tid = otid(), lane = tid & 63, w = tid >> 6, c16 = lane & 15, hq = lane >> 4;
  const size_t tok0 = (size_t)b * 2048 + c * 64 + 16 * w;
  const u16* qg = (const u16*)(p.ws + W_QG) + (tok0 + c16) * 512 + h * 128 + 8 * hq;
  bf16x8 af[4];
#pragma unroll
  for (int ks = 0; ks < 4; ++ks) af[ks] = *(const bf16x8*)(qg + 32 * ks);
  const float* oraw = (const float*)(p.ws + W_ORAW) + (tok0 + 4 * hq) * 512 + h * 128 + c16;
  const u16* spt = (const u16*)(p.ws + W_SPT) + ((size_t)it * 128 + c16) * 128 + 8 * hq;
  f32x4 acc[8];
#pragma unroll
  for (int et = 0; et < 8; ++et) {
#pragma unroll
    for (int r = 0; r < 4; ++r) acc[et][r] = oraw[(size_t)r * 512 + 16 * et];
#pragma unroll
    for (int ks = 0; ks < 4; ++ks) {
      const bf16x8 bfr = *(const bf16x8*)(spt + (size_t)(16 * et) * 128 + 32 * ks);
      acc[et] = MFMA16(af[ks], bfr, acc[et]);
    }
  }
  const u16* zb = (const u16*)(p.ws + W_ZB) + (tok0 + 4 * hq) * 512 + h * 128 + c16;
  u16* ob = (u16*)(p.ws + W_OB) + (tok0 + 4 * hq) * 512 + h * 128 + c16;
  u16 zv[4][8]; float ng[8];
#pragma unroll
  for (int r = 0; r < 4; ++r)
#pragma unroll
    for (int et = 0; et < 8; ++et) zv[r][et] = zb[(size_t)r * 512 + 16 * et];
#pragma unroll
  for (int et = 0; et < 8; ++et) ng[et] = p.hg_norm_g[h * 128 + 16 * et + c16];
#pragma unroll
  for (int r = 0; r < 4; ++r) {
    float v = 0.f;
#pragma unroll
    for (int et = 0; et < 8; ++et) v += acc[et][r] * acc[et][r];
    v += __shfl_xor(v, 1); v += __shfl_xor(v, 2); v += __shfl_xor(v, 4); v += __shfl_xor(v, 8);
    const float rs = rsqrtf(v * (1.f / 128.f) + 1e-6f);
#pragma unroll
    for (int et = 0; et < 8; ++et) ob[(size_t)r * 512 + 16 * et] = f2bf(acc[et][r] * rs * ng[et] * siluf_(bf2f(zv[r][et])));
  }
}

typedef __attribute__((address_space(3))) const float lds_cf;
template <int NR>
DI void sa_scores(const float* qrows_, const float4 (&kk)[16], float (&sc)[NR]) {
  lds_cf* qrows = (lds_cf*)qrows_; asm volatile("" : "+v"(qrows));
#pragma unroll
  for (int r = 0; r < NR; ++r) {
    float a0 = 0.f, a1 = 0.f;
#pragma unroll
    for (int dq = 0; dq < 16; dq += 2) {
      const f32x4 q0 = *(const __attribute__((address_space(3))) f32x4*)(qrows + r * 64 + dq * 4), q1 = *(const __attribute__((address_space(3))) f32x4*)(qrows + r * 64 + dq * 4 + 4);
      a0 += q0[0] * kk[dq].x + q0[1] * kk[dq].y + q0[2] * kk[dq].z + q0[3] * kk[dq].w;
      a1 += q1[0] * kk[dq + 1].x + q1[1] * kk[dq + 1].y + q1[2] * kk[dq + 1].z + q1[3] * kk[dq + 1].w;
    }
    sc[r] = a0 + a1;
    asm volatile("" : "+v"(sc[r]) :: "memory");
  }
}
DI void sa_load_f32(const float* rowp, bool ok, float4 (&kk)[16]) {
#pragma unroll
  for (int i = 0; i < 16; ++i) kk[i] = ok ? ((const float4*)rowp)[i] : make_float4(0.f, 0.f, 0.f, 0.f);
}
template <int NR>
DI void sa_softmax(float* P, int nk, int row, int sub) {
  float m = -3.0e38f;
  for (int k = sub; k < nk; k += 16) m = fmaxf(m, P[k * NR + row]);
  m = fmaxf(m, __shfl_xor(m, 1)); m = fmaxf(m, __shfl_xor(m, 2)); m = fmaxf(m, __shfl_xor(m, 4)); m = fmaxf(m, __shfl_xor(m, 8));
  float l = 0.f;
  for (int k = sub; k < nk; k += 16) { const float sv = P[k * NR + row]; const float pv = (sv > -1.0e38f) ? __builtin_amdgcn_exp2f(sv - m) : 0.f; P[k * NR + row] = pv; l += pv; }
  l += __shfl_xor(l, 1); l += __shfl_xor(l, 2); l += __shfl_xor(l, 4); l += __shfl_xor(l, 8);
  const float inv = (l > 0.f) ? 1.f / l : 0.f;
  for (int k = sub; k < nk; k += 16) P[k * NR + row] *= inv;
}

DI void sa_load_bf16(const u16* rowp, bool ok, float4 (&kk)[16]) {
#pragma unroll
  for (int i = 0; i < 8; ++i) {
    const uint4 u = ok ? ((const uint4*)rowp)[i] : make_uint4(0u, 0u, 0u, 0u);
    kk[2 * i] = make_float4(bflo(u.x), bfhi(u.x), bflo(u.y), bfhi(u.y)); kk[2 * i + 1] = make_float4(bflo(u.z), bfhi(u.z), bflo(u.w), bfhi(u.w));
  }
}
template <class VRow>
DI void sa_pv(const float* P, int k0, int k1, const VRow& vrow, int lane, float (&o)[4]) {
#pragma unroll 1
  for (int kb = k0; kb < k1; kb += 32) {
    float vv[32];
#pragma unroll
    for (int i = 0; i < 32; ++i) vv[i] = vrow((kb + i < k1) ? kb + i : k1 - 1, lane);
#pragma unroll
    for (int i = 0; i < 32; ++i) {
      const int key = (kb + i < k1) ? kb + i : k1 - 1;
      const float4 p4 = *(const float4*)(P + key * 4); const float v = (kb + i < k1) ? vv[i] : 0.f;
      o[0] += p4.x * v; o[1] += p4.y * v; o[2] += p4.z * v; o[3] += p4.w * v;
    }
  }
}
template <int CTRL> DI float dppf(float v) { return __builtin_bit_cast(float, __builtin_amdgcn_update_dpp(0, __builtin_bit_cast(int, v), CTRL, 0xF, 0xF, false)); }
DI float red16(float v) { v += dppf<0xB1>(v); v += dppf<0x4E>(v); v += dppf<0x141>(v); v += dppf<0x140>(v); return v; }
template <class KRow, class Fin>
DI void sa_tile4(const float4 (&q4)[4], float* Pdst, const KRow& krow, const Fin& fin, int lane) {
  const int chunk = lane & 15, k4 = lane >> 4;
  float4 kv[16];
#pragma unroll
  for (int i = 0; i < 16; ++i) kv[i] = krow(4 * i + k4, chunk);
#pragma unroll
  for (int i = 0; i < 16; ++i) {
    float sr[4];
#pragma unroll
    for (int r = 0; r < 4; ++r) sr[r] = red16(q4[r].x * kv[i].x + q4[r].y * kv[i].y + q4[r].z * kv[i].z + q4[r].w * kv[i].w);
    const float mine = (chunk == 0) ? sr[0] : ((chunk == 1) ? sr[1] : ((chunk == 2) ? sr[2] : sr[3]));
    const float fv = fin(4 * i + k4, chunk & 3, mine);
    if (chunk < 4) Pdst[(4 * i + k4) * 4 + chunk] = fv;
  }
}
DI void sa_softmax_row(float* P, int nk, int row, int lane) {
  float m = -3.0e38f;
  for (int k = lane; k < nk; k += 64) m = fmaxf(m, P[k * 4 + row]);
  m = wave_max(m);
  float l = 0.f;
  for (int k = lane; k < nk; k += 64) { const float sv = P[k * 4 + row]; const float pv = (sv > -1.0e38f) ? __builtin_amdgcn_exp2f(sv - m) : 0.f; P[k * 4 + row] = pv; l += pv; }
  l = wave_sum(l);
  const float inv = (l > 0.f) ? 1.f / l : 0.f;
  for (int k = lane; k < nk; k += 64) P[k * 4 + row] *= inv;
}
DI void sample_attn_item(const Params& p, int it, char* lds) {
  const int t = it & 3, g = (it >> 2) & 1, b = it >> 3, tid = otid(), lane = tid & 63, w = __builtin_amdgcn_readfirstlane(tid >> 6);
  float* qs = (float*)lds;
  float* Pc = qs + 256;
  float* Pw = Pc + 512;
  float* Ps = Pw + 2304;
  float* obuf = Ps + 2048;
  float* imp = obuf + 3072;
  int* sel = (int*)(imp + 36);
  int* pts = sel + 8;
  float* btab = (float*)(pts + 16);
  const size_t tok = (size_t)(NTP + b * 4 + t);
  const int qpos = PAST + t, seq = BATCH + b;
  __syncthreads();
  qs[tid] = bf2f(((const u16*)(p.ws + W_Q))[tok * 512 + (g * 4 + (tid >> 6)) * 64 + lane]);
  for (int i = tid; i < 4 * 129; i += 256) { const int r = i / 129, rel = i % 129; const int bk = rel < 128 ? T5B[rel] : 31; btab[i] = p.rel_bias[bk * 8 + g * 4 + r] * LOG2E; }
  if (tid < 16) pts[tid] = p.pt[b * 16 + tid];
  __syncthreads();
  const float* fresh_wk = p.out + O_SWK + ((size_t)b * 512 + 508) * 128 + g * 64;
  const float* fresh_wv = p.out + O_SWK + (size_t)DEC_BATCH * 512 * 128 + ((size_t)b * 512 + 508) * 128 + g * 64;
  const float* fresh_sk = p.out + O_SCK + 2 * (size_t)NTS * 128 + (size_t)(b * 4) * 128 + g * 64;
  const float* fresh_sv = p.out + O_SCK + 3 * (size_t)NTS * 128 + (size_t)(b * 4) * 128 + g * 64;
  float4 q4[4];
#pragma unroll
  for (int r = 0; r < 4; ++r) q4[r] = *(const float4*)(qs + r * 64 + (lane & 15) * 4);
  for (int ti = w; ti < 11; ti += 4) {
    if (ti < 2) {
      const u16* kc = (const u16*)(p.ws + W_KCMP) + (size_t)(seq * 2 + g) * 128 * 64;
      sa_tile4(q4, Pc + ti * 256,
               [&](int k, int c) { const int n = 64 * ti + k; const uint2 u = *(const uint2*)(kc + (size_t)n * 64 + c * 4); return make_float4(bflo(u.x), bfhi(u.x), bflo(u.y), bfhi(u.y)); },
               [&](int k, int r, float sv) { const int n = 64 * ti + k; const int rel = qpos - (16 * n + 31); return (n < 127) ? sv + btab[r * 129 + (rel < 128 ? rel : 128)] : -3.0e38f; }, lane);
    } else {
      const int k0 = (ti - 2) * 64;
      sa_tile4(q4, Pw + k0 * 4,
               [&](int k, int c) { const int key = (k0 + k < 516) ? k0 + k : 515;
                 const float* rp = (key < 512) ? (p.swk + ((size_t)b * 512 + key) * 128 + g * 64) : (fresh_wk + (size_t)(key - 512) * 128);
                 return *(const float4*)(rp + c * 4); },
               [&](int k, int r, float sv) { const int key = k0 + k; const int rel = qpos - (PAST - 512 + key);
                 const bool ok = key < 516 && rel >= 0 && rel < 512; return ok ? sv + btab[r * 129 + (rel < 128 ? rel : 128)] : -3.0e38f; }, lane);
    }
  }
  __syncthreads();
  sa_softmax_row(Pc, 128, w, lane);
  sa_softmax_row(Pw, 576, w, lane);
  __syncthreads();
  if (w == 0) {
    if (lane < 33) {
      const int j = lane; float sm = 0.f;
      for (int u = -1; u <= 3; ++u) { const int n = 4 * j + u; if (n >= 0 && n < 127) { const float4 p4 = *(const float4*)(Pc + n * 4); sm += (p4.x + p4.y + p4.z + p4.w) * ((u == -1 || u == 3) ? 1.f : 2.f); } }
      imp[j] = sm;
    }
    if (lane == 0) {
      sel[0] = 0; sel[1] = 31; sel[2] = 32;
      unsigned taken = 0u;
      for (int c = 0; c < 5; ++c) {
        float best = -1.f; int bi = 1;
        for (int j = 1; j <= 30; ++j) { const float v = imp[j]; if (!((taken >> j) & 1u) && v > best) { best = v; bi = j; } }
        taken |= 1u << bi; sel[3 + c] = bi;
      }
    }
  }
  __syncthreads();
  for (int jj = w; jj < 8; jj += 4) {
    const int blk = sel[jj];
    const float* kbase = (blk < 32) ? (p.csk + (((size_t)pts[blk >> 1] * 128 + (blk & 1) * 64) * 2 + g) * 64) : fresh_sk;
    sa_tile4(q4, Ps + jj * 256,
             [&](int k, int c) { const int kk = (blk < 32) ? k : (k & 3); return *(const float4*)(kbase + (size_t)kk * 128 + c * 4); },
             [&](int k, int r, float sv) { const int rel = qpos - (blk * 64 + k); const bool ok = (blk < 32 || k < 4) && rel >= 0;
               return ok ? sv + btab[r * 129 + (rel < 0 ? 0 : (rel < 128 ? rel : 128))] : -3.0e38f; }, lane);
  }
  {
    float oc[4] = {0.f, 0.f, 0.f, 0.f}, ow[4] = {0.f, 0.f, 0.f, 0.f};
    const float* vc = (const float*)(p.ws + W_VCF) + (size_t)(b * 2 + g) * 128 * 64;
    sa_pv(Pc, 32 * w, (32 * w + 32 < 127) ? 32 * w + 32 : 127, [&](int k, int l) { return vc[(size_t)k * 64 + l]; }, lane, oc);
    const float* vst = p.swv + (size_t)b * 512 * 128 + g * 64;
    sa_pv(Pw, 129 * w, 129 * w + 129, [&](int k, int l) { const float* rp = (k < 512) ? (vst + (size_t)k * 128) : (fresh_wv + (size_t)(k - 512) * 128); return rp[l]; }, lane, ow);
#pragma unroll
    for (int r = 0; r < 4; ++r) { obuf[((0 * 4 + w) * 4 + r) * 64 + lane] = oc[r]; obuf[((1 * 4 + w) * 4 + r) * 64 + lane] = ow[r]; }
  }
  __syncthreads();
  sa_softmax_row(Ps, 512, w, lane);
  __syncthreads();
  {
    float os[4] = {0.f, 0.f, 0.f, 0.f};
    for (int jj = 2 * w; jj < 2 * w + 2; ++jj) {
      const int blk = sel[jj];
      const float* vbase; int ns;
      if (blk < 32) { vbase = p.csv + (((size_t)pts[blk >> 1] * 128 + (blk & 1) * 64) * 2 + g) * 64; ns = 64; } else { vbase = fresh_sv; ns = 4; }
      sa_pv(Ps + jj * 64 * 4, 0, ns, [&](int k, int l) { return vbase[(size_t)k * 128 + l]; }, lane, os);
    }
#pragma unroll
    for (int r = 0; r < 4; ++r) obuf[((2 * 4 + w) * 4 + r) * 64 + lane] = os[r];
  }
  __syncthreads();
  {
    const int r = tid >> 6, hd = g * 4 + r;
    const float* gt = (const float*)(p.ws + W_GATE) + tok * 24;
    float o = 0.f;
#pragma unroll
    for (int br = 0; br < 3; ++br) {
      float a = 0.f;
#pragma unroll
      for (int ww = 0; ww < 4; ++ww) a += obuf[((br * 4 + ww) * 4 + r) * 64 + lane];
      o += gt[(br == 0 ? 0 : (br == 1 ? 16 : 8)) + hd] * a;
    }
    ((u16*)(p.ws + W_OA))[tok * 512 + hd * 64 + lane] = f2bf(o * bf2f(((const u16*)(p.ws + W_ZA))[tok * 512 + hd * 64 + lane]));
  }
}

constexpr int P2_HP = BATCH * 4 * 32;
constexpr int P2_CMP = BATCH * 2 * 2;
constexpr int P2_SA = DEC_BATCH * 2 * 4;
constexpr int P2_HS = DEC_BATCH * 4;
constexpr int P2_TOTAL = P2_HP + P2_CMP + P2_SA + P2_HS;
DI void phase2_item(const Params& p, int it, char* lds) {
  if (it < P2_SA) { sample_attn_item(p, it, lds); return; }
  it -= P2_SA;
  if (it < P2_CMP) {
    const int kv = it & 1, g = (it >> 1) & 1, b = it >> 2;
    LoadCellBf16 al{(const u16*)(p.ws + W_KV) + (size_t)kv * NT * 128 + (size_t)b * 2048 * 128 + g * 64};
    comp_tile(p, al, b, g, kv, lds); return;
  }
  it -= P2_CMP;
  if (it < P2_HS) { hgrn_sample_item(p, it, lds); return; }
  it -= P2_HS;
  hgrn_h1_item(p, it, lds);
}

constexpr int AKS = 72, AVS = 68, ACS = 132;
DI bf16x8 pack8(const f32x16& x, int s2) {
  uint4 u; u.x = pk2(x[8 * s2], x[8 * s2 + 1]); u.y = pk2(x[8 * s2 + 2], x[8 * s2 + 3]);
  u.z = pk2(x[8 * s2 + 4], x[8 * s2 + 5]); u.w = pk2(x[8 * s2 + 6], x[8 * s2 + 7]);
  return __builtin_bit_cast(bf16x8, u);
}
DI void zero16(f32x16& x) {
#pragma unroll
  for (int i = 0; i < 16; ++i) x[i] = 0.f;
}

constexpr int T2N = 264;
template <int MODE>
DI void attn_tile(const u16* Kt, const u16* Vt, const float* t2r, float cfar, const bf16x8 (&qf)[4], int qpos, int kpos0, bool lane_on,
                  float& m_run, float& l_run, f32x16 (&oacc)[2], int ql, int hh) {
  f32x16 sacc[2];
#pragma unroll
  for (int kt = 0; kt < 2; ++kt) {
    zero16(sacc[kt]);
#pragma unroll
    for (int ks = 0; ks < 4; ++ks) {
      const bf16x8 kf = *(const bf16x8*)(Kt + (32 * kt + ql) * AKS + 16 * ks + 8 * hh);
      sacc[kt] = MFMA32(kf, qf[ks], sacc[kt]);
    }
  }
  float mt = -1.0e30f;
  if (MODE == 0) {
#pragma unroll
    for (int kt = 0; kt < 2; ++kt)
#pragma unroll
      for (int i = 0; i < 16; ++i) mt = fmaxf(mt, sacc[kt][i]);
    mt = lane_on ? mt + cfar : -1.0e30f;
  } else if (MODE == 1) {
    const float* tb = t2r + (lane_on ? (qpos - kpos0 + 63 - 4 * hh) : 59) - 59;
#pragma unroll
    for (int kt = 0; kt < 2; ++kt)
#pragma unroll
      for (int i = 0; i < 16; ++i) {
        sacc[kt][i] += tb[59 - (32 * kt + (i & 3) + 8 * (i >> 2))];
        mt = fmaxf(mt, sacc[kt][i]);
      }
  } else {
    const int thr = qpos - kpos0 - 4 * hh - 512;
#pragma unroll
    for (int kt = 0; kt < 2; ++kt)
#pragma unroll
      for (int i = 0; i < 16; ++i) {
        const bool ok = lane_on && (32 * kt + (i & 3) + 8 * (i >> 2)) > thr;
        sacc[kt][i] = ok ? sacc[kt][i] + cfar : -1.0e30f;
        mt = fmaxf(mt, sacc[kt][i]);
      }
  }
  mt = fmaxf(mt, __shfl_xor(mt, 32));
  const float mn = fmaxf(m_run, mt);
  if (!__all(mn == m_run)) {
    const float alpha = __builtin_amdgcn_exp2f(m_run - mn);
    l_run *= alpha;
#pragma unroll
    for (int dt = 0; dt < 2; ++dt)
#pragma unroll
      for (int i = 0; i < 16; ++i) oacc[dt][i] *= alpha;
  }
  m_run = mn;
  float ls = 0.f;
  if (MODE == 0) {
    const float dsh = lane_on ? cfar - mn : -1.0e30f;
#pragma unroll
    for (int kt = 0; kt < 2; ++kt)
#pragma unroll
      for (int i = 0; i < 16; ++i) { const float pv = __builtin_amdgcn_exp2f(sacc[kt][i] + dsh); sacc[kt][i] = pv; ls += pv; }
  } else {
#pragma unroll
    for (int kt = 0; kt < 2; ++kt)
#pragma unroll
      for (int i = 0; i < 16; ++i) {
        const float pv = (sacc[kt][i] > -1.0e29f) ? __builtin_amdgcn_exp2f(sacc[kt][i] - mn) : 0.f;
        sacc[kt][i] = pv; ls += pv;
      }
  }
  l_run += ls;
#pragma unroll
  for (int kt = 0; kt < 2; ++kt)
#pragma unroll
    for (int s2 = 0; s2 < 2; ++s2) {
      const bf16x8 pf = pack8(sacc[kt], s2);
#pragma unroll
      for (int dt = 0; dt < 2; ++dt) {
        const u16* vp = Vt + (32 * kt + 16 * s2 + 4 * hh + ((ql & 15) >> 2)) * AKS + 32 * dt + (ql & 16) + 4 * (ql & 3);
        const bf16x8 vf = cat8(tr_read(vp), tr_read(vp + 8 * AKS));
        oacc[dt] = MFMA32(vf, pf, oacc[dt]);
      }
    }
}

DI void attn_load_tile(u16* Kt, u16* Vt, const u16* ksrc  , const u16* vtsrc  ) {
  const int tid = otid512();
  {
    const int idx = tid, rw = idx >> 3, ch = idx & 7;
    *(uint4*)(Kt + rw * AKS + ch * 8) = *(const uint4*)(ksrc + (size_t)rw * 128 + ch * 8);
    const uint4 v = *(const uint4*)(vtsrc + (size_t)rw * 2048 + ch * 8);
    *(uint2*)(Vt + rw * AVS + ch * 8) = make_uint2(v.x, v.y);
    *(uint2*)(Vt + rw * AVS + ch * 8 + 4) = make_uint2(v.z, v.w);
  }
}

DI void prompt_attn_item(const Params& p, int it, char* lds) {
  const int qt = (it < 256) ? (31 - (it & 31)) : (it & 31), g = (it >> 5) & 1, b = (it >> 6) & 3 | ((it >> 8) << 2);
  const int t0 = qt * 64;
  const int tid = otid512(), lane = tid & 63, w = tid >> 6, ql = lane & 31, hh = lane >> 5, tl = ql >> 2, r = ql & 3;
  const int qpos = t0 + 8 * w + tl, head = g * 4 + r;
  const size_t tok = (size_t)b * 2048 + qpos;
  u16* Kt = (u16*)lds;
  u16* Vt = Kt + 128 * AKS;
  float* brel = (float*)(Vt + 128 * AKS);
  float* t2 = brel + 4 * 129;
  unsigned* wmask = (unsigned*)(t2 + 4 * T2N);
  const u16* Qb = (const u16*)(p.ws + W_Q);
  __syncthreads();
  for (int i = tid; i < 4 * 129; i += 512) { const int rr = i / 129, rel = i % 129; const int bk = rel < 128 ? T5B[rel] : 31; brel[i] = p.rel_bias[bk * 8 + g * 4 + rr] * LOG2E; }
  for (int i = tid; i < 4 * T2N; i += 512) { const int rr = i / T2N, rel = i % T2N - 63; const int bk = rel < 128 ? T5B[rel < 0 ? 0 : rel] : 31;
    t2[i] = (rel < 0) ? -1.0e30f : p.rel_bias[bk * 8 + g * 4 + rr] * LOG2E; }
  bf16x8 qf[4];
#pragma unroll
  for (int ks = 0; ks < 4; ++ks) qf[ks] = *(const bf16x8*)(Qb + tok * 512 + head * 64 + 16 * ks + 8 * hh);
  const float* gt = (const float*)(p.ws + W_GATE) + tok * 24;
  const float* brel_r = brel + r * 129;
  const float* t2r = t2 + r * T2N;
  const float cfar = p.rel_bias[31 * 8 + head] * LOG2E;
  f32x16 of[2];
  unsigned selm;
  {
#pragma unroll
    for (int i = 0; i < 2; ++i) {
      const int idx = tid + 512 * i, n = idx >> 3, ch = idx & 7;
      *(uint4*)(Kt + n * AKS + ch * 8) = *(const uint4*)((const u16*)(p.ws + W_KCMP) + ((size_t)(b * 2 + g) * 128 + n) * 64 + ch * 8);
      *(uint4*)(Vt + n * AKS + ch * 8) = *(const uint4*)((const u16*)(p.ws + W_VCMP) + ((size_t)(b * 2 + g) * 128 + n) * 64 + ch * 8);
    }
    __syncthreads();
    f32x16 sacc[4];
#pragma unroll
    for (int kt = 0; kt < 4; ++kt) {
      zero16(sacc[kt]);
#pragma unroll
      for (int ks = 0; ks < 4; ++ks) {
        const bf16x8 kf = *(const bf16x8*)(Kt + (32 * kt + ql) * AKS + 16 * ks + 8 * hh);
        sacc[kt] = MFMA32(kf, qf[ks], sacc[kt]);
      }
    }
    float mt = -1.0e30f;
#pragma unroll
    for (int kt = 0; kt < 4; ++kt)
#pragma unroll
      for (int i = 0; i < 16; ++i) {
        const int n = 32 * kt + crow(i, hh);
        const int rel = qpos - (16 * n + 31);
        const bool ok = rel >= 0 && n < 127;
        const float sv = sacc[kt][i] + brel_r[rel < 0 ? 0 : (rel < 128 ? rel : 128)];
        sacc[kt][i] = ok ? sv : -1.0e30f;
        mt = fmaxf(mt, sacc[kt][i]);
      }
    mt = fmaxf(mt, __shfl_xor(mt, 32));
    float ls = 0.f;
#pragma unroll
    for (int kt = 0; kt < 4; ++kt)
#pragma unroll
      for (int i = 0; i < 16; ++i) { const float pv = (sacc[kt][i] > -1.0e29f) ? __builtin_amdgcn_exp2f(sacc[kt][i] - mt) : 0.f; sacc[kt][i] = pv; ls += pv; }
    ls += __shfl_xor(ls, 32);
    const float inv = ls > 0.f ? 1.f / ls : 0.f;
#pragma unroll
    for (int kt = 0; kt < 4; ++kt)
#pragma unroll
      for (int i = 0; i < 16; ++i) sacc[kt][i] *= inv;
    f32x16 oc[2]; zero16(oc[0]); zero16(oc[1]);
#pragma unroll
    for (int kt = 0; kt < 4; ++kt)
#pragma unroll
      for (int s2 = 0; s2 < 2; ++s2) {
        const bf16x8 pf = pack8(sacc[kt], s2);
#pragma unroll
        for (int dt = 0; dt < 2; ++dt) {
          const u16* vp = Vt + (32 * kt + 16 * s2 + 4 * hh + ((ql & 15) >> 2)) * AKS + 32 * dt + (ql & 16) + 4 * (ql & 3);
          const bf16x8 vf = cat8(tr_read(vp), tr_read(vp + 8 * AKS));
          oc[dt] = MFMA32(vf, pf, oc[dt]);
        }
      }
    const float g0 = gt[head];
#pragma unroll
    for (int dt = 0; dt < 2; ++dt)
#pragma unroll
      for (int i = 0; i < 16; ++i) of[dt][i] = g0 * oc[dt][i];
    float im[16], cm[16];
#pragma unroll
    for (int kt = 0; kt < 4; ++kt)
#pragma unroll
      for (int q4 = 0; q4 < 4; ++q4) {
        const float p0 = sacc[kt][4 * q4], p1 = sacc[kt][4 * q4 + 1], p2 = sacc[kt][4 * q4 + 2], p3 = sacc[kt][4 * q4 + 3];
        im[4 * kt + q4] = 2.f * (p0 + p1 + p2) + p3; cm[4 * kt + q4] = p3;
      }
#pragma unroll
    for (int m = 0; m < 16; ++m) cm[m] = __shfl_xor(cm[m], 32);
#pragma unroll
    for (int m = 15; m >= 0; --m) im[m] += hh ? cm[m] : (m > 0 ? cm[m - 1] : 0.f);
#pragma unroll
    for (int m = 0; m < 16; ++m) { im[m] += __shfl_xor(im[m], 1); im[m] += __shfl_xor(im[m], 2); }
    float ev[16], od[16];
#pragma unroll
    for (int m = 0; m < 16; ++m) { const float ot = __shfl_xor(im[m], 32); ev[m] = hh ? ot : im[m]; od[m] = hh ? im[m] : ot; }
    const int cur = qpos >> 6;
    if (cur < 8) selm = (2u << cur) - 1u;
    else {
      selm = 1u | (1u << cur) | (1u << (cur - 1));
      for (int c = 0; c < 5; ++c) {
        float best = -1.f;
#pragma unroll
        for (int J = 0; J < 32; ++J) { const float v = (J <= cur && !((selm >> J) & 1u)) ? ((J & 1) ? od[J >> 1] : ev[J >> 1]) : -1.f; best = fmaxf(best, v); }
        int bi = 32;
#pragma unroll
        for (int J = 31; J >= 0; --J) { const float v = (J <= cur && !((selm >> J) & 1u)) ? ((J & 1) ? od[J >> 1] : ev[J >> 1]) : -1.f; if (v == best) bi = J; }
        if (best >= 0.f) selm |= 1u << bi;
      }
    }
    unsigned um = selm;
    um |= __shfl_xor(um, 4); um |= __shfl_xor(um, 8); um |= __shfl_xor(um, 16);
    if (lane == 0) wmask[w] = um;
  }
  __syncthreads();
  const unsigned un = wmask[0] | wmask[1] | wmask[2] | wmask[3] | wmask[4] | wmask[5] | wmask[6] | wmask[7];
  {
    const u16* ks = (const u16*)(p.ws + W_KV) + (size_t)2 * NT * 128 + (size_t)b * 2048 * 128 + g * 64;
    const u16* vts = (const u16*)(p.ws + W_KV) + (size_t)3 * NT * 128 + (size_t)b * 2048 * 128 + g * 64;
    const u16* kw = (const u16*)(p.ws + W_KV) + (size_t)4 * NT * 128 + (size_t)b * 2048 * 128 + g * 64;
    const u16* vtw = (const u16*)(p.ws + W_KV) + (size_t)5 * NT * 128 + (size_t)b * 2048 * 128 + g * 64;
    const int rw = tid >> 3, ch = tid & 7;
    uint4 kreg, vreg;
#define ATT_PREFETCH(kb, vb, j_) do { kreg = *(const uint4*)((kb) + ((size_t)(j_) * 64 + rw) * 128 + ch * 8); vreg = *(const uint4*)((vb) + ((size_t)(j_) * 64 + rw) * 128 + ch * 8); } while (0)
#define ATT_COMMIT(par_) do { *(uint4*)(Kt + ((par_) * 64 + rw) * AKS + ch * 8) = kreg; *(uint4*)(Vt + ((par_) * 64 + rw) * AKS + ch * 8) = vreg; } while (0)
    const int jlo = (t0 >= 511) ? ((t0 - 511) >> 6) : 0, jhi = (t0 + 63) >> 6;
    int par = 0;
    {
      float m_run = -1.0e30f, l_run = 0.f; f32x16 oacc[2]; zero16(oacc[0]); zero16(oacc[1]);
      unsigned rem = un;
      int j = __builtin_ctz(rem); rem &= rem - 1u;
      ATT_PREFETCH(ks, vts, j);
      for (;;) {
        ATT_COMMIT(par);
        const int jn = rem ? __builtin_ctz(rem) : -1;
        if (jn >= 0) { rem &= rem - 1u; ATT_PREFETCH(ks, vts, jn); } else { ATT_PREFETCH(kw, vtw, jlo); }
        __syncthreads();
        const bool on = (selm >> j) & 1u;
        if (__ballot(on) != 0ull) {
          if (64 * j + 63 + 128 <= t0 + 8 * w) attn_tile<0>(Kt + par * 64 * AKS, Vt + par * 64 * AKS, t2r, cfar, qf, qpos, j * 64, on, m_run, l_run, oacc, ql, hh);
          else attn_tile<1>(Kt + par * 64 * AKS, Vt + par * 64 * AKS, t2r, cfar, qf, qpos, j * 64, on, m_run, l_run, oacc, ql, hh);
        }
        par ^= 1;
        if (jn < 0) break;
        j = jn;
      }
      l_run += __shfl_xor(l_run, 32);
      const float sc = gt[8 + head] * (l_run > 0.f ? 1.f / l_run : 0.f);
#pragma unroll
      for (int dt = 0; dt < 2; ++dt)
#pragma unroll
        for (int i = 0; i < 16; ++i) of[dt][i] += sc * oacc[dt][i];
    }
    {
      float m_run = -1.0e30f, l_run = 0.f; f32x16 oacc[2]; zero16(oacc[0]); zero16(oacc[1]);
      for (int j = jlo; j <= jhi; ++j) {
        ATT_COMMIT(par);
        if (j < jhi) ATT_PREFETCH(kw, vtw, j + 1);
        __syncthreads();
        const u16* Kp = Kt + par * 64 * AKS; const u16* Vp = Vt + par * 64 * AKS;
        if (64 * j + 63 + 128 > t0 + 8 * w) attn_tile<1>(Kp, Vp, t2r, cfar, qf, qpos, j * 64, true, m_run, l_run, oacc, ql, hh);
        else if (64 * j + 511 >= t0 + 8 * w + 7) attn_tile<0>(Kp, Vp, t2r, cfar, qf, qpos, j * 64, true, m_run, l_run, oacc, ql, hh);
        else attn_tile<2>(Kp, Vp, t2r, cfar, qf, qpos, j * 64, true, m_run, l_run, oacc, ql, hh);
        par ^= 1;
      }
      l_run += __shfl_xor(l_run, 32);
      const float sc = gt[16 + head] * (l_run > 0.f ? 1.f / l_run : 0.f);
#pragma unroll
      for (int dt = 0; dt < 2; ++dt)
#pragma unroll
        for (int i = 0; i < 16; ++i) of[dt][i] += sc * oacc[dt][i];
    }
#undef ATT_PREFETCH
#undef ATT_COMMIT
  }
  {
    const u16* za = (const u16*)(p.ws + W_ZA) + tok * 512 + head * 64; u16* oa = (u16*)(p.ws + W_OA) + tok * 512 + head * 64;
    uint2 zz[2][4];
#pragma unroll
    for (int dt = 0; dt < 2; ++dt)
#pragma unroll
      for (int q4 = 0; q4 < 4; ++q4) zz[dt][q4] = *(const uint2*)(za + 32 * dt + 8 * q4 + 4 * hh);
#pragma unroll
    for (int dt = 0; dt < 2; ++dt)
#pragma unroll
      for (int q4 = 0; q4 < 4; ++q4) {
        const int dd = 32 * dt + 8 * q4 + 4 * hh;
        const uint2 z = zz[dt][q4];
        uint2 o; o.x = pk2(of[dt][4 * q4] * bflo(z.x), of[dt][4 * q4 + 1] * bfhi(z.x)); o.y = pk2(of[dt][4 * q4 + 2] * bflo(z.y), of[dt][4 * q4 + 3] * bfhi(z.y));
        *(uint2*)(oa + dd) = o;
      }
  }
}
constexpr int P3_FIN = BATCH * 4 * 32;
constexpr int P3_ATT = BATCH * 2 * 32;
constexpr int P3_TOTAL = P3_FIN + P3_ATT;

constexpr int P4_TOTAL = 128 * 8 + 4 * 16;
template <int NI>
DI void merge_a_tile_t(const Params& p, int tm, int tn, char* lds) {
  f32x16 aa[2][NI], ab[2][NI]; zero_acc<NI>(aa); zero_acc<NI>(ab);
  gemm_glds<NI>(aa, (const u16*)(p.ws + W_OA) + (size_t)tm * 128 * 512, 512, (const u16*)(p.ws + W_WBAT) + (size_t)tn * 64 * NI * 512, 512, 8, lds);
  gemm_glds<NI>(ab, (const u16*)(p.ws + W_OB) + (size_t)tm * 128 * 512, 512, (const u16*)(p.ws + W_WBBT) + (size_t)tn * 64 * NI * 512, 512, 8, lds);
  const int tid = otid(), lane = tid & 63, wave = tid >> 6, wm = wave >> 1, wn = wave & 1, r = lane & 31, h = lane >> 5;
#pragma unroll
  for (int mi = 0; mi < 2; ++mi)
#pragma unroll
    for (int ni = 0; ni < NI; ++ni) {
      const int c = tn * 64 * NI + wn * 32 * NI + ni * 32 + r;
      u16 ga[16], gb[16];
#pragma unroll
      for (int i = 0; i < 16; ++i) { const size_t off = (size_t)(tm * 128 + wm * 64 + mi * 32 + crow(i, h)) * 1024 + c; ga[i] = ((const u16*)(p.ws + W_SA))[off]; gb[i] = ((const u16*)(p.ws + W_SB))[off]; }
#pragma unroll
      for (int i = 0; i < 16; ++i) {
        const size_t off = (size_t)(tm * 128 + wm * 64 + mi * 32 + crow(i, h)) * 1024 + c;
        ((u16*)(p.ws + W_Y))[off] = f2bf(bf2f(ga[i]) * aa[mi][ni][i] + bf2f(gb[i]) * ab[mi][ni][i]);
      }
    }
}
DI void merge_a_tile(const Params& p, int it, char* lds) {
  if (it < 1024) merge_a_tile_t<2>(p, it >> 3, it & 7, lds);
  else { it -= 1024; merge_a_tile_t<1>(p, 128 + (it >> 4), it & 15, lds); }
}
constexpr int P5_TOTAL = 128 * 8 + 4 * 16;
template <int NI>
DI void merge_b_tile_t(const Params& p, int tm, int tn, char* lds) {
  f32x16 acc[2][NI]; zero_acc<NI>(acc);
  gemm_glds<NI>(acc, (const u16*)(p.ws + W_Y) + (size_t)tm * 128 * 1024, 1024, (const u16*)(p.ws + W_WOUTT) + (size_t)tn * 64 * NI * 1024, 1024, 16, lds);
  const int tid = otid(), lane = tid & 63, wave = tid >> 6, wm = wave >> 1, wn = wave & 1, r = lane & 31, h = lane >> 5;
  const float* xin = (tm < 128) ? p.x_prompt : (p.x_sample - (size_t)NTP * 1024);
#pragma unroll
  for (int mi = 0; mi < 2; ++mi) {
    float xv[16][NI];
#pragma unroll
    for (int i = 0; i < 16; ++i)
#pragma unroll
      for (int ni = 0; ni < NI; ++ni) xv[i][ni] = xin[(size_t)(tm * 128 + wm * 64 + mi * 32 + crow(i, h)) * 1024 + tn * 64 * NI + wn * 32 * NI + ni * 32 + r];
#pragma unroll
    for (int i = 0; i < 16; ++i) {
      const size_t row = (size_t)(tm * 128 + wm * 64 + mi * 32 + crow(i, h));
#pragma unroll
      for (int ni = 0; ni < NI; ++ni) {
        const int c = tn * 64 * NI + wn * 32 * NI + ni * 32 + r;
        p.out[row * 1024 + c] = acc[mi][ni][i] + xv[i][ni];
      }
    }
  }
}
DI void merge_b_tile(const Params& p, int it, char* lds) {
  if (it < 1024) merge_b_tile_t<2>(p, it >> 3, it & 7, lds);
  else { it -= 1024; merge_b_tile_t<1>(p, 128 + (it >> 4), it & 15, lds); }
}
constexpr int P6_TOTAL = NT / 8;
DI void final_norm_item(const Params& p, int it) {
  const int tid_ = otid(), lane = tid_ & 63, wave = tid_ >> 6; const size_t row = (size_t)it * 8 + wave * 2;
  float* o = p.out + row * 1024;
  float4 v[2][4]; float ss[2] = {0.f, 0.f};
#pragma unroll
  for (int rr = 0; rr < 2; ++rr)
#pragma unroll
    for (int i = 0; i < 4; ++i) v[rr][i] = *(const float4*)(o + rr * 1024 + (i * 64 + lane) * 4);
#pragma unroll
  for (int rr = 0; rr < 2; ++rr) {
#pragma unroll
    for (int i = 0; i < 4; ++i) ss[rr] += v[rr][i].x * v[rr][i].x + v[rr][i].y * v[rr][i].y + v[rr][i].z * v[rr][i].z + v[rr][i].w * v[rr][i].w;
    ss[rr] = wave_sum(ss[rr]);
  }
#pragma unroll
  for (int rr = 0; rr < 2; ++rr) {
    const float rs = rsqrtf(ss[rr] * (1.f / 1024.f) + 1e-6f);
#pragma unroll
    for (int i = 0; i < 4; ++i) {
      const float4 gg = *(const float4*)(p.final_g + (i * 64 + lane) * 4);
      *(float4*)(o + rr * 1024 + (i * 64 + lane) * 4) = make_float4(v[rr][i].x * rs * gg.x, v[rr][i].y * rs * gg.y, v[rr][i].z * rs * gg.z, v[rr][i].w * rs * gg.w);
    }
  }
}

namespace pg8 {
#define PG8_LAS __attribute__((address_space(3)))
typedef unsigned short bf16_t;
typedef short bf16x8 __attribute__((ext_vector_type(8)));
typedef float f32x4 __attribute__((ext_vector_type(4)));
typedef unsigned u32x4 __attribute__((ext_vector_type(4)));
constexpr int BM = 256, BK = 64, HALF = 128, HTB = HALF * BK * 2  , STAGE_BYTES = 8 * HTB, NXCD = 8, WGM = 8;

__host__ __device__ __forceinline__ int lds_byte(int r, int c) { const int st = (r >> 4) * 2 + (c >> 5), rr = r & 15, cc = c & 31, ob = rr * 64 + cc * 2; return st * 1024 + (ob ^ (((ob >> 9) & 1) << 5)); }
__host__ __device__ __forceinline__ void stage_rc(int b, int& R, int& C) { const int st = b / 1024, sb = b % 1024, swz = sb ^ (((sb >> 9) & 1) << 5); R = (st >> 1) * 16 + swz / 64; C = (st & 1) * 32 + (swz % 64) / 2; }
__host__ __device__ __forceinline__ int perm32(int rho) { const int n = rho >> 4, i = rho & 15; return 8 * (i >> 2) + 4 * n + (i & 3); }

struct Unit { int pm, pn; };
struct Gemm { const bf16_t* A; const bf16_t* Bt; int M, N, K; };

struct StaticOrder {
    int nM, nN, nwg, G, c;
    __host__ __device__ void init(int M, int N, int G_, int c_) { nM = M / BM; nN = N / BM; nwg = nM * nN; G = G_; c = c_; }
    __host__ __device__ bool next(int i, Unit& u) const {
        const long L = (long)i * G + c; if (L >= nwg) return false;
        int wgid = (int)L; { const int q = nwg / NXCD, r = nwg % NXCD, xcd = wgid % NXCD, off = wgid / NXCD; wgid = (xcd < r ? xcd * (q + 1) : r * (q + 1) + (xcd - r) * q) + off; }
        const int nig = WGM * nN, gid = wgid / nig, fm = gid * WGM, gsz = (nM - fm) < WGM ? (nM - fm) : WGM;
        u.pm = fm + ((wgid % nig) % gsz); u.pn = (wgid % nig) / gsz; return true;
    }
    __device__ __forceinline__ void a_ready(const Unit&) const {}
    __device__ __forceinline__ void done(const Unit&) const {}
};

template <class Epi, class Sched, bool STAMP = false>
__device__ __forceinline__ void gemm_phase(PG8_LAS unsigned char* lds, const Gemm g, const Sched& S, const Epi& E, unsigned long long* stamps) {
    int tid_ = threadIdx.x; asm volatile("" : "+v"(tid_));
    const int tid = tid_, wid = __builtin_amdgcn_readfirstlane(tid >> 6), lane = tid & 63, wr = wid >> 2, wc = wid & 3, fr = lane & 15, fq = lane >> 4;
    const int K = g.K, nt = K / BK;
    int ts_lo = 0, ts_hi = 0, nts = 0; const unsigned long long rt_entry = STAMP ? (unsigned long long)wall_clock64() : 0ull;
#define PG8_STAMP() do { if (STAMP && wid == 0 && nts < 64) { const unsigned long long _c = (unsigned long long)clock64(); \
        ts_lo = (lane == nts) ? (int)(unsigned)_c : ts_lo; ts_hi = (lane == nts) ? (int)(unsigned)(_c >> 32) : ts_hi; ++nts; } } while (0)
    PG8_STAMP();
    unsigned voffA[2], voffB[2];
#pragma unroll
    for (int i = 0; i < 2; ++i) { int R, C; stage_rc(tid * 16 + i * 8192, R, C); const int Rb = Epi::PERM ? ((R & ~31) + perm32(R & 31)) : R;
        voffA[i] = (unsigned)(R * K + C) * 2u; voffB[i] = (unsigned)(Rb * K + C) * 2u; }
    const size_t kstep = (size_t)(BK * 2);
    const size_t hstep = (size_t)HALF * K * 2;
    const size_t tstep = 2 * hstep;
    const unsigned ldsw = (unsigned)wid * 1024u;
    const int aoff = lds_byte(wr * 64 + fr, fq * 8), boff = lds_byte(wc * 32 + fr, fq * 8);
#define PG8_SA(b, h) (((b) * 2 + (h)) * HTB)
#define PG8_SB(b, h) ((4 + (b) * 2 + (h)) * HTB)
#define PG8_STAGE(bufoff, gbase, voff) do { _Pragma("unroll") for (int _i = 0; _i < 2; ++_i) \
        __builtin_amdgcn_global_load_lds((const unsigned*)((const char*)(gbase) + (voff)[_i]), (PG8_LAS unsigned*)(lds + (bufoff) + ldsw + _i * 8192), 16, 0, 0); } while (0)
#define PG8_LDA(dst, b, h) do { _Pragma("unroll") for (int m = 0; m < 4; ++m) _Pragma("unroll") for (int k = 0; k < 2; ++k) dst[m][k] = *(const PG8_LAS bf16x8*)(lds + PG8_SA(b, h) + aoff + m * 2048 + k * 1024); } while (0)
#define PG8_LDB(dst, b, h) do { _Pragma("unroll") for (int n = 0; n < 2; ++n) _Pragma("unroll") for (int k = 0; k < 2; ++k) dst[n][k] = *(const PG8_LAS bf16x8*)(lds + PG8_SB(b, h) + boff + n * 2048 + k * 1024); } while (0)
#define PG8_MMA(ai, bj, At, Bt) do { __builtin_amdgcn_s_setprio(1); _Pragma("unroll") for (int m = 0; m < 4; ++m) _Pragma("unroll") for (int n = 0; n < 2; ++n) _Pragma("unroll") for (int k = 0; k < 2; ++k) \
        acc[ai][bj][m][n] = __builtin_amdgcn_mfma_f32_16x16x32_bf16(Bt[n][k], At[m][k], acc[ai][bj][m][n], 0, 0, 0); __builtin_amdgcn_s_setprio(0); } while (0)
#define PG8_WAIT_V(n) asm volatile("s_waitcnt vmcnt(" #n ")" ::: "memory")
#define PG8_WAIT_L(n) asm volatile("s_waitcnt lgkmcnt(" #n ")" ::: "memory")
#define PG8_BAR __builtin_amdgcn_s_barrier()
#define PG8_SCHED __builtin_amdgcn_sched_barrier(0)
    Unit cur, nxt; int ui = 0;
    if (!S.next(0, cur)) return;
    f32x4 acc[2][2][4][2];
#pragma unroll
    for (int a = 0; a < 2; ++a)
#pragma unroll
        for (int b = 0; b < 2; ++b)
#pragma unroll
            for (int m = 0; m < 4; ++m)
#pragma unroll
                for (int n = 0; n < 2; ++n) acc[a][b][m][n] = (f32x4){0.f, 0.f, 0.f, 0.f};
    bf16x8 At[4][2], B0[2][2], B1[2][2];
    const char* cA = (const char*)g.A + (size_t)cur.pm * tstep; const char* cB = (const char*)g.Bt + (size_t)cur.pn * tstep;
    S.a_ready(cur);
    PG8_STAGE(PG8_SB(0, 0), cB, voffB); PG8_STAGE(PG8_SA(0, 0), cA, voffA); PG8_STAGE(PG8_SB(0, 1), cB + hstep, voffB); PG8_STAGE(PG8_SA(0, 1), cA + hstep, voffA);
    if (wr == 1) PG8_BAR;
    PG8_WAIT_V(4); PG8_BAR;
    PG8_STAGE(PG8_SB(1, 0), cB + kstep, voffB); PG8_STAGE(PG8_SA(1, 0), cA + kstep, voffA); PG8_STAGE(PG8_SB(1, 1), cB + hstep + kstep, voffB);
    PG8_WAIT_V(6); PG8_BAR;
    PG8_STAMP();
    for (;;) {
        const bool has_next = S.next(ui + 1, nxt);
        const char* nA = has_next ? (const char*)g.A + (size_t)nxt.pm * tstep : cA; const char* nB = has_next ? (const char*)g.Bt + (size_t)nxt.pn * tstep : cB;
        for (int t = 0; t < nt; t += 2) {
            const bool last = (t == nt - 2);
            const char* a1 = cA + (size_t)(t + 1) * kstep;
            const char* a2 = last ? nA : cA + (size_t)(t + 2) * kstep; const char* b2 = last ? nB : cB + (size_t)(t + 2) * kstep;
            const char* a3 = a2 + kstep; const char* b3 = b2 + kstep;
            if (last && has_next) S.a_ready(nxt);
            PG8_LDB(B0, 0, 0); PG8_SCHED; PG8_LDA(At, 0, 0); PG8_STAGE(PG8_SA(1, 1), a1 + hstep, voffA);
            PG8_WAIT_L(8); PG8_BAR; PG8_WAIT_L(0); PG8_MMA(0, 0, At, B0); PG8_BAR; PG8_SCHED;
            PG8_LDB(B1, 0, 1); PG8_STAGE(PG8_SB(0, 0), b2, voffB);
            PG8_BAR; PG8_WAIT_L(0); PG8_MMA(0, 1, At, B1); PG8_BAR;
            PG8_LDA(At, 0, 1); PG8_STAGE(PG8_SA(0, 0), a2, voffA);
            PG8_BAR; PG8_WAIT_L(0); PG8_MMA(1, 0, At, B0); PG8_BAR; PG8_SCHED;
            PG8_STAGE(PG8_SB(0, 1), b2 + hstep, voffB);
            PG8_WAIT_V(6); PG8_BAR; PG8_MMA(1, 1, At, B1); PG8_BAR;
            PG8_LDB(B0, 1, 0); PG8_SCHED; PG8_LDA(At, 1, 0); PG8_STAGE(PG8_SA(0, 1), a2 + hstep, voffA);
            PG8_WAIT_L(8); PG8_BAR; PG8_WAIT_L(0); PG8_MMA(0, 0, At, B0); PG8_BAR; PG8_SCHED;
            PG8_LDB(B1, 1, 1); PG8_STAGE(PG8_SB(1, 0), b3, voffB);
            PG8_BAR; PG8_WAIT_L(0); PG8_MMA(0, 1, At, B1); PG8_BAR;
            PG8_LDA(At, 1, 1); PG8_STAGE(PG8_SA(1, 0), a3, voffA);
            PG8_BAR; PG8_WAIT_L(0); PG8_MMA(1, 0, At, B0); PG8_BAR; PG8_SCHED;
            PG8_STAGE(PG8_SB(1, 1), b3 + hstep, voffB);
            PG8_WAIT_V(6); PG8_BAR; PG8_MMA(1, 1, At, B1); PG8_BAR;
        }
        PG8_STAMP();
        if constexpr (!Epi::AFTER_DRAIN) { E(acc, cur, wr, wc, fr, fq); S.done(cur); }
        PG8_STAMP();
        if (!has_next) break;
#pragma unroll
        for (int a = 0; a < 2; ++a)
#pragma unroll
            for (int b = 0; b < 2; ++b)
#pragma unroll
                for (int m = 0; m < 4; ++m)
#pragma unroll
                    for (int n = 0; n < 2; ++n) acc[a][b][m][n] = (f32x4){0.f, 0.f, 0.f, 0.f};
        cur = nxt; cA = nA; cB = nB; ++ui;
    }
    PG8_WAIT_V(0);
    if (wr == 0) PG8_BAR;
    PG8_BAR;
    if constexpr (Epi::AFTER_DRAIN) { E.fused(acc, cur, wr, wc, fr, fq, lds, wid, lane); S.done(cur); }
    PG8_STAMP();
    if (STAMP && wid == 0) { stamps[lane] = lane < nts ? (((unsigned long long)(unsigned)ts_hi << 32) | (unsigned)ts_lo) : 0ull;
        if (lane == 62) stamps[62] = rt_entry; if (lane == 63) stamps[63] = (unsigned long long)wall_clock64(); }
#undef PG8_STAMP
#undef PG8_SA
#undef PG8_SB
#undef PG8_STAGE
#undef PG8_LDA
#undef PG8_LDB
#undef PG8_MMA
#undef PG8_WAIT_V
#undef PG8_WAIT_L
#undef PG8_BAR
#undef PG8_SCHED
}
}


DI uint4 pack8f(const float (&v)[8]) { uint4 u; u.x = pk2(v[0], v[1]); u.y = pk2(v[2], v[3]); u.z = pk2(v[4], v[5]); u.w = pk2(v[6], v[7]); return u; }
struct EpiProj {
  static constexpr bool PERM = true, AFTER_DRAIN = false;
  Params p;
#define EPI_ROWS(BODY) _Pragma("unroll") for (int ai = 0; ai < 2; ++ai) _Pragma("unroll") for (int m = 0; m < 4; ++m) { \
      const size_t row = (size_t)(u.pm * 256 + ai * 128 + wr * 64 + m * 16 + fr); float v[8]; \
      _Pragma("unroll") for (int j = 0; j < 4; ++j) { v[j] = acc[ai][bj][m][0][j]; v[4 + j] = acc[ai][bj][m][1][j]; } BODY }
  DI void operator()(const pg8::f32x4 (&acc)[2][2][4][2], const pg8::Unit& u, int wr, int wc, int fr, int fq) const {
    const bool samp = u.pm >= NTP / 256;
#pragma unroll
    for (int bj = 0; bj < 2; ++bj) {
      const int tn = 2 * u.pn + bj;
      const int c = wc * 32 + 8 * fq;
      if (tn < 4) {
        u16* d = (u16*)(p.ws + W_Q) + tn * 128 + c;
        EPI_ROWS({ _Pragma("unroll") for (int j = 0; j < 8; ++j) v[j] *= 0.125f * LOG2E; *(uint4*)(d + row * 512) = pack8f(v); })
      } else if (tn < 10) {
        const int kvg = tn - 4;
        u16* d = (u16*)(p.ws + W_KV) + (size_t)kvg * NT * 128 + c;
        if (!samp) {
          if (kvg < 4) {
            float* o = p.out + O_PCK + (size_t)kvg * NTP * 128 + c;
            EPI_ROWS({ *(uint4*)(d + row * 128) = pack8f(v); float* q_ = o + row * 128; *(float4*)q_ = make_float4(v[0], v[1], v[2], v[3]); *(float4*)(q_ + 4) = make_float4(v[4], v[5], v[6], v[7]); })
          } else if ((u.pm & 7) >= 6) {
            float* o = p.out + O_PWK + (size_t)(kvg - 4) * BATCH * 512 * 128 + c;
            EPI_ROWS({ *(uint4*)(d + row * 128) = pack8f(v); const size_t wr_ = (row >> 11) * 512 + (row & 2047) - 1536;
                       float* q_ = o + wr_ * 128; *(float4*)q_ = make_float4(v[0], v[1], v[2], v[3]); *(float4*)(q_ + 4) = make_float4(v[4], v[5], v[6], v[7]); })
          } else {
            EPI_ROWS({ *(uint4*)(d + row * 128) = pack8f(v); })
          }
        } else {
          float* o = (kvg < 4) ? (p.out + O_SCK + (size_t)kvg * NTS * 128 + c) : (p.out + O_SWK + (size_t)(kvg - 4) * DEC_BATCH * 512 * 128 + c);
          const bool win = kvg >= 4;
          EPI_ROWS({ *(uint4*)(d + row * 128) = pack8f(v); const size_t sr = row - NTP; const size_t orow = win ? ((sr >> 2) * 512 + 508 + (sr & 3)) : sr;
                     float* q_ = o + orow * 128; *(float4*)q_ = make_float4(v[0], v[1], v[2], v[3]); *(float4*)(q_ + 4) = make_float4(v[4], v[5], v[6], v[7]); })
        }
      } else if (tn < 14) {
        u16* d = (u16*)(p.ws + W_ZA) + (tn - 10) * 128 + c;
        EPI_ROWS({ _Pragma("unroll") for (int j = 0; j < 8; ++j) v[j] = siluf_(v[j]); *(uint4*)(d + row * 512) = pack8f(v); })
      } else if (tn >= 26 && tn < 30) {
        u16* d = (u16*)(p.ws + W_ZB) + (tn - 26) * 128 + c;
        EPI_ROWS({ *(uint4*)(d + row * 512) = pack8f(v); })
      } else if (tn < 18 || (tn >= 22 && tn < 26)) {
        u16* d = (u16*)(p.ws + (tn < 18 ? W_QB : W_VB)) + (tn < 18 ? tn - 14 : tn - 22) * 128 + c;
        EPI_ROWS({ *(uint4*)(d + row * 512) = pack8f(v); })
      } else if (tn < 22) {
        float* dg = (float*)(p.ws + W_GB) + (tn - 18) * 128 + c;
        EPI_ROWS({ float* q_ = dg + row * 512; *(float4*)q_ = make_float4(v[0], v[1], v[2], v[3]); *(float4*)(q_ + 4) = make_float4(v[4], v[5], v[6], v[7]); })
      } else if (tn < 46) {
        u16* d = (u16*)(p.ws + (tn < 38 ? W_SA : W_SB)) + (tn < 38 ? tn - 30 : tn - 38) * 128 + c;
        EPI_ROWS({ _Pragma("unroll") for (int j = 0; j < 8; ++j) v[j] = sigmoidf_(v[j]); *(uint4*)(d + row * 1024) = pack8f(v); })
      } else if (tn == 46 && c < 24) {
        float* d = (float*)(p.ws + W_GATE) + c;
        EPI_ROWS({ float* q_ = d + row * 24; *(float4*)q_ = make_float4(sigmoidf_(v[0]), sigmoidf_(v[1]), sigmoidf_(v[2]), sigmoidf_(v[3]));
                   *(float4*)(q_ + 4) = make_float4(sigmoidf_(v[4]), sigmoidf_(v[5]), sigmoidf_(v[6]), sigmoidf_(v[7])); })
      }
    }
  }
#undef EPI_ROWS
};

struct EpiOut {
  static constexpr bool PERM = false, AFTER_DRAIN = false;
  const float* x; float* out;
  DI void operator()(const pg8::f32x4 (&acc)[2][2][4][2], const pg8::Unit& u, int wr, int wc, int fr, int fq) const {
#pragma unroll
    for (int ai = 0; ai < 2; ++ai)
#pragma unroll
      for (int mh = 0; mh < 2; ++mh) {
        float4 xv[2][2][2];
#pragma unroll
        for (int m2 = 0; m2 < 2; ++m2)
#pragma unroll
          for (int bj = 0; bj < 2; ++bj)
#pragma unroll
            for (int n = 0; n < 2; ++n) {
              const size_t off = (size_t)(u.pm * 256 + ai * 128 + wr * 64 + (2 * mh + m2) * 16 + fr) * 1024 + u.pn * 256 + wc * 32 + 4 * fq + bj * 128 + n * 16;
              xv[m2][bj][n] = *(const float4*)(x + off);
            }
#pragma unroll
        for (int m2 = 0; m2 < 2; ++m2)
#pragma unroll
          for (int bj = 0; bj < 2; ++bj)
#pragma unroll
            for (int n = 0; n < 2; ++n) {
              const int m = 2 * mh + m2;
              const size_t off = (size_t)(u.pm * 256 + ai * 128 + wr * 64 + m * 16 + fr) * 1024 + u.pn * 256 + wc * 32 + 4 * fq + bj * 128 + n * 16;
              const float4 xq = xv[m2][bj][n];
              *(float4*)(out + off) = make_float4(acc[ai][bj][m][n][0] + xq.x, acc[ai][bj][m][n][1] + xq.y, acc[ai][bj][m][n][2] + xq.z, acc[ai][bj][m][n][3] + xq.w);
            }
      }
  }
};

template <bool SECOND>
struct EpiMerge {
  static constexpr bool PERM = true, AFTER_DRAIN = false;
  const u16* gate; u16* Y;
  DI void operator()(const pg8::f32x4 (&acc)[2][2][4][2], const pg8::Unit& u, int wr, int wc, int fr, int fq) const {
#pragma unroll
    for (int ai = 0; ai < 2; ++ai) {
      uint4 gv[4][2], yv[4][2];
#pragma unroll
      for (int m = 0; m < 4; ++m)
#pragma unroll
        for (int bj = 0; bj < 2; ++bj) {
          const size_t off = (size_t)(u.pm * 256 + ai * 128 + wr * 64 + m * 16 + fr) * 1024 + u.pn * 256 + wc * 32 + 8 * fq + bj * 128;
          gv[m][bj] = *(const uint4*)(gate + off);
          if (SECOND) yv[m][bj] = *(const uint4*)(Y + off);
        }
#pragma unroll
      for (int m = 0; m < 4; ++m)
#pragma unroll
        for (int bj = 0; bj < 2; ++bj) {
          const size_t off = (size_t)(u.pm * 256 + ai * 128 + wr * 64 + m * 16 + fr) * 1024 + u.pn * 256 + wc * 32 + 8 * fq + bj * 128;
          const uint4 g4 = gv[m][bj];
          float v[8];
          v[0] = bflo(g4.x) * acc[ai][bj][m][0][0]; v[1] = bfhi(g4.x) * acc[ai][bj][m][0][1]; v[2] = bflo(g4.y) * acc[ai][bj][m][0][2]; v[3] = bfhi(g4.y) * acc[ai][bj][m][0][3];
          v[4] = bflo(g4.z) * acc[ai][bj][m][1][0]; v[5] = bfhi(g4.z) * acc[ai][bj][m][1][1]; v[6] = bflo(g4.w) * acc[ai][bj][m][1][2]; v[7] = bfhi(g4.w) * acc[ai][bj][m][1][3];
          if (SECOND) {
            const uint4 y4 = yv[m][bj];
            v[0] += bflo(y4.x); v[1] += bfhi(y4.x); v[2] += bflo(y4.y); v[3] += bfhi(y4.y); v[4] += bflo(y4.z); v[5] += bfhi(y4.z); v[6] += bflo(y4.w); v[7] += bfhi(y4.w);
          }
          *(uint4*)(Y + off) = pack8f(v);
        }
    }
  }
};

#define XB_TMO      128
#define XB_XCNT(j)  (256  + 64 * (j))
#define XB_XSUB(j)  (1280 + 64 * (j))
#define XB_XGEN(j)  (2304 + 64 * (j))
#define XB_TOP      3328
#define XB_TOPGEN   3392
#define XCD_BAR_WORDS 3456
#define XB_SPIN_CAP (1u << 18)
#define LAS __attribute__((address_space(3)))
DI unsigned xb_ld(unsigned* p)              { return __hip_atomic_load(p, __ATOMIC_RELAXED, __HIP_MEMORY_SCOPE_AGENT); }
DI unsigned xb_add(unsigned* p, unsigned v) { return __hip_atomic_fetch_add(p, v, __ATOMIC_RELAXED, __HIP_MEMORY_SCOPE_AGENT); }
DI unsigned xb_xcc_id() { return (unsigned)__builtin_amdgcn_s_getreg((3 << 11) | 20) & 0xFu; }
#define XB_SPIN(cond, bar) do { unsigned _sp = 0; while (cond) { __builtin_amdgcn_s_sleep(1); \
    if ((++_sp & 255u) == 0u) { if (xb_ld(&(bar)[XB_TMO])) break; if (_sp > XB_SPIN_CAP) { atomicAdd(&(bar)[XB_TMO], 1u); break; } } } } while (0)
struct XcdBarrier { unsigned* bar; unsigned x; volatile LAS unsigned* st; };
DI XcdBarrier xcd_barrier_post(unsigned* bar, volatile LAS unsigned* st) {
  XcdBarrier b; b.bar = bar; b.x = xb_xcc_id(); b.st = st;
  if (threadIdx.x == 0) (void)xb_add(&bar[XB_XCNT(b.x)], 1u);
  return b;
}
DI void xcd_barrier_complete(unsigned* bar, unsigned x, unsigned& nloc, unsigned& nx) {
  const unsigned G = gridDim.x * gridDim.y * gridDim.z;
  unsigned sum, cnt, mine, sp = 0u;
  for (;;) {
    sum = 0u; cnt = 0u; mine = 0u;
#pragma unroll
    for (unsigned j = 0; j < 16; ++j) { const unsigned c = xb_ld(&bar[XB_XCNT(j)]); sum += c; cnt += (c > 0u) ? 1u : 0u; mine = (j == x) ? c : mine; }
    if (sum == G) break;
    __builtin_amdgcn_s_sleep(1);
    if ((++sp & 255u) == 0u) { if (xb_ld(&bar[XB_TMO])) break; if (sp > XB_SPIN_CAP) { atomicAdd(&bar[XB_TMO], 1u); break; } }
  }
  nloc = mine > 0u ? mine : 1u; nx = cnt > 0u ? cnt : 1u;
}
DI void xcd_barrier(XcdBarrier& b) {
  asm volatile("s_waitcnt vmcnt(0)" ::: "memory");
  __syncthreads();
  if (threadIdx.x == 0) {
    unsigned* bar = b.bar;
    __builtin_amdgcn_s_waitcnt(0);
    unsigned nloc = b.st[0], nx = b.st[1];
    if (nloc == 0u) { xcd_barrier_complete(bar, b.x, nloc, nx); b.st[0] = nloc; b.st[1] = nx; }
    const unsigned old = xb_add(&bar[XB_XSUB(b.x)], 1u);
    const unsigned gen = old / nloc;
    if (old + 1u == (gen + 1u) * nloc) {
      __builtin_amdgcn_fence(__ATOMIC_RELEASE, "agent");
      asm volatile("s_waitcnt vmcnt(0)" ::: "memory");
      const unsigned og = xb_add(&bar[XB_TOP], 1u);
      const unsigned tg = og / nx;
      if (og + 1u == (tg + 1u) * nx) xb_add(&bar[XB_TOPGEN], 1u);
      else XB_SPIN(xb_ld(&bar[XB_TOPGEN]) == tg, bar);
      __builtin_amdgcn_fence(__ATOMIC_ACQUIRE, "agent");
      xb_add(&bar[XB_XGEN(b.x)], 1u);
      asm volatile("s_waitcnt vmcnt(0)" ::: "memory");
    } else {
      XB_SPIN(xb_ld(&bar[XB_XGEN(b.x)]) == gen, bar);
      __builtin_amdgcn_fence(__ATOMIC_ACQUIRE, "agent");
      asm volatile("s_waitcnt vmcnt(0)" ::: "memory");
    }
  }
  __syncthreads();
}


template <int PH>
DI void run_phase(const Params& p, char* lds_all) {
  const int half = __builtin_amdgcn_readfirstlane(threadIdx.x >> 8);
  const int vb = blockIdx.x * 2 + half, nvb = gridDim.x * 2;
  char* lds = lds_all + half * 65536;
  if (PH == 0) { for (int it = vb; it < P0_TOTAL; it += nvb) phase0_item(p, it, lds); }
  if (PH == 1) {
    for (int it = vb; it < P1_CMP; it += nvb) phase1_item(p, it, lds);
    __syncthreads();
    pg8::StaticOrder S; S.init(NT, NPAD, gridDim.x, blockIdx.x);
    const pg8::Gemm gm{(const pg8::bf16_t*)(p.ws + W_XN), (const pg8::bf16_t*)(p.ws + W_WINT), NT, NPAD, 1024};
    const EpiProj E{p};
    pg8::gemm_phase<EpiProj, pg8::StaticOrder, false>((PG8_LAS unsigned char*)lds_all, gm, S, E, nullptr);
  }
  if (PH == 2) {
    volatile LAS unsigned* wq = (volatile LAS unsigned*)(lds_all + 128 * 1024 + 8);
    unsigned* ctr = (unsigned*)(p.ws + W_BAR);
    for (;;) {
      __syncthreads();
      if (threadIdx.x == 0) wq[0] = __hip_atomic_fetch_add(ctr, 1u, __ATOMIC_RELAXED, __HIP_MEMORY_SCOPE_AGENT);
      __syncthreads();
      const unsigned pr = wq[0];
      if (pr >= (unsigned)(P2_TOTAL / 2)) break;
      phase2_item(p, (int)pr * 2 + half, lds);
    }
  }
  if (PH == 7) { for (int it = vb; it < H2_ITEMS; it += nvb) hgrn_h2_item(p, it); }
  if (PH == 3) {
    for (int it = vb; it < P3_FIN; it += nvb) hgrn_h3_item(p, it);
    for (int it = blockIdx.x; it < P3_ATT; it += gridDim.x) prompt_attn_item(p, it, lds_all);
  }
  if (PH == 4) {
    for (int it = vb; it < 64; it += nvb) merge_a_tile_t<1>(p, 128 + (it >> 4), it & 15, lds);
    __syncthreads();
    pg8::StaticOrder S; S.init(NTP, 1024, gridDim.x, blockIdx.x);
    { const pg8::Gemm gm{(const pg8::bf16_t*)(p.ws + W_OA), (const pg8::bf16_t*)(p.ws + W_WBAT), NTP, 1024, 512};
      const EpiMerge<false> E{(const u16*)(p.ws + W_SA), (u16*)(p.ws + W_Y)};
      pg8::gemm_phase<EpiMerge<false>, pg8::StaticOrder, false>((PG8_LAS unsigned char*)lds_all, gm, S, E, nullptr); }
    { const pg8::Gemm gm{(const pg8::bf16_t*)(p.ws + W_OB), (const pg8::bf16_t*)(p.ws + W_WBBT), NTP, 1024, 512};
      const EpiMerge<true> E{(const u16*)(p.ws + W_SB), (u16*)(p.ws + W_Y)};
      pg8::gemm_phase<EpiMerge<true>, pg8::StaticOrder, false>((PG8_LAS unsigned char*)lds_all, gm, S, E, nullptr); }
  }
  if (PH == 5) {
    for (int it = vb; it < 64; it += nvb) merge_b_tile_t<1>(p, 128 + (it >> 4), it & 15, lds);
    __syncthreads();
    pg8::StaticOrder S; S.init(NTP, 1024, gridDim.x, blockIdx.x);
    const pg8::Gemm gm{(const pg8::bf16_t*)(p.ws + W_Y), (const pg8::bf16_t*)(p.ws + W_WOUTT), NTP, 1024, 1024};
    const EpiOut E{p.x_prompt, p.out};
    pg8::gemm_phase<EpiOut, pg8::StaticOrder, false>((PG8_LAS unsigned char*)lds_all, gm, S, E, nullptr);
  }
  if (PH == 6) { for (int it = vb; it < P6_TOTAL; it += nvb) final_norm_item(p, it); }
}

constexpr int LDS_DYN = 128 * 1024 + 16;
__global__ void __launch_bounds__(512, 2) k_mega(Params p) {
  extern __shared__ __attribute__((aligned(16))) char lds[];
  volatile LAS unsigned* st = (volatile LAS unsigned*)(lds + 128 * 1024);
  if (threadIdx.x == 0) { st[0] = 0u; st[1] = 0u; }
  __syncthreads();
  XcdBarrier bar = xcd_barrier_post((unsigned*)(p.ws + W_BAR), st);
  run_phase<0>(p, lds); xcd_barrier(bar);
  run_phase<1>(p, lds); xcd_barrier(bar);
  run_phase<2>(p, lds); xcd_barrier(bar);
  run_phase<7>(p, lds); xcd_barrier(bar);
  run_phase<3>(p, lds); xcd_barrier(bar);
  run_phase<4>(p, lds); xcd_barrier(bar);
  run_phase<5>(p, lds); xcd_barrier(bar);
  run_phase<6>(p, lds);
}

extern "C" void kernel_launch(void* const* d_in, const int* in_sizes, int n_in, void* d_out, int out_size,
                              void* d_ws, size_t ws_size, hipStream_t stream) {
  Params p{};
  p.x_prompt = (const float*)d_in[0]; p.x_sample = (const float*)d_in[1];
  p.cck = (const float*)d_in[2]; p.ccv = (const float*)d_in[3]; p.csk = (const float*)d_in[4]; p.csv = (const float*)d_in[5];
  p.swk = (const float*)d_in[6]; p.swv = (const float*)d_in[7]; p.shg = (const float*)d_in[8]; p.pt = (const int*)d_in[9];
  p.norm_g = (const float*)d_in[10]; p.w_in = (const float*)d_in[11];
  p.pos_k = (const float*)d_in[12]; p.w1_k = (const float*)d_in[13]; p.w2_k = (const float*)d_in[14];
  p.pos_v = (const float*)d_in[15]; p.w1_v = (const float*)d_in[16]; p.w2_v = (const float*)d_in[17];
  p.rel_bias = (const float*)d_in[18]; p.hg_lower = (const float*)d_in[19]; p.hg_norm_g = (const float*)d_in[20];
  p.w_ba = (const float*)d_in[21]; p.w_bb = (const float*)d_in[22]; p.w_out = (const float*)d_in[23]; p.final_g = (const float*)d_in[24];
  p.out = (float*)d_out; p.ws = (char*)d_ws;
  if ((size_t)out_size != O_END || ws_size < W_END) { fprintf(stderr, "kernel_launch: unexpected sizes out=%d ws=%zu (need %zu / %zu)\n", out_size, ws_size, (size_t)O_END, (size_t)W_END); return; }
  static int grid_blocks = 0;
  if (!grid_blocks) {
    int dev = 0, cus = 0, per_cu = 0;
    hipGetDevice(&dev);
    hipDeviceGetAttribute(&cus, hipDeviceAttributeMultiprocessorCount, dev);
    hipFuncSetAttribute((const void*)k_mega, hipFuncAttributeMaxDynamicSharedMemorySize, LDS_DYN);
    hipOccupancyMaxActiveBlocksPerMultiprocessor(&per_cu, k_mega, 512, LDS_DYN);
    if (per_cu < 1) fprintf(stderr, "kernel_launch: occupancy query reports %d blocks per CU\n", per_cu);
    grid_blocks = cus;
  }
  hipMemsetAsync((char*)d_ws + W_BAR, 0, XCD_BAR_WORDS * 4, stream);
  void* args[] = {&p};
  hipError_t e = hipLaunchCooperativeKernel((void*)k_mega, dim3(grid_blocks), dim3(512), args, LDS_DYN, stream);
  if (e != hipSuccess) fprintf(stderr, "cooperative launch failed: %s (grid %d)\n", hipGetErrorString(e), grid_blocks);
}
```
